# Optimizing an MI355X kernel written in HIP

```python
import jax, jax.numpy as jnp
from jax import lax
import numpy as np

D_MODEL = 1024
BATCH = 8
SEQ = 2048
DEPTH = 1
DEC_BATCH = 128
DEC_SEQ = 1
PAST_LEN = 16384
PAGE_SIZE = 128

N_BRANCH = 3
BRANCH_W = D_MODEL
POOL_WINDOWS = (2, 4, 8, 16)
POOL_GROUPS = len(POOL_WINDOWS)
POOL_GW = BRANCH_W // POOL_GROUPS
POOL_HIST = max(POOL_WINDOWS) - 1
SGU_CHUNK = 128
SGU_GROUPS = 4
SGU_GW = BRANCH_W // SGU_GROUPS
N_MEM = 256
XA_HEADS = 4
XA_HD = BRANCH_W // XA_HEADS
EPS = 1e-6
IN_COLS = 7 * BRANCH_W + N_BRANCH * D_MODEL

kernel_name = "hybrid_pool_sgu_memxattn_step"


def _rmsnorm(x, g):
    xf = x.astype(jnp.float32)
    y = xf * lax.rsqrt(jnp.mean(xf * xf, axis=-1, keepdims=True) + EPS)
    return (y * g.astype(jnp.float32)).astype(x.dtype)


def _pool_mix(p, hist, pos0, pool_w, pool_scale):
    B, S, _ = p.shape
    ext = jnp.concatenate([hist, p], axis=1).astype(jnp.float32)
    cs = jnp.pad(jnp.cumsum(ext, axis=1), ((0, 0), (1, 0), (0, 0)))
    pos = pos0 + jnp.arange(S)
    outs = []
    for g, w in enumerate(POOL_WINDOWS):
        sl = slice(g * POOL_GW, (g + 1) * POOL_GW)
        win = cs[:, POOL_HIST + 1:POOL_HIST + 1 + S, sl] - cs[:, POOL_HIST + 1 - w:POOL_HIST + 1 - w + S, sl]
        cnt = jnp.minimum(w, pos + 1).astype(jnp.float32)[None, :, None]
        outs.append(win / cnt - ext[:, POOL_HIST:, sl])
    d = jnp.stack(outs, axis=2)
    y = jnp.einsum('bsgc,gcd->bsgd', d, pool_w.astype(jnp.float32)).reshape(B, S, BRANCH_W)
    return (y * pool_scale.astype(jnp.float32)).astype(p.dtype)


def _spatial_gate(v, w_s, b_s):
    B, S, _ = v.shape
    n_chunk = -(-S // SGU_CHUNK)
    pad = n_chunk * SGU_CHUNK - S
    vp = jnp.pad(v, ((0, 0), (0, pad), (0, 0))).reshape(B, n_chunk, SGU_CHUNK, SGU_GROUPS, SGU_GW)
    mask = jnp.tril(jnp.ones((SGU_CHUNK, SGU_CHUNK), dtype=bool))
    w = jnp.where(mask[None], w_s, jnp.zeros_like(w_s))
    out = jnp.einsum('gts,bcsgd->bctgd', w, vp) + b_s.T[None, None, :, :, None]
    return out.reshape(B, n_chunk * SGU_CHUNK, BRANCH_W)[:, :S]


def _mem_kv(mem, mem_norm_g, w_kv):
    B = mem.shape[0]
    kv = _rmsnorm(mem, mem_norm_g) @ w_kv
    k, v = jnp.split(kv, 2, axis=-1)
    return (k.reshape(B, N_MEM, XA_HEADS, XA_HD), v.reshape(B, N_MEM, XA_HEADS, XA_HD))


def _cross_attn(q, k, v):
    B, S, _ = q.shape
    q = q.reshape(B, S, XA_HEADS, XA_HD)
    s = jnp.einsum('bqhd,bkhd->bhqk', q, k).astype(jnp.float32) * (XA_HD ** -0.5)
    pr = jax.nn.softmax(s, axis=-1).astype(v.dtype)
    return jnp.einsum('bhqk,bkhd->bqhd', pr, v).reshape(B, S, BRANCH_W)


def _layer(x, hist, pos0, mem_k, mem_v, norm_in_g, w_in, pool_w, pool_scale,
           sgu_norm_g, sgu_w, sgu_b, w_down, w_out):
    B, S, _ = x.shape
    h = _rmsnorm(x, norm_in_g)
    proj = h @ w_in
    cuts = [BRANCH_W * i for i in range(1, 8)]
    p_in, p_z, u, v, s_z, q, a_z, gates = jnp.split(proj, cuts, axis=-1)
    o_pool = _pool_mix(p_in, hist, pos0, pool_w, pool_scale) * jax.nn.silu(p_z)
    vn = _rmsnorm(v, sgu_norm_g)
    o_sgu = u * _spatial_gate(vn, sgu_w, sgu_b) * jax.nn.silu(s_z)
    o_xa = _cross_attn(q, mem_k, mem_v) * jax.nn.silu(a_z)
    br = jnp.stack([o_pool, o_sgu, o_xa], axis=2)
    yb = jnp.einsum('bsnc,ncd->bsnd', br, w_down)
    g = jax.nn.sigmoid(gates.reshape(B, S, N_BRANCH, D_MODEL))
    merged = jnp.sum(g * yb, axis=2)
    x = x + merged @ w_out
    new_hist = jnp.concatenate([hist, p_in], axis=1)[:, -POOL_HIST:]
    return x, new_hist, vn


def setup_inputs(seed: int = 0) -> dict:
    key = jax.random.key(seed)
    ks = jax.random.split(key, 24)
    f32 = jnp.float32
    nrm = lambda k, shp, s: jax.random.normal(k, shp, f32) * s
    return {
        "x_prompt": nrm(ks[0], (BATCH, SEQ, D_MODEL), 1.0),
        "x_sample": nrm(ks[1], (DEC_BATCH, DEC_SEQ, D_MODEL), 1.0),
        "state_pool": nrm(ks[2], (DEPTH, DEC_BATCH, POOL_HIST, BRANCH_W), 1.0),
        "cache_mem_k": nrm(ks[3], (DEPTH, DEC_BATCH, N_MEM, XA_HEADS, XA_HD), 1.0),
        "cache_mem_v": nrm(ks[4], (DEPTH, DEC_BATCH, N_MEM, XA_HEADS, XA_HD), 1.0),
        "mem_prompt": nrm(ks[5], (BATCH, N_MEM, D_MODEL), 1.0),
        "norm_in_g": 1.0 + nrm(ks[6], (DEPTH, D_MODEL), 0.02),
        "w_in": nrm(ks[7], (DEPTH, D_MODEL, IN_COLS), D_MODEL ** -0.5),
        "pool_w": nrm(ks[8], (DEPTH, POOL_GROUPS, POOL_GW, POOL_GW), POOL_GW ** -0.5),
        "pool_scale": 1.0 + nrm(ks[9], (DEPTH, BRANCH_W), 0.1),
        "sgu_norm_g": 1.0 + nrm(ks[10], (DEPTH, BRANCH_W), 0.02),
        "sgu_w": nrm(ks[11], (DEPTH, SGU_GROUPS, SGU_CHUNK, SGU_CHUNK), SGU_CHUNK ** -0.5),
        "sgu_b": 1.0 + nrm(ks[12], (DEPTH, SGU_GROUPS, SGU_CHUNK), 0.01),
        "mem_norm_g": 1.0 + nrm(ks[13], (DEPTH, D_MODEL), 0.02),
        "w_kv": nrm(ks[14], (DEPTH, D_MODEL, 2 * BRANCH_W), D_MODEL ** -0.5),
        "w_down": nrm(ks[15], (DEPTH, N_BRANCH, BRANCH_W, D_MODEL), BRANCH_W ** -0.5),
        "w_out": nrm(ks[16], (DEPTH, D_MODEL, D_MODEL), D_MODEL ** -0.5),
        "norm_f_g": 1.0 + nrm(ks[17], (D_MODEL,), 0.02),
    }


def reference(x_prompt, x_sample, state_pool, cache_mem_k, cache_mem_v, mem_prompt,
              norm_in_g, w_in, pool_w, pool_scale, sgu_norm_g, sgu_w, sgu_b,
              mem_norm_g, w_kv, w_down, w_out, norm_f_g):
    xp, xs = x_prompt, x_sample
    hist_p0 = jnp.zeros((x_prompt.shape[0], POOL_HIST, BRANCH_W), x_prompt.dtype)
    pool_p, pool_s, mk_p, mv_p, sgu_v_s = [], [], [], [], []
    for l in range(DEPTH):
        lw = (norm_in_g[l], w_in[l], pool_w[l], pool_scale[l], sgu_norm_g[l], sgu_w[l],
              sgu_b[l], w_down[l], w_out[l])
        k_p, v_p = _mem_kv(mem_prompt, mem_norm_g[l], w_kv[l])
        xp, hp, _ = _layer(xp, hist_p0, 0, k_p, v_p, *lw)
        xs, hs, vs = _layer(xs, state_pool[l], PAST_LEN, cache_mem_k[l], cache_mem_v[l], *lw)
        pool_p.append(hp)
        pool_s.append(hs)
        mk_p.append(k_p)
        mv_p.append(v_p)
        sgu_v_s.append(vs)
    y_prompt = _rmsnorm(xp, norm_f_g)
    y_sample = _rmsnorm(xs, norm_f_g)
    return (y_prompt, y_sample, jnp.stack(pool_p), jnp.stack(pool_s), jnp.stack(mk_p),
            jnp.stack(mv_p), jnp.stack(sgu_v_s))
```

```cpp
#include <hip/hip_runtime.h>
#include <hip/hip_cooperative_groups.h>
#include <cstdio>
#include <cstdint>
namespace cg = cooperative_groups;

#define LAS __attribute__((address_space(3)))
typedef unsigned short bf16;
typedef short bf16x8 __attribute__((ext_vector_type(8)));
typedef short s16x4 __attribute__((ext_vector_type(4)));
typedef float f32x4 __attribute__((ext_vector_type(4)));
typedef unsigned u32x4 __attribute__((ext_vector_type(4)));
typedef unsigned u32x2 __attribute__((ext_vector_type(2)));

constexpr int DM = 1024, NBATCH = 8, SEQ = 2048, NS = 128, NMEM = 256;
constexpr int MPR = NBATCH * SEQ;
constexpr int MV = MPR + NS;
constexpr int MP = MPR + 256;
constexpr int NPAN = MP / 256;
constexpr int INC = 10240;
constexpr float EPS = 1e-6f;
constexpr size_t O_YP = 0, O_YS = O_YP + (size_t)MPR * DM, O_POOLP = O_YS + (size_t)NS * DM, O_POOLS = O_POOLP + (size_t)NBATCH * 15 * DM,
                 O_MK = O_POOLS + (size_t)NS * 15 * DM, O_MV = O_MK + (size_t)NBATCH * NMEM * DM, O_SV = O_MV + (size_t)NBATCH * NMEM * DM, O_END = O_SV + (size_t)NS * DM;
constexpr size_t ROWB = (size_t)MP * DM * 2;
constexpr size_t WS_CTL = 0, CTL_BYTES = 40960;
constexpr size_t WS_VSS2 = CTL_BYTES;
constexpr size_t WS_DS = WS_VSS2 + 32768;
constexpr size_t WS_HS = WS_DS + 262144;
constexpr size_t WS_H = WS_HS + 524288;
constexpr size_t WS_WIN = WS_H + (size_t)(MP + 2048) * DM * 2;
constexpr size_t WS_WD = WS_WIN + (size_t)(INC + 2048) * DM * 2;
constexpr size_t WS_WO3 = WS_WD + (size_t)3 * DM * DM * 2;
constexpr size_t WS_PW = WS_WO3 + (size_t)3 * DM * DM * 2;
constexpr size_t WS_SW = WS_PW + (size_t)4 * 256 * 256 * 2;
constexpr size_t WS_VSS = WS_SW + (size_t)4 * 128 * 128 * 2;
constexpr size_t WS_KB = WS_VSS + (size_t)MP * 16 * 4;
constexpr size_t WS_VB = WS_KB + (size_t)2048 * DM * 2;
constexpr size_t WS_PROJ = WS_VB + (size_t)2048 * DM * 2;
constexpr size_t WS_GATE = WS_PROJ + 7 * ROWB;
constexpr size_t WS_BR = WS_GATE + 3 * ROWB;
constexpr size_t WS_MG = WS_PROJ;
constexpr size_t WS_GYS = WS_H;
constexpr size_t WS_END = WS_BR + 3 * ROWB;
constexpr int LDS_BYTES = 147456;
constexpr int CW_PANEL = 4096, CW_SAMPLE = 4096 + 64 * 64;

__device__ __forceinline__ unsigned f2bf(float f) { unsigned u = __builtin_bit_cast(unsigned, f); return (u + 0x7fffu + ((u >> 16) & 1u)) >> 16; }
__device__ __forceinline__ unsigned pk2(float lo, float hi) { unsigned r; asm volatile("v_cvt_pk_bf16_f32 %0, %1, %2" : "=v"(r) : "v"(lo), "v"(hi)); return r; }
__device__ __forceinline__ float bflo(unsigned w) { return __builtin_bit_cast(float, w << 16); }
__device__ __forceinline__ float bfhi(unsigned w) { return __builtin_bit_cast(float, w & 0xffff0000u); }
__device__ __forceinline__ float silu_f(float x) { return x * __builtin_amdgcn_rcpf(1.f + __expf(-x)); }
__device__ __forceinline__ float sigm_f(float x) { return __builtin_amdgcn_rcpf(1.f + __expf(-x)); }
__device__ __forceinline__ float wave_sum(float v) {
#pragma unroll
    for (int o = 1; o < 64; o <<= 1) v += __shfl_xor(v, o);
    return v;
}
__device__ __forceinline__ float wave_max(float v) {
#pragma unroll
    for (int o = 1; o < 64; o <<= 1) v = fmaxf(v, __shfl_xor(v, o));
    return v;
}
__device__ __forceinline__ bf16x8 tr_read2(const LAS unsigned char* a0, const LAS unsigned char* a1) {
    const s16x4 lo = __builtin_amdgcn_ds_read_tr16_b64_v4i16((LAS s16x4*)a0);
    const s16x4 hi = __builtin_amdgcn_ds_read_tr16_b64_v4i16((LAS s16x4*)a1);
    return (bf16x8){lo[0], lo[1], lo[2], lo[3], hi[0], hi[1], hi[2], hi[3]};
}

#define XB_TMO      128
#define XB_XCNT(j)  (256  + 64 * (j))
#define XB_XSUB(j)  (1280 + 64 * (j))
#define XB_XGEN(j)  (2304 + 64 * (j))
#define XB_TOP      3328
#define XB_TOPGEN   3392
#define XCD_BAR_WORDS 3456
#define XB_SPIN_CAP (1u << 18)

__device__ __forceinline__ unsigned xb_ld(unsigned* p)              { return __hip_atomic_load(p, __ATOMIC_RELAXED, __HIP_MEMORY_SCOPE_AGENT); }
__device__ __forceinline__ unsigned xb_add(unsigned* p, unsigned v) { return __hip_atomic_fetch_add(p, v, __ATOMIC_RELAXED, __HIP_MEMORY_SCOPE_AGENT); }
__device__ __forceinline__ unsigned xb_xcc_id() { return (unsigned)__builtin_amdgcn_s_getreg((3 << 11) | 20) & 0xFu; }
#define XB_SPIN(cond, bar) do { unsigned _sp = 0; while (cond) { __builtin_amdgcn_s_sleep(1); \
    if ((++_sp & 255u) == 0u) { if (xb_ld(&(bar)[XB_TMO])) break; if (_sp > XB_SPIN_CAP) { atomicAdd(&(bar)[XB_TMO], 1u); break; } } } } while (0)

struct XcdBarrier {
    unsigned* bar; unsigned x;
    volatile LAS unsigned* st;
};

__device__ __forceinline__ XcdBarrier xcd_barrier_post(unsigned* bar, volatile LAS unsigned* st) {
    XcdBarrier b; b.bar = bar; b.x = xb_xcc_id(); b.st = st;
    if (threadIdx.x == 0) (void)xb_add(&bar[XB_XCNT(b.x)], 1u);
    return b;
}
__device__ __forceinline__ void xcd_barrier_complete(unsigned* bar, unsigned x, unsigned& nloc, unsigned& nx) {
    const unsigned G = gridDim.x;
    unsigned sum, cnt, mine, sp = 0u;
    for (;;) {
        sum = 0u; cnt = 0u; mine = 0u;
#pragma unroll
        for (unsigned j = 0; j < 16; ++j) { const unsigned c = xb_ld(&bar[XB_XCNT(j)]); sum += c; cnt += (c > 0u) ? 1u : 0u; mine = (j == x) ? c : mine; }
        if (sum == G) break;
        __builtin_amdgcn_s_sleep(1);
        if ((++sp & 255u) == 0u) { if (xb_ld(&bar[XB_TMO])) break; if (sp > XB_SPIN_CAP) { atomicAdd(&bar[XB_TMO], 1u); break; } }
    }
    nloc = mine > 0u ? mine : 1u; nx = cnt > 0u ? cnt : 1u;
}

__device__ __forceinline__ void xcd_barrier(const XcdBarrier& b) {
    asm volatile("s_waitcnt vmcnt(0)" ::: "memory");
    __syncthreads();
    if (threadIdx.x == 0) {
        unsigned* bar = b.bar;
        __builtin_amdgcn_s_waitcnt(0);
        unsigned nloc = b.st[0], nx = b.st[1];
        if (nloc == 0u) { xcd_barrier_complete(bar, b.x, nloc, nx); b.st[0] = nloc; b.st[1] = nx; }
        const unsigned old = xb_add(&bar[XB_XSUB(b.x)], 1u);
        const unsigned gen = old / nloc;
        if (old + 1u == (gen + 1u) * nloc) {
            __builtin_amdgcn_fence(__ATOMIC_RELEASE, "agent");
            asm volatile("s_waitcnt vmcnt(0)" ::: "memory");
            const unsigned og = xb_add(&bar[XB_TOP], 1u);
            const unsigned tg = og / nx;
            if (og + 1u == (tg + 1u) * nx) xb_add(&bar[XB_TOPGEN], 1u);
            else XB_SPIN(xb_ld(&bar[XB_TOPGEN]) == tg, bar);
            __builtin_amdgcn_fence(__ATOMIC_ACQUIRE, "agent");
            xb_add(&bar[XB_XGEN(b.x)], 1u);
            asm volatile("s_waitcnt vmcnt(0)" ::: "memory");
        } else {
            XB_SPIN(xb_ld(&bar[XB_XGEN(b.x)]) == gen, bar);
            __builtin_amdgcn_fence(__ATOMIC_ACQUIRE, "agent");
            asm volatile("s_waitcnt vmcnt(0)" ::: "memory");
        }
    }
    __syncthreads();
}

namespace pg8 {
#define PG8_LAS __attribute__((address_space(3)))
typedef unsigned short bf16_t;
constexpr int BM = 256, BK = 64, HALF = 128, HTB = HALF * BK * 2, STAGE_BYTES = 8 * HTB, NXCD = 8, WGM = 8;
__host__ __device__ __forceinline__ int lds_byte(int r, int c) { const int st = (r >> 4) * 2 + (c >> 5), rr = r & 15, cc = c & 31, ob = rr * 64 + cc * 2; return st * 1024 + (ob ^ (((ob >> 9) & 1) << 5)); }
__host__ __device__ __forceinline__ void stage_rc(int b, int& R, int& C) { const int st = b / 1024, sb = b % 1024, swz = sb ^ (((sb >> 9) & 1) << 5); R = (st >> 1) * 16 + swz / 64; C = (st & 1) * 32 + (swz % 64) / 2; }
__host__ __device__ __forceinline__ int perm32(int rho) { const int n = rho >> 4, i = rho & 15; return 8 * (i >> 2) + 4 * n + (i & 3); }
struct Unit { int pm, pn; };
struct Gemm { const bf16_t* A; const bf16_t* Bt; int M, N, K; };
struct StaticOrder {
    int nM, nN, nwg, G, c;
    __host__ __device__ void init(int M, int N, int G_, int c_) { nM = M / BM; nN = N / BM; nwg = nM * nN; G = G_; c = c_; }
    __host__ __device__ bool next(int i, Unit& u) const {
        const long L = (long)i * G + c; if (L >= nwg) return false;
        int wgid = (int)L; { const int q = nwg / NXCD, r = nwg % NXCD, xcd = wgid % NXCD, off = wgid / NXCD; wgid = (xcd < r ? xcd * (q + 1) : r * (q + 1) + (xcd - r) * q) + off; }
        const int nig = WGM * nN, gid = wgid / nig, fm = gid * WGM, gsz = (nM - fm) < WGM ? (nM - fm) : WGM;
        u.pm = fm + ((wgid % nig) % gsz); u.pn = (wgid % nig) / gsz; return true;
    }
    __device__ __forceinline__ void a_ready(const Unit&) const {}
    __device__ __forceinline__ void done(const Unit&) const {}
};

template <class Epi, class Sched>
__device__ __forceinline__ void gemm_phase(PG8_LAS unsigned char* lds, const Gemm g, const Sched& S, const Epi& E) {
    const int tid = threadIdx.x, wid = __builtin_amdgcn_readfirstlane(tid >> 6), lane = tid & 63, wr = wid >> 2, wc = wid & 3, fr = lane & 15, fq = lane >> 4;
    const int K = g.K, nt = K / BK;
    unsigned voffA[2], voffB[2];
#pragma unroll
    for (int i = 0; i < 2; ++i) { int R, C; stage_rc(tid * 16 + i * 8192, R, C); const int Rb = Epi::PERM ? ((R & ~31) + perm32(R & 31)) : R;
        voffA[i] = (unsigned)(R * K + C) * 2u; voffB[i] = (unsigned)(Rb * K + C) * 2u; }
    const size_t kstep = (size_t)(BK * 2);
    const size_t hstep = (size_t)HALF * K * 2;
    const size_t tstep = 2 * hstep;
    const unsigned ldsw = (unsigned)wid * 1024u;
    const int aoff = lds_byte(wr * 64 + fr, fq * 8), boff = lds_byte(wc * 32 + fr, fq * 8);
#define PG8_SA(b, h) (((b) * 2 + (h)) * HTB)
#define PG8_SB(b, h) ((4 + (b) * 2 + (h)) * HTB)
#define PG8_STAGE(bufoff, gbase, voff) do { _Pragma("unroll") for (int _i = 0; _i < 2; ++_i) \
        __builtin_amdgcn_global_load_lds((const unsigned*)((const char*)(gbase) + (voff)[_i]), (PG8_LAS unsigned*)(lds + (bufoff) + ldsw + _i * 8192), 16, 0, 0); } while (0)
#define PG8_LDA(dst, b, h) do { _Pragma("unroll") for (int m = 0; m < 4; ++m) _Pragma("unroll") for (int k = 0; k < 2; ++k) dst[m][k] = *(const PG8_LAS bf16x8*)(lds + PG8_SA(b, h) + aoff + m * 2048 + k * 1024); } while (0)
#define PG8_LDB(dst, b, h) do { _Pragma("unroll") for (int n = 0; n < 2; ++n) _Pragma("unroll") for (int k = 0; k < 2; ++k) dst[n][k] = *(const PG8_LAS bf16x8*)(lds + PG8_SB(b, h) + boff + n * 2048 + k * 1024); } while (0)
#define PG8_MMA(ai, bj, At, Bt) do { __builtin_amdgcn_s_setprio(1); _Pragma("unroll") for (int m = 0; m < 4; ++m) _Pragma("unroll") for (int n = 0; n < 2; ++n) _Pragma("unroll") for (int k = 0; k < 2; ++k) \
        acc[ai][bj][m][n] = __builtin_amdgcn_mfma_f32_16x16x32_bf16(Bt[n][k], At[m][k], acc[ai][bj][m][n], 0, 0, 0); __builtin_amdgcn_s_setprio(0); } while (0)
#define PG8_WAIT_V(n) asm volatile("s_waitcnt vmcnt(" #n ")" ::: "memory")
#define PG8_WAIT_L(n) asm volatile("s_waitcnt lgkmcnt(" #n ")" ::: "memory")
#define PG8_BAR __builtin_amdgcn_s_barrier()
#define PG8_SCHED __builtin_amdgcn_sched_barrier(0)
    Unit cur, nxt; int ui = 0;
    if (!S.next(0, cur)) return;
    f32x4 acc[2][2][4][2];
#pragma unroll
    for (int a = 0; a < 2; ++a)
#pragma unroll
        for (int b = 0; b < 2; ++b)
#pragma unroll
            for (int m = 0; m < 4; ++m)
#pragma unroll
                for (int n = 0; n < 2; ++n) acc[a][b][m][n] = (f32x4){0.f, 0.f, 0.f, 0.f};
    bf16x8 At[4][2], B0[2][2], B1[2][2];
    const char* cA = (const char*)g.A + (size_t)cur.pm * tstep; const char* cB = (const char*)g.Bt + (size_t)cur.pn * tstep;
    S.a_ready(cur);
    PG8_STAGE(PG8_SB(0, 0), cB, voffB); PG8_STAGE(PG8_SA(0, 0), cA, voffA); PG8_STAGE(PG8_SB(0, 1), cB + hstep, voffB); PG8_STAGE(PG8_SA(0, 1), cA + hstep, voffA);
    if (wr == 1) PG8_BAR;
    PG8_WAIT_V(4); PG8_BAR;
    PG8_STAGE(PG8_SB(1, 0), cB + kstep, voffB); PG8_STAGE(PG8_SA(1, 0), cA + kstep, voffA); PG8_STAGE(PG8_SB(1, 1), cB + hstep + kstep, voffB);
    PG8_WAIT_V(6); PG8_BAR;
    for (;;) {
        const bool has_next = S.next(ui + 1, nxt);
        const char* nA = has_next ? (const char*)g.A + (size_t)nxt.pm * tstep : cA; const char* nB = has_next ? (const char*)g.Bt + (size_t)nxt.pn * tstep : cB;
        E.prefetch(cur, wid, lane, lds + STAGE_BYTES + wid * 1024);
        for (int t = 0; t < nt; t += 2) {
            const bool last = (t == nt - 2);
            const char* a1 = cA + (size_t)(t + 1) * kstep;
            const char* a2 = last ? nA : cA + (size_t)(t + 2) * kstep; const char* b2 = last ? nB : cB + (size_t)(t + 2) * kstep;
            const char* a3 = a2 + kstep; const char* b3 = b2 + kstep;
            if (last && has_next) S.a_ready(nxt);
            PG8_LDB(B0, 0, 0); PG8_SCHED; PG8_LDA(At, 0, 0); PG8_STAGE(PG8_SA(1, 1), a1 + hstep, voffA);
            PG8_WAIT_L(8); PG8_BAR; PG8_WAIT_L(0); PG8_MMA(0, 0, At, B0); PG8_BAR; PG8_SCHED;
            PG8_LDB(B1, 0, 1); PG8_STAGE(PG8_SB(0, 0), b2, voffB);
            PG8_BAR; PG8_WAIT_L(0); PG8_MMA(0, 1, At, B1); PG8_BAR;
            PG8_LDA(At, 0, 1); PG8_STAGE(PG8_SA(0, 0), a2, voffA);
            PG8_BAR; PG8_WAIT_L(0); PG8_MMA(1, 0, At, B0); PG8_BAR; PG8_SCHED;
            PG8_STAGE(PG8_SB(0, 1), b2 + hstep, voffB);
            PG8_WAIT_V(6); PG8_BAR; PG8_MMA(1, 1, At, B1); PG8_BAR;
            PG8_LDB(B0, 1, 0); PG8_SCHED; PG8_LDA(At, 1, 0); PG8_STAGE(PG8_SA(0, 1), a2 + hstep, voffA);
            PG8_WAIT_L(8); PG8_BAR; PG8_WAIT_L(0); PG8_MMA(0, 0, At, B0); PG8_BAR; PG8_SCHED;
            PG8_LDB(B1, 1, 1); PG8_STAGE(PG8_SB(1, 0), b3, voffB);
            PG8_BAR; PG8_WAIT_L(0); PG8_MMA(0, 1, At, B1); PG8_BAR;
            PG8_LDA(At, 1, 1); PG8_STAGE(PG8_SA(1, 0), a3, voffA);
            PG8_BAR; PG8_WAIT_L(0); PG8_MMA(1, 0, At, B0); PG8_BAR; PG8_SCHED;
            PG8_STAGE(PG8_SB(1, 1), b3 + hstep, voffB);
            PG8_WAIT_V(6); PG8_BAR; PG8_MMA(1, 1, At, B1); PG8_BAR;
        }
        if constexpr (!Epi::AFTER_DRAIN) { E(acc, cur, wr, wc, fr, fq); S.done(cur); }
        if (!has_next) break;
#pragma unroll
        for (int a = 0; a < 2; ++a)
#pragma unroll
            for (int b = 0; b < 2; ++b)
#pragma unroll
                for (int m = 0; m < 4; ++m)
#pragma unroll
                    for (int n = 0; n < 2; ++n) acc[a][b][m][n] = (f32x4){0.f, 0.f, 0.f, 0.f};
        cur = nxt; cA = nA; cB = nB; ++ui;
    }
    PG8_WAIT_V(0);
    if (wr == 0) PG8_BAR;
    PG8_BAR;
    if constexpr (Epi::AFTER_DRAIN) { E.fused(acc, cur, wr, wc, fr, fq); S.done(cur); }
#undef PG8_SA
#undef PG8_SB
#undef PG8_STAGE
#undef PG8_LDA
#undef PG8_LDB
#undef PG8_MMA
#undef PG8_WAIT_V
#undef PG8_WAIT_L
#undef PG8_BAR
#undef PG8_SCHED
}
}

struct KArgs {
    const float* in[18];
    float* out;
    unsigned char* ws;
    int ph_lo, ph_hi;
    int cg_sync, pad;
};
enum { I_XP = 0, I_XS, I_SPOOL, I_CK, I_CV, I_MEM, I_NORMG, I_WIN, I_POOLW, I_POOLSC, I_SGUNG, I_SGUW, I_SGUB, I_MEMNG, I_WKV, I_WDOWN, I_WOUT, I_NORMF };

struct P1Order {
    pg8::StaticOrder so; int G, c;
    __device__ void init(int G_, int c_) { so.init(MPR, INC, G_, c_); G = G_; c = c_; }
    __device__ bool next(int i, pg8::Unit& u) const {
        const long L = (long)i * G + c;
        if (L < so.nwg) return so.next(i, u);
        const int e = (int)(L - so.nwg); if (e >= 104) return false;
        if (e < 64) { u.pm = NPAN + (e >> 3); u.pn = 40 + (e & 7); } else { u.pm = 64; u.pn = e - 64; }
        return true;
    }
    __device__ __forceinline__ void a_ready(const pg8::Unit&) const {}
    __device__ __forceinline__ void done(const pg8::Unit&) const {}
};
struct EpiProj {
    static constexpr bool PERM = true, AFTER_DRAIN = false;
    bf16* proj; bf16* gate; float* vss; bf16* kb; bf16* vb; float* out; const float* hs; bf16* dsr;
    __device__ __forceinline__ void prefetch(const pg8::Unit&, int, int, LAS unsigned char*) const {}
    __device__ __forceinline__ void operator()(const f32x4 (&acc)[2][2][4][2], const pg8::Unit& u, int wr, int wc, int fr, int fq) const {
        if (u.pn < 40) {
            const int sec = u.pn >> 2;
            const int act = (sec == 1 || sec == 4 || sec == 6) ? 1 : (sec >= 7 ? 2 : 0);
            const int row0 = u.pm * 256 + wr * 64 + fr, cs0 = (u.pn & 3) * 256 + wc * 32 + 8 * fq;
            bf16* base; int ld;
            if (sec < 7) { base = proj + (size_t)sec * MP * DM; ld = DM; } else { base = gate + (sec - 7) * DM; ld = 3 * DM; }
            const bool poolrows = (sec == 0) && (((u.pm & 7) == 7) || u.pm == 64);
#pragma unroll
            for (int ai = 0; ai < 2; ++ai)
#pragma unroll
                for (int m = 0; m < 4; ++m) {
                    const int r = row0 + ai * 128 + m * 16; float ss = 0.f;
#pragma unroll
                    for (int bj = 0; bj < 2; ++bj) {
                        f32x4 v0 = acc[ai][bj][m][0], v1 = acc[ai][bj][m][1]; const int cs = cs0 + bj * 128;
                        if (sec == 3) ss += (v0[0] * v0[0] + v0[1] * v0[1]) + (v0[2] * v0[2] + v0[3] * v0[3]) + (v1[0] * v1[0] + v1[1] * v1[1]) + (v1[2] * v1[2] + v1[3] * v1[3]);
                        if (poolrows) {
                            float* dst = nullptr;
                            if (r < MPR) { const int t = r & (SEQ - 1); if (t >= SEQ - 15) dst = out + O_POOLP + ((size_t)(r >> 11) * 15 + (t - (SEQ - 15))) * DM + cs; }
                            else if (r < MV) { dst = out + O_POOLS + ((size_t)(r - MPR) * 15 + 14) * DM + cs;
                                const float* hp = hs + (size_t)(r - MPR) * DM + cs; const f32x4 h0 = *(const f32x4*)hp, h1 = *(const f32x4*)(hp + 4); const float inv = 1.f / (float)(2 << (cs >> 8));
                                u32x4 d; d.x = pk2((h0.x + v0[0]) * inv - v0[0], (h0.y + v0[1]) * inv - v0[1]); d.y = pk2((h0.z + v0[2]) * inv - v0[2], (h0.w + v0[3]) * inv - v0[3]);
                                d.z = pk2((h1.x + v1[0]) * inv - v1[0], (h1.y + v1[1]) * inv - v1[1]); d.w = pk2((h1.z + v1[2]) * inv - v1[2], (h1.w + v1[3]) * inv - v1[3]);
                                *(u32x4*)(dsr + (size_t)(r - MPR) * DM + cs) = d; }
                            if (dst) { *(f32x4*)dst = v0; *(f32x4*)(dst + 4) = v1; }
                        }
                        if (act == 1) {
#pragma unroll
                            for (int j = 0; j < 4; ++j) { v0[j] = silu_f(v0[j]); v1[j] = silu_f(v1[j]); } }
                        if (act == 2) {
#pragma unroll
                            for (int j = 0; j < 4; ++j) { v0[j] = sigm_f(v0[j]); v1[j] = sigm_f(v1[j]); } }
                        u32x4 w; w.x = pk2(v0[0], v0[1]); w.y = pk2(v0[2], v0[3]); w.z = pk2(v1[0], v1[1]); w.w = pk2(v1[2], v1[3]);
                        __builtin_nontemporal_store(w, (u32x4*)(base + (size_t)r * ld + cs));
                    }
                    if (sec == 3) { ss += __shfl_xor(ss, 16); ss += __shfl_xor(ss, 32); if (fq == 0) vss[(size_t)r * 16 + (u.pn & 3) * 4 + wc] = ss; }
                }
        } else {
            const int b = u.pm - NPAN, ct = (u.pn - 40) * 256;
            const bool isv = ct >= DM; const int cb = (isv ? ct - DM : ct) + wc * 32 + 8 * fq;
            float* of = out + (isv ? O_MV : O_MK); bf16* ob = isv ? vb : kb;
#pragma unroll
            for (int ai = 0; ai < 2; ++ai)
#pragma unroll
                for (int m = 0; m < 4; ++m) {
                    const size_t j = (size_t)b * 256 + ai * 128 + wr * 64 + m * 16 + fr;
#pragma unroll
                    for (int bj = 0; bj < 2; ++bj) {
                        const f32x4 v0 = acc[ai][bj][m][0], v1 = acc[ai][bj][m][1]; const int cs = cb + bj * 128;
                        __builtin_nontemporal_store(v0, (f32x4*)(of + j * DM + cs)); __builtin_nontemporal_store(v1, (f32x4*)(of + j * DM + cs + 4));
                        u32x4 w; w.x = pk2(v0[0], v0[1]); w.y = pk2(v0[2], v0[3]); w.z = pk2(v1[0], v1[1]); w.w = pk2(v1[2], v1[3]);
                        *(u32x4*)(ob + j * DM + cs) = w;
                    }
                }
        }
    }
};
struct P3Order {
    pg8::StaticOrder so;
    __device__ void init(int G_, int c_) { so.init(MPR, DM, G_, c_); }
    __device__ bool next(int i, pg8::Unit& u) const { const int rnd = i / 3, b = i - 3 * rnd; pg8::Unit t; if (!so.next(rnd, t)) return false; u.pm = b * NPAN + t.pm; u.pn = b * 4 + t.pn; return true; }
    __device__ __forceinline__ void a_ready(const pg8::Unit&) const {}
    __device__ __forceinline__ void done(const pg8::Unit&) const {}
};
struct EpiGate {
    static constexpr bool PERM = true, AFTER_DRAIN = false;
    const bf16* gate; bf16* mg;
    __device__ __forceinline__ void prefetch(const pg8::Unit& u, int wid, int lane, LAS unsigned char* scr) const {
        const int b = u.pn >> 2, pm = u.pm - b * NPAN, t = wid * 64 + lane;
#pragma unroll
        for (int j = 0; j < 2; ++j) { const int li = t + 512 * j, row = li >> 2, seg = li & 3; const size_t r = (size_t)(pm * 256 + row);
            __builtin_amdgcn_global_load_lds((const unsigned*)(gate + r * (3 * DM) + b * DM + (u.pn & 3) * 256 + seg * 64), (LAS unsigned*)(scr + j * 256), 4, 0, 0); }
    }
    __device__ __forceinline__ void operator()(const f32x4 (&acc)[2][2][4][2], const pg8::Unit& u, int wr, int wc, int fr, int fq) const {
        const int b = u.pn >> 2, pm = u.pm - b * NPAN;
        const int row0 = pm * 256 + wr * 64 + fr, c0 = (u.pn & 3) * 256 + wc * 32 + 8 * fq;
#pragma unroll
        for (int ai = 0; ai < 2; ++ai)
#pragma unroll
            for (int m = 0; m < 4; ++m) {
                const size_t r = (size_t)(row0 + ai * 128 + m * 16);
#pragma unroll
                for (int bj = 0; bj < 2; ++bj) {
                    const f32x4 v0 = acc[ai][bj][m][0], v1 = acc[ai][bj][m][1]; const int c = c0 + bj * 128;
                    const u32x4 g8 = *(const u32x4*)(gate + r * (3 * DM) + b * DM + c);
                    float o0 = v0[0] * bflo(g8.x), o1 = v0[1] * bfhi(g8.x), o2 = v0[2] * bflo(g8.y), o3 = v0[3] * bfhi(g8.y);
                    float o4 = v1[0] * bflo(g8.z), o5 = v1[1] * bfhi(g8.z), o6 = v1[2] * bflo(g8.w), o7 = v1[3] * bfhi(g8.w);
                    if (b > 0) { const u32x4 p = *(const u32x4*)(mg + r * DM + c);
                        o0 += bflo(p.x); o1 += bfhi(p.x); o2 += bflo(p.y); o3 += bfhi(p.y); o4 += bflo(p.z); o5 += bfhi(p.z); o6 += bflo(p.w); o7 += bfhi(p.w); }
                    u32x4 w; w.x = pk2(o0, o1); w.y = pk2(o2, o3); w.z = pk2(o4, o5); w.w = pk2(o6, o7);
                    if (b == 2) __builtin_nontemporal_store(w, (u32x4*)(mg + r * DM + c)); else *(u32x4*)(mg + r * DM + c) = w;
                }
            }
    }
};
__device__ __forceinline__ void st_agent(float* p, float v) { __hip_atomic_store((unsigned*)p, __builtin_bit_cast(unsigned, v), __ATOMIC_RELAXED, __HIP_MEMORY_SCOPE_AGENT); }
__device__ __forceinline__ float ld_agent(const float* p) { return __builtin_bit_cast(float, __hip_atomic_load((unsigned*)p, __ATOMIC_RELAXED, __HIP_MEMORY_SCOPE_AGENT)); }
__device__ __forceinline__ void wait_count(unsigned* w, unsigned want) {
    unsigned sp = 0;
    while ((unsigned)__builtin_amdgcn_readfirstlane(__hip_atomic_load(w, __ATOMIC_RELAXED, __HIP_MEMORY_SCOPE_AGENT)) < want) { __builtin_amdgcn_s_sleep(2); if (++sp > (1u << 22)) break; }
    __builtin_amdgcn_fence(__ATOMIC_ACQUIRE, "agent");
    asm volatile("s_waitcnt vmcnt(0)" ::: "memory");
}
struct EpiOutNorm {
    static constexpr bool PERM = false, AFTER_DRAIN = true;
    const float* xp; const float* gf; float* out; float* slots; unsigned* cnt;
    __device__ __forceinline__ void prefetch(const pg8::Unit& u, int wid, int lane, LAS unsigned char* scr) const {
        const int t = wid * 64 + lane;
#pragma unroll
        for (int j = 0; j < 4; ++j) { const int li = t + 512 * j, row = li >> 3, seg = li & 7;
            __builtin_amdgcn_global_load_lds((const unsigned*)(xp + (size_t)(u.pm * 256 + row) * DM + u.pn * 256 + seg * 32), (LAS unsigned*)(scr + j * 256), 4, 0, 0); }
    }
    __device__ __forceinline__ void operator()(const f32x4 (&)[2][2][4][2], const pg8::Unit&, int, int, int, int) const {}
    __device__ __forceinline__ void fused(f32x4 (&acc)[2][2][4][2], const pg8::Unit& u, int wr, int wc, int fr, int fq) const {
        const int row0 = u.pm * 256 + wr * 64 + fr, col0 = u.pn * 256 + wc * 32 + 4 * fq;
#pragma unroll
        for (int ai = 0; ai < 2; ++ai)
#pragma unroll
            for (int m = 0; m < 4; ++m) { const size_t r = (size_t)(row0 + ai * 128 + m * 16); float ss = 0.f;
#pragma unroll
                for (int bj = 0; bj < 2; ++bj)
#pragma unroll
                    for (int n = 0; n < 2; ++n) { const int c = col0 + bj * 128 + n * 16; const f32x4 v = acc[ai][bj][m][n] + __builtin_nontemporal_load((const f32x4*)(xp + r * DM + c)); acc[ai][bj][m][n] = v;
                        ss += (v.x * v.x + v.y * v.y) + (v.z * v.z + v.w * v.w); }
                ss += __shfl_xor(ss, 16); ss += __shfl_xor(ss, 32);
                if (fq == 0) st_agent(slots + r * 16 + u.pn * 4 + wc, ss); }
        asm volatile("s_waitcnt vmcnt(0)" ::: "memory");
        if (fr == 0 && fq == 0) __hip_atomic_fetch_add(cnt + 64 * u.pm, 1u, __ATOMIC_RELAXED, __HIP_MEMORY_SCOPE_AGENT);
        if (threadIdx.x < 64) wait_count(cnt + 64 * u.pm, 32u);
        __syncthreads();
#pragma unroll
        for (int ai = 0; ai < 2; ++ai)
#pragma unroll
            for (int m = 0; m < 4; ++m) { const size_t r = (size_t)(row0 + ai * 128 + m * 16); float tot = 0.f;
                { const f32x4* sp = (const f32x4*)(slots + r * 16); const f32x4 p0 = sp[0], p1 = sp[1], p2 = sp[2], p3 = sp[3];
                  tot = (((p0.x + p0.y) + (p0.z + p0.w)) + ((p1.x + p1.y) + (p1.z + p1.w))) + (((p2.x + p2.y) + (p2.z + p2.w)) + ((p3.x + p3.y) + (p3.z + p3.w))); }
                const float rs = rsqrtf(tot * (1.f / DM) + EPS);
#pragma unroll
                for (int bj = 0; bj < 2; ++bj)
#pragma unroll
                    for (int n = 0; n < 2; ++n) { const int c = col0 + bj * 128 + n * 16; const f32x4 g = *(const f32x4*)(gf + c); const f32x4 v = acc[ai][bj][m][n];
                        __builtin_nontemporal_store((f32x4){v.x * rs * g.x, v.y * rs * g.y, v.z * rs * g.z, v.w * rs * g.w}, (f32x4*)(out + O_YP + r * DM + c)); } }
    }
};

template <class Epi>
__device__ __forceinline__ void skinny_gemm(LAS unsigned char* lds, const bf16* A0, int lda, size_t a_grp_stride, int strips_per_grp, int nseg, int aseg,
                                            const bf16* Bt, int ldb, int K, int nstrips, int first, int step, const Epi& E) {
    int tid_ = threadIdx.x; asm volatile("" : "+v"(tid_));
    const int tid = tid_, lane = tid & 63, wv = tid >> 6, fr = lane & 15, fq = lane >> 4, rh = wv & 1, kq = wv >> 1;
    LAS float* part = (LAS float*)lds;
    const int nks = K / 128;
    for (int s = first; s < nstrips; s += step) {
        const bf16* A = A0 + (size_t)(s / strips_per_grp) * a_grp_stride + (size_t)(rh * 64 + fr) * lda + fq * 8;
        const bf16* B = Bt + (size_t)(16 * s + fr) * ldb + fq * 8;
        f32x4 acc[4];
#pragma unroll
        for (int rb = 0; rb < 4; ++rb) acc[rb] = (f32x4){0.f, 0.f, 0.f, 0.f};
        for (int seg = 0; seg < nseg; ++seg) {
#pragma unroll 4
            for (int k = 0; k < nks; ++k) {
                const int ko = (kq * nks + k) * 32;
                const bf16x8 bfr = *(const bf16x8*)(B + ko);
#pragma unroll
                for (int rb = 0; rb < 4; ++rb) { const bf16x8 afr = *(const bf16x8*)(A + (size_t)rb * 16 * lda + seg * aseg + ko);
                    acc[rb] = __builtin_amdgcn_mfma_f32_16x16x32_bf16(bfr, afr, acc[rb], 0, 0, 0); }
            }
        }
#pragma unroll
        for (int rb = 0; rb < 4; ++rb) *(LAS f32x4*)(part + ((kq * 128 + rh * 64 + rb * 16 + fr) * 16 + fq * 4)) = acc[rb];
        __syncthreads();
        { const int row = tid >> 2, cq = tid & 3; const LAS float* p = part + row * 16 + cq * 4;
          const f32x4 v = (*(const LAS f32x4*)p + *(const LAS f32x4*)(p + 2048)) + (*(const LAS f32x4*)(p + 4096) + *(const LAS f32x4*)(p + 6144));
          E(s, row, 16 * s + cq * 4, v, cq); }
        __syncthreads();
    }
}
struct EpiS1 {
    bf16* proj; bf16* gate; float* vss2; float* out; const float* hist; bf16* ds;
    __device__ __forceinline__ void operator()(int s, int row, int c, f32x4 v, int cq) const {
        const int sec = c >> 10, cs = c & 1023; const size_t m = (size_t)(MPR + row);
        if (sec == 0) { *(f32x4*)(out + O_POOLS + ((size_t)row * 15 + 14) * DM + cs) = v;
            const int w = 2 << (cs >> 8); f32x4 sm = v;
#pragma unroll
            for (int j = 0; j < 15; ++j) if (j < w - 1) sm = sm + *(const f32x4*)(hist + ((size_t)row * 15 + 14 - j) * DM + cs);
            const float inv = 1.f / (float)w;
            u32x2 d; d.x = pk2(sm.x * inv - v.x, sm.y * inv - v.y); d.y = pk2(sm.z * inv - v.z, sm.w * inv - v.w);
            *(u32x2*)(ds + (size_t)row * DM + cs) = d; }
        if (sec == 3) { float ss = (v.x * v.x + v.y * v.y) + (v.z * v.z + v.w * v.w); ss += __shfl_xor(ss, 1); ss += __shfl_xor(ss, 2); if (cq == 0) vss2[row * 64 + (s - 192)] = ss; }
        if (sec == 1 || sec == 4 || sec == 6) { v.x = silu_f(v.x); v.y = silu_f(v.y); v.z = silu_f(v.z); v.w = silu_f(v.w); }
        if (sec >= 7) { v.x = sigm_f(v.x); v.y = sigm_f(v.y); v.z = sigm_f(v.z); v.w = sigm_f(v.w); }
        u32x2 w; w.x = pk2(v.x, v.y); w.y = pk2(v.z, v.w);
        if (sec < 7) *(u32x2*)(proj + (size_t)sec * MP * DM + m * DM + cs) = w; else *(u32x2*)(gate + m * (3 * DM) + (sec - 7) * DM + cs) = w;
    }
};
struct EpiS3 {
    const bf16* gate; bf16* gys;
    __device__ __forceinline__ void operator()(int s, int row, int c, f32x4 v, int cq) const {
        const u32x2 g = *(const u32x2*)(gate + (size_t)(MPR + row) * (3 * DM) + c);
        u32x2 w; w.x = pk2(v.x * bflo(g.x), v.y * bfhi(g.x)); w.y = pk2(v.z * bflo(g.y), v.w * bfhi(g.y));
        *(u32x2*)(gys + (size_t)row * (3 * DM) + c) = w;
    }
};
struct EpiS4 {
    const float* xs; const float* gf; float* out; float* slots2; unsigned* cnt2;
    __device__ __forceinline__ void operator()(int s, int row, int c, f32x4 v, int cq) const {
        v = v + *(const f32x4*)(xs + (size_t)row * DM + c);
        float ss = (v.x * v.x + v.y * v.y) + (v.z * v.z + v.w * v.w); ss += __shfl_xor(ss, 1); ss += __shfl_xor(ss, 2);
        if (cq == 0) st_agent(slots2 + row * 64 + s, ss);
        asm volatile("s_waitcnt vmcnt(0)" ::: "memory");
        __syncthreads();
        if (threadIdx.x == 0) __hip_atomic_fetch_add(cnt2, 1u, __ATOMIC_RELAXED, __HIP_MEMORY_SCOPE_AGENT);
        if (threadIdx.x < 64) wait_count(cnt2, 64u);
        __syncthreads();
        float tot = 0.f;
        { const f32x4* sp = (const f32x4*)(slots2 + row * 64 + cq * 16); const f32x4 p0 = sp[0], p1 = sp[1], p2 = sp[2], p3 = sp[3];
          tot = (((p0.x + p0.y) + (p0.z + p0.w)) + ((p1.x + p1.y) + (p1.z + p1.w))) + (((p2.x + p2.y) + (p2.z + p2.w)) + ((p3.x + p3.y) + (p3.z + p3.w))); }
        tot += __shfl_xor(tot, 1); tot += __shfl_xor(tot, 2);
        const float rs = rsqrtf(tot * (1.f / DM) + EPS); const f32x4 g = *(const f32x4*)(gf + c);
        *(f32x4*)(out + O_YS + (size_t)row * DM + c) = (f32x4){v.x * rs * g.x, v.y * rs * g.y, v.z * rs * g.z, v.w * rs * g.w};
    }
};


__device__ __forceinline__ void sample_out_split(const KArgs& a, LAS unsigned char* lds, int item) {
    int tid_ = threadIdx.x; asm volatile("" : "+v"(tid_));
    const int tid = tid_, lane = tid & 63, wv = tid >> 6, fr = lane & 15, fq = lane >> 4, s = item >> 2, rq = item & 3;
    const bf16* A = (const bf16*)(a.ws + WS_GYS) + (size_t)(rq * 32 + fr) * (3 * DM) + fq * 8;
    const bf16* B = (const bf16*)(a.ws + WS_WO3) + (size_t)(16 * s + fr) * DM + fq * 8;
    f32x4 acc0 = (f32x4){0.f, 0.f, 0.f, 0.f}, acc1 = acc0;
#pragma unroll
    for (int kk = 0; kk < 12; ++kk) { const int k = 384 * wv + 32 * kk;
        const bf16x8 bfr = *(const bf16x8*)(B + (k & 1023)); const bf16x8 a0 = *(const bf16x8*)(A + k), a1 = *(const bf16x8*)(A + (size_t)16 * (3 * DM) + k);
        acc0 = __builtin_amdgcn_mfma_f32_16x16x32_bf16(bfr, a0, acc0, 0, 0, 0); acc1 = __builtin_amdgcn_mfma_f32_16x16x32_bf16(bfr, a1, acc1, 0, 0, 0); }
    LAS float* part = (LAS float*)lds;
    *(LAS f32x4*)(part + (wv * 32 + fr) * 16 + fq * 4) = acc0; *(LAS f32x4*)(part + (wv * 32 + 16 + fr) * 16 + fq * 4) = acc1;
    __syncthreads();
    const int row = tid >> 4, col = tid & 15, grow = rq * 32 + row, c = 16 * s + col;
    float v = 0.f;
#pragma unroll
    for (int w8 = 0; w8 < 8; ++w8) v += part[(w8 * 32 + row) * 16 + col];
    v += a.in[I_XS][(size_t)grow * DM + c];
    float ss = v * v; ss += __shfl_xor(ss, 1); ss += __shfl_xor(ss, 2); ss += __shfl_xor(ss, 4); ss += __shfl_xor(ss, 8);
    float* slots2 = (float*)(a.ws + WS_VSS2); unsigned* cnt = (unsigned*)(a.ws + WS_CTL) + CW_SAMPLE + 64 * rq;
    if (col == 0) st_agent(slots2 + grow * 64 + s, ss);
    asm volatile("s_waitcnt vmcnt(0)" ::: "memory");
    __syncthreads();
    if (tid == 0) __hip_atomic_fetch_add(cnt, 1u, __ATOMIC_RELAXED, __HIP_MEMORY_SCOPE_AGENT);
    if (tid < 64) wait_count(cnt, 64u);
    __syncthreads();
    const f32x4 p4 = *(const f32x4*)(slots2 + grow * 64 + col * 4);
    float tot = (p4.x + p4.y) + (p4.z + p4.w); tot += __shfl_xor(tot, 1); tot += __shfl_xor(tot, 2); tot += __shfl_xor(tot, 4); tot += __shfl_xor(tot, 8);
    a.out[O_YS + (size_t)grow * DM + c] = v * rsqrtf(tot * (1.f / DM) + EPS) * a.in[I_NORMF][c];
    __syncthreads();
}

__device__ __forceinline__ void p0_transpose_item(const float* W, int N, bf16* WT, int row_off, int ldo, int koff, LAS float* scr, int item, int lane) {
    const int nblk = N / 32, kb = item / nblk, nb = item % nblk, k0 = 64 * kb, n0 = 32 * nb;
#pragma unroll 8
    for (int i = 0; i < 32; ++i) { const int kk = 2 * i + (lane >> 5); scr[kk * 33 + (lane & 31)] = W[(size_t)(k0 + kk) * N + n0 + (lane & 31)]; }
    asm volatile("s_waitcnt lgkmcnt(0)" ::: "memory");
    const int c = lane & 7;
#pragma unroll
    for (int j = 0; j < 4; ++j) { const int n = (lane >> 3) + 8 * j; const LAS float* s = scr + (8 * c) * 33 + n;
        u32x4 o; o.x = pk2(s[0 * 33], s[1 * 33]); o.y = pk2(s[2 * 33], s[3 * 33]); o.z = pk2(s[4 * 33], s[5 * 33]); o.w = pk2(s[6 * 33], s[7 * 33]);
        *(u32x4*)(WT + (size_t)(row_off + n0 + n) * ldo + koff + k0 + 8 * c) = o; }
    asm volatile("s_waitcnt lgkmcnt(0)" ::: "memory");
}
__device__ __forceinline__ void rms_row_to_bf16(const float* xrow, const float* gain, bf16* orow, int lane) {
    const f32x4* xr = (const f32x4*)xrow + lane; const f32x4* gr = (const f32x4*)gain + lane;
    f32x4 v[4]; float s = 0.f;
#pragma unroll
    for (int j = 0; j < 4; ++j) { v[j] = xr[64 * j]; s += (v[j].x * v[j].x + v[j].y * v[j].y) + (v[j].z * v[j].z + v[j].w * v[j].w); }
    const float rs = rsqrtf(wave_sum(s) * (1.f / DM) + EPS);
    u32x2* o8 = (u32x2*)orow + lane;
#pragma unroll
    for (int j = 0; j < 4; ++j) { const f32x4 g = gr[64 * j]; u32x2 w; w.x = pk2(v[j].x * rs * g.x, v[j].y * rs * g.y); w.y = pk2(v[j].z * rs * g.z, v[j].w * rs * g.w); o8[64 * j] = w; }
}
__device__ __forceinline__ void rms_row2_to_bf16(const float* x0, const float* x1, const float* gain, bf16* o0, bf16* o1, int lane) {
    const f32x4* xr0 = (const f32x4*)x0 + lane; const f32x4* xr1 = (const f32x4*)x1 + lane; const f32x4* gr = (const f32x4*)gain + lane;
    f32x4 v[4], w[4]; float s = 0.f, t = 0.f;
#pragma unroll
    for (int j = 0; j < 4; ++j) { v[j] = __builtin_nontemporal_load(xr0 + 64 * j); w[j] = __builtin_nontemporal_load(xr1 + 64 * j); }
#pragma unroll
    for (int j = 0; j < 4; ++j) { s += (v[j].x * v[j].x + v[j].y * v[j].y) + (v[j].z * v[j].z + v[j].w * v[j].w); t += (w[j].x * w[j].x + w[j].y * w[j].y) + (w[j].z * w[j].z + w[j].w * w[j].w); }
#pragma unroll
    for (int o = 1; o < 64; o <<= 1) { s += __shfl_xor(s, o); t += __shfl_xor(t, o); }
    const float rs = rsqrtf(s * (1.f / DM) + EPS), rt = rsqrtf(t * (1.f / DM) + EPS);
    u32x2* p0 = (u32x2*)o0 + lane; u32x2* p1 = (u32x2*)o1 + lane;
#pragma unroll
    for (int j = 0; j < 4; ++j) { const f32x4 g = gr[64 * j]; u32x2 a; a.x = pk2(v[j].x * rs * g.x, v[j].y * rs * g.y); a.y = pk2(v[j].z * rs * g.z, v[j].w * rs * g.w); p0[64 * j] = a;
        u32x2 b; b.x = pk2(w[j].x * rt * g.x, w[j].y * rt * g.y); b.y = pk2(w[j].z * rt * g.z, w[j].w * rt * g.w); p1[64 * j] = b; }
}
__device__ __forceinline__ void p0_prologue(const KArgs& a, LAS unsigned char* lds, int G) {
    const int tid = threadIdx.x, lane = tid & 63, wave = tid >> 6;
    LAS float* scr = (LAS float*)(lds + wave * 16384);
    const int gw = blockIdx.x * 8 + wave, NGW = G * 8;
    bf16* H = (bf16*)(a.ws + WS_H); bf16* WinT = (bf16*)(a.ws + WS_WIN); bf16* WdT = (bf16*)(a.ws + WS_WD); bf16* Wo3 = (bf16*)(a.ws + WS_WO3);
    bf16* PwT = (bf16*)(a.ws + WS_PW); bf16* SW = (bf16*)(a.ws + WS_SW);
    constexpr int I_IN = 16 * (INC / 32), I_KV = 16 * (2048 / 32), I_D = 16 * 32, I_O = 16 * 32, I_P = 4 * 8;
    constexpr int NITEMS = I_IN + I_KV + 3 * I_D + I_O + 4 * I_P;
    for (int it = gw; it < NITEMS; it += NGW) {
        int r = it;
        if (r < I_IN) { p0_transpose_item(a.in[I_WIN], INC, WinT, 0, DM, 0, scr, r, lane); continue; } r -= I_IN;
        if (r < I_KV) { p0_transpose_item(a.in[I_WKV], 2048, WinT, INC, DM, 0, scr, r, lane); continue; } r -= I_KV;
        if (r < 3 * I_D) { const int b = r / I_D; p0_transpose_item(a.in[I_WDOWN] + (size_t)b * DM * DM, DM, WdT, b * DM, DM, 0, scr, r % I_D, lane); continue; } r -= 3 * I_D;
        if (r < I_O) { p0_transpose_item(a.in[I_WOUT], DM, Wo3, 0, DM, 0, scr, r, lane); continue; } r -= I_O;
        { const int g = r / I_P; p0_transpose_item(a.in[I_POOLW] + (size_t)g * 256 * 256, 256, PwT, g * 256, 256, 0, scr, r % I_P, lane); }
    }
    for (int m = gw; m + NGW < MPR; m += 2 * NGW)
        rms_row2_to_bf16(a.in[I_XP] + (size_t)m * DM, a.in[I_XP] + (size_t)(m + NGW) * DM, a.in[I_NORMG], H + (size_t)m * DM, H + (size_t)(m + NGW) * DM, lane);
    const int mdone = (MPR / (2 * NGW)) * (2 * NGW);
    for (int m = mdone + gw; m < MP + 2048; m += NGW) {
        bf16* orow = H + (size_t)m * DM;
        if (m < MPR) rms_row_to_bf16(a.in[I_XP] + (size_t)m * DM, a.in[I_NORMG], orow, lane);
        else if (m < MV) rms_row_to_bf16(a.in[I_XS] + (size_t)(m - MPR) * DM, a.in[I_NORMG], orow, lane);
        else if (m < MP) { u32x2* o8 = (u32x2*)orow + lane;
#pragma unroll
            for (int j = 0; j < 4; ++j) o8[64 * j] = (u32x2){0u, 0u}; }
        else rms_row_to_bf16(a.in[I_MEM] + (size_t)(m - MP) * DM, a.in[I_MEMNG], orow, lane);
    }
    const size_t gt = (size_t)blockIdx.x * 512 + tid, NGT = (size_t)G * 512;
    for (size_t i = gt; i < (size_t)4 * 128 * 128; i += NGT) { const int s = (int)(i & 127), t = (int)((i >> 7) & 127); SW[i] = (bf16)(s <= t ? f2bf(a.in[I_SGUW][i]) : 0u); }
    for (size_t i = gt; i < (size_t)NS * 256; i += NGT) { const size_t smp = i >> 8, c = (i & 255) * 4; const int w = 2 << (int)(c >> 8); f32x4 sm = (f32x4){0.f, 0.f, 0.f, 0.f};
#pragma unroll
        for (int j = 0; j < 15; ++j) if (j < w - 1) sm = sm + *(const f32x4*)(a.in[I_SPOOL] + (smp * 15 + 14 - j) * DM + c);
        *(f32x4*)((float*)(a.ws + WS_HS) + smp * DM + c) = sm; }
    for (size_t i = gt; i < (size_t)NS * 14 * 256; i += NGT) { const size_t smp = i / (14 * 256), rem = i % (14 * 256), r = rem / 256, c4 = rem % 256;
        *(f32x4*)(a.out + O_POOLS + (smp * 15 + r) * DM + c4 * 4) = *(const f32x4*)(a.in[I_SPOOL] + (smp * 15 + r + 1) * DM + c4 * 4); }
}

constexpr int RSV = 544;
constexpr int RS = 528;
__device__ __forceinline__ void pool_part(const KArgs& a, LAS unsigned char* lds, int rt, int g) {
    int tid_ = threadIdx.x; asm volatile("" : "+v"(tid_));
    const int tid = tid_, lane = tid & 63, wv = tid >> 6, fr = lane & 15, fq = lane >> 4;
    const int m0 = rt * 128, w = 2 << g;
    const bf16* PIN = (const bf16*)(a.ws + WS_PROJ); const bf16* PZ = PIN + (size_t)MP * DM;
    const bf16* PwT = (const bf16*)(a.ws + WS_PW); bf16* BR0 = (bf16*)(a.ws + WS_BR);
    LAS unsigned char* Pb = lds; LAS unsigned char* Db = lds + 75520;
    u32x2 zf[8][2]; f32x4 scv[2]; bf16x8 Bf[2][8];
    const bf16* pw = PwT + (size_t)(g * 256 + wv * 32 + fr) * 256 + fq * 8;
    if (rt < 128) {
        const int t0 = (rt & 15) * 128;
        u32x4 tv[9];
#pragma unroll
        for (int i = 0; i < 9; ++i) { const int idx = tid + i * 512, row = idx >> 5, ch = idx & 31; tv[i] = (u32x4){0u, 0u, 0u, 0u};
            if (idx < 143 * 32 && !(t0 == 0 && row < 15)) tv[i] = *(const u32x4*)(PIN + (size_t)(m0 - 15 + row) * DM + g * 256 + ch * 8); }
#pragma unroll
        for (int rb = 0; rb < 8; ++rb)
#pragma unroll
            for (int nn = 0; nn < 2; ++nn) zf[rb][nn] = *(const u32x2*)(PZ + (size_t)(m0 + rb * 16 + fr) * DM + g * 256 + wv * 32 + nn * 16 + fq * 4);
#pragma unroll
        for (int nn = 0; nn < 2; ++nn) { scv[nn] = *(const f32x4*)(a.in[I_POOLSC] + g * 256 + wv * 32 + nn * 16 + fq * 4);
#pragma unroll
            for (int ks = 0; ks < 8; ++ks) Bf[nn][ks] = *(const bf16x8*)(pw + nn * 16 * 256 + ks * 32); }
#pragma unroll
        for (int i = 0; i < 9; ++i) { const int idx = tid + i * 512, row = idx >> 5, ch = idx & 31; if (idx < 143 * 32) *(LAS u32x4*)(Pb + row * RS + ch * 16) = tv[i]; }
        __syncthreads();
        {
            const int ch = tid & 31, r0 = (tid >> 5) * 8;
            float s0 = 0.f, s1 = 0.f, s2 = 0.f, s3 = 0.f, s4 = 0.f, s5 = 0.f, s6 = 0.f, s7 = 0.f;
            for (int j = 1; j < w; ++j) { const u32x4 v = *(const LAS u32x4*)(Pb + (r0 + 15 - j) * RS + ch * 16);
                s0 += bflo(v.x); s1 += bfhi(v.x); s2 += bflo(v.y); s3 += bfhi(v.y); s4 += bflo(v.z); s5 += bfhi(v.z); s6 += bflo(v.w); s7 += bfhi(v.w); }
#pragma unroll
            for (int i = 0; i < 8; ++i) { const int r = r0 + i;
                const u32x4 own = *(const LAS u32x4*)(Pb + (r + 15) * RS + ch * 16); const u32x4 old = *(const LAS u32x4*)(Pb + (r + 16 - w) * RS + ch * 16);
                s0 += bflo(own.x); s1 += bfhi(own.x); s2 += bflo(own.y); s3 += bfhi(own.y); s4 += bflo(own.z); s5 += bfhi(own.z); s6 += bflo(own.w); s7 += bfhi(own.w);
                const int cnt = min(w, t0 + r + 1); const float inv = 1.f / (float)cnt;
                u32x4 d; d.x = pk2(s0 * inv - bflo(own.x), s1 * inv - bfhi(own.x)); d.y = pk2(s2 * inv - bflo(own.y), s3 * inv - bfhi(own.y));
                d.z = pk2(s4 * inv - bflo(own.z), s5 * inv - bfhi(own.z)); d.w = pk2(s6 * inv - bflo(own.w), s7 * inv - bfhi(own.w));
                *(LAS u32x4*)(Db + r * RS + ch * 16) = d;
                s0 -= bflo(old.x); s1 -= bfhi(old.x); s2 -= bflo(old.y); s3 -= bfhi(old.y); s4 -= bflo(old.z); s5 -= bfhi(old.z); s6 -= bflo(old.w); s7 -= bfhi(old.w); }
        }
    } else {
#pragma unroll
        for (int rb = 0; rb < 8; ++rb)
#pragma unroll
            for (int nn = 0; nn < 2; ++nn) zf[rb][nn] = *(const u32x2*)(PZ + (size_t)(m0 + rb * 16 + fr) * DM + g * 256 + wv * 32 + nn * 16 + fq * 4);
#pragma unroll
        for (int nn = 0; nn < 2; ++nn) { scv[nn] = *(const f32x4*)(a.in[I_POOLSC] + g * 256 + wv * 32 + nn * 16 + fq * 4);
#pragma unroll
            for (int ks = 0; ks < 8; ++ks) Bf[nn][ks] = *(const bf16x8*)(pw + nn * 16 * 256 + ks * 32); }
        const bf16* DS = (const bf16*)(a.ws + WS_DS);
        u32x4 td[8];
#pragma unroll
        for (int i = 0; i < 8; ++i) { const int idx = tid + i * 512, r = idx >> 5, ch = idx & 31; td[i] = *(const u32x4*)(DS + (size_t)r * DM + g * 256 + ch * 8); }
#pragma unroll
        for (int i = 0; i < 8; ++i) { const int idx = tid + i * 512, r = idx >> 5, ch = idx & 31; *(LAS u32x4*)(Db + r * RS + ch * 16) = td[i]; }
    }
    __syncthreads();
#pragma unroll
    for (int rb = 0; rb < 8; ++rb) {
        f32x4 acc0 = (f32x4){0.f, 0.f, 0.f, 0.f}, acc1 = acc0;
#pragma unroll
        for (int ks = 0; ks < 8; ++ks) { const bf16x8 A = *(const LAS bf16x8*)(Db + (rb * 16 + fr) * RS + (ks * 32 + fq * 8) * 2);
            acc0 = __builtin_amdgcn_mfma_f32_16x16x32_bf16(Bf[0][ks], A, acc0, 0, 0, 0); acc1 = __builtin_amdgcn_mfma_f32_16x16x32_bf16(Bf[1][ks], A, acc1, 0, 0, 0); }
        const size_t m = (size_t)(m0 + rb * 16 + fr);
#pragma unroll
        for (int nn = 0; nn < 2; ++nn) { const int c = g * 256 + wv * 32 + nn * 16 + fq * 4; const f32x4 acc = nn ? acc1 : acc0;
            const f32x4 sc = scv[nn]; const u32x2 z = zf[rb][nn];
            u32x2 o; o.x = pk2(acc[0] * sc.x * bflo(z.x), acc[1] * sc.y * bfhi(z.x)); o.y = pk2(acc[2] * sc.z * bflo(z.y), acc[3] * sc.w * bfhi(z.y));
            *(u32x2*)(BR0 + m * DM + c) = o; }
    }
    __syncthreads();
}
__device__ __forceinline__ void sgu_part(const KArgs& a, LAS unsigned char* lds, int rt, int g) {
    int tid_ = threadIdx.x; asm volatile("" : "+v"(tid_));
    const int tid = tid_, lane = tid & 63, wv = tid >> 6, fr = lane & 15, fq = lane >> 4;
    const int m0 = rt * 128;
    const bf16* U = (const bf16*)(a.ws + WS_PROJ) + (size_t)2 * MP * DM; const bf16* V = U + (size_t)MP * DM; const bf16* SZ = V + (size_t)MP * DM;
    const bf16* SW = (const bf16*)(a.ws + WS_SW); const float* VSS = (const float*)(a.ws + WS_VSS); bf16* BR1 = (bf16*)(a.ws + WS_BR) + (size_t)MP * DM;
    LAS unsigned char* Vb = lds; LAS unsigned char* UZb = lds + 128 * RS; LAS float* rbuf = (LAS float*)(lds + 256 * RS);
    u32x4 tv[8], tu[8], tz[8];
#pragma unroll
    for (int i = 0; i < 8; ++i) { const int idx = tid + i * 512, s = idx >> 5, ch = idx & 31; const size_t o = (size_t)(m0 + s) * DM + g * 256 + ch * 8;
        tv[i] = *(const u32x4*)(V + o); tu[i] = *(const u32x4*)(U + o); tz[i] = *(const u32x4*)(SZ + o); }
    if (tid < 128) { const f32x4* p = (const f32x4*)(VSS + (size_t)(m0 + tid) * 16); const f32x4 p0 = p[0], p1 = p[1], p2 = p[2], p3 = p[3];
        const float s = ((p0.x + p0.y) + (p0.z + p0.w)) + ((p1.x + p1.y) + (p1.z + p1.w)) + ((p2.x + p2.y) + (p2.z + p2.w)) + ((p3.x + p3.y) + (p3.z + p3.w));
        rbuf[tid] = rsqrtf(s * (1.f / DM) + EPS); }
    const f32x4 gv0 = *(const f32x4*)(a.in[I_SGUNG] + g * 256 + wv * 32 + fq * 4), gv1 = *(const f32x4*)(a.in[I_SGUNG] + g * 256 + wv * 32 + 16 + fq * 4);
    float biasv[8];
#pragma unroll
    for (int tb = 0; tb < 8; ++tb) biasv[tb] = a.in[I_SGUB][g * 128 + tb * 16 + fr];
    __syncthreads();
#pragma unroll
    for (int i = 0; i < 8; ++i) { const int idx = tid + i * 512, s = idx >> 5, ch = idx & 31; const float r = rbuf[s];
        u32x4 v; v.x = pk2(bflo(tv[i].x) * r, bfhi(tv[i].x) * r); v.y = pk2(bflo(tv[i].y) * r, bfhi(tv[i].y) * r); v.z = pk2(bflo(tv[i].z) * r, bfhi(tv[i].z) * r); v.w = pk2(bflo(tv[i].w) * r, bfhi(tv[i].w) * r);
        *(LAS u32x4*)(Vb + s * RS + ch * 16) = v;
        u32x4 q; q.x = pk2(bflo(tu[i].x) * bflo(tz[i].x), bfhi(tu[i].x) * bfhi(tz[i].x)); q.y = pk2(bflo(tu[i].y) * bflo(tz[i].y), bfhi(tu[i].y) * bfhi(tz[i].y));
        q.z = pk2(bflo(tu[i].z) * bflo(tz[i].z), bfhi(tu[i].z) * bfhi(tz[i].z)); q.w = pk2(bflo(tu[i].w) * bflo(tz[i].w), bfhi(tu[i].w) * bfhi(tz[i].w));
        *(LAS u32x4*)(UZb + s * RS + ch * 16) = q; }
    __syncthreads();
    const int q = fr >> 2, p = fr & 3;
    bf16x8 Vf[4][2];
#pragma unroll
    for (int ks = 0; ks < 4; ++ks)
#pragma unroll
        for (int nn = 0; nn < 2; ++nn) { const LAS unsigned char* a0 = Vb + (32 * ks + 8 * fq + q) * RS + (wv * 32 + nn * 16 + 4 * p) * 2; Vf[ks][nn] = tr_read2(a0, a0 + 4 * RS); }
#pragma unroll
    for (int tb = 0; tb < 8; ++tb) {
        f32x4 acc0 = (f32x4){0.f, 0.f, 0.f, 0.f}, acc1 = acc0;
        const int t = tb * 16 + fr;
#pragma unroll
        for (int ks = 0; ks < 4; ++ks) if (ks <= (tb >> 1)) {
            const bf16x8 A = *(const bf16x8*)(SW + (size_t)(g * 128 + t) * 128 + ks * 32 + fq * 8);
            acc0 = __builtin_amdgcn_mfma_f32_16x16x32_bf16(Vf[ks][0], A, acc0, 0, 0, 0); acc1 = __builtin_amdgcn_mfma_f32_16x16x32_bf16(Vf[ks][1], A, acc1, 0, 0, 0);
        }
        const size_t m = (size_t)(m0 + t); const float bias = biasv[tb];
#pragma unroll
        for (int nn = 0; nn < 2; ++nn) { const int cl = wv * 32 + nn * 16 + fq * 4; const f32x4 acc = nn ? acc1 : acc0; const f32x4 gv = nn ? gv1 : gv0;
            const u32x2 uz = *(const LAS u32x2*)(UZb + t * RS + cl * 2);
            u32x2 o; o.x = pk2((acc[0] * gv.x + bias) * bflo(uz.x), (acc[1] * gv.y + bias) * bfhi(uz.x)); o.y = pk2((acc[2] * gv.z + bias) * bflo(uz.y), (acc[3] * gv.w + bias) * bfhi(uz.y));
            *(u32x2*)(BR1 + m * DM + g * 256 + cl) = o; }
    }
    __syncthreads();
}
__device__ __forceinline__ void attn_part(const KArgs& a, LAS unsigned char* lds, int rt, int g) {
    int tid_ = threadIdx.x; asm volatile("" : "+v"(tid_));
    const int tid = tid_, lane = tid & 63, wv = tid >> 6, fr = lane & 15, fq = lane >> 4;
    const int m0 = rt * 128, b = rt >> 4;
    const bf16* Q = (const bf16*)(a.ws + WS_PROJ) + (size_t)5 * MP * DM; const bf16* AZ = Q + (size_t)MP * DM;
    const bf16* KB = (const bf16*)(a.ws + WS_KB); const bf16* VB = (const bf16*)(a.ws + WS_VB); bf16* BR2 = (bf16*)(a.ws + WS_BR) + (size_t)2 * MP * DM;
    LAS unsigned char* Kb = lds;
    const size_t m = (size_t)(m0 + wv * 16 + fr);
    bf16x8 Qf[8];
    {
        u32x4 tk[16];
#pragma unroll
        for (int i = 0; i < 16; ++i) { const int idx = tid + i * 512, key = idx >> 5, ch = idx & 31; tk[i] = *(const u32x4*)(KB + (size_t)(b * 256 + key) * DM + g * 256 + ch * 8); }
#pragma unroll
        for (int ks = 0; ks < 8; ++ks) Qf[ks] = *(const bf16x8*)(Q + m * DM + g * 256 + ks * 32 + fq * 8);
#pragma unroll
        for (int i = 0; i < 16; ++i) { const int idx = tid + i * 512, key = idx >> 5, ch = idx & 31; *(LAS u32x4*)(Kb + key * RS + ch * 16) = tk[i]; }
    }
    __syncthreads();
    u32x4 tvv[16];
#pragma unroll
    for (int i = 0; i < 16; ++i) { const int idx = tid + i * 512, key = idx >> 5, ch = idx & 31; tvv[i] = *(const u32x4*)(VB + (size_t)(b * 256 + key) * DM + g * 256 + ch * 8); }
    f32x4 sacc[16];
#pragma unroll
    for (int kb = 0; kb < 16; ++kb) { sacc[kb] = (f32x4){0.f, 0.f, 0.f, 0.f};
#pragma unroll
        for (int ks = 0; ks < 8; ++ks) { const bf16x8 Kf = *(const LAS bf16x8*)(Kb + (kb * 16 + fr) * RS + (ks * 32 + fq * 8) * 2);
            sacc[kb] = __builtin_amdgcn_mfma_f32_16x16x32_bf16(Kf, Qf[ks], sacc[kb], 0, 0, 0); }
        if (kb & 1) __builtin_amdgcn_sched_barrier(0); }
    float mx = -3.0e38f;
#pragma unroll
    for (int kb = 0; kb < 16; ++kb) mx = fmaxf(mx, fmaxf(fmaxf(sacc[kb][0], sacc[kb][1]), fmaxf(sacc[kb][2], sacc[kb][3])));
    mx = fmaxf(mx, __shfl_xor(mx, 16)); mx = fmaxf(mx, __shfl_xor(mx, 32));
    float sum = 0.f;
#pragma unroll
    for (int kb = 0; kb < 16; ++kb)
#pragma unroll
        for (int j = 0; j < 4; ++j) { const float pj = __expf((sacc[kb][j] - mx) * 0.0625f); sacc[kb][j] = pj; sum += pj; }
    sum += __shfl_xor(sum, 16); sum += __shfl_xor(sum, 32);
    const float isum = 1.f / sum;
    bf16x8 Pf[8];
#pragma unroll
    for (int k2 = 0; k2 < 8; ++k2) { u32x4 w; w.x = pk2(sacc[2 * k2][0], sacc[2 * k2][1]); w.y = pk2(sacc[2 * k2][2], sacc[2 * k2][3]);
        w.z = pk2(sacc[2 * k2 + 1][0], sacc[2 * k2 + 1][1]); w.w = pk2(sacc[2 * k2 + 1][2], sacc[2 * k2 + 1][3]); Pf[k2] = __builtin_bit_cast(bf16x8, w); }
    __syncthreads();
#pragma unroll
    for (int i = 0; i < 16; ++i) { const int idx = tid + i * 512, key = idx >> 5, ch = idx & 31; *(LAS u32x4*)(Kb + key * RSV + ch * 16) = tvv[i]; }
    u32x2 zf[16];
#pragma unroll
    for (int db = 0; db < 16; ++db) zf[db] = *(const u32x2*)(AZ + m * DM + g * 256 + db * 16 + fq * 4);
    __syncthreads();
    const int q = fr >> 2, p = fr & 3;
#pragma unroll
    for (int db = 0; db < 16; ++db) {
        f32x4 o = (f32x4){0.f, 0.f, 0.f, 0.f};
#pragma unroll
        for (int k2 = 0; k2 < 8; ++k2) { const LAS unsigned char* a0 = Kb + (32 * k2 + 4 * fq + q) * RSV + (db * 16 + 4 * p) * 2;
            const bf16x8 Vf = tr_read2(a0, a0 + 16 * RSV); o = __builtin_amdgcn_mfma_f32_16x16x32_bf16(Vf, Pf[k2], o, 0, 0, 0); }
        const int c = g * 256 + db * 16 + fq * 4; const u32x2 z = zf[db];
        u32x2 w; w.x = pk2(o[0] * isum * bflo(z.x), o[1] * isum * bfhi(z.x)); w.y = pk2(o[2] * isum * bflo(z.y), o[3] * isum * bfhi(z.y));
        *(u32x2*)(BR2 + m * DM + c) = w;
        if (db & 1) __builtin_amdgcn_sched_barrier(0);
    }
    __syncthreads();
}
__device__ __forceinline__ void sgu_sample(const KArgs& a, int g, int rb) {
    int tid_ = threadIdx.x; asm volatile("" : "+v"(tid_));
    const int tid = tid_;
    const bf16* U = (const bf16*)(a.ws + WS_PROJ) + (size_t)2 * MP * DM; const bf16* V = U + (size_t)MP * DM; const bf16* SZ = V + (size_t)MP * DM;
    const float* VSS = (const float*)(a.ws + WS_VSS); bf16* BR1 = (bf16*)(a.ws + WS_BR) + (size_t)MP * DM;
    const float w00 = a.in[I_SGUW][(size_t)g * 128 * 128], b0 = a.in[I_SGUB][g * 128];
    for (int idx = tid; idx < 16 * 64; idx += 512) {
        const int i = rb * 16 + (idx >> 6), c = g * 256 + (idx & 63) * 4; const size_t m = (size_t)(MPR + i);
        const float s = wave_sum((idx & 63) < 16 ? VSS[m * 16 + (idx & 63)] : 0.f);
        const float rs = rsqrtf(s * (1.f / DM) + EPS);
        const f32x4 gv = *(const f32x4*)(a.in[I_SGUNG] + c);
        const u32x2 v4 = *(const u32x2*)(V + m * DM + c), u4 = *(const u32x2*)(U + m * DM + c), z = *(const u32x2*)(SZ + m * DM + c);
        f32x4 vn; vn.x = bflo(v4.x) * rs * gv.x; vn.y = bfhi(v4.x) * rs * gv.y; vn.z = bflo(v4.y) * rs * gv.z; vn.w = bfhi(v4.y) * rs * gv.w;
        *(f32x4*)(a.out + O_SV + (size_t)i * DM + c) = vn;
        u32x2 o; o.x = pk2(bflo(u4.x) * (w00 * vn.x + b0) * bflo(z.x), bfhi(u4.x) * (w00 * vn.y + b0) * bfhi(z.x));
        o.y = pk2(bflo(u4.y) * (w00 * vn.z + b0) * bflo(z.y), bfhi(u4.y) * (w00 * vn.w + b0) * bfhi(z.y));
        *(u32x2*)(BR1 + m * DM + c) = o;
    }
}
__device__ __forceinline__ void attn_sample(const KArgs& a, LAS unsigned char* lds, int i, int h) {
    int tid_ = threadIdx.x; asm volatile("" : "+v"(tid_));
    const int tid = tid_, lane = tid & 63, wv = tid >> 6;
    const bf16* Q = (const bf16*)(a.ws + WS_PROJ) + (size_t)5 * MP * DM; const bf16* AZ = Q + (size_t)MP * DM; bf16* BR2 = (bf16*)(a.ws + WS_BR) + (size_t)2 * MP * DM;
    const size_t m = (size_t)(MPR + i);
    const float* Kc = a.in[I_CK] + ((size_t)i * NMEM * 4 + h) * 256 + lane * 4;
    const float* Vc = a.in[I_CV] + ((size_t)i * NMEM * 4 + h) * 256 + lane * 4;
    LAS float* sc = (LAS float*)lds; LAS float* part = (LAS float*)(lds + 1024);
    const u32x2 q2 = *(const u32x2*)(Q + m * DM + h * 256 + lane * 4);
    const f32x4 qv = (f32x4){bflo(q2.x), bfhi(q2.x), bflo(q2.y), bfhi(q2.y)};
    {
        f32x4 kv[32]; float pd[32];
#pragma unroll
        for (int j = 0; j < 32; ++j) kv[j] = __builtin_nontemporal_load((const f32x4*)(Kc + (size_t)(wv * 32 + j) * 1024));
#pragma unroll
        for (int j = 0; j < 32; ++j) pd[j] = (kv[j].x * qv.x + kv[j].y * qv.y) + (kv[j].z * qv.z + kv[j].w * qv.w);
#pragma unroll
        for (int j = 0; j < 32; ++j) { const float d = wave_sum(pd[j]); if (lane == 0) sc[wv * 32 + j] = d * 0.0625f; }
    }
    f32x4 vv[32];
#pragma unroll
    for (int j = 0; j < 32; ++j) vv[j] = __builtin_nontemporal_load((const f32x4*)(Vc + (size_t)(wv * 32 + j) * 1024));
    __syncthreads();
    const f32x4 s4 = *(const LAS f32x4*)(sc + lane * 4);
    const float mx = wave_max(fmaxf(fmaxf(s4.x, s4.y), fmaxf(s4.z, s4.w)));
    const float sum = wave_sum((__expf(s4.x - mx) + __expf(s4.y - mx)) + (__expf(s4.z - mx) + __expf(s4.w - mx)));
    f32x4 o = (f32x4){0.f, 0.f, 0.f, 0.f};
#pragma unroll
    for (int j = 0; j < 32; ++j) { const float pj = __expf(sc[wv * 32 + j] - mx); o += vv[j] * pj; }
    *(LAS f32x4*)(part + wv * 256 + lane * 4) = o;
    __syncthreads();
    if (tid < 256) { float t = 0.f;
#pragma unroll
        for (int w8 = 0; w8 < 8; ++w8) t += part[w8 * 256 + tid];
        const int c = h * 256 + tid; const unsigned short zb = AZ[m * DM + c]; const float z = __builtin_bit_cast(float, (unsigned)zb << 16);
        BR2[m * DM + c] = (bf16)f2bf(t / sum * z); }
    __syncthreads();
}
__device__ __forceinline__ void p2_mixers(const KArgs& a, LAS unsigned char* lds, int G) {
    constexpr int NU = 512 + 512 + 4 + 32;
    if (G == 256) {
        const int c = blockIdx.x;
        for (int k = 0; k < 4; ++k) { const int kk = (c & 1) ? (k ^ 2) : k;
            if (kk < 2) { const int u = c + kk * 256, rt = u >> 2, g = u & 3; pool_part(a, lds, rt, g); sgu_part(a, lds, rt, g); attn_part(a, lds, rt, g); }
            else { const int e = c + (kk - 2) * 256; attn_sample(a, lds, e >> 2, e & 3); } }
        if (c < 4) pool_part(a, lds, 128, c); else if (c >= 8 && c < 40) sgu_sample(a, (c - 8) >> 3, (c - 8) & 7);
        return;
    }
    for (int u = blockIdx.x; u < NU; u += G) {
        if (u < 512) { const int rt = u >> 2, g = u & 3; pool_part(a, lds, rt, g); sgu_part(a, lds, rt, g); attn_part(a, lds, rt, g); }
        else if (u < 1024) { const int e = u - 512; attn_sample(a, lds, e >> 2, e & 3); }
        else if (u < 1028) pool_part(a, lds, 128, u - 1024);
        else sgu_sample(a, (u - 1028) >> 3, (u - 1028) & 7);
    }
}
__device__ __forceinline__ void p5_norm(const KArgs& a, int G) {
    const int tid = threadIdx.x, lane = tid & 63, wave = tid >> 6;
    const int gw = blockIdx.x * 8 + wave, NGW = G * 8;
    const f32x4* gr = (const f32x4*)a.in[I_NORMF] + lane;
    for (int m = gw; m < MV; m += NGW) {
        f32x4* xr = (f32x4*)(a.out + (size_t)m * DM) + lane;
        f32x4 v[4]; float s = 0.f;
#pragma unroll
        for (int j = 0; j < 4; ++j) { v[j] = xr[64 * j]; s += (v[j].x * v[j].x + v[j].y * v[j].y) + (v[j].z * v[j].z + v[j].w * v[j].w); }
        const float rs = rsqrtf(wave_sum(s) * (1.f / DM) + EPS);
#pragma unroll
        for (int j = 0; j < 4; ++j) { const f32x4 g = gr[64 * j]; xr[64 * j] = (f32x4){v[j].x * rs * g.x, v[j].y * rs * g.y, v[j].z * rs * g.z, v[j].w * rs * g.w}; }
    }
}

__global__ void __launch_bounds__(512, 2) fwd_megakernel(KArgs a) {
    extern __shared__ __attribute__((aligned(16))) unsigned char lds_raw[];
    LAS unsigned char* lds = (LAS unsigned char*)lds_raw;
    cg::grid_group grid = cg::this_grid();
    const int G = gridDim.x;
    const int lo = a.ph_lo, hi = a.ph_hi;
    volatile LAS unsigned* bst = (volatile LAS unsigned*)(lds + LDS_BYTES - 64);
    if (threadIdx.x == 0) { bst[0] = 0u; bst[1] = 0u; }
    __syncthreads();
    const XcdBarrier bar = xcd_barrier_post((unsigned*)(a.ws + WS_CTL), bst);
#define IN(k) (lo <= (k) && (k) < hi)
#define SEAM(k) do { if (IN(k) && IN((k) + 1)) { if (a.cg_sync) grid.sync(); else xcd_barrier(bar); } } while (0)
    if (IN(0)) p0_prologue(a, lds, G);
    SEAM(0);
    if (IN(1)) {
        pg8::Gemm g{(const bf16*)(a.ws + WS_H), (const bf16*)(a.ws + WS_WIN), MP, INC, DM};
        P1Order S; S.init(G, (int)blockIdx.x);
        EpiProj E{(bf16*)(a.ws + WS_PROJ), (bf16*)(a.ws + WS_GATE), (float*)(a.ws + WS_VSS), (bf16*)(a.ws + WS_KB), (bf16*)(a.ws + WS_VB), a.out, (const float*)(a.ws + WS_HS), (bf16*)(a.ws + WS_DS)};
        pg8::gemm_phase<EpiProj, P1Order>(lds, g, S, E);
    }
    SEAM(1);
    if (IN(2)) p2_mixers(a, lds, G);
    SEAM(2);
    if (IN(3)) {
        pg8::Gemm g{(const bf16*)(a.ws + WS_BR), (const bf16*)(a.ws + WS_WD), MPR, 3 * DM, DM};
        P3Order S; S.init(G, (int)blockIdx.x);
        EpiGate E{(const bf16*)(a.ws + WS_GATE), (bf16*)(a.ws + WS_MG)};
        pg8::gemm_phase<EpiGate, P3Order>(lds, g, S, E);
        EpiS3 E3{(const bf16*)(a.ws + WS_GATE), (bf16*)(a.ws + WS_GYS)};
        skinny_gemm(lds, (const bf16*)(a.ws + WS_BR) + (size_t)MPR * DM, DM, (size_t)MP * DM, 64, 1, 0, (const bf16*)(a.ws + WS_WD), DM, DM, 192, (int)blockIdx.x, G, E3);
    }
    SEAM(3);
    if (IN(4)) {
        pg8::Gemm g{(const bf16*)(a.ws + WS_MG), (const bf16*)(a.ws + WS_WO3), MPR, DM, DM};
        pg8::StaticOrder S; S.init(MPR, DM, G, (int)blockIdx.x);
        unsigned* ctl = (unsigned*)(a.ws + WS_CTL);
        EpiOutNorm E{a.in[I_XP], a.in[I_NORMF], a.out, (float*)(a.ws + WS_VSS), ctl + CW_PANEL};
        pg8::gemm_phase<EpiOutNorm, pg8::StaticOrder>(lds, g, S, E);
        sample_out_split(a, lds, (int)blockIdx.x);
    }
#undef IN
#undef SEAM
}

extern "C" void kernel_launch(void* const* d_in, const int* in_sizes, int n_in, void* d_out, int out_size, void* d_ws, size_t ws_size, hipStream_t stream) {
    static int grid = 0;
    if (grid == 0) {
        if (n_in != 18 || (size_t)out_size != O_END || ws_size < WS_END) { fprintf(stderr, "kernel_launch: unexpected shapes (n_in %d out %d ws %zu, need %zu)\n", n_in, out_size, ws_size, (size_t)WS_END); grid = -1; return; }
        int dev = 0, cus = 0, per_cu = 0;
        hipGetDevice(&dev); hipDeviceGetAttribute(&cus, hipDeviceAttributeMultiprocessorCount, dev);
        if (hipFuncSetAttribute((const void*)fwd_megakernel, hipFuncAttributeMaxDynamicSharedMemorySize, LDS_BYTES) != hipSuccess) { fprintf(stderr, "kernel_launch: hipFuncSetAttribute failed\n"); grid = -1; return; }
        if (hipOccupancyMaxActiveBlocksPerMultiprocessor(&per_cu, (const void*)fwd_megakernel, 512, LDS_BYTES) != hipSuccess || per_cu < 1) { fprintf(stderr, "kernel_launch: occupancy query failed (%d)\n", per_cu); grid = -1; return; }
        if (cus != 256) { fprintf(stderr, "kernel_launch: built for a 256-CU device (one 256x256 tile per workgroup in the last two phases), got %d\n", cus); grid = -1; return; }
        grid = cus;
    }
    if (grid < 0) return;
    if (hipMemsetAsync((char*)d_ws + WS_CTL, 0, CTL_BYTES, stream) != hipSuccess) { fprintf(stderr, "kernel_launch: memset failed\n"); return; }
    KArgs a{};
    for (int i = 0; i < 18; ++i) a.in[i] = (const float*)d_in[i];
    a.out = (float*)d_out; a.ws = (unsigned char*)d_ws; a.ph_lo = 0; a.ph_hi = 5;
    void* args[] = {&a};
    hipError_t e = hipLaunchCooperativeKernel((const void*)fwd_megakernel, dim3(grid), dim3(512), args, LDS_BYTES, stream);
    if (e != hipSuccess) fprintf(stderr, "cooperative launch failed: %s (grid %d)\n", hipGetErrorString(e), grid);
}
```

```cpp
#include <hip/hip_runtime.h>
#include <hip/hip_cooperative_groups.h>
#include <cstdio>
#include <cstdint>
namespace cg = cooperative_groups;

#define LAS __attribute__((address_space(3)))
typedef unsigned short bf16;
typedef short bf16x8 __attribute__((ext_vector_type(8)));
typedef short s16x4 __attribute__((ext_vector_type(4)));
typedef float f32x4 __attribute__((ext_vector_type(4)));
typedef unsigned u32x4 __attribute__((ext_vector_type(4)));
typedef unsigned u32x2 __attribute__((ext_vector_type(2)));

constexpr int DM = 1024, NBATCH = 8, SEQ = 2048, NS = 128, NMEM = 256;
constexpr int MPR = NBATCH * SEQ;
constexpr int MV = MPR + NS;
constexpr int MP = MPR + 256;
constexpr int NPAN = MP / 256;
constexpr int INC = 10240;
constexpr float EPS = 1e-6f;
constexpr size_t O_YP = 0, O_YS = O_YP + (size_t)MPR * DM, O_POOLP = O_YS + (size_t)NS * DM, O_POOLS = O_POOLP + (size_t)NBATCH * 15 * DM,
                 O_MK = O_POOLS + (size_t)NS * 15 * DM, O_MV = O_MK + (size_t)NBATCH * NMEM * DM, O_SV = O_MV + (size_t)NBATCH * NMEM * DM, O_END = O_SV + (size_t)NS * DM;
constexpr size_t ROWB = (size_t)MP * DM * 2;
constexpr size_t WS_CTL = 0, CTL_BYTES = 40960;
constexpr size_t WS_VSS2 = CTL_BYTES;
constexpr size_t WS_DS = WS_VSS2 + 32768;
constexpr size_t WS_HS = WS_DS + 262144;
constexpr size_t WS_H = WS_HS + 524288;
constexpr size_t WS_WIN = WS_H + (size_t)(MP + 2048) * DM * 2;
constexpr size_t WS_WD = WS_WIN + (size_t)(INC + 2048) * DM * 2;
constexpr size_t WS_WO3 = WS_WD + (size_t)3 * DM * DM * 2;
constexpr size_t WS_PW = WS_WO3 + (size_t)3 * DM * DM * 2;
constexpr size_t WS_SW = WS_PW + (size_t)4 * 256 * 256 * 2;
constexpr size_t WS_VSS = WS_SW + (size_t)4 * 128 * 128 * 2;
constexpr size_t WS_KB = WS_VSS + (size_t)MP * 16 * 4;
constexpr size_t WS_VB = WS_KB + (size_t)2048 * DM * 2;
constexpr size_t WS_PROJ = WS_VB + (size_t)2048 * DM * 2;
constexpr size_t WS_GATE = WS_PROJ + 7 * ROWB;
constexpr size_t WS_BR = WS_GATE + 3 * ROWB;
constexpr size_t WS_MG = WS_PROJ;
constexpr size_t WS_GYS = WS_H;
constexpr size_t WS_END = WS_BR + 3 * ROWB;
constexpr int LDS_BYTES = 147456;
constexpr int CW_PANEL = 4096, CW_SAMPLE = 4096 + 64 * 64;

__device__ __forceinline__ unsigned f2bf(float f) { unsigned u = __builtin_bit_cast(unsigned, f); return (u + 0x7fffu + ((u >> 16) & 1u)) >> 16; }
__device__ __forceinline__ unsigned pk2(float lo, float hi) { unsigned r; asm volatile("v_cvt_pk_bf16_f32 %0, %1, %2" : "=v"(r) : "v"(lo), "v"(hi)); return r; }
__device__ __forceinline__ float bflo(unsigned w) { return __builtin_bit_cast(float, w << 16); }
__device__ __forceinline__ float bfhi(unsigned w) { return __builtin_bit_cast(float, w & 0xffff0000u); }
__device__ __forceinline__ float silu_f(float x) { return x * __builtin_amdgcn_rcpf(1.f + __expf(-x)); }
__device__ __forceinline__ float sigm_f(float x) { return __builtin_amdgcn_rcpf(1.f + __expf(-x)); }
__device__ __forceinline__ float wave_sum(float v) {
#pragma unroll
    for (int o = 1; o < 64; o <<= 1) v += __shfl_xor(v, o);
    return v;
}
__device__ __forceinline__ float wave_max(float v) {
#pragma unroll
    for (int o = 1; o < 64; o <<= 1) v = fmaxf(v, __shfl_xor(v, o));
    return v;
}
__device__ __forceinline__ bf16x8 tr_read2(const LAS unsigned char* a0, const LAS unsigned char* a1) {
    const s16x4 lo = __builtin_amdgcn_ds_read_tr16_b64_v4i16((LAS s16x4*)a0);
    const s16x4 hi = __builtin_amdgcn_ds_read_tr16_b64_v4i16((LAS s16x4*)a1);
    return (bf16x8){lo[0], lo[1], lo[2], lo[3], hi[0], hi[1], hi[2], hi[3]};
}

#define XB_TMO      128
#define XB_XCNT(j)  (256  + 64 * (j))
#define XB_XSUB(j)  (1280 + 64 * (j))
#define XB_XGEN(j)  (2304 + 64 * (j))
#define XB_TOP      3328
#define XB_TOPGEN   3392
#define XCD_BAR_WORDS 3456
#define XB_SPIN_CAP (1u << 18)

__device__ __forceinline__ unsigned xb_ld(unsigned* p)              { return __hip_atomic_load(p, __ATOMIC_RELAXED, __HIP_MEMORY_SCOPE_AGENT); }
__device__ __forceinline__ unsigned xb_add(unsigned* p, unsigned v) { return __hip_atomic_fetch_add(p, v, __ATOMIC_RELAXED, __HIP_MEMORY_SCOPE_AGENT); }
__device__ __forceinline__ unsigned xb_xcc_id() { return (unsigned)__builtin_amdgcn_s_getreg((3 << 11) | 20) & 0xFu; }
#define XB_SPIN(cond, bar) do { unsigned _sp = 0; while (cond) { __builtin_amdgcn_s_sleep(1); \
    if ((++_sp & 255u) == 0u) { if (xb_ld(&(bar)[XB_TMO])) break; if (_sp > XB_SPIN_CAP) { atomicAdd(&(bar)[XB_TMO], 1u); break; } } } } while (0)

struct XcdBarrier {
    unsigned* bar; unsigned x;
    volatile LAS unsigned* st;
};

__device__ __forceinline__ XcdBarrier xcd_barrier_post(unsigned* bar, volatile LAS unsigned* st) {
    XcdBarrier b; b.bar = bar; b.x = xb_xcc_id(); b.st = st;
    if (threadIdx.x == 0) (void)xb_add(&bar[XB_XCNT(b.x)], 1u);
    return b;
}
__device__ __forceinline__ void xcd_barrier_complete(unsigned* bar, unsigned x, unsigned& nloc, unsigned& nx) {
    const unsigned G = gridDim.x;
    unsigned sum, cnt, mine, sp = 0u;
    for (;;) {
        sum = 0u; cnt = 0u; mine = 0u;
#pragma unroll
        for (unsigned j = 0; j < 16; ++j) { const unsigned c = xb_ld(&bar[XB_XCNT(j)]); sum += c; cnt += (c > 0u) ? 1u : 0u; mine = (j == x) ? c : mine; }
        if (sum == G) break;
        __builtin_amdgcn_s_sleep(1);
        if ((++sp & 255u) == 0u) { if (xb_ld(&bar[XB_TMO])) break; if (sp > XB_SPIN_CAP) { atomicAdd(&bar[XB_TMO], 1u); break; } }
    }
    nloc = mine > 0u ? mine : 1u; nx = cnt > 0u ? cnt : 1u;
}

__device__ __forceinline__ void xcd_barrier(const XcdBarrier& b) {
    asm volatile("s_waitcnt vmcnt(0)" ::: "memory");
    __syncthreads();
    if (threadIdx.x == 0) {
        unsigned* bar = b.bar;
        __builtin_amdgcn_s_waitcnt(0);
        unsigned nloc = b.st[0], nx = b.st[1];
        if (nloc == 0u) { xcd_barrier_complete(bar, b.x, nloc, nx); b.st[0] = nloc; b.st[1] = nx; }
        const unsigned old = xb_add(&bar[XB_XSUB(b.x)], 1u);
        const unsigned gen = old / nloc;
        if (old + 1u == (gen + 1u) * nloc) {
            __builtin_amdgcn_fence(__ATOMIC_RELEASE, "agent");
            asm volatile("s_waitcnt vmcnt(0)" ::: "memory");
            const unsigned og = xb_add(&bar[XB_TOP], 1u);
            const unsigned tg = og / nx;
            if (og + 1u == (tg + 1u) * nx) xb_add(&bar[XB_TOPGEN], 1u);
            else XB_SPIN(xb_ld(&bar[XB_TOPGEN]) == tg, bar);
            __builtin_amdgcn_fence(__ATOMIC_ACQUIRE, "agent");
            xb_add(&bar[XB_XGEN(b.x)], 1u);
            asm volatile("s_waitcnt vmcnt(0)" ::: "memory");
        } else {
            XB_SPIN(xb_ld(&bar[XB_XGEN(b.x)]) == gen, bar);
            __builtin_amdgcn_fence(__ATOMIC_ACQUIRE, "agent");
            asm volatile("s_waitcnt vmcnt(0)" ::: "memory");
        }
    }
    __syncthreads();
}

namespace pg8 {
#define PG8_LAS __attribute__((address_space(3)))
typedef unsigned short bf16_t;
constexpr int BM = 256, BK = 64, HALF = 128, HTB = HALF * BK * 2, STAGE_BYTES = 8 * HTB, NXCD = 8, WGM = 8;
__host__ __device__ __forceinline__ int lds_byte(int r, int c) { const int st = (r >> 4) * 2 + (c >> 5), rr = r & 15, cc = c & 31, ob = rr * 64 + cc * 2; return st * 1024 + (ob ^ (((ob >> 9) & 1) << 5)); }
__host__ __device__ __forceinline__ void stage_rc(int b, int& R, int& C) { const int st = b / 1024, sb = b % 1024, swz = sb ^ (((sb >> 9) & 1) << 5); R = (st >> 1) * 16 + swz / 64; C = (st & 1) * 32 + (swz % 64) / 2; }
__host__ __device__ __forceinline__ int perm32(int rho) { const int n = rho >> 4, i = rho & 15; return 8 * (i >> 2) + 4 * n + (i & 3); }
struct Unit { int pm, pn; };
struct Gemm { const bf16_t* A; const bf16_t* Bt; int M, N, K; };
struct StaticOrder {
    int nM, nN, nwg, G, c;
    __host__ __device__ void init(int M, int N, int G_, int c_) { nM = M / BM; nN = N / BM; nwg = nM * nN; G = G_; c = c_; }
    __host__ __device__ bool next(int i, Unit& u) const {
        const long L = (long)i * G + c; if (L >= nwg) return false;
        int wgid = (int)L; { const int q = nwg / NXCD, r = nwg % NXCD, xcd = wgid % NXCD, off = wgid / NXCD; wgid = (xcd < r ? xcd * (q + 1) : r * (q + 1) + (xcd - r) * q) + off; }
        const int nig = WGM * nN, gid = wgid / nig, fm = gid * WGM, gsz = (nM - fm) < WGM ? (nM - fm) : WGM;
        u.pm = fm + ((wgid % nig) % gsz); u.pn = (wgid % nig) / gsz; return true;
    }
    __device__ __forceinline__ void a_ready(const Unit&) const {}
    __device__ __forceinline__ void done(const Unit&) const {}
};

template <class Epi, class Sched>
__device__ __forceinline__ void gemm_phase(PG8_LAS unsigned char* lds, const Gemm g, const Sched& S, const Epi& E) {
    const int tid = threadIdx.x, wid = __builtin_amdgcn_readfirstlane(tid >> 6), lane = tid & 63, wr = wid >> 2, wc = wid & 3, fr = lane & 15, fq = lane >> 4;
    const int K = g.K, nt = K / BK;
    unsigned voffA[2], voffB[2];
#pragma unroll
    for (int i = 0; i < 2; ++i) { int R, C; stage_rc(tid * 16 + i * 8192, R, C); const int Rb = Epi::PERM ? ((R & ~31) + perm32(R & 31)) : R;
        voffA[i] = (unsigned)(R * K + C) * 2u; voffB[i] = (unsigned)(Rb * K + C) * 2u; }
    const size_t kstep = (size_t)(BK * 2);
    const size_t hstep = (size_t)HALF * K * 2;
    const size_t tstep = 2 * hstep;
    const unsigned ldsw = (unsigned)wid * 1024u;
    const int aoff = lds_byte(wr * 64 + fr, fq * 8), boff = lds_byte(wc * 32 + fr, fq * 8);
#define PG8_SA(b, h) (((b) * 2 + (h)) * HTB)
#define PG8_SB(b, h) ((4 + (b) * 2 + (h)) * HTB)
#define PG8_STAGE(bufoff, gbase, voff) do { _Pragma("unroll") for (int _i = 0; _i < 2; ++_i) \
        __builtin_amdgcn_global_load_lds((const unsigned*)((const char*)(gbase) + (voff)[_i]), (PG8_LAS unsigned*)(lds + (bufoff) + ldsw + _i * 8192), 16, 0, 0); } while (0)
#define PG8_LDA(dst, b, h) do { _Pragma("unroll") for (int m = 0; m < 4; ++m) _Pragma("unroll") for (int k = 0; k < 2; ++k) dst[m][k] = *(const PG8_LAS bf16x8*)(lds + PG8_SA(b, h) + aoff + m * 2048 + k * 1024); } while (0)
#define PG8_LDB(dst, b, h) do { _Pragma("unroll") for (int n = 0; n < 2; ++n) _Pragma("unroll") for (int k = 0; k < 2; ++k) dst[n][k] = *(const PG8_LAS bf16x8*)(lds + PG8_SB(b, h) + boff + n * 2048 + k * 1024); } while (0)
#define PG8_MMA(ai, bj, At, Bt) do { __builtin_amdgcn_s_setprio(1); _Pragma("unroll") for (int m = 0; m < 4; ++m) _Pragma("unroll") for (int n = 0; n < 2; ++n) _Pragma("unroll") for (int k = 0; k < 2; ++k) \
        acc[ai][bj][m][n] = __builtin_amdgcn_mfma_f32_16x16x32_bf16(Bt[n][k], At[m][k], acc[ai][bj][m][n], 0, 0, 0); __builtin_amdgcn_s_setprio(0); } while (0)
#define PG8_WAIT_V(n) asm volatile("s_waitcnt vmcnt(" #n ")" ::: "memory")
#define PG8_WAIT_L(n) asm volatile("s_waitcnt lgkmcnt(" #n ")" ::: "memory")
#define PG8_BAR __builtin_amdgcn_s_barrier()
#define PG8_SCHED __builtin_amdgcn_sched_barrier(0)
    Unit cur, nxt; int ui = 0;
    if (!S.next(0, cur)) return;
    f32x4 acc[2][2][4][2];
#pragma unroll
    for (int a = 0; a < 2; ++a)
#pragma unroll
        for (int b = 0; b < 2; ++b)
#pragma unroll
            for (int m = 0; m < 4; ++m)
#pragma unroll
                for (int n = 0; n < 2; ++n) acc[a][b][m][n] = (f32x4){0.f, 0.f, 0.f, 0.f};
    bf16x8 At[4][2], B0[2][2], B1[2][2];
    const char* cA = (const char*)g.A + (size_t)cur.pm * tstep; const char* cB = (const char*)g.Bt + (size_t)cur.pn * tstep;
    S.a_ready(cur);
    PG8_STAGE(PG8_SB(0, 0), cB, voffB); PG8_STAGE(PG8_SA(0, 0), cA, voffA); PG8_STAGE(PG8_SB(0, 1), cB + hstep, voffB); PG8_STAGE(PG8_SA(0, 1), cA + hstep, voffA);
    if (wr == 1) PG8_BAR;
    PG8_WAIT_V(4); PG8_BAR;
    PG8_STAGE(PG8_SB(1, 0), cB + kstep, voffB); PG8_STAGE(PG8_SA(1, 0), cA + kstep, voffA); PG8_STAGE(PG8_SB(1, 1), cB + hstep + kstep, voffB);
    PG8_WAIT_V(6); PG8_BAR;
    for (;;) {
        const bool has_next = S.next(ui + 1, nxt);
        const char* nA = has_next ? (const char*)g.A + (size_t)nxt.pm * tstep : cA; const char* nB = has_next ? (const char*)g.Bt + (size_t)nxt.pn * tstep : cB;
        E.prefetch(cur, wid, lane, lds + STAGE_BYTES + wid * 1024);
        for (int t = 0; t < nt; t += 2) {
            const bool last = (t == nt - 2);
            const char* a1 = cA + (size_t)(t + 1) * kstep;
            const char* a2 = last ? nA : cA + (size_t)(t + 2) * kstep; const char* b2 = last ? nB : cB + (size_t)(t + 2) * kstep;
            const char* a3 = a2 + kstep; const char* b3 = b2 + kstep;
            if (last && has_next) S.a_ready(nxt);
            PG8_LDB(B0, 0, 0); PG8_SCHED; PG8_LDA(At, 0, 0); PG8_STAGE(PG8_SA(1, 1), a1 + hstep, voffA);
            PG8_WAIT_L(8); PG8_BAR; PG8_WAIT_L(0); PG8_MMA(0, 0, At, B0); PG8_BAR; PG8_SCHED;
            PG8_LDB(B1, 0, 1); PG8_STAGE(PG8_SB(0, 0), b2, voffB);
            PG8_BAR; PG8_WAIT_L(0); PG8_MMA(0, 1, At, B1); PG8_BAR;
            PG8_LDA(At, 0, 1); PG8_STAGE(PG8_SA(0, 0), a2, voffA);
            PG8_BAR; PG8_WAIT_L(0); PG8_MMA(1, 0, At, B0); PG8_BAR; PG8_SCHED;
            PG8_STAGE(PG8_SB(0, 1), b2 + hstep, voffB);
            PG8_WAIT_V(6); PG8_BAR; PG8_MMA(1, 1, At, B1); PG8_BAR;
            PG8_LDB(B0, 1, 0); PG8_SCHED; PG8_LDA(At, 1, 0); PG8_STAGE(PG8_SA(0, 1), a2 + hstep, voffA);
            PG8_WAIT_L(8); PG8_BAR; PG8_WAIT_L(0); PG8_MMA(0, 0, At, B0); PG8_BAR; PG8_SCHED;
            PG8_LDB(B1, 1, 1); PG8_STAGE(PG8_SB(1, 0), b3, voffB);
            PG8_BAR; PG8_WAIT_L(0); PG8_MMA(0, 1, At, B1); PG8_BAR;
            PG8_LDA(At, 1, 1); PG8_STAGE(PG8_SA(1, 0), a3, voffA);
            PG8_BAR; PG8_WAIT_L(0); PG8_MMA(1, 0, At, B0); PG8_BAR; PG8_SCHED;
            PG8_STAGE(PG8_SB(1, 1), b3 + hstep, voffB);
            PG8_WAIT_V(6); PG8_BAR; PG8_MMA(1, 1, At, B1); PG8_BAR;
        }
        if constexpr (!Epi::AFTER_DRAIN) { E(acc, cur, wr, wc, fr, fq); S.done(cur); }
        if (!has_next) break;
#pragma unroll
        for (int a = 0; a < 2; ++a)
#pragma unroll
            for (int b = 0; b < 2; ++b)
#pragma unroll
                for (int m = 0; m < 4; ++m)
#pragma unroll
                    for (int n = 0; n < 2; ++n) acc[a][b][m][n] = (f32x4){0.f, 0.f, 0.f, 0.f};
        cur = nxt; cA = nA; cB = nB; ++ui;
    }
    PG8_WAIT_V(0);
    if (wr == 0) PG8_BAR;
    PG8_BAR;
    if constexpr (Epi::AFTER_DRAIN) { E.fused(acc, cur, wr, wc, fr, fq); S.done(cur); }
#undef PG8_SA
#undef PG8_SB
#undef PG8_STAGE
#undef PG8_LDA
#undef PG8_LDB
#undef PG8_MMA
#undef PG8_WAIT_V
#undef PG8_WAIT_L
#undef PG8_BAR
#undef PG8_SCHED
}
}

struct KArgs {
    const float* in[18];
    float* out;
    unsigned char* ws;
    int ph_lo, ph_hi;
    int cg_sync, pad;
};
enum { I_XP = 0, I_XS, I_SPOOL, I_CK, I_CV, I_MEM, I_NORMG, I_WIN, I_POOLW, I_POOLSC, I_SGUNG, I_SGUW, I_SGUB, I_MEMNG, I_WKV, I_WDOWN, I_WOUT, I_NORMF };

struct P1Order {
    pg8::StaticOrder so; int G, c;
    __device__ void init(int G_, int c_) { so.init(MPR, INC, G_, c_); G = G_; c = c_; }
    __device__ bool next(int i, pg8::Unit& u) const {
        const long L = (long)i * G + c;
        if (L < so.nwg) return so.next(i, u);
        const int e = (int)(L - so.nwg); if (e >= 104) return false;
        if (e < 64) { u.pm = NPAN + (e >> 3); u.pn = 40 + (e & 7); } else { u.pm = 64; u.pn = e - 64; }
        return true;
    }
    __device__ __forceinline__ void a_ready(const pg8::Unit&) const {}
    __device__ __forceinline__ void done(const pg8::Unit&) const {}
};
struct EpiProj {
    static constexpr bool PERM = true, AFTER_DRAIN = false;
    bf16* proj; bf16* gate; float* vss; bf16* kb; bf16* vb; float* out; const float* hs; bf16* dsr;
    __device__ __forceinline__ void prefetch(const pg8::Unit&, int, int, LAS unsigned char*) const {}
    __device__ __forceinline__ void operator()(const f32x4 (&acc)[2][2][4][2], const pg8::Unit& u, int wr, int wc, int fr, int fq) const {
        if (u.pn < 40) {
            const int sec = u.pn >> 2;
            const int act = (sec == 1 || sec == 4 || sec == 6) ? 1 : (sec >= 7 ? 2 : 0);
            const int row0 = u.pm * 256 + wr * 64 + fr, cs0 = (u.pn & 3) * 256 + wc * 32 + 8 * fq;
            bf16* base; int ld;
            if (sec < 7) { base = proj + (size_t)sec * MP * DM; ld = DM; } else { base = gate + (sec - 7) * DM; ld = 3 * DM; }
            const bool poolrows = (sec == 0) && (((u.pm & 7) == 7) || u.pm == 64);
#pragma unroll
            for (int ai = 0; ai < 2; ++ai)
#pragma unroll
                for (int m = 0; m < 4; ++m) {
                    const int r = row0 + ai * 128 + m * 16; float ss = 0.f;
#pragma unroll
                    for (int bj = 0; bj < 2; ++bj) {
                        f32x4 v0 = acc[ai][bj][m][0], v1 = acc[ai][bj][m][1]; const int cs = cs0 + bj * 128;
                        if (sec == 3) ss += (v0[0] * v0[0] + v0[1] * v0[1]) + (v0[2] * v0[2] + v0[3] * v0[3]) + (v1[0] * v1[0] + v1[1] * v1[1]) + (v1[2] * v1[2] + v1[3] * v1[3]);
                        if (poolrows) {
                            float* dst = nullptr;
                            if (r < MPR) { const int t = r & (SEQ - 1); if (t >= SEQ - 15) dst = out + O_POOLP + ((size_t)(r >> 11) * 15 + (t - (SEQ - 15))) * DM + cs; }
                            else if (r < MV) { dst = out + O_POOLS + ((size_t)(r - MPR) * 15 + 14) * DM + cs;
                                const float* hp = hs + (size_t)(r - MPR) * DM + cs; const f32x4 h0 = *(const f32x4*)hp, h1 = *(const f32x4*)(hp + 4); const float inv = 1.f / (float)(2 << (cs >> 8));
                                u32x4 d; d.x = pk2((h0.x + v0[0]) * inv - v0[0], (h0.y + v0[1]) * inv - v0[1]); d.y = pk2((h0.z + v0[2]) * inv - v0[2], (h0.w + v0[3]) * inv - v0[3]);
                                d.z = pk2((h1.x + v1[0]) * inv - v1[0], (h1.y + v1[1]) * inv - v1[1]); d.w = pk2((h1.z + v1[2]) * inv - v1[2], (h1.w + v1[3]) * inv - v1[3]);
                                *(u32x4*)(dsr + (size_t)(r - MPR) * DM + cs) = d; }
                            if (dst) { *(f32x4*)dst = v0; *(f32x4*)(dst + 4) = v1; }
                        }
                        if (act == 1) {
#pragma unroll
                            for (int j = 0; j < 4; ++j) { v0[j] = silu_f(v0[j]); v1[j] = silu_f(v1[j]); } }
                        if (act == 2) {
#pragma unroll
                            for (int j = 0; j < 4; ++j) { v0[j] = sigm_f(v0[j]); v1[j] = sigm_f(v1[j]); } }
                        u32x4 w; w.x = pk2(v0[0], v0[1]); w.y = pk2(v0[2], v0[3]); w.z = pk2(v1[0], v1[1]); w.w = pk2(v1[2], v1[3]);
                        __builtin_nontemporal_store(w, (u32x4*)(base + (size_t)r * ld + cs));
                    }
                    if (sec == 3) { ss += __shfl_xor(ss, 16); ss += __shfl_xor(ss, 32); if (fq == 0) vss[(size_t)r * 16 + (u.pn & 3) * 4 + wc] = ss; }
                }
        } else {
            const int b = u.pm - NPAN, ct = (u.pn - 40) * 256;
            const bool isv = ct >= DM; const int cb = (isv ? ct - DM : ct) + wc * 32 + 8 * fq;
            float* of = out + (isv ? O_MV : O_MK); bf16* ob = isv ? vb : kb;
#pragma unroll
            for (int ai = 0; ai < 2; ++ai)
#pragma unroll
                for (int m = 0; m < 4; ++m) {
                    const size_t j = (size_t)b * 256 + ai * 128 + wr * 64 + m * 16 + fr;
#pragma unroll
                    for (int bj = 0; bj < 2; ++bj) {
                        const f32x4 v0 = acc[ai][bj][m][0], v1 = acc[ai][bj][m][1]; const int cs = cb + bj * 128;
                        __builtin_nontemporal_store(v0, (f32x4*)(of + j * DM + cs)); __builtin_nontemporal_store(v1, (f32x4*)(of + j * DM + cs + 4));
                        u32x4 w; w.x = pk2(v0[0], v0[1]); w.y = pk2(v0[2], v0[3]); w.z = pk2(v1[0], v1[1]); w.w = pk2(v1[2], v1[3]);
                        *(u32x4*)(ob + j * DM + cs) = w;
                    }
                }
        }
    }
};
struct P3Order {
    pg8::StaticOrder so;
    __device__ void init(int G_, int c_) { so.init(MPR, DM, G_, c_); }
    __device__ bool next(int i, pg8::Unit& u) const { const int rnd = i / 3, b = i - 3 * rnd; pg8::Unit t; if (!so.next(rnd, t)) return false; u.pm = b * NPAN + t.pm; u.pn = b * 4 + t.pn; return true; }
    __device__ __forceinline__ void a_ready(const pg8::Unit&) const {}
    __device__ __forceinline__ void done(const pg8::Unit&) const {}
};
struct EpiGate {
    static constexpr bool PERM = true, AFTER_DRAIN = false;
    const bf16* gate; bf16* mg;
    __device__ __forceinline__ void prefetch(const pg8::Unit& u, int wid, int lane, LAS unsigned char* scr) const {
        const int b = u.pn >> 2, pm = u.pm - b * NPAN, t = wid * 64 + lane;
#pragma unroll
        for (int j = 0; j < 2; ++j) { const int li = t + 512 * j, row = li >> 2, seg = li & 3; const size_t r = (size_t)(pm * 256 + row);
            __builtin_amdgcn_global_load_lds((const unsigned*)(gate + r * (3 * DM) + b * DM + (u.pn & 3) * 256 + seg * 64), (LAS unsigned*)(scr + j * 256), 4, 0, 0); }
    }
    __device__ __forceinline__ void operator()(const f32x4 (&acc)[2][2][4][2], const pg8::Unit& u, int wr, int wc, int fr, int fq) const {
        const int b = u.pn >> 2, pm = u.pm - b * NPAN;
        const int row0 = pm * 256 + wr * 64 + fr, c0 = (u.pn & 3) * 256 + wc * 32 + 8 * fq;
#pragma unroll
        for (int ai = 0; ai < 2; ++ai)
#pragma unroll
            for (int m = 0; m < 4; ++m) {
                const size_t r = (size_t)(row0 + ai * 128 + m * 16);
#pragma unroll
                for (int bj = 0; bj < 2; ++bj) {
                    const f32x4 v0 = acc[ai][bj][m][0], v1 = acc[ai][bj][m][1]; const int c = c0 + bj * 128;
                    const u32x4 g8 = *(const u32x4*)(gate + r * (3 * DM) + b * DM + c);
                    float o0 = v0[0] * bflo(g8.x), o1 = v0[1] * bfhi(g8.x), o2 = v0[2] * bflo(g8.y), o3 = v0[3] * bfhi(g8.y);
                    float o4 = v1[0] * bflo(g8.z), o5 = v1[1] * bfhi(g8.z), o6 = v1[2] * bflo(g8.w), o7 = v1[3] * bfhi(g8.w);
                    if (b > 0) { const u32x4 p = *(const u32x4*)(mg + r * DM + c);
                        o0 += bflo(p.x); o1 += bfhi(p.x); o2 += bflo(p.y); o3 += bfhi(p.y); o4 += bflo(p.z); o5 += bfhi(p.z); o6 += bflo(p.w); o7 += bfhi(p.w); }
                    u32x4 w; w.x = pk2(o0, o1); w.y = pk2(o2, o3); w.z = pk2(o4, o5); w.w = pk2(o6, o7);
                    if (b == 2) __builtin_nontemporal_store(w, (u32x4*)(mg + r * DM + c)); else *(u32x4*)(mg + r * DM + c) = w;
                }
            }
    }
};
__device__ __forceinline__ void st_agent(float* p, float v) { __hip_atomic_store((unsigned*)p, __builtin_bit_cast(unsigned, v), __ATOMIC_RELAXED, __HIP_MEMORY_SCOPE_AGENT); }
__device__ __forceinline__ float ld_agent(const float* p) { return __builtin_bit_cast(float, __hip_atomic_load((unsigned*)p, __ATOMIC_RELAXED, __HIP_MEMORY_SCOPE_AGENT)); }
__device__ __forceinline__ void wait_count(unsigned* w, unsigned want) {
    unsigned sp = 0;
    while ((unsigned)__builtin_amdgcn_readfirstlane(__hip_atomic_load(w, __ATOMIC_RELAXED, __HIP_MEMORY_SCOPE_AGENT)) < want) { __builtin_amdgcn_s_sleep(2); if (++sp > (1u << 22)) break; }
    __builtin_amdgcn_fence(__ATOMIC_ACQUIRE, "agent");
    asm volatile("s_waitcnt vmcnt(0)" ::: "memory");
}
struct EpiOutNorm {
    static constexpr bool PERM = false, AFTER_DRAIN = true;
    const float* xp; const float* gf; float* out; float* slots; unsigned* cnt;
    __device__ __forceinline__ void prefetch(const pg8::Unit& u, int wid, int lane, LAS unsigned char* scr) const {
        const int t = wid * 64 + lane;
#pragma unroll
        for (int j = 0; j < 4; ++j) { const int li = t + 512 * j, row = li >> 3, seg = li & 7;
            __builtin_amdgcn_global_load_lds((const unsigned*)(xp + (size_t)(u.pm * 256 + row) * DM + u.pn * 256 + seg * 32), (LAS unsigned*)(scr + j * 256), 4, 0, 0); }
    }
    __device__ __forceinline__ void operator()(const f32x4 (&)[2][2][4][2], const pg8::Unit&, int, int, int, int) const {}
    __device__ __forceinline__ void fused(f32x4 (&acc)[2][2][4][2], const pg8::Unit& u, int wr, int wc, int fr, int fq) const {
        const int row0 = u.pm * 256 + wr * 64 + fr, col0 = u.pn * 256 + wc * 32 + 4 * fq;
#pragma unroll
        for (int ai = 0; ai < 2; ++ai)
#pragma unroll
            for (int m = 0; m < 4; ++m) { const size_t r = (size_t)(row0 + ai * 128 + m * 16); float ss = 0.f;
#pragma unroll
                for (int bj = 0; bj < 2; ++bj)
#pragma unroll
                    for (int n = 0; n < 2; ++n) { const int c = col0 + bj * 128 + n * 16; const f32x4 v = acc[ai][bj][m][n] + __builtin_nontemporal_load((const f32x4*)(xp + r * DM + c)); acc[ai][bj][m][n] = v;
                        ss += (v.x * v.x + v.y * v.y) + (v.z * v.z + v.w * v.w); }
                ss += __shfl_xor(ss, 16); ss += __shfl_xor(ss, 32);
                if (fq == 0) st_agent(slots + r * 16 + u.pn * 4 + wc, ss); }
        asm volatile("s_waitcnt vmcnt(0)" ::: "memory");
        if (fr == 0 && fq == 0) __hip_atomic_fetch_add(cnt + 64 * u.pm, 1u, __ATOMIC_RELAXED, __HIP_MEMORY_SCOPE_AGENT);
        if (threadIdx.x < 64) wait_count(cnt + 64 * u.pm, 32u);
        __syncthreads();
#pragma unroll
        for (int ai = 0; ai < 2; ++ai)
#pragma unroll
            for (int m = 0; m < 4; ++m) { const size_t r = (size_t)(row0 + ai * 128 + m * 16); float tot = 0.f;
                { const f32x4* sp = (const f32x4*)(slots + r * 16); const f32x4 p0 = sp[0], p1 = sp[1], p2 = sp[2], p3 = sp[3];
                  tot = (((p0.x + p0.y) + (p0.z + p0.w)) + ((p1.x + p1.y) + (p1.z + p1.w))) + (((p2.x + p2.y) + (p2.z + p2.w)) + ((p3.x + p3.y) + (p3.z + p3.w))); }
                const float rs = rsqrtf(tot * (1.f / DM) + EPS);
#pragma unroll
                for (int bj = 0; bj < 2; ++bj)
#pragma unroll
                    for (int n = 0; n < 2; ++n) { const int c = col0 + bj * 128 + n * 16; const f32x4 g = *(const f32x4*)(gf + c); const f32x4 v = acc[ai][bj][m][n];
                        __builtin_nontemporal_store((f32x4){v.x * rs * g.x, v.y * rs * g.y, v.z * rs * g.z, v.w * rs * g.w}, (f32x4*)(out + O_YP + r * DM + c)); } }
    }
};

template <class Epi>
__device__ __forceinline__ void skinny_gemm(LAS unsigned char* lds, const bf16* A0, int lda, size_t a_grp_stride, int strips_per_grp, int nseg, int aseg,
                                            const bf16* Bt, int ldb, int K, int nstrips, int first, int step, const Epi& E) {
    int tid_ = threadIdx.x; asm volatile("" : "+v"(tid_));
    const int tid = tid_, lane = tid & 63, wv = tid >> 6, fr = lane & 15, fq = lane >> 4, rh = wv & 1, kq = wv >> 1;
    LAS float* part = (LAS float*)lds;
    const int nks = K / 128;
    for (int s = first; s < nstrips; s += step) {
        const bf16* A = A0 + (size_t)(s / strips_per_grp) * a_grp_stride + (size_t)(rh * 64 + fr) * lda + fq * 8;
        const bf16* B = Bt + (size_t)(16 * s + fr) * ldb + fq * 8;
        f32x4 acc[4];
#pragma unroll
        for (int rb = 0; rb < 4; ++rb) acc[rb] = (f32x4){0.f, 0.f, 0.f, 0.f};
        for (int seg = 0; seg < nseg; ++seg) {
#pragma unroll 4
            for (int k = 0; k < nks; ++k) {
                const int ko = (kq * nks + k) * 32;
                const bf16x8 bfr = *(const bf16x8*)(B + ko);
#pragma unroll
                for (int rb = 0; rb < 4; ++rb) { const bf16x8 afr = *(const bf16x8*)(A + (size_t)rb * 16 * lda + seg * aseg + ko);
                    acc[rb] = __builtin_amdgcn_mfma_f32_16x16x32_bf16(bfr, afr, acc[rb], 0, 0, 0); }
            }
        }
#pragma unroll
        for (int rb = 0; rb < 4; ++rb) *(LAS f32x4*)(part + ((kq * 128 + rh * 64 + rb * 16 + fr) * 16 + fq * 4)) = acc[rb];
        __syncthreads();
        { const int row = tid >> 2, cq = tid & 3; const LAS float* p = part + row * 16 + cq * 4;
          const f32x4 v = (*(const LAS f32x4*)p + *(const LAS f32x4*)(p + 2048)) + (*(const LAS f32x4*)(p + 4096) + *(const LAS f32x4*)(p + 6144));
          E(s, row, 16 * s + cq * 4, v, cq); }
        __syncthreads();
    }
}
struct EpiS1 {
    bf16* proj; bf16* gate; float* vss2; float* out; const float* hist; bf16* ds;
    __device__ __forceinline__ void operator()(int s, int row, int c, f32x4 v, int cq) const {
        const int sec = c >> 10, cs = c & 1023; const size_t m = (size_t)(MPR + row);
        if (sec == 0) { *(f32x4*)(out + O_POOLS + ((size_t)row * 15 + 14) * DM + cs) = v;
            const int w = 2 << (cs >> 8); f32x4 sm = v;
#pragma unroll
            for (int j = 0; j < 15; ++j) if (j < w - 1) sm = sm + *(const f32x4*)(hist + ((size_t)row * 15 + 14 - j) * DM + cs);
            const float inv = 1.f / (float)w;
            u32x2 d; d.x = pk2(sm.x * inv - v.x, sm.y * inv - v.y); d.y = pk2(sm.z * inv - v.z, sm.w * inv - v.w);
            *(u32x2*)(ds + (size_t)row * DM + cs) = d; }
        if (sec == 3) { float ss = (v.x * v.x + v.y * v.y) + (v.z * v.z + v.w * v.w); ss += __shfl_xor(ss, 1); ss += __shfl_xor(ss, 2); if (cq == 0) vss2[row * 64 + (s - 192)] = ss; }
        if (sec == 1 || sec == 4 || sec == 6) { v.x = silu_f(v.x); v.y = silu_f(v.y); v.z = silu_f(v.z); v.w = silu_f(v.w); }
        if (sec >= 7) { v.x = sigm_f(v.x); v.y = sigm_f(v.y); v.z = sigm_f(v.z); v.w = sigm_f(v.w); }
        u32x2 w; w.x = pk2(v.x, v.y); w.y = pk2(v.z, v.w);
        if (sec < 7) *(u32x2*)(proj + (size_t)sec * MP * DM + m * DM + cs) = w; else *(u32x2*)(gate + m * (3 * DM) + (sec - 7) * DM + cs) = w;
    }
};
struct EpiS3 {
    const bf16* gate; bf16* gys;
    __device__ __forceinline__ void operator()(int s, int row, int c, f32x4 v, int cq) const {
        const u32x2 g = *(const u32x2*)(gate + (size_t)(MPR + row) * (3 * DM) + c);
        u32x2 w; w.x = pk2(v.x * bflo(g.x), v.y * bfhi(g.x)); w.y = pk2(v.z * bflo(g.y), v.w * bfhi(g.y));
        *(u32x2*)(gys + (size_t)row * (3 * DM) + c) = w;
    }
};
struct EpiS4 {
    const float* xs; const float* gf; float* out; float* slots2; unsigned* cnt2;
    __device__ __forceinline__ void operator()(int s, int row, int c, f32x4 v, int cq) const {
        v = v + *(const f32x4*)(xs + (size_t)row * DM + c);
        float ss = (v.x * v.x + v.y * v.y) + (v.z * v.z + v.w * v.w); ss += __shfl_xor(ss, 1); ss += __shfl_xor(ss, 2);
        if (cq == 0) st_agent(slots2 + row * 64 + s, ss);
        asm volatile("s_waitcnt vmcnt(0)" ::: "memory");
        __syncthreads();
        if (threadIdx.x == 0) __hip_atomic_fetch_add(cnt2, 1u, __ATOMIC_RELAXED, __HIP_MEMORY_SCOPE_AGENT);
        if (threadIdx.x < 64) wait_count(cnt2, 64u);
        __syncthreads();
        float tot = 0.f;
        { const f32x4* sp = (const f32x4*)(slots2 + row * 64 + cq * 16); const f32x4 p0 = sp[0], p1 = sp[1], p2 = sp[2], p3 = sp[3];
          tot = (((p0.x + p0.y) + (p0.z + p0.w)) + ((p1.x + p1.y) + (p1.z + p1.w))) + (((p2.x + p2.y) + (p2.z + p2.w)) + ((p3.x + p3.y) + (p3.z + p3.w))); }
        tot += __shfl_xor(tot, 1); tot += __shfl_xor(tot, 2);
        const float rs = rsqrtf(tot * (1.f / DM) + EPS); const f32x4 g = *(const f32x4*)(gf + c);
        *(f32x4*)(out + O_YS + (size_t)row * DM + c) = (f32x4){v.x * rs * g.x, v.y * rs * g.y, v.z * rs * g.z, v.w * rs * g.w};
    }
};


__device__ __forceinline__ void sample_out_split(const KArgs& a, LAS unsigned char* lds, int item) {
    int tid_ = threadIdx.x; asm volatile("" : "+v"(tid_));
    const int tid = tid_, lane = tid & 63, wv = tid >> 6, fr = lane & 15, fq = lane >> 4, s = item >> 2, rq = item & 3;
    const bf16* A = (const bf16*)(a.ws + WS_GYS) + (size_t)(rq * 32 + fr) * (3 * DM) + fq * 8;
    const bf16* B = (const bf16*)(a.ws + WS_WO3) + (size_t)(16 * s + fr) * DM + fq * 8;
    f32x4 acc0 = (f32x4){0.f, 0.f, 0.f, 0.f}, acc1 = acc0;
#pragma unroll
    for (int kk = 0; kk < 12; ++kk) { const int k = 384 * wv + 32 * kk;
        const bf16x8 bfr = *(const bf16x8*)(B + (k & 1023)); const bf16x8 a0 = *(const bf16x8*)(A + k), a1 = *(const bf16x8*)(A + (size_t)16 * (3 * DM) + k);
        acc0 = __builtin_amdgcn_mfma_f32_16x16x32_bf16(bfr, a0, acc0, 0, 0, 0); acc1 = __builtin_amdgcn_mfma_f32_16x16x32_bf16(bfr, a1, acc1, 0, 0, 0); }
    LAS float* part = (LAS float*)lds;
    *(LAS f32x4*)(part + (wv * 32 + fr) * 16 + fq * 4) = acc0; *(LAS f32x4*)(part + (wv * 32 + 16 + fr) * 16 + fq * 4) = acc1;
    __syncthreads();
    const int row = tid >> 4, col = tid & 15, grow = rq * 32 + row, c = 16 * s + col;
    float v = 0.f;
#pragma unroll
    for (int w8 = 0; w8 < 8; ++w8) v += part[(w8 * 32 + row) * 16 + col];
    v += a.in[I_XS][(size_t)grow * DM + c];
    float ss = v * v; ss += __shfl_xor(ss, 1); ss += __shfl_xor(ss, 2); ss += __shfl_xor(ss, 4); ss += __shfl_xor(ss, 8);
    float* slots2 = (float*)(a.ws + WS_VSS2); unsigned* cnt = (unsigned*)(a.ws + WS_CTL) + CW_SAMPLE + 64 * rq;
    if (col == 0) st_agent(slots2 + grow * 64 + s, ss);
    asm volatile("s_waitcnt vmcnt(0)" ::: "memory");
    __syncthreads();
    if (tid == 0) __hip_atomic_fetch_add(cnt, 1u, __ATOMIC_RELAXED, __HIP_MEMORY_SCOPE_AGENT);
    if (tid < 64) wait_count(cnt, 64u);
    __syncthreads();
    const f32x4 p4 = *(const f32x4*)(slots2 + grow * 64 + col * 4);
    float tot = (p4.x + p4.y) + (p4.z + p4.w); tot += __shfl_xor(tot, 1); tot += __shfl_xor(tot, 2); tot += __shfl_xor(tot, 4); tot += __shfl_xor(tot, 8);
    a.out[O_YS + (size_t)grow * DM + c] = v * rsqrtf(tot * (1.f / DM) + EPS) * a.in[I_NORMF][c];
    __syncthreads();
}

__device__ __forceinline__ void p0_transpose_item(const float* W, int N, bf16* WT, int row_off, int ldo, int koff, LAS float* scr, int item, int lane) {
    const int nblk = N / 32, kb = item / nblk, nb = item % nblk, k0 = 64 * kb, n0 = 32 * nb;
#pragma unroll 8
    for (int i = 0; i < 32; ++i) { const int kk = 2 * i + (lane >> 5); scr[kk * 33 + (lane & 31)] = W[(size_t)(k0 + kk) * N + n0 + (lane & 31)]; }
    asm volatile("s_waitcnt lgkmcnt(0)" ::: "memory");
    const int c = lane & 7;
#pragma unroll
    for (int j = 0; j < 4; ++j) { const int n = (lane >> 3) + 8 * j; const LAS float* s = scr + (8 * c) * 33 + n;
        u32x4 o; o.x = pk2(s[0 * 33], s[1 * 33]); o.y = pk2(s[2 * 33], s[3 * 33]); o.z = pk2(s[4 * 33], s[5 * 33]); o.w = pk2(s[6 * 33], s[7 * 33]);
        *(u32x4*)(WT + (size_t)(row_off + n0 + n) * ldo + koff + k0 + 8 * c) = o; }
    asm volatile("s_waitcnt lgkmcnt(0)" ::: "memory");
}
__device__ __forceinline__ void rms_row_to_bf16(const float* xrow, const float* gain, bf16* orow, int lane) {
    const f32x4* xr = (const f32x4*)xrow + lane; const f32x4* gr = (const f32x4*)gain + lane;
    f32x4 v[4]; float s = 0.f;
#pragma unroll
    for (int j = 0; j < 4; ++j) { v[j] = xr[64 * j]; s += (v[j].x * v[j].x + v[j].y * v[j].y) + (v[j].z * v[j].z + v[j].w * v[j].w); }
    const float rs = rsqrtf(wave_sum(s) * (1.f / DM) + EPS);
    u32x2* o8 = (u32x2*)orow + lane;
#pragma unroll
    for (int j = 0; j < 4; ++j) { const f32x4 g = gr[64 * j]; u32x2 w; w.x = pk2(v[j].x * rs * g.x, v[j].y * rs * g.y); w.y = pk2(v[j].z * rs * g.z, v[j].w * rs * g.w); o8[64 * j] = w; }
}
__device__ __forceinline__ void rms_row2_to_bf16(const float* x0, const float* x1, const float* gain, bf16* o0, bf16* o1, int lane) {
    const f32x4* xr0 = (const f32x4*)x0 + lane; const f32x4* xr1 = (const f32x4*)x1 + lane; const f32x4* gr = (const f32x4*)gain + lane;
    f32x4 v[4], w[4]; float s = 0.f, t = 0.f;
#pragma unroll
    for (int j = 0; j < 4; ++j) { v[j] = __builtin_nontemporal_load(xr0 + 64 * j); w[j] = __builtin_nontemporal_load(xr1 + 64 * j); }
#pragma unroll
    for (int j = 0; j < 4; ++j) { s += (v[j].x * v[j].x + v[j].y * v[j].y) + (v[j].z * v[j].z + v[j].w * v[j].w); t += (w[j].x * w[j].x + w[j].y * w[j].y) + (w[j].z * w[j].z + w[j].w * w[j].w); }
#pragma unroll
    for (int o = 1; o < 64; o <<= 1) { s += __shfl_xor(s, o); t += __shfl_xor(t, o); }
    const float rs = rsqrtf(s * (1.f / DM) + EPS), rt = rsqrtf(t * (1.f / DM) + EPS);
    u32x2* p0 = (u32x2*)o0 + lane; u32x2* p1 = (u32x2*)o1 + lane;
#pragma unroll
    for (int j = 0; j < 4; ++j) { const f32x4 g = gr[64 * j]; u32x2 a; a.x = pk2(v[j].x * rs * g.x, v[j].y * rs * g.y); a.y = pk2(v[j].z * rs * g.z, v[j].w * rs * g.w); p0[64 * j] = a;
        u32x2 b; b.x = pk2(w[j].x * rt * g.x, w[j].y * rt * g.y); b.y = pk2(w[j].z * rt * g.z, w[j].w * rt * g.w); p1[64 * j] = b; }
}
__device__ __forceinline__ void p0_prologue(const KArgs& a, LAS unsigned char* lds, int G) {
    const int tid = threadIdx.x, lane = tid & 63, wave = tid >> 6;
    LAS float* scr = (LAS float*)(lds + wave * 16384);
    const int gw = blockIdx.x * 8 + wave, NGW = G * 8;
    bf16* H = (bf16*)(a.ws + WS_H); bf16* WinT = (bf16*)(a.ws + WS_WIN); bf16* WdT = (bf16*)(a.ws + WS_WD); bf16* Wo3 = (bf16*)(a.ws + WS_WO3);
    bf16* PwT = (bf16*)(a.ws + WS_PW); bf16* SW = (bf16*)(a.ws + WS_SW);
    constexpr int I_IN = 16 * (INC / 32), I_KV = 16 * (2048 / 32), I_D = 16 * 32, I_O = 16 * 32, I_P = 4 * 8;
    constexpr int NITEMS = I_IN + I_KV + 3 * I_D + I_O + 4 * I_P;
    for (int it = gw; it < NITEMS; it += NGW) {
        int r = it;
        if (r < I_IN) { p0_transpose_item(a.in[I_WIN], INC, WinT, 0, DM, 0, scr, r, lane); continue; } r -= I_IN;
        if (r < I_KV) { p0_transpose_item(a.in[I_WKV], 2048, WinT, INC, DM, 0, scr, r, lane); continue; } r -= I_KV;
        if (r < 3 * I_D) { const int b = r / I_D; p0_transpose_item(a.in[I_WDOWN] + (size_t)b * DM * DM, DM, WdT, b * DM, DM, 0, scr, r % I_D, lane); continue; } r -= 3 * I_D;
        if (r < I_O) { p0_transpose_item(a.in[I_WOUT], DM, Wo3, 0, DM, 0, scr, r, lane); continue; } r -= I_O;
        { const int g = r / I_P; p0_transpose_item(a.in[I_POOLW] + (size_t)g * 256 * 256, 256, PwT, g * 256, 256, 0, scr, r % I_P, lane); }
    }
    for (int m = gw; m + NGW < MPR; m += 2 * NGW)
        rms_row2_to_bf16(a.in[I_XP] + (size_t)m * DM, a.in[I_XP] + (size_t)(m + NGW) * DM, a.in[I_NORMG], H + (size_t)m * DM, H + (size_t)(m + NGW) * DM, lane);
    const int mdone = (MPR / (2 * NGW)) * (2 * NGW);
    for (int m = mdone + gw; m < MP + 2048; m += NGW) {
        bf16* orow = H + (size_t)m * DM;
        if (m < MPR) rms_row_to_bf16(a.in[I_XP] + (size_t)m * DM, a.in[I_NORMG], orow, lane);
        else if (m < MV) rms_row_to_bf16(a.in[I_XS] + (size_t)(m - MPR) * DM, a.in[I_NORMG], orow, lane);
        else if (m < MP) { u32x2* o8 = (u32x2*)orow + lane;
#pragma unroll
            for (int j = 0; j < 4; ++j) o8[64 * j] = (u32x2){0u, 0u}; }
        else rms_row_to_bf16(a.in[I_MEM] + (size_t)(m - MP) * DM, a.in[I_MEMNG], orow, lane);
    }
    const size_t gt = (size_t)blockIdx.x * 512 + tid, NGT = (size_t)G * 512;
    for (size_t i = gt; i < (size_t)4 * 128 * 128; i += NGT) { const int s = (int)(i & 127), t = (int)((i >> 7) & 127); SW[i] = (bf16)(s <= t ? f2bf(a.in[I_SGUW][i]) : 0u); }
    for (size_t i = gt; i < (size_t)NS * 256; i += NGT) { const size_t smp = i >> 8, c = (i & 255) * 4; const int w = 2 << (int)(c >> 8); f32x4 sm = (f32x4){0.f, 0.f, 0.f, 0.f};
#pragma unroll
        for (int j = 0; j < 15; ++j) if (j < w - 1) sm = sm + *(const f32x4*)(a.in[I_SPOOL] + (smp * 15 + 14 - j) * DM + c);
        *(f32x4*)((float*)(a.ws + WS_HS) + smp * DM + c) = sm; }
    for (size_t i = gt; i < (size_t)NS * 14 * 256; i += NGT) { const size_t smp = i / (14 * 256), rem = i % (14 * 256), r = rem / 256, c4 = rem % 256;
        *(f32x4*)(a.out + O_POOLS + (smp * 15 + r) * DM + c4 * 4) = *(const f32x4*)(a.in[I_SPOOL] + (smp * 15 + r + 1) * DM + c4 * 4); }
}

constexpr int RSV = 544;
constexpr int RS = 528;
__device__ __forceinline__ void pool_part(const KArgs& a, LAS unsigned char* lds, int rt, int g) {
    int tid_ = threadIdx.x; asm volatile("" : "+v"(tid_));
    const int tid = tid_, lane = tid & 63, wv = tid >> 6, fr = lane & 15, fq = lane >> 4;
    const int m0 = rt * 128, w = 2 << g;
    const bf16* PIN = (const bf16*)(a.ws + WS_PROJ); const bf16* PZ = PIN + (size_t)MP * DM;
    const bf16* PwT = (const bf16*)(a.ws + WS_PW); bf16* BR0 = (bf16*)(a.ws + WS_BR);
    LAS unsigned char* Pb = lds; LAS unsigned char* Db = lds + 75520;
    u32x4 zf[8]; f32x4 scv[2]; bf16x8 Bf[2][8];
    const bf16* pw = PwT + (size_t)(g * 256 + wv * 32 + 8 * (fr >> 2) + (fr & 3)) * 256 + fq * 8;
    if (rt < 128) {
        const int t0 = (rt & 15) * 128;
        u32x4 tv[9];
#pragma unroll
        for (int i = 0; i < 9; ++i) { const int idx = tid + i * 512, row = idx >> 5, ch = idx & 31; tv[i] = (u32x4){0u, 0u, 0u, 0u};
            if (idx < 143 * 32 && !(t0 == 0 && row < 15)) tv[i] = *(const u32x4*)(PIN + (size_t)(m0 - 15 + row) * DM + g * 256 + ch * 8); }
#pragma unroll
        for (int rb = 0; rb < 8; ++rb) zf[rb] = *(const u32x4*)(PZ + (size_t)(m0 + rb * 16 + fr) * DM + g * 256 + wv * 32 + 8 * fq);
#pragma unroll
        for (int nn = 0; nn < 2; ++nn) { scv[nn] = *(const f32x4*)(a.in[I_POOLSC] + g * 256 + wv * 32 + 8 * fq + 4 * nn);
#pragma unroll
            for (int ks = 0; ks < 8; ++ks) Bf[nn][ks] = *(const bf16x8*)(pw + nn * 4 * 256 + ks * 32); }
#pragma unroll
        for (int i = 0; i < 9; ++i) { const int idx = tid + i * 512, row = idx >> 5, ch = idx & 31; if (idx < 143 * 32) *(LAS u32x4*)(Pb + row * RS + ch * 16) = tv[i]; }
        __syncthreads();
        {
            const int ch = tid & 31, r0 = (tid >> 5) * 8;
            float s0 = 0.f, s1 = 0.f, s2 = 0.f, s3 = 0.f, s4 = 0.f, s5 = 0.f, s6 = 0.f, s7 = 0.f;
            for (int j = 1; j < w; ++j) { const u32x4 v = *(const LAS u32x4*)(Pb + (r0 + 15 - j) * RS + ch * 16);
                s0 += bflo(v.x); s1 += bfhi(v.x); s2 += bflo(v.y); s3 += bfhi(v.y); s4 += bflo(v.z); s5 += bfhi(v.z); s6 += bflo(v.w); s7 += bfhi(v.w); }
#pragma unroll
            for (int i = 0; i < 8; ++i) { const int r = r0 + i;
                const u32x4 own = *(const LAS u32x4*)(Pb + (r + 15) * RS + ch * 16); const u32x4 old = *(const LAS u32x4*)(Pb + (r + 16 - w) * RS + ch * 16);
                s0 += bflo(own.x); s1 += bfhi(own.x); s2 += bflo(own.y); s3 += bfhi(own.y); s4 += bflo(own.z); s5 += bfhi(own.z); s6 += bflo(own.w); s7 += bfhi(own.w);
                const int cnt = min(w, t0 + r + 1); const float inv = 1.f / (float)cnt;
                u32x4 d; d.x = pk2(s0 * inv - bflo(own.x), s1 * inv - bfhi(own.x)); d.y = pk2(s2 * inv - bflo(own.y), s3 * inv - bfhi(own.y));
                d.z = pk2(s4 * inv - bflo(own.z), s5 * inv - bfhi(own.z)); d.w = pk2(s6 * inv - bflo(own.w), s7 * inv - bfhi(own.w));
                *(LAS u32x4*)(Db + r * RS + ch * 16) = d;
                s0 -= bflo(old.x); s1 -= bfhi(old.x); s2 -= bflo(old.y); s3 -= bfhi(old.y); s4 -= bflo(old.z); s5 -= bfhi(old.z); s6 -= bflo(old.w); s7 -= bfhi(old.w); }
        }
    } else {
#pragma unroll
        for (int rb = 0; rb < 8; ++rb) zf[rb] = *(const u32x4*)(PZ + (size_t)(m0 + rb * 16 + fr) * DM + g * 256 + wv * 32 + 8 * fq);
#pragma unroll
        for (int nn = 0; nn < 2; ++nn) { scv[nn] = *(const f32x4*)(a.in[I_POOLSC] + g * 256 + wv * 32 + 8 * fq + 4 * nn);
#pragma unroll
            for (int ks = 0; ks < 8; ++ks) Bf[nn][ks] = *(const bf16x8*)(pw + nn * 4 * 256 + ks * 32); }
        const bf16* DS = (const bf16*)(a.ws + WS_DS);
        u32x4 td[8];
#pragma unroll
        for (int i = 0; i < 8; ++i) { const int idx = tid + i * 512, r = idx >> 5, ch = idx & 31; td[i] = *(const u32x4*)(DS + (size_t)r * DM + g * 256 + ch * 8); }
#pragma unroll
        for (int i = 0; i < 8; ++i) { const int idx = tid + i * 512, r = idx >> 5, ch = idx & 31; *(LAS u32x4*)(Db + r * RS + ch * 16) = td[i]; }
    }
    __syncthreads();
#pragma unroll
    for (int rb = 0; rb < 8; ++rb) {
        f32x4 acc0 = (f32x4){0.f, 0.f, 0.f, 0.f}, acc1 = acc0;
#pragma unroll
        for (int ks = 0; ks < 8; ++ks) { const bf16x8 A = *(const LAS bf16x8*)(Db + (rb * 16 + fr) * RS + (ks * 32 + fq * 8) * 2);
            acc0 = __builtin_amdgcn_mfma_f32_16x16x32_bf16(Bf[0][ks], A, acc0, 0, 0, 0); acc1 = __builtin_amdgcn_mfma_f32_16x16x32_bf16(Bf[1][ks], A, acc1, 0, 0, 0); }
        const size_t m = (size_t)(m0 + rb * 16 + fr); const int c = g * 256 + wv * 32 + 8 * fq; const u32x4 z = zf[rb];
        u32x4 o; o.x = pk2(acc0[0] * scv[0].x * bflo(z.x), acc0[1] * scv[0].y * bfhi(z.x)); o.y = pk2(acc0[2] * scv[0].z * bflo(z.y), acc0[3] * scv[0].w * bfhi(z.y));
        o.z = pk2(acc1[0] * scv[1].x * bflo(z.z), acc1[1] * scv[1].y * bfhi(z.z)); o.w = pk2(acc1[2] * scv[1].z * bflo(z.w), acc1[3] * scv[1].w * bfhi(z.w));
        *(u32x4*)(BR0 + m * DM + c) = o;
    }
    __syncthreads();
}
__device__ __forceinline__ void sgu_part(const KArgs& a, LAS unsigned char* lds, int rt, int g) {
    int tid_ = threadIdx.x; asm volatile("" : "+v"(tid_));
    const int tid = tid_, lane = tid & 63, wv = tid >> 6, fr = lane & 15, fq = lane >> 4;
    const int m0 = rt * 128;
    const bf16* U = (const bf16*)(a.ws + WS_PROJ) + (size_t)2 * MP * DM; const bf16* V = U + (size_t)MP * DM; const bf16* SZ = V + (size_t)MP * DM;
    const bf16* SW = (const bf16*)(a.ws + WS_SW); const float* VSS = (const float*)(a.ws + WS_VSS); bf16* BR1 = (bf16*)(a.ws + WS_BR) + (size_t)MP * DM;
    LAS unsigned char* Vb = lds; LAS unsigned char* UZb = lds + 128 * RS; LAS float* rbuf = (LAS float*)(lds + 256 * RS);
    u32x4 tv[8], tu[8], tz[8];
#pragma unroll
    for (int i = 0; i < 8; ++i) { const int idx = tid + i * 512, s = idx >> 5, ch = idx & 31; const size_t o = (size_t)(m0 + s) * DM + g * 256 + ch * 8;
        tv[i] = *(const u32x4*)(V + o); tu[i] = *(const u32x4*)(U + o); tz[i] = *(const u32x4*)(SZ + o); }
    if (tid < 128) { const f32x4* p = (const f32x4*)(VSS + (size_t)(m0 + tid) * 16); const f32x4 p0 = p[0], p1 = p[1], p2 = p[2], p3 = p[3];
        const float s = ((p0.x + p0.y) + (p0.z + p0.w)) + ((p1.x + p1.y) + (p1.z + p1.w)) + ((p2.x + p2.y) + (p2.z + p2.w)) + ((p3.x + p3.y) + (p3.z + p3.w));
        rbuf[tid] = rsqrtf(s * (1.f / DM) + EPS); }
    const f32x4 gv0 = *(const f32x4*)(a.in[I_SGUNG] + g * 256 + wv * 32 + 8 * fq), gv1 = *(const f32x4*)(a.in[I_SGUNG] + g * 256 + wv * 32 + 8 * fq + 4);
    float biasv[8];
#pragma unroll
    for (int tb = 0; tb < 8; ++tb) biasv[tb] = a.in[I_SGUB][g * 128 + tb * 16 + fr];
    __syncthreads();
#pragma unroll
    for (int i = 0; i < 8; ++i) { const int idx = tid + i * 512, s = idx >> 5, ch = idx & 31; const float r = rbuf[s];
        u32x4 v; v.x = pk2(bflo(tv[i].x) * r, bfhi(tv[i].x) * r); v.y = pk2(bflo(tv[i].y) * r, bfhi(tv[i].y) * r); v.z = pk2(bflo(tv[i].z) * r, bfhi(tv[i].z) * r); v.w = pk2(bflo(tv[i].w) * r, bfhi(tv[i].w) * r);
        *(LAS u32x4*)(Vb + s * RS + ch * 16) = v;
        u32x4 q; q.x = pk2(bflo(tu[i].x) * bflo(tz[i].x), bfhi(tu[i].x) * bfhi(tz[i].x)); q.y = pk2(bflo(tu[i].y) * bflo(tz[i].y), bfhi(tu[i].y) * bfhi(tz[i].y));
        q.z = pk2(bflo(tu[i].z) * bflo(tz[i].z), bfhi(tu[i].z) * bfhi(tz[i].z)); q.w = pk2(bflo(tu[i].w) * bflo(tz[i].w), bfhi(tu[i].w) * bfhi(tz[i].w));
        *(LAS u32x4*)(UZb + s * RS + ch * 16) = q; }
    __syncthreads();
    const int q = fr >> 2, p = fr & 3;
    bf16x8 Vf[4][2];
#pragma unroll
    for (int ks = 0; ks < 4; ++ks)
#pragma unroll
        for (int nn = 0; nn < 2; ++nn) { const LAS unsigned char* a0 = Vb + (32 * ks + 8 * fq + q) * RS + (wv * 32 + 8 * p + 4 * nn) * 2; Vf[ks][nn] = tr_read2(a0, a0 + 4 * RS); }
#pragma unroll
    for (int tb = 0; tb < 8; ++tb) {
        f32x4 acc0 = (f32x4){0.f, 0.f, 0.f, 0.f}, acc1 = acc0;
        const int t = tb * 16 + fr;
#pragma unroll
        for (int ks = 0; ks < 4; ++ks) if (ks <= (tb >> 1)) {
            const bf16x8 A = *(const bf16x8*)(SW + (size_t)(g * 128 + t) * 128 + ks * 32 + fq * 8);
            acc0 = __builtin_amdgcn_mfma_f32_16x16x32_bf16(Vf[ks][0], A, acc0, 0, 0, 0); acc1 = __builtin_amdgcn_mfma_f32_16x16x32_bf16(Vf[ks][1], A, acc1, 0, 0, 0);
        }
        const size_t m = (size_t)(m0 + t); const float bias = biasv[tb];
        { const int cl = wv * 32 + 8 * fq; const u32x4 uz = *(const LAS u32x4*)(UZb + t * RS + cl * 2);
          u32x4 o; o.x = pk2((acc0[0] * gv0.x + bias) * bflo(uz.x), (acc0[1] * gv0.y + bias) * bfhi(uz.x)); o.y = pk2((acc0[2] * gv0.z + bias) * bflo(uz.y), (acc0[3] * gv0.w + bias) * bfhi(uz.y));
          o.z = pk2((acc1[0] * gv1.x + bias) * bflo(uz.z), (acc1[1] * gv1.y + bias) * bfhi(uz.z)); o.w = pk2((acc1[2] * gv1.z + bias) * bflo(uz.w), (acc1[3] * gv1.w + bias) * bfhi(uz.w));
          *(u32x4*)(BR1 + m * DM + g * 256 + cl) = o; }
    }
    __syncthreads();
}
__device__ __forceinline__ void attn_part(const KArgs& a, LAS unsigned char* lds, int rt, int g) {
    int tid_ = threadIdx.x; asm volatile("" : "+v"(tid_));
    const int tid = tid_, lane = tid & 63, wv = tid >> 6, fr = lane & 15, fq = lane >> 4;
    const int m0 = rt * 128, b = rt >> 4;
    const bf16* Q = (const bf16*)(a.ws + WS_PROJ) + (size_t)5 * MP * DM; const bf16* AZ = Q + (size_t)MP * DM;
    const bf16* KB = (const bf16*)(a.ws + WS_KB); const bf16* VB = (const bf16*)(a.ws + WS_VB); bf16* BR2 = (bf16*)(a.ws + WS_BR) + (size_t)2 * MP * DM;
    LAS unsigned char* Kb = lds;
    const size_t m = (size_t)(m0 + wv * 16 + fr);
    bf16x8 Qf[8];
    {
        u32x4 tk[16];
#pragma unroll
        for (int i = 0; i < 16; ++i) { const int idx = tid + i * 512, key = idx >> 5, ch = idx & 31; tk[i] = *(const u32x4*)(KB + (size_t)(b * 256 + key) * DM + g * 256 + ch * 8); }
#pragma unroll
        for (int ks = 0; ks < 8; ++ks) Qf[ks] = *(const bf16x8*)(Q + m * DM + g * 256 + ks * 32 + fq * 8);
#pragma unroll
        for (int i = 0; i < 16; ++i) { const int idx = tid + i * 512, key = idx >> 5, ch = idx & 31; *(LAS u32x4*)(Kb + key * RS + ch * 16) = tk[i]; }
    }
    __syncthreads();
    u32x4 tvv[16];
#pragma unroll
    for (int i = 0; i < 16; ++i) { const int idx = tid + i * 512, key = idx >> 5, ch = idx & 31; tvv[i] = *(const u32x4*)(VB + (size_t)(b * 256 + key) * DM + g * 256 + ch * 8); }
    f32x4 sacc[16];
#pragma unroll
    for (int kb = 0; kb < 16; ++kb) { sacc[kb] = (f32x4){0.f, 0.f, 0.f, 0.f};
#pragma unroll
        for (int ks = 0; ks < 8; ++ks) { const bf16x8 Kf = *(const LAS bf16x8*)(Kb + (kb * 16 + fr) * RS + (ks * 32 + fq * 8) * 2);
            sacc[kb] = __builtin_amdgcn_mfma_f32_16x16x32_bf16(Kf, Qf[ks], sacc[kb], 0, 0, 0); }
        if (kb & 1) __builtin_amdgcn_sched_barrier(0); }
    float mx = -3.0e38f;
#pragma unroll
    for (int kb = 0; kb < 16; ++kb) mx = fmaxf(mx, fmaxf(fmaxf(sacc[kb][0], sacc[kb][1]), fmaxf(sacc[kb][2], sacc[kb][3])));
    mx = fmaxf(mx, __shfl_xor(mx, 16)); mx = fmaxf(mx, __shfl_xor(mx, 32));
    float sum = 0.f;
#pragma unroll
    for (int kb = 0; kb < 16; ++kb)
#pragma unroll
        for (int j = 0; j < 4; ++j) { const float pj = __expf((sacc[kb][j] - mx) * 0.0625f); sacc[kb][j] = pj; sum += pj; }
    sum += __shfl_xor(sum, 16); sum += __shfl_xor(sum, 32);
    const float isum = 1.f / sum;
    bf16x8 Pf[8];
#pragma unroll
    for (int k2 = 0; k2 < 8; ++k2) { u32x4 w; w.x = pk2(sacc[2 * k2][0], sacc[2 * k2][1]); w.y = pk2(sacc[2 * k2][2], sacc[2 * k2][3]);
        w.z = pk2(sacc[2 * k2 + 1][0], sacc[2 * k2 + 1][1]); w.w = pk2(sacc[2 * k2 + 1][2], sacc[2 * k2 + 1][3]); Pf[k2] = __builtin_bit_cast(bf16x8, w); }
    __syncthreads();
#pragma unroll
    for (int i = 0; i < 16; ++i) { const int idx = tid + i * 512, key = idx >> 5, ch = idx & 31; *(LAS u32x4*)(Kb + key * RSV + ch * 16) = tvv[i]; }
    u32x4 zf[8];
#pragma unroll
    for (int d2 = 0; d2 < 8; ++d2) zf[d2] = *(const u32x4*)(AZ + m * DM + g * 256 + d2 * 32 + 8 * fq);
    __syncthreads();
    const int q = fr >> 2, p = fr & 3;
#pragma unroll
    for (int d2 = 0; d2 < 8; ++d2) {
        f32x4 o0 = (f32x4){0.f, 0.f, 0.f, 0.f}, o1 = o0;
#pragma unroll
        for (int k2 = 0; k2 < 8; ++k2) { const LAS unsigned char* a0 = Kb + (32 * k2 + 4 * fq + q) * RSV + (d2 * 32 + 8 * p) * 2;
            const bf16x8 Vf0 = tr_read2(a0, a0 + 16 * RSV), Vf1 = tr_read2(a0 + 8, a0 + 8 + 16 * RSV);
            o0 = __builtin_amdgcn_mfma_f32_16x16x32_bf16(Vf0, Pf[k2], o0, 0, 0, 0); o1 = __builtin_amdgcn_mfma_f32_16x16x32_bf16(Vf1, Pf[k2], o1, 0, 0, 0); }
        const int c = g * 256 + d2 * 32 + 8 * fq; const u32x4 z = zf[d2];
        u32x4 w; w.x = pk2(o0[0] * isum * bflo(z.x), o0[1] * isum * bfhi(z.x)); w.y = pk2(o0[2] * isum * bflo(z.y), o0[3] * isum * bfhi(z.y));
        w.z = pk2(o1[0] * isum * bflo(z.z), o1[1] * isum * bfhi(z.z)); w.w = pk2(o1[2] * isum * bflo(z.w), o1[3] * isum * bfhi(z.w));
        *(u32x4*)(BR2 + m * DM + c) = w;
        __builtin_amdgcn_sched_barrier(0);
    }
    __syncthreads();
}
__device__ __forceinline__ void sgu_sample(const KArgs& a, int g, int rb) {
    int tid_ = threadIdx.x; asm volatile("" : "+v"(tid_));
    const int tid = tid_;
    const bf16* U = (const bf16*)(a.ws + WS_PROJ) + (size_t)2 * MP * DM; const bf16* V = U + (size_t)MP * DM; const bf16* SZ = V + (size_t)MP * DM;
    const float* VSS = (const float*)(a.ws + WS_VSS); bf16* BR1 = (bf16*)(a.ws + WS_BR) + (size_t)MP * DM;
    const float w00 = a.in[I_SGUW][(size_t)g * 128 * 128], b0 = a.in[I_SGUB][g * 128];
    for (int idx = tid; idx < 16 * 64; idx += 512) {
        const int i = rb * 16 + (idx >> 6), c = g * 256 + (idx & 63) * 4; const size_t m = (size_t)(MPR + i);
        const float s = wave_sum((idx & 63) < 16 ? VSS[m * 16 + (idx & 63)] : 0.f);
        const float rs = rsqrtf(s * (1.f / DM) + EPS);
        const f32x4 gv = *(const f32x4*)(a.in[I_SGUNG] + c);
        const u32x2 v4 = *(const u32x2*)(V + m * DM + c), u4 = *(const u32x2*)(U + m * DM + c), z = *(const u32x2*)(SZ + m * DM + c);
        f32x4 vn; vn.x = bflo(v4.x) * rs * gv.x; vn.y = bfhi(v4.x) * rs * gv.y; vn.z = bflo(v4.y) * rs * gv.z; vn.w = bfhi(v4.y) * rs * gv.w;
        *(f32x4*)(a.out + O_SV + (size_t)i * DM + c) = vn;
        u32x2 o; o.x = pk2(bflo(u4.x) * (w00 * vn.x + b0) * bflo(z.x), bfhi(u4.x) * (w00 * vn.y + b0) * bfhi(z.x));
        o.y = pk2(bflo(u4.y) * (w00 * vn.z + b0) * bflo(z.y), bfhi(u4.y) * (w00 * vn.w + b0) * bfhi(z.y));
        *(u32x2*)(BR1 + m * DM + c) = o;
    }
}
__device__ __forceinline__ void attn_sample(const KArgs& a, LAS unsigned char* lds, int i, int h) {
    int tid_ = threadIdx.x; asm volatile("" : "+v"(tid_));
    const int tid = tid_, lane = tid & 63, wv = tid >> 6;
    const bf16* Q = (const bf16*)(a.ws + WS_PROJ) + (size_t)5 * MP * DM; const bf16* AZ = Q + (size_t)MP * DM; bf16* BR2 = (bf16*)(a.ws + WS_BR) + (size_t)2 * MP * DM;
    const size_t m = (size_t)(MPR + i);
    const float* Kc = a.in[I_CK] + ((size_t)i * NMEM * 4 + h) * 256 + lane * 4;
    const float* Vc = a.in[I_CV] + ((size_t)i * NMEM * 4 + h) * 256 + lane * 4;
    LAS float* sc = (LAS float*)lds; LAS float* part = (LAS float*)(lds + 1024);
    const u32x2 q2 = *(const u32x2*)(Q + m * DM + h * 256 + lane * 4);
    const f32x4 qv = (f32x4){bflo(q2.x), bfhi(q2.x), bflo(q2.y), bfhi(q2.y)};
    {
        f32x4 kv[32]; float pd[32];
#pragma unroll
        for (int j = 0; j < 32; ++j) kv[j] = __builtin_nontemporal_load((const f32x4*)(Kc + (size_t)(wv * 32 + j) * 1024));
#pragma unroll
        for (int j = 0; j < 32; ++j) pd[j] = (kv[j].x * qv.x + kv[j].y * qv.y) + (kv[j].z * qv.z + kv[j].w * qv.w);
#pragma unroll
        for (int j = 0; j < 32; ++j) { const float d = wave_sum(pd[j]); if (lane == 0) sc[wv * 32 + j] = d * 0.0625f; }
    }
    f32x4 vv[32];
#pragma unroll
    for (int j = 0; j < 32; ++j) vv[j] = __builtin_nontemporal_load((const f32x4*)(Vc + (size_t)(wv * 32 + j) * 1024));
    __syncthreads();
    const f32x4 s4 = *(const LAS f32x4*)(sc + lane * 4);
    const float mx = wave_max(fmaxf(fmaxf(s4.x, s4.y), fmaxf(s4.z, s4.w)));
    const float sum = wave_sum((__expf(s4.x - mx) + __expf(s4.y - mx)) + (__expf(s4.z - mx) + __expf(s4.w - mx)));
    f32x4 o = (f32x4){0.f, 0.f, 0.f, 0.f};
#pragma unroll
    for (int j = 0; j < 32; ++j) { const float pj = __expf(sc[wv * 32 + j] - mx); o += vv[j] * pj; }
    *(LAS f32x4*)(part + wv * 256 + lane * 4) = o;
    __syncthreads();
    if (tid < 256) { float t = 0.f;
#pragma unroll
        for (int w8 = 0; w8 < 8; ++w8) t += part[w8 * 256 + tid];
        const int c = h * 256 + tid; const unsigned short zb = AZ[m * DM + c]; const float z = __builtin_bit_cast(float, (unsigned)zb << 16);
        BR2[m * DM + c] = (bf16)f2bf(t / sum * z); }
    __syncthreads();
}
__device__ __forceinline__ void p2_mixers(const KArgs& a, LAS unsigned char* lds, int G) {
    constexpr int NU = 512 + 512 + 4 + 32;
    if (G == 256) {
        const int c = blockIdx.x;
        for (int k = 0; k < 4; ++k) { const int kk = (c & 1) ? (k ^ 2) : k;
            if (kk < 2) { const int u = c + kk * 256, rt = u >> 2, g = u & 3; pool_part(a, lds, rt, g); sgu_part(a, lds, rt, g); attn_part(a, lds, rt, g); }
            else { const int e = c + (kk - 2) * 256; attn_sample(a, lds, e >> 2, e & 3); } }
        if (c < 4) pool_part(a, lds, 128, c); else if (c >= 8 && c < 40) sgu_sample(a, (c - 8) >> 3, (c - 8) & 7);
        return;
    }
    for (int u = blockIdx.x; u < NU; u += G) {
        if (u < 512) { const int rt = u >> 2, g = u & 3; pool_part(a, lds, rt, g); sgu_part(a, lds, rt, g); attn_part(a, lds, rt, g); }
        else if (u < 1024) { const int e = u - 512; attn_sample(a, lds, e >> 2, e & 3); }
        else if (u < 1028) pool_part(a, lds, 128, u - 1024);
        else sgu_sample(a, (u - 1028) >> 3, (u - 1028) & 7);
    }
}
__device__ __forceinline__ void p5_norm(const KArgs& a, int G) {
    const int tid = threadIdx.x, lane = tid & 63, wave = tid >> 6;
    const int gw = blockIdx.x * 8 + wave, NGW = G * 8;
    const f32x4* gr = (const f32x4*)a.in[I_NORMF] + lane;
    for (int m = gw; m < MV; m += NGW) {
        f32x4* xr = (f32x4*)(a.out + (size_t)m * DM) + lane;
        f32x4 v[4]; float s = 0.f;
#pragma unroll
        for (int j = 0; j < 4; ++j) { v[j] = xr[64 * j]; s += (v[j].x * v[j].x + v[j].y * v[j].y) + (v[j].z * v[j].z + v[j].w * v[j].w); }
        const float rs = rsqrtf(wave_sum(s) * (1.f / DM) + EPS);
#pragma unroll
        for (int j = 0; j < 4; ++j) { const f32x4 g = gr[64 * j]; xr[64 * j] = (f32x4){v[j].x * rs * g.x, v[j].y * rs * g.y, v[j].z * rs * g.z, v[j].w * rs * g.w}; }
    }
}

__global__ void __launch_bounds__(512, 2) fwd_megakernel(KArgs a) {
    extern __shared__ __attribute__((aligned(16))) unsigned char lds_raw[];
    LAS unsigned char* lds = (LAS unsigned char*)lds_raw;
    cg::grid_group grid = cg::this_grid();
    const int G = gridDim.x;
    const int lo = a.ph_lo, hi = a.ph_hi;
    volatile LAS unsigned* bst = (volatile LAS unsigned*)(lds + LDS_BYTES - 64);
    if (threadIdx.x == 0) { bst[0] = 0u; bst[1] = 0u; }
    __syncthreads();
    const XcdBarrier bar = xcd_barrier_post((unsigned*)(a.ws + WS_CTL), bst);
#define IN(k) (lo <= (k) && (k) < hi)
#define SEAM(k) do { if (IN(k) && IN((k) + 1)) { if (a.cg_sync) grid.sync(); else xcd_barrier(bar); } } while (0)
    if (IN(0)) p0_prologue(a, lds, G);
    SEAM(0);
    if (IN(1)) {
        pg8::Gemm g{(const bf16*)(a.ws + WS_H), (const bf16*)(a.ws + WS_WIN), MP, INC, DM};
        P1Order S; S.init(G, (int)blockIdx.x);
        EpiProj E{(bf16*)(a.ws + WS_PROJ), (bf16*)(a.ws + WS_GATE), (float*)(a.ws + WS_VSS), (bf16*)(a.ws + WS_KB), (bf16*)(a.ws + WS_VB), a.out, (const float*)(a.ws + WS_HS), (bf16*)(a.ws + WS_DS)};
        pg8::gemm_phase<EpiProj, P1Order>(lds, g, S, E);
    }
    SEAM(1);
    if (IN(2)) p2_mixers(a, lds, G);
    SEAM(2);
    if (IN(3)) {
        pg8::Gemm g{(const bf16*)(a.ws + WS_BR), (const bf16*)(a.ws + WS_WD), MPR, 3 * DM, DM};
        P3Order S; S.init(G, (int)blockIdx.x);
        EpiGate E{(const bf16*)(a.ws + WS_GATE), (bf16*)(a.ws + WS_MG)};
        pg8::gemm_phase<EpiGate, P3Order>(lds, g, S, E);
        EpiS3 E3{(const bf16*)(a.ws + WS_GATE), (bf16*)(a.ws + WS_GYS)};
        skinny_gemm(lds, (const bf16*)(a.ws + WS_BR) + (size_t)MPR * DM, DM, (size_t)MP * DM, 64, 1, 0, (const bf16*)(a.ws + WS_WD), DM, DM, 192, (int)blockIdx.x, G, E3);
    }
    SEAM(3);
    if (IN(4)) {
        pg8::Gemm g{(const bf16*)(a.ws + WS_MG), (const bf16*)(a.ws + WS_WO3), MPR, DM, DM};
        pg8::StaticOrder S; S.init(MPR, DM, G, (int)blockIdx.x);
        unsigned* ctl = (unsigned*)(a.ws + WS_CTL);
        EpiOutNorm E{a.in[I_XP], a.in[I_NORMF], a.out, (float*)(a.ws + WS_VSS), ctl + CW_PANEL};
        pg8::gemm_phase<EpiOutNorm, pg8::StaticOrder>(lds, g, S, E);
        sample_out_split(a, lds, (int)blockIdx.x);
    }
#undef IN
#undef SEAM
}

extern "C" void kernel_launch(void* const* d_in, const int* in_sizes, int n_in, void* d_out, int out_size, void* d_ws, size_t ws_size, hipStream_t stream) {
    static int grid = 0;
    if (grid == 0) {
        if (n_in != 18 || (size_t)out_size != O_END || ws_size < WS_END) { fprintf(stderr, "kernel_launch: unexpected shapes (n_in %d out %d ws %zu, need %zu)\n", n_in, out_size, ws_size, (size_t)WS_END); grid = -1; return; }
        int dev = 0, cus = 0, per_cu = 0;
        hipGetDevice(&dev); hipDeviceGetAttribute(&cus, hipDeviceAttributeMultiprocessorCount, dev);
        if (hipFuncSetAttribute((const void*)fwd_megakernel, hipFuncAttributeMaxDynamicSharedMemorySize, LDS_BYTES) != hipSuccess) { fprintf(stderr, "kernel_launch: hipFuncSetAttribute failed\n"); grid = -1; return; }
        if (hipOccupancyMaxActiveBlocksPerMultiprocessor(&per_cu, (const void*)fwd_megakernel, 512, LDS_BYTES) != hipSuccess || per_cu < 1) { fprintf(stderr, "kernel_launch: occupancy query failed (%d)\n", per_cu); grid = -1; return; }
        if (cus != 256) { fprintf(stderr, "kernel_launch: built for a 256-CU device (one 256x256 tile per workgroup in the last two phases), got %d\n", cus); grid = -1; return; }
        grid = cus;
    }
    if (grid < 0) return;
    if (hipMemsetAsync((char*)d_ws + WS_CTL, 0, CTL_BYTES, stream) != hipSuccess) { fprintf(stderr, "kernel_launch: memset failed\n"); return; }
    KArgs a{};
    for (int i = 0; i < 18; ++i) a.in[i] = (const float*)d_in[i];
    a.out = (float*)d_out; a.ws = (unsigned char*)d_ws; a.ph_lo = 0; a.ph_hi = 5;
    void* args[] = {&a};
    hipError_t e = hipLaunchCooperativeKernel((const void*)fwd_megakernel, dim3(grid), dim3(512), args, LDS_BYTES, stream);
    if (e != hipSuccess) fprintf(stderr, "cooperative launch failed: %s (grid %d)\n", hipGetErrorString(e), grid);
}
```

```cpp
#include <hip/hip_runtime.h>
#include <hip/hip_cooperative_groups.h>
#include <cstdio>
#include <cstdint>
namespace cg = cooperative_groups;

#define LAS __attribute__((address_space(3)))
typedef unsigned short bf16;
typedef short bf16x8 __attribute__((ext_vector_type(8)));
typedef short s16x4 __attribute__((ext_vector_type(4)));
typedef float f32x4 __attribute__((ext_vector_type(4)));
typedef unsigned u32x4 __attribute__((ext_vector_type(4)));
typedef unsigned u32x2 __attribute__((ext_vector_type(2)));

constexpr int DM = 1024, NBATCH = 8, SEQ = 2048, NS = 128, NMEM = 256;
constexpr int MPR = NBATCH * SEQ;
constexpr int MV = MPR + NS;
constexpr int MP = MPR + 256;
constexpr int NPAN = MP / 256;
constexpr int INC = 10240;
constexpr float EPS = 1e-6f;
constexpr size_t O_YP = 0, O_YS = O_YP + (size_t)MPR * DM, O_POOLP = O_YS + (size_t)NS * DM, O_POOLS = O_POOLP + (size_t)NBATCH * 15 * DM,
                 O_MK = O_POOLS + (size_t)NS * 15 * DM, O_MV = O_MK + (size_t)NBATCH * NMEM * DM, O_SV = O_MV + (size_t)NBATCH * NMEM * DM, O_END = O_SV + (size_t)NS * DM;
constexpr size_t ROWB = (size_t)MP * DM * 2;
constexpr size_t WS_CTL = 0, CTL_BYTES = 40960;
constexpr size_t WS_VSS2 = CTL_BYTES;
constexpr size_t WS_DS = WS_VSS2 + 32768;
constexpr size_t WS_HS = WS_DS + 262144;
constexpr size_t WS_H = WS_HS + 524288;
constexpr size_t WS_WIN = WS_H + (size_t)(MP + 2048) * DM * 2;
constexpr size_t WS_WD = WS_WIN + (size_t)(INC + 2048) * DM * 2;
constexpr size_t WS_WO3 = WS_WD + (size_t)3 * DM * DM * 2;
constexpr size_t WS_PW = WS_WO3 + (size_t)3 * DM * DM * 2;
constexpr size_t WS_SW = WS_PW + (size_t)4 * 256 * 256 * 2;
constexpr size_t WS_VSS = WS_SW + (size_t)4 * 128 * 128 * 2;
constexpr size_t WS_KB = WS_VSS + (size_t)MP * 16 * 4;
constexpr size_t WS_VB = WS_KB + (size_t)2048 * DM * 2;
constexpr size_t WS_PROJ = WS_VB + (size_t)2048 * DM * 2;
constexpr size_t WS_GATE = WS_PROJ + 7 * ROWB;
constexpr size_t WS_BR = WS_GATE + 3 * ROWB;
constexpr size_t WS_MG = WS_PROJ;
constexpr size_t WS_GYS = WS_H;
constexpr size_t WS_END = WS_BR + 3 * ROWB;
constexpr int LDS_BYTES = 147456;
constexpr int CW_PANEL = 4096, CW_SAMPLE = 4096 + 64 * 64;

__device__ __forceinline__ unsigned f2bf(float f) { unsigned u = __builtin_bit_cast(unsigned, f); return (u + 0x7fffu + ((u >> 16) & 1u)) >> 16; }
__device__ __forceinline__ unsigned pk2(float lo, float hi) { unsigned r; asm volatile("v_cvt_pk_bf16_f32 %0, %1, %2" : "=v"(r) : "v"(lo), "v"(hi)); return r; }
__device__ __forceinline__ float bflo(unsigned w) { return __builtin_bit_cast(float, w << 16); }
__device__ __forceinline__ float bfhi(unsigned w) { return __builtin_bit_cast(float, w & 0xffff0000u); }
__device__ __forceinline__ float silu_f(float x) { return x * __builtin_amdgcn_rcpf(1.f + __expf(-x)); }
__device__ __forceinline__ float sigm_f(float x) { return __builtin_amdgcn_rcpf(1.f + __expf(-x)); }
__device__ __forceinline__ float wave_sum(float v) {
#pragma unroll
    for (int o = 1; o < 64; o <<= 1) v += __shfl_xor(v, o);
    return v;
}
__device__ __forceinline__ float wave_max(float v) {
#pragma unroll
    for (int o = 1; o < 64; o <<= 1) v = fmaxf(v, __shfl_xor(v, o));
    return v;
}
__device__ __forceinline__ bf16x8 tr_read2(const LAS unsigned char* a0, const LAS unsigned char* a1) {
    const s16x4 lo = __builtin_amdgcn_ds_read_tr16_b64_v4i16((LAS s16x4*)a0);
    const s16x4 hi = __builtin_amdgcn_ds_read_tr16_b64_v4i16((LAS s16x4*)a1);
    return (bf16x8){lo[0], lo[1], lo[2], lo[3], hi[0], hi[1], hi[2], hi[3]};
}

#define XB_TMO      128
#define XB_XCNT(j)  (256  + 64 * (j))
#define XB_XSUB(j)  (1280 + 64 * (j))
#define XB_XGEN(j)  (2304 + 64 * (j))
#define XB_TOP      3328
#define XB_TOPGEN   3392
#define XCD_BAR_WORDS 3456
#define XB_SPIN_CAP (1u << 18)

__device__ __forceinline__ unsigned xb_ld(unsigned* p)              { return __hip_atomic_load(p, __ATOMIC_RELAXED, __HIP_MEMORY_SCOPE_AGENT); }
__device__ __forceinline__ unsigned xb_add(unsigned* p, unsigned v) { return __hip_atomic_fetch_add(p, v, __ATOMIC_RELAXED, __HIP_MEMORY_SCOPE_AGENT); }
__device__ __forceinline__ unsigned xb_xcc_id() { return (unsigned)__builtin_amdgcn_s_getreg((3 << 11) | 20) & 0xFu; }
#define XB_SPIN(cond, bar) do { unsigned _sp = 0; while (cond) { __builtin_amdgcn_s_sleep(1); \
    if ((++_sp & 255u) == 0u) { if (xb_ld(&(bar)[XB_TMO])) break; if (_sp > XB_SPIN_CAP) { atomicAdd(&(bar)[XB_TMO], 1u); break; } } } } while (0)

struct XcdBarrier {
    unsigned* bar; unsigned x;
    volatile LAS unsigned* st;
};

__device__ __forceinline__ XcdBarrier xcd_barrier_post(unsigned* bar, volatile LAS unsigned* st) {
    XcdBarrier b; b.bar = bar; b.x = xb_xcc_id(); b.st = st;
    if (threadIdx.x == 0) (void)xb_add(&bar[XB_XCNT(b.x)], 1u);
    return b;
}
__device__ __forceinline__ void xcd_barrier_complete(unsigned* bar, unsigned x, unsigned& nloc, unsigned& nx) {
    const unsigned G = gridDim.x;
    unsigned sum, cnt, mine, sp = 0u;
    for (;;) {
        sum = 0u; cnt = 0u; mine = 0u;
#pragma unroll
        for (unsigned j = 0; j < 16; ++j) { const unsigned c = xb_ld(&bar[XB_XCNT(j)]); sum += c; cnt += (c > 0u) ? 1u : 0u; mine = (j == x) ? c : mine; }
        if (sum == G) break;
        __builtin_amdgcn_s_sleep(1);
        if ((++sp & 255u) == 0u) { if (xb_ld(&bar[XB_TMO])) break; if (sp > XB_SPIN_CAP) { atomicAdd(&bar[XB_TMO], 1u); break; } }
    }
    nloc = mine > 0u ? mine : 1u; nx = cnt > 0u ? cnt : 1u;
}

__device__ __forceinline__ void xcd_barrier(const XcdBarrier& b) {
    asm volatile("s_waitcnt vmcnt(0)" ::: "memory");
    __syncthreads();
    if (threadIdx.x == 0) {
        unsigned* bar = b.bar;
        __builtin_amdgcn_s_waitcnt(0);
        unsigned nloc = b.st[0], nx = b.st[1];
        if (nloc == 0u) { xcd_barrier_complete(bar, b.x, nloc, nx); b.st[0] = nloc; b.st[1] = nx; }
        const unsigned old = xb_add(&bar[XB_XSUB(b.x)], 1u);
        const unsigned gen = old / nloc;
        if (old + 1u == (gen + 1u) * nloc) {
            __builtin_amdgcn_fence(__ATOMIC_RELEASE, "agent");
            asm volatile("s_waitcnt vmcnt(0)" ::: "memory");
            const unsigned og = xb_add(&bar[XB_TOP], 1u);
            const unsigned tg = og / nx;
            if (og + 1u == (tg + 1u) * nx) xb_add(&bar[XB_TOPGEN], 1u);
            else XB_SPIN(xb_ld(&bar[XB_TOPGEN]) == tg, bar);
            __builtin_amdgcn_fence(__ATOMIC_ACQUIRE, "agent");
            xb_add(&bar[XB_XGEN(b.x)], 1u);
            asm volatile("s_waitcnt vmcnt(0)" ::: "memory");
        } else {
            XB_SPIN(xb_ld(&bar[XB_XGEN(b.x)]) == gen, bar);
            __builtin_amdgcn_fence(__ATOMIC_ACQUIRE, "agent");
            asm volatile("s_waitcnt vmcnt(0)" ::: "memory");
        }
    }
    __syncthreads();
}

namespace pg8 {
#define PG8_LAS __attribute__((address_space(3)))
typedef unsigned short bf16_t;
constexpr int BM = 256, BK = 64, HALF = 128, HTB = HALF * BK * 2, STAGE_BYTES = 8 * HTB, NXCD = 8, WGM = 8;
__host__ __device__ __forceinline__ int lds_byte(int r, int c) { const int st = (r >> 4) * 2 + (c >> 5), rr = r & 15, cc = c & 31, ob = rr * 64 + cc * 2; return st * 1024 + (ob ^ (((ob >> 9) & 1) << 5)); }
__host__ __device__ __forceinline__ void stage_rc(int b, int& R, int& C) { const int st = b / 1024, sb = b % 1024, swz = sb ^ (((sb >> 9) & 1) << 5); R = (st >> 1) * 16 + swz / 64; C = (st & 1) * 32 + (swz % 64) / 2; }
__host__ __device__ __forceinline__ int perm32(int rho) { const int n = rho >> 4, i = rho & 15; return 8 * (i >> 2) + 4 * n + (i & 3); }
struct Unit { int pm, pn; };
struct Gemm { const bf16_t* A; const bf16_t* Bt; int M, N, K; };
struct StaticOrder {
    int nM, nN, nwg, G, c;
    __host__ __device__ void init(int M, int N, int G_, int c_) { nM = M / BM; nN = N / BM; nwg = nM * nN; G = G_; c = c_; }
    __host__ __device__ bool next(int i, Unit& u) const {
        const long L = (long)i * G + c; if (L >= nwg) return false;
        int wgid = (int)L; { const int q = nwg / NXCD, r = nwg % NXCD, xcd = wgid % NXCD, off = wgid / NXCD; wgid = (xcd < r ? xcd * (q + 1) : r * (q + 1) + (xcd - r) * q) + off; }
        const int nig = WGM * nN, gid = wgid / nig, fm = gid * WGM, gsz = (nM - fm) < WGM ? (nM - fm) : WGM;
        u.pm = fm + ((wgid % nig) % gsz); u.pn = (wgid % nig) / gsz; return true;
    }
    __device__ __forceinline__ void a_ready(const Unit&) const {}
    __device__ __forceinline__ void done(const Unit&) const {}
};

template <class Epi, class Sched>
__device__ __forceinline__ void gemm_phase(PG8_LAS unsigned char* lds, const Gemm g, const Sched& S, const Epi& E) {
    const int tid = threadIdx.x, wid = __builtin_amdgcn_readfirstlane(tid >> 6), lane = tid & 63, wr = wid >> 2, wc = wid & 3, fr = lane & 15, fq = lane >> 4;
    const int K = g.K, nt = K / BK;
    unsigned voffA[2], voffB[2];
#pragma unroll
    for (int i = 0; i < 2; ++i) { int R, C; stage_rc(tid * 16 + i * 8192, R, C); const int Rb = Epi::PERM ? ((R & ~31) + perm32(R & 31)) : R;
        voffA[i] = (unsigned)(R * K + C) * 2u; voffB[i] = (unsigned)(Rb * K + C) * 2u; }
    const size_t kstep = (size_t)(BK * 2);
    const size_t hstep = (size_t)HALF * K * 2;
    const size_t tstep = 2 * hstep;
    const unsigned ldsw = (unsigned)wid * 1024u;
    const int aoff = lds_byte(wr * 64 + fr, fq * 8), boff = lds_byte(wc * 32 + fr, fq * 8);
#define PG8_SA(b, h) (((b) * 2 + (h)) * HTB)
#define PG8_SB(b, h) ((4 + (b) * 2 + (h)) * HTB)
#define PG8_STAGE(bufoff, gbase, voff) do { _Pragma("unroll") for (int _i = 0; _i < 2; ++_i) \
        __builtin_amdgcn_global_load_lds((const unsigned*)((const char*)(gbase) + (voff)[_i]), (PG8_LAS unsigned*)(lds + (bufoff) + ldsw + _i * 8192), 16, 0, 0); } while (0)
#define PG8_LDA(dst, b, h) do { _Pragma("unroll") for (int m = 0; m < 4; ++m) _Pragma("unroll") for (int k = 0; k < 2; ++k) dst[m][k] = *(const PG8_LAS bf16x8*)(lds + PG8_SA(b, h) + aoff + m * 2048 + k * 1024); } while (0)
#define PG8_LDB(dst, b, h) do { _Pragma("unroll") for (int n = 0; n < 2; ++n) _Pragma("unroll") for (int k = 0; k < 2; ++k) dst[n][k] = *(const PG8_LAS bf16x8*)(lds + PG8_SB(b, h) + boff + n * 2048 + k * 1024); } while (0)
#define PG8_MMA(ai, bj, At, Bt) do { __builtin_amdgcn_s_setprio(1); _Pragma("unroll") for (int m = 0; m < 4; ++m) _Pragma("unroll") for (int n = 0; n < 2; ++n) _Pragma("unroll") for (int k = 0; k < 2; ++k) \
        acc[ai][bj][m][n] = __builtin_amdgcn_mfma_f32_16x16x32_bf16(Bt[n][k], At[m][k], acc[ai][bj][m][n], 0, 0, 0); __builtin_amdgcn_s_setprio(0); } while (0)
#define PG8_WAIT_V(n) asm volatile("s_waitcnt vmcnt(" #n ")" ::: "memory")
#define PG8_WAIT_L(n) asm volatile("s_waitcnt lgkmcnt(" #n ")" ::: "memory")
#define PG8_BAR __builtin_amdgcn_s_barrier()
#define PG8_SCHED __builtin_amdgcn_sched_barrier(0)
    Unit cur, nxt; int ui = 0;
    if (!S.next(0, cur)) return;
    f32x4 acc[2][2][4][2];
#pragma unroll
    for (int a = 0; a < 2; ++a)
#pragma unroll
        for (int b = 0; b < 2; ++b)
#pragma unroll
            for (int m = 0; m < 4; ++m)
#pragma unroll
                for (int n = 0; n < 2; ++n) acc[a][b][m][n] = (f32x4){0.f, 0.f, 0.f, 0.f};
    bf16x8 At[4][2], B0[2][2], B1[2][2];
    const char* cA = (const char*)g.A + (size_t)cur.pm * tstep; const char* cB = (const char*)g.Bt + (size_t)cur.pn * tstep;
    S.a_ready(cur);
    PG8_STAGE(PG8_SB(0, 0), cB, voffB); PG8_STAGE(PG8_SA(0, 0), cA, voffA); PG8_STAGE(PG8_SB(0, 1), cB + hstep, voffB); PG8_STAGE(PG8_SA(0, 1), cA + hstep, voffA);
    if (wr == 1) PG8_BAR;
    PG8_WAIT_V(4); PG8_BAR;
    PG8_STAGE(PG8_SB(1, 0), cB + kstep, voffB); PG8_STAGE(PG8_SA(1, 0), cA + kstep, voffA); PG8_STAGE(PG8_SB(1, 1), cB + hstep + kstep, voffB);
    PG8_WAIT_V(6); PG8_BAR;
    for (;;) {
        const bool has_next = S.next(ui + 1, nxt);
        const char* nA = has_next ? (const char*)g.A + (size_t)nxt.pm * tstep : cA; const char* nB = has_next ? (const char*)g.Bt + (size_t)nxt.pn * tstep : cB;
        E.prefetch(cur, wid, lane, lds + STAGE_BYTES + wid * 1024);
        for (int t = 0; t < nt; t += 2) {
            const bool last = (t == nt - 2);
            const char* a1 = cA + (size_t)(t + 1) * kstep;
            const char* a2 = last ? nA : cA + (size_t)(t + 2) * kstep; const char* b2 = last ? nB : cB + (size_t)(t + 2) * kstep;
            const char* a3 = a2 + kstep; const char* b3 = b2 + kstep;
            if (last && has_next) S.a_ready(nxt);
            PG8_LDB(B0, 0, 0); PG8_SCHED; PG8_LDA(At, 0, 0); PG8_STAGE(PG8_SA(1, 1), a1 + hstep, voffA);
            PG8_WAIT_L(8); PG8_BAR; PG8_WAIT_L(0); PG8_MMA(0, 0, At, B0); PG8_BAR; PG8_SCHED;
            PG8_LDB(B1, 0, 1); PG8_STAGE(PG8_SB(0, 0), b2, voffB);
            PG8_BAR; PG8_WAIT_L(0); PG8_MMA(0, 1, At, B1); PG8_BAR;
            PG8_LDA(At, 0, 1); PG8_STAGE(PG8_SA(0, 0), a2, voffA);
            PG8_BAR; PG8_WAIT_L(0); PG8_MMA(1, 0, At, B0); PG8_BAR; PG8_SCHED;
            PG8_STAGE(PG8_SB(0, 1), b2 + hstep, voffB);
            PG8_WAIT_V(6); PG8_BAR; PG8_MMA(1, 1, At, B1); PG8_BAR;
            PG8_LDB(B0, 1, 0); PG8_SCHED; PG8_LDA(At, 1, 0); PG8_STAGE(PG8_SA(0, 1), a2 + hstep, voffA);
            PG8_WAIT_L(8); PG8_BAR; PG8_WAIT_L(0); PG8_MMA(0, 0, At, B0); PG8_BAR; PG8_SCHED;
            PG8_LDB(B1, 1, 1); PG8_STAGE(PG8_SB(1, 0), b3, voffB);
            PG8_BAR; PG8_WAIT_L(0); PG8_MMA(0, 1, At, B1); PG8_BAR;
            PG8_LDA(At, 1, 1); PG8_STAGE(PG8_SA(1, 0), a3, voffA);
            PG8_BAR; PG8_WAIT_L(0); PG8_MMA(1, 0, At, B0); PG8_BAR; PG8_SCHED;
            PG8_STAGE(PG8_SB(1, 1), b3 + hstep, voffB);
            PG8_WAIT_V(6); PG8_BAR; PG8_MMA(1, 1, At, B1); PG8_BAR;
        }
        if constexpr (!Epi::AFTER_DRAIN) { E(acc, cur, wr, wc, fr, fq); S.done(cur); }
        if (!has_next) break;
#pragma unroll
        for (int a = 0; a < 2; ++a)
#pragma unroll
            for (int b = 0; b < 2; ++b)
#pragma unroll
                for (int m = 0; m < 4; ++m)
#pragma unroll
                    for (int n = 0; n < 2; ++n) acc[a][b][m][n] = (f32x4){0.f, 0.f, 0.f, 0.f};
        cur = nxt; cA = nA; cB = nB; ++ui;
    }
    PG8_WAIT_V(0);
    if (wr == 0) PG8_BAR;
    PG8_BAR;
    if constexpr (Epi::AFTER_DRAIN) { E.fused(acc, cur, wr, wc, fr, fq); S.done(cur); }
#undef PG8_SA
#undef PG8_SB
#undef PG8_STAGE
#undef PG8_LDA
#undef PG8_LDB
#undef PG8_MMA
#undef PG8_WAIT_V
#undef PG8_WAIT_L
#undef PG8_BAR
#undef PG8_SCHED
}
}

struct KArgs {
    const float* in[18];
    float* out;
    unsigned char* ws;
    int ph_lo, ph_hi;
    int cg_sync, pad;
};
enum { I_XP = 0, I_XS, I_SPOOL, I_CK, I_CV, I_MEM, I_NORMG, I_WIN, I_POOLW, I_POOLSC, I_SGUNG, I_SGUW, I_SGUB, I_MEMNG, I_WKV, I_WDOWN, I_WOUT, I_NORMF };

struct P1Order {
    pg8::StaticOrder so; int G, c;
    __device__ void init(int G_, int c_) { so.init(MPR, INC, G_, c_); G = G_; c = c_; }
    __device__ bool next(int i, pg8::Unit& u) const {
        const long L = (long)i * G + c;
        if (L < so.nwg) return so.next(i, u);
        const int e = (int)(L - so.nwg); if (e >= 104) return false;
        if (e < 64) { u.pm = NPAN + (e >> 3); u.pn = 40 + (e & 7); } else { u.pm = 64; u.pn = e - 64; }
        return true;
    }
    __device__ __forceinline__ void a_ready(const pg8::Unit&) const {}
    __device__ __forceinline__ void done(const pg8::Unit&) const {}
};
struct EpiProj {
    static constexpr bool PERM = true, AFTER_DRAIN = false;
    bf16* proj; bf16* gate; float* vss; bf16* kb; bf16* vb; float* out; const float* hs; bf16* dsr;
    __device__ __forceinline__ void prefetch(const pg8::Unit&, int, int, LAS unsigned char*) const {}
    __device__ __forceinline__ void operator()(const f32x4 (&acc)[2][2][4][2], const pg8::Unit& u, int wr, int wc, int fr, int fq) const {
        if (u.pn < 40) {
            const int sec = u.pn >> 2;
            const int act = (sec == 1 || sec == 4 || sec == 6) ? 1 : (sec >= 7 ? 2 : 0);
            const int row0 = u.pm * 256 + wr * 64 + fr, cs0 = (u.pn & 3) * 256 + wc * 32 + 8 * fq;
            bf16* base; int ld;
            if (sec < 7) { base = proj + (size_t)sec * MP * DM; ld = DM; } else { base = gate + (sec - 7) * DM; ld = 3 * DM; }
            const bool poolrows = (sec == 0) && (((u.pm & 7) == 7) || u.pm == 64);
#pragma unroll
            for (int ai = 0; ai < 2; ++ai)
#pragma unroll
                for (int m = 0; m < 4; ++m) {
                    const int r = row0 + ai * 128 + m * 16; float ss = 0.f;
#pragma unroll
                    for (int bj = 0; bj < 2; ++bj) {
                        f32x4 v0 = acc[ai][bj][m][0], v1 = acc[ai][bj][m][1]; const int cs = cs0 + bj * 128;
                        if (sec == 3) ss += (v0[0] * v0[0] + v0[1] * v0[1]) + (v0[2] * v0[2] + v0[3] * v0[3]) + (v1[0] * v1[0] + v1[1] * v1[1]) + (v1[2] * v1[2] + v1[3] * v1[3]);
                        if (poolrows) {
                            float* dst = nullptr;
                            if (r < MPR) { const int t = r & (SEQ - 1); if (t >= SEQ - 15) dst = out + O_POOLP + ((size_t)(r >> 11) * 15 + (t - (SEQ - 15))) * DM + cs; }
                            else if (r < MV) { dst = out + O_POOLS + ((size_t)(r - MPR) * 15 + 14) * DM + cs;
                                const float* hp = hs + (size_t)(r - MPR) * DM + cs; const f32x4 h0 = *(const f32x4*)hp, h1 = *(const f32x4*)(hp + 4); const float inv = 1.f / (float)(2 << (cs >> 8));
                                u32x4 d; d.x = pk2((h0.x + v0[0]) * inv - v0[0], (h0.y + v0[1]) * inv - v0[1]); d.y = pk2((h0.z + v0[2]) * inv - v0[2], (h0.w + v0[3]) * inv - v0[3]);
                                d.z = pk2((h1.x + v1[0]) * inv - v1[0], (h1.y + v1[1]) * inv - v1[1]); d.w = pk2((h1.z + v1[2]) * inv - v1[2], (h1.w + v1[3]) * inv - v1[3]);
                                *(u32x4*)(dsr + (size_t)(r - MPR) * DM + cs) = d; }
                            if (dst) { *(f32x4*)dst = v0; *(f32x4*)(dst + 4) = v1; }
                        }
                        if (act == 1) {
#pragma unroll
                            for (int j = 0; j < 4; ++j) { v0[j] = silu_f(v0[j]); v1[j] = silu_f(v1[j]); } }
                        if (act == 2) {
#pragma unroll
                            for (int j = 0; j < 4; ++j) { v0[j] = sigm_f(v0[j]); v1[j] = sigm_f(v1[j]); } }
                        u32x4 w; w.x = pk2(v0[0], v0[1]); w.y = pk2(v0[2], v0[3]); w.z = pk2(v1[0], v1[1]); w.w = pk2(v1[2], v1[3]);
                        __builtin_nontemporal_store(w, (u32x4*)(base + (size_t)r * ld + cs));
                    }
                    if (sec == 3) { ss += __shfl_xor(ss, 16); ss += __shfl_xor(ss, 32); if (fq == 0) vss[(size_t)r * 16 + (u.pn & 3) * 4 + wc] = ss; }
                }
        } else {
            const int b = u.pm - NPAN, ct = (u.pn - 40) * 256;
            const bool isv = ct >= DM; const int cb = (isv ? ct - DM : ct) + wc * 32 + 8 * fq;
            float* of = out + (isv ? O_MV : O_MK); bf16* ob = isv ? vb : kb;
#pragma unroll
            for (int ai = 0; ai < 2; ++ai)
#pragma unroll
                for (int m = 0; m < 4; ++m) {
                    const size_t j = (size_t)b * 256 + ai * 128 + wr * 64 + m * 16 + fr;
#pragma unroll
                    for (int bj = 0; bj < 2; ++bj) {
                        const f32x4 v0 = acc[ai][bj][m][0], v1 = acc[ai][bj][m][1]; const int cs = cb + bj * 128;
                        __builtin_nontemporal_store(v0, (f32x4*)(of + j * DM + cs)); __builtin_nontemporal_store(v1, (f32x4*)(of + j * DM + cs + 4));
                        u32x4 w; w.x = pk2(v0[0], v0[1]); w.y = pk2(v0[2], v0[3]); w.z = pk2(v1[0], v1[1]); w.w = pk2(v1[2], v1[3]);
                        *(u32x4*)(ob + j * DM + cs) = w;
                    }
                }
        }
    }
};
struct P3Order {
    pg8::StaticOrder so;
    __device__ void init(int G_, int c_) { so.init(MPR, DM, G_, c_); }
    __device__ bool next(int i, pg8::Unit& u) const { const int rnd = i / 3, b = i - 3 * rnd; pg8::Unit t; if (!so.next(rnd, t)) return false; u.pm = b * NPAN + t.pm; u.pn = b * 4 + t.pn; return true; }
    __device__ __forceinline__ void a_ready(const pg8::Unit&) const {}
    __device__ __forceinline__ void done(const pg8::Unit&) const {}
};
struct EpiGate {
    static constexpr bool PERM = true, AFTER_DRAIN = false;
    const bf16* gate; bf16* mg;
    __device__ __forceinline__ void prefetch(const pg8::Unit& u, int wid, int lane, LAS unsigned char* scr) const {
        const int b = u.pn >> 2, pm = u.pm - b * NPAN, t = wid * 64 + lane;
#pragma unroll
        for (int j = 0; j < 2; ++j) { const int li = t + 512 * j, row = li >> 2, seg = li & 3; const size_t r = (size_t)(pm * 256 + row);
            __builtin_amdgcn_global_load_lds((const unsigned*)(gate + r * (3 * DM) + b * DM + (u.pn & 3) * 256 + seg * 64), (LAS unsigned*)(scr + j * 256), 4, 0, 0); }
    }
    __device__ __forceinline__ void operator()(const f32x4 (&acc)[2][2][4][2], const pg8::Unit& u, int wr, int wc, int fr, int fq) const {
        const int b = u.pn >> 2, pm = u.pm - b * NPAN;
        const int row0 = pm * 256 + wr * 64 + fr, c0 = (u.pn & 3) * 256 + wc * 32 + 8 * fq;
#pragma unroll
        for (int ai = 0; ai < 2; ++ai)
#pragma unroll
            for (int m = 0; m < 4; ++m) {
                const size_t r = (size_t)(row0 + ai * 128 + m * 16);
#pragma unroll
                for (int bj = 0; bj < 2; ++bj) {
                    const f32x4 v0 = acc[ai][bj][m][0], v1 = acc[ai][bj][m][1]; const int c = c0 + bj * 128;
                    const u32x4 g8 = *(const u32x4*)(gate + r * (3 * DM) + b * DM + c);
                    float o0 = v0[0] * bflo(g8.x), o1 = v0[1] * bfhi(g8.x), o2 = v0[2] * bflo(g8.y), o3 = v0[3] * bfhi(g8.y);
                    float o4 = v1[0] * bflo(g8.z), o5 = v1[1] * bfhi(g8.z), o6 = v1[2] * bflo(g8.w), o7 = v1[3] * bfhi(g8.w);
                    if (b > 0) { const u32x4 p = *(const u32x4*)(mg + r * DM + c);
                        o0 += bflo(p.x); o1 += bfhi(p.x); o2 += bflo(p.y); o3 += bfhi(p.y); o4 += bflo(p.z); o5 += bfhi(p.z); o6 += bflo(p.w); o7 += bfhi(p.w); }
                    u32x4 w; w.x = pk2(o0, o1); w.y = pk2(o2, o3); w.z = pk2(o4, o5); w.w = pk2(o6, o7);
                    if (b == 2) __builtin_nontemporal_store(w, (u32x4*)(mg + r * DM + c)); else *(u32x4*)(mg + r * DM + c) = w;
                }
            }
    }
};
__device__ __forceinline__ void st_agent(float* p, float v) { __hip_atomic_store((unsigned*)p, __builtin_bit_cast(unsigned, v), __ATOMIC_RELAXED, __HIP_MEMORY_SCOPE_AGENT); }
__device__ __forceinline__ float ld_agent(const float* p) { return __builtin_bit_cast(float, __hip_atomic_load((unsigned*)p, __ATOMIC_RELAXED, __HIP_MEMORY_SCOPE_AGENT)); }
__device__ __forceinline__ void wait_count(unsigned* w, unsigned want) {
    unsigned sp = 0;
    while ((unsigned)__builtin_amdgcn_readfirstlane(__hip_atomic_load(w, __ATOMIC_RELAXED, __HIP_MEMORY_SCOPE_AGENT)) < want) { __builtin_amdgcn_s_sleep(2); if (++sp > (1u << 22)) break; }
    __builtin_amdgcn_fence(__ATOMIC_ACQUIRE, "agent");
    asm volatile("s_waitcnt vmcnt(0)" ::: "memory");
}
struct EpiOutNorm {
    static constexpr bool PERM = false, AFTER_DRAIN = true;
    const float* xp; const float* gf; float* out; float* slots; unsigned* cnt;
    __device__ __forceinline__ void prefetch(const pg8::Unit& u, int wid, int lane, LAS unsigned char* scr) const {
        const int t = wid * 64 + lane;
#pragma unroll
        for (int j = 0; j < 4; ++j) { const int li = t + 512 * j, row = li >> 3, seg = li & 7;
            __builtin_amdgcn_global_load_lds((const unsigned*)(xp + (size_t)(u.pm * 256 + row) * DM + u.pn * 256 + seg * 32), (LAS unsigned*)(scr + j * 256), 4, 0, 0); }
    }
    __device__ __forceinline__ void operator()(const f32x4 (&)[2][2][4][2], const pg8::Unit&, int, int, int, int) const {}
    __device__ __forceinline__ void fused(f32x4 (&acc)[2][2][4][2], const pg8::Unit& u, int wr, int wc, int fr, int fq) const {
        const int row0 = u.pm * 256 + wr * 64 + fr, col0 = u.pn * 256 + wc * 32 + 4 * fq;
#pragma unroll
        for (int ai = 0; ai < 2; ++ai)
#pragma unroll
            for (int m = 0; m < 4; ++m) { const size_t r = (size_t)(row0 + ai * 128 + m * 16); float ss = 0.f;
#pragma unroll
                for (int bj = 0; bj < 2; ++bj)
#pragma unroll
                    for (int n = 0; n < 2; ++n) { const int c = col0 + bj * 128 + n * 16; const f32x4 v = acc[ai][bj][m][n] + __builtin_nontemporal_load((const f32x4*)(xp + r * DM + c)); acc[ai][bj][m][n] = v;
                        ss += (v.x * v.x + v.y * v.y) + (v.z * v.z + v.w * v.w); }
                ss += __shfl_xor(ss, 16); ss += __shfl_xor(ss, 32);
                if (fq == 0) st_agent(slots + r * 16 + u.pn * 4 + wc, ss); }
        asm volatile("s_waitcnt vmcnt(0)" ::: "memory");
        if (fr == 0 && fq == 0) __hip_atomic_fetch_add(cnt + 64 * u.pm, 1u, __ATOMIC_RELAXED, __HIP_MEMORY_SCOPE_AGENT);
        if (threadIdx.x < 64) wait_count(cnt + 64 * u.pm, 32u);
        __syncthreads();
#pragma unroll
        for (int ai = 0; ai < 2; ++ai)
#pragma unroll
            for (int m = 0; m < 4; ++m) { const size_t r = (size_t)(row0 + ai * 128 + m * 16); float tot = 0.f;
                { const f32x4* sp = (const f32x4*)(slots + r * 16); const f32x4 p0 = sp[0], p1 = sp[1], p2 = sp[2], p3 = sp[3];
                  tot = (((p0.x + p0.y) + (p0.z + p0.w)) + ((p1.x + p1.y) + (p1.z + p1.w))) + (((p2.x + p2.y) + (p2.z + p2.w)) + ((p3.x + p3.y) + (p3.z + p3.w))); }
                const float rs = rsqrtf(tot * (1.f / DM) + EPS);
#pragma unroll
                for (int bj = 0; bj < 2; ++bj)
#pragma unroll
                    for (int n = 0; n < 2; ++n) { const int c = col0 + bj * 128 + n * 16; const f32x4 g = *(const f32x4*)(gf + c); const f32x4 v = acc[ai][bj][m][n];
                        __builtin_nontemporal_store((f32x4){v.x * rs * g.x, v.y * rs * g.y, v.z * rs * g.z, v.w * rs * g.w}, (f32x4*)(out + O_YP + r * DM + c)); } }
    }
};

template <class Epi>
__device__ __forceinline__ void skinny_gemm(LAS unsigned char* lds, const bf16* A0, int lda, size_t a_grp_stride, int strips_per_grp, int nseg, int aseg,
                                            const bf16* Bt, int ldb, int K, int nstrips, int first, int step, const Epi& E) {
    int tid_ = threadIdx.x; asm volatile("" : "+v"(tid_));
    const int tid = tid_, lane = tid & 63, wv = tid >> 6, fr = lane & 15, fq = lane >> 4, rh = wv & 1, kq = wv >> 1;
    LAS float* part = (LAS float*)lds;
    const int nks = K / 128;
    for (int s = first; s < nstrips; s += step) {
        const bf16* A = A0 + (size_t)(s / strips_per_grp) * a_grp_stride + (size_t)(rh * 64 + fr) * lda + fq * 8;
        const bf16* B = Bt + (size_t)(16 * s + fr) * ldb + fq * 8;
        f32x4 acc[4];
#pragma unroll
        for (int rb = 0; rb < 4; ++rb) acc[rb] = (f32x4){0.f, 0.f, 0.f, 0.f};
        for (int seg = 0; seg < nseg; ++seg) {
#pragma unroll 4
            for (int k = 0; k < nks; ++k) {
                const int ko = (kq * nks + k) * 32;
                const bf16x8 bfr = *(const bf16x8*)(B + ko);
#pragma unroll
                for (int rb = 0; rb < 4; ++rb) { const bf16x8 afr = *(const bf16x8*)(A + (size_t)rb * 16 * lda + seg * aseg + ko);
                    acc[rb] = __builtin_amdgcn_mfma_f32_16x16x32_bf16(bfr, afr, acc[rb], 0, 0, 0); }
            }
        }
#pragma unroll
        for (int rb = 0; rb < 4; ++rb) *(LAS f32x4*)(part + ((kq * 128 + rh * 64 + rb * 16 + fr) * 16 + fq * 4)) = acc[rb];
        __syncthreads();
        { const int row = tid >> 2, cq = tid & 3; const LAS float* p = part + row * 16 + cq * 4;
          const f32x4 v = (*(const LAS f32x4*)p + *(const LAS f32x4*)(p + 2048)) + (*(const LAS f32x4*)(p + 4096) + *(const LAS f32x4*)(p + 6144));
          E(s, row, 16 * s + cq * 4, v, cq); }
        __syncthreads();
    }
}
struct EpiS1 {
    bf16* proj; bf16* gate; float* vss2; float* out; const float* hist; bf16* ds;
    __device__ __forceinline__ void operator()(int s, int row, int c, f32x4 v, int cq) const {
        const int sec = c >> 10, cs = c & 1023; const size_t m = (size_t)(MPR + row);
        if (sec == 0) { *(f32x4*)(out + O_POOLS + ((size_t)row * 15 + 14) * DM + cs) = v;
            const int w = 2 << (cs >> 8); f32x4 sm = v;
#pragma unroll
            for (int j = 0; j < 15; ++j) if (j < w - 1) sm = sm + *(const f32x4*)(hist + ((size_t)row * 15 + 14 - j) * DM + cs);
            const float inv = 1.f / (float)w;
            u32x2 d; d.x = pk2(sm.x * inv - v.x, sm.y * inv - v.y); d.y = pk2(sm.z * inv - v.z, sm.w * inv - v.w);
            *(u32x2*)(ds + (size_t)row * DM + cs) = d; }
        if (sec == 3) { float ss = (v.x * v.x + v.y * v.y) + (v.z * v.z + v.w * v.w); ss += __shfl_xor(ss, 1); ss += __shfl_xor(ss, 2); if (cq == 0) vss2[row * 64 + (s - 192)] = ss; }
        if (sec == 1 || sec == 4 || sec == 6) { v.x = silu_f(v.x); v.y = silu_f(v.y); v.z = silu_f(v.z); v.w = silu_f(v.w); }
        if (sec >= 7) { v.x = sigm_f(v.x); v.y = sigm_f(v.y); v.z = sigm_f(v.z); v.w = sigm_f(v.w); }
        u32x2 w; w.x = pk2(v.x, v.y); w.y = pk2(v.z, v.w);
        if (sec < 7) *(u32x2*)(proj + (size_t)sec * MP * DM + m * DM + cs) = w; else *(u32x2*)(gate + m * (3 * DM) + (sec - 7) * DM + cs) = w;
    }
};
struct EpiS3 {
    const bf16* gate; bf16* gys;
    __device__ __forceinline__ void operator()(int s, int row, int c, f32x4 v, int cq) const {
        const u32x2 g = *(const u32x2*)(gate + (size_t)(MPR + row) * (3 * DM) + c);
        u32x2 w; w.x = pk2(v.x * bflo(g.x), v.y * bfhi(g.x)); w.y = pk2(v.z * bflo(g.y), v.w * bfhi(g.y));
        *(u32x2*)(gys + (size_t)row * (3 * DM) + c) = w;
    }
};
struct EpiS4 {
    const float* xs; const float* gf; float* out; float* slots2; unsigned* cnt2;
    __device__ __forceinline__ void operator()(int s, int row, int c, f32x4 v, int cq) const {
        v = v + *(const f32x4*)(xs + (size_t)row * DM + c);
        float ss = (v.x * v.x + v.y * v.y) + (v.z * v.z + v.w * v.w); ss += __shfl_xor(ss, 1); ss += __shfl_xor(ss, 2);
        if (cq == 0) st_agent(slots2 + row * 64 + s, ss);
        asm volatile("s_waitcnt vmcnt(0)" ::: "memory");
        __syncthreads();
        if (threadIdx.x == 0) __hip_atomic_fetch_add(cnt2, 1u, __ATOMIC_RELAXED, __HIP_MEMORY_SCOPE_AGENT);
        if (threadIdx.x < 64) wait_count(cnt2, 64u);
        __syncthreads();
        float tot = 0.f;
        { const f32x4* sp = (const f32x4*)(slots2 + row * 64 + cq * 16); const f32x4 p0 = sp[0], p1 = sp[1], p2 = sp[2], p3 = sp[3];
          tot = (((p0.x + p0.y) + (p0.z + p0.w)) + ((p1.x + p1.y) + (p1.z + p1.w))) + (((p2.x + p2.y) + (p2.z + p2.w)) + ((p3.x + p3.y) + (p3.z + p3.w))); }
        tot += __shfl_xor(tot, 1); tot += __shfl_xor(tot, 2);
        const float rs = rsqrtf(tot * (1.f / DM) + EPS); const f32x4 g = *(const f32x4*)(gf + c);
        *(f32x4*)(out + O_YS + (size_t)row * DM + c) = (f32x4){v.x * rs * g.x, v.y * rs * g.y, v.z * rs * g.z, v.w * rs * g.w};
    }
};


__device__ __forceinline__ void sample_out_split(const KArgs& a, LAS unsigned char* lds, int item) {
    int tid_ = threadIdx.x; asm volatile("" : "+v"(tid_));
    const int tid = tid_, lane = tid & 63, wv = tid >> 6, fr = lane & 15, fq = lane >> 4, s = item >> 2, rq = item & 3;
    const bf16* A = (const bf16*)(a.ws + WS_GYS) + (size_t)(rq * 32 + fr) * (3 * DM) + fq * 8;
    const bf16* B = (const bf16*)(a.ws + WS_WO3) + (size_t)(16 * s + fr) * DM + fq * 8;
    f32x4 acc0 = (f32x4){0.f, 0.f, 0.f, 0.f}, acc1 = acc0;
#pragma unroll
    for (int kk = 0; kk < 12; ++kk) { const int k = 384 * wv + 32 * kk;
        const bf16x8 bfr = *(const bf16x8*)(B + (k & 1023)); const bf16x8 a0 = *(const bf16x8*)(A + k), a1 = *(const bf16x8*)(A + (size_t)16 * (3 * DM) + k);
        acc0 = __builtin_amdgcn_mfma_f32_16x16x32_bf16(bfr, a0, acc0, 0, 0, 0); acc1 = __builtin_amdgcn_mfma_f32_16x16x32_bf16(bfr, a1, acc1, 0, 0, 0); }
    LAS float* part = (LAS float*)lds;
    *(LAS f32x4*)(part + (wv * 32 + fr) * 16 + fq * 4) = acc0; *(LAS f32x4*)(part + (wv * 32 + 16 + fr) * 16 + fq * 4) = acc1;
    __syncthreads();
    const int row = tid >> 4, col = tid & 15, grow = rq * 32 + row, c = 16 * s + col;
    float v = 0.f;
#pragma unroll
    for (int w8 = 0; w8 < 8; ++w8) v += part[(w8 * 32 + row) * 16 + col];
    v += a.in[I_XS][(size_t)grow * DM + c];
    float ss = v * v; ss += __shfl_xor(ss, 1); ss += __shfl_xor(ss, 2); ss += __shfl_xor(ss, 4); ss += __shfl_xor(ss, 8);
    float* slots2 = (float*)(a.ws + WS_VSS2); unsigned* cnt = (unsigned*)(a.ws + WS_CTL) + CW_SAMPLE + 64 * rq;
    if (col == 0) st_agent(slots2 + grow * 64 + s, ss);
    asm volatile("s_waitcnt vmcnt(0)" ::: "memory");
    __syncthreads();
    if (tid == 0) __hip_atomic_fetch_add(cnt, 1u, __ATOMIC_RELAXED, __HIP_MEMORY_SCOPE_AGENT);
    if (tid < 64) wait_count(cnt, 64u);
    __syncthreads();
    const f32x4 p4 = *(const f32x4*)(slots2 + grow * 64 + col * 4);
    float tot = (p4.x + p4.y) + (p4.z + p4.w); tot += __shfl_xor(tot, 1); tot += __shfl_xor(tot, 2); tot += __shfl_xor(tot, 4); tot += __shfl_xor(tot, 8);
    a.out[O_YS + (size_t)grow * DM + c] = v * rsqrtf(tot * (1.f / DM) + EPS) * a.in[I_NORMF][c];
    __syncthreads();
}

__device__ __forceinline__ void p0_transpose_item(const float* W, int N, bf16* WT, int row_off, int ldo, int koff, LAS float* scr, int item, int lane) {
    const int nblk = N / 32, kb = item / nblk, nb = item % nblk, k0 = 64 * kb, n0 = 32 * nb;
#pragma unroll 8
    for (int i = 0; i < 32; ++i) { const int kk = 2 * i + (lane >> 5); scr[kk * 33 + (lane & 31)] = __builtin_nontemporal_load(W + (size_t)(k0 + kk) * N + n0 + (lane & 31)); }
    asm volatile("s_waitcnt lgkmcnt(0)" ::: "memory");
    const int c = lane & 7;
#pragma unroll
    for (int j = 0; j < 4; ++j) { const int n = (lane >> 3) + 8 * j; const LAS float* s = scr + (8 * c) * 33 + n;
        u32x4 o; o.x = pk2(s[0 * 33], s[1 * 33]); o.y = pk2(s[2 * 33], s[3 * 33]); o.z = pk2(s[4 * 33], s[5 * 33]); o.w = pk2(s[6 * 33], s[7 * 33]);
        *(u32x4*)(WT + (size_t)(row_off + n0 + n) * ldo + koff + k0 + 8 * c) = o; }
    asm volatile("s_waitcnt lgkmcnt(0)" ::: "memory");
}
__device__ __forceinline__ void rms_row_to_bf16(const float* xrow, const float* gain, bf16* orow, int lane) {
    const f32x4* xr = (const f32x4*)xrow + lane; const f32x4* gr = (const f32x4*)gain + lane;
    f32x4 v[4]; float s = 0.f;
#pragma unroll
    for (int j = 0; j < 4; ++j) { v[j] = xr[64 * j]; s += (v[j].x * v[j].x + v[j].y * v[j].y) + (v[j].z * v[j].z + v[j].w * v[j].w); }
    const float rs = rsqrtf(wave_sum(s) * (1.f / DM) + EPS);
    u32x2* o8 = (u32x2*)orow + lane;
#pragma unroll
    for (int j = 0; j < 4; ++j) { const f32x4 g = gr[64 * j]; u32x2 w; w.x = pk2(v[j].x * rs * g.x, v[j].y * rs * g.y); w.y = pk2(v[j].z * rs * g.z, v[j].w * rs * g.w); o8[64 * j] = w; }
}
__device__ __forceinline__ void rms_row2_to_bf16(const float* x0, const float* x1, const float* gain, bf16* o0, bf16* o1, int lane) {
    const f32x4* xr0 = (const f32x4*)x0 + lane; const f32x4* xr1 = (const f32x4*)x1 + lane; const f32x4* gr = (const f32x4*)gain + lane;
    f32x4 v[4], w[4]; float s = 0.f, t = 0.f;
#pragma unroll
    for (int j = 0; j < 4; ++j) { v[j] = __builtin_nontemporal_load(xr0 + 64 * j); w[j] = __builtin_nontemporal_load(xr1 + 64 * j); }
#pragma unroll
    for (int j = 0; j < 4; ++j) { s += (v[j].x * v[j].x + v[j].y * v[j].y) + (v[j].z * v[j].z + v[j].w * v[j].w); t += (w[j].x * w[j].x + w[j].y * w[j].y) + (w[j].z * w[j].z + w[j].w * w[j].w); }
#pragma unroll
    for (int o = 1; o < 64; o <<= 1) { s += __shfl_xor(s, o); t += __shfl_xor(t, o); }
    const float rs = rsqrtf(s * (1.f / DM) + EPS), rt = rsqrtf(t * (1.f / DM) + EPS);
    u32x2* p0 = (u32x2*)o0 + lane; u32x2* p1 = (u32x2*)o1 + lane;
#pragma unroll
    for (int j = 0; j < 4; ++j) { const f32x4 g = gr[64 * j]; u32x2 a; a.x = pk2(v[j].x * rs * g.x, v[j].y * rs * g.y); a.y = pk2(v[j].z * rs * g.z, v[j].w * rs * g.w); p0[64 * j] = a;
        u32x2 b; b.x = pk2(w[j].x * rt * g.x, w[j].y * rt * g.y); b.y = pk2(w[j].z * rt * g.z, w[j].w * rt * g.w); p1[64 * j] = b; }
}
__device__ __forceinline__ void p0_prologue(const KArgs& a, LAS unsigned char* lds, int G) {
    const int tid = threadIdx.x, lane = tid & 63, wave = tid >> 6;
    LAS float* scr = (LAS float*)(lds + wave * 16384);
    const int gw = blockIdx.x * 8 + wave, NGW = G * 8;
    bf16* H = (bf16*)(a.ws + WS_H); bf16* WinT = (bf16*)(a.ws + WS_WIN); bf16* WdT = (bf16*)(a.ws + WS_WD); bf16* Wo3 = (bf16*)(a.ws + WS_WO3);
    bf16* PwT = (bf16*)(a.ws + WS_PW); bf16* SW = (bf16*)(a.ws + WS_SW);
    constexpr int I_IN = 16 * (INC / 32), I_KV = 16 * (2048 / 32), I_D = 16 * 32, I_O = 16 * 32, I_P = 4 * 8;
    constexpr int NITEMS = I_IN + I_KV + 3 * I_D + I_O + 4 * I_P;
    for (int it = gw; it < NITEMS; it += NGW) {
        int r = it;
        if (r < I_IN) { p0_transpose_item(a.in[I_WIN], INC, WinT, 0, DM, 0, scr, r, lane); continue; } r -= I_IN;
        if (r < I_KV) { p0_transpose_item(a.in[I_WKV], 2048, WinT, INC, DM, 0, scr, r, lane); continue; } r -= I_KV;
        if (r < 3 * I_D) { const int b = r / I_D; p0_transpose_item(a.in[I_WDOWN] + (size_t)b * DM * DM, DM, WdT, b * DM, DM, 0, scr, r % I_D, lane); continue; } r -= 3 * I_D;
        if (r < I_O) { p0_transpose_item(a.in[I_WOUT], DM, Wo3, 0, DM, 0, scr, r, lane); continue; } r -= I_O;
        { const int g = r / I_P; p0_transpose_item(a.in[I_POOLW] + (size_t)g * 256 * 256, 256, PwT, g * 256, 256, 0, scr, r % I_P, lane); }
    }
    for (int m = gw; m + NGW < MPR; m += 2 * NGW)
        rms_row2_to_bf16(a.in[I_XP] + (size_t)m * DM, a.in[I_XP] + (size_t)(m + NGW) * DM, a.in[I_NORMG], H + (size_t)m * DM, H + (size_t)(m + NGW) * DM, lane);
    const int mdone = (MPR / (2 * NGW)) * (2 * NGW);
    for (int m = mdone + gw; m < MP + 2048; m += NGW) {
        bf16* orow = H + (size_t)m * DM;
        if (m < MPR) rms_row_to_bf16(a.in[I_XP] + (size_t)m * DM, a.in[I_NORMG], orow, lane);
        else if (m < MV) rms_row_to_bf16(a.in[I_XS] + (size_t)(m - MPR) * DM, a.in[I_NORMG], orow, lane);
        else if (m < MP) { u32x2* o8 = (u32x2*)orow + lane;
#pragma unroll
            for (int j = 0; j < 4; ++j) o8[64 * j] = (u32x2){0u, 0u}; }
        else rms_row_to_bf16(a.in[I_MEM] + (size_t)(m - MP) * DM, a.in[I_MEMNG], orow, lane);
    }
    const size_t gt = (size_t)blockIdx.x * 512 + tid, NGT = (size_t)G * 512;
    for (size_t i = gt; i < (size_t)4 * 128 * 128; i += NGT) { const int s = (int)(i & 127), t = (int)((i >> 7) & 127); SW[i] = (bf16)(s <= t ? f2bf(a.in[I_SGUW][i]) : 0u); }
    for (size_t i = gt; i < (size_t)NS * 256; i += NGT) { const size_t smp = i >> 8, c = (i & 255) * 4; const int w = 2 << (int)(c >> 8); f32x4 sm = (f32x4){0.f, 0.f, 0.f, 0.f};
#pragma unroll
        for (int j = 0; j < 15; ++j) if (j < w - 1) sm = sm + *(const f32x4*)(a.in[I_SPOOL] + (smp * 15 + 14 - j) * DM + c);
        *(f32x4*)((float*)(a.ws + WS_HS) + smp * DM + c) = sm; }
    for (size_t i = gt; i < (size_t)NS * 14 * 256; i += NGT) { const size_t smp = i / (14 * 256), rem = i % (14 * 256), r = rem / 256, c4 = rem % 256;
        __builtin_nontemporal_store(*(const f32x4*)(a.in[I_SPOOL] + (smp * 15 + r + 1) * DM + c4 * 4), (f32x4*)(a.out + O_POOLS + (smp * 15 + r) * DM + c4 * 4)); }
}

constexpr int RSV = 544;
constexpr int RS = 528;
__device__ __forceinline__ void pool_part(const KArgs& a, LAS unsigned char* lds, int rt, int g) {
    int tid_ = threadIdx.x; asm volatile("" : "+v"(tid_));
    const int tid = tid_, lane = tid & 63, wv = tid >> 6, fr = lane & 15, fq = lane >> 4;
    const int m0 = rt * 128, w = 2 << g;
    const bf16* PIN = (const bf16*)(a.ws + WS_PROJ); const bf16* PZ = PIN + (size_t)MP * DM;
    const bf16* PwT = (const bf16*)(a.ws + WS_PW); bf16* BR0 = (bf16*)(a.ws + WS_BR);
    LAS unsigned char* Pb = lds; LAS unsigned char* Db = lds + 75520;
    u32x4 zf[8]; f32x4 scv[2]; bf16x8 Bf[2][8];
    const bf16* pw = PwT + (size_t)(g * 256 + wv * 32 + 8 * (fr >> 2) + (fr & 3)) * 256 + fq * 8;
    if (rt < 128) {
        const int t0 = (rt & 15) * 128;
        u32x4 tv[9];
#pragma unroll
        for (int i = 0; i < 9; ++i) { const int idx = tid + i * 512, row = idx >> 5, ch = idx & 31; tv[i] = (u32x4){0u, 0u, 0u, 0u};
            if (idx < 143 * 32 && !(t0 == 0 && row < 15)) tv[i] = *(const u32x4*)(PIN + (size_t)(m0 - 15 + row) * DM + g * 256 + ch * 8); }
#pragma unroll
        for (int rb = 0; rb < 8; ++rb) zf[rb] = __builtin_nontemporal_load((const u32x4*)(PZ + (size_t)(m0 + rb * 16 + fr) * DM + g * 256 + wv * 32 + 8 * fq));
#pragma unroll
        for (int nn = 0; nn < 2; ++nn) { scv[nn] = *(const f32x4*)(a.in[I_POOLSC] + g * 256 + wv * 32 + 8 * fq + 4 * nn);
#pragma unroll
            for (int ks = 0; ks < 8; ++ks) Bf[nn][ks] = *(const bf16x8*)(pw + nn * 4 * 256 + ks * 32); }
#pragma unroll
        for (int i = 0; i < 9; ++i) { const int idx = tid + i * 512, row = idx >> 5, ch = idx & 31; if (idx < 143 * 32) *(LAS u32x4*)(Pb + row * RS + ch * 16) = tv[i]; }
        __syncthreads();
        {
            const int ch = tid & 31, r0 = (tid >> 5) * 8;
            float s0 = 0.f, s1 = 0.f, s2 = 0.f, s3 = 0.f, s4 = 0.f, s5 = 0.f, s6 = 0.f, s7 = 0.f;
            for (int j = 1; j < w; ++j) { const u32x4 v = *(const LAS u32x4*)(Pb + (r0 + 15 - j) * RS + ch * 16);
                s0 += bflo(v.x); s1 += bfhi(v.x); s2 += bflo(v.y); s3 += bfhi(v.y); s4 += bflo(v.z); s5 += bfhi(v.z); s6 += bflo(v.w); s7 += bfhi(v.w); }
#pragma unroll
            for (int i = 0; i < 8; ++i) { const int r = r0 + i;
                const u32x4 own = *(const LAS u32x4*)(Pb + (r + 15) * RS + ch * 16); const u32x4 old = *(const LAS u32x4*)(Pb + (r + 16 - w) * RS + ch * 16);
                s0 += bflo(own.x); s1 += bfhi(own.x); s2 += bflo(own.y); s3 += bfhi(own.y); s4 += bflo(own.z); s5 += bfhi(own.z); s6 += bflo(own.w); s7 += bfhi(own.w);
                const int cnt = min(w, t0 + r + 1); const float inv = 1.f / (float)cnt;
                u32x4 d; d.x = pk2(s0 * inv - bflo(own.x), s1 * inv - bfhi(own.x)); d.y = pk2(s2 * inv - bflo(own.y), s3 * inv - bfhi(own.y));
                d.z = pk2(s4 * inv - bflo(own.z), s5 * inv - bfhi(own.z)); d.w = pk2(s6 * inv - bflo(own.w), s7 * inv - bfhi(own.w));
                *(LAS u32x4*)(Db + r * RS + ch * 16) = d;
                s0 -= bflo(old.x); s1 -= bfhi(old.x); s2 -= bflo(old.y); s3 -= bfhi(old.y); s4 -= bflo(old.z); s5 -= bfhi(old.z); s6 -= bflo(old.w); s7 -= bfhi(old.w); }
        }
    } else {
#pragma unroll
        for (int rb = 0; rb < 8; ++rb) zf[rb] = __builtin_nontemporal_load((const u32x4*)(PZ + (size_t)(m0 + rb * 16 + fr) * DM + g * 256 + wv * 32 + 8 * fq));
#pragma unroll
        for (int nn = 0; nn < 2; ++nn) { scv[nn] = *(const f32x4*)(a.in[I_POOLSC] + g * 256 + wv * 32 + 8 * fq + 4 * nn);
#pragma unroll
            for (int ks = 0; ks < 8; ++ks) Bf[nn][ks] = *(const bf16x8*)(pw + nn * 4 * 256 + ks * 32); }
        const bf16* DS = (const bf16*)(a.ws + WS_DS);
        u32x4 td[8];
#pragma unroll
        for (int i = 0; i < 8; ++i) { const int idx = tid + i * 512, r = idx >> 5, ch = idx & 31; td[i] = *(const u32x4*)(DS + (size_t)r * DM + g * 256 + ch * 8); }
#pragma unroll
        for (int i = 0; i < 8; ++i) { const int idx = tid + i * 512, r = idx >> 5, ch = idx & 31; *(LAS u32x4*)(Db + r * RS + ch * 16) = td[i]; }
    }
    __syncthreads();
#pragma unroll
    for (int rb = 0; rb < 8; ++rb) {
        f32x4 acc0 = (f32x4){0.f, 0.f, 0.f, 0.f}, acc1 = acc0;
#pragma unroll
        for (int ks = 0; ks < 8; ++ks) { const bf16x8 A = *(const LAS bf16x8*)(Db + (rb * 16 + fr) * RS + (ks * 32 + fq * 8) * 2);
            acc0 = __builtin_amdgcn_mfma_f32_16x16x32_bf16(Bf[0][ks], A, acc0, 0, 0, 0); acc1 = __builtin_amdgcn_mfma_f32_16x16x32_bf16(Bf[1][ks], A, acc1, 0, 0, 0); }
        const size_t m = (size_t)(m0 + rb * 16 + fr); const int c = g * 256 + wv * 32 + 8 * fq; const u32x4 z = zf[rb];
        u32x4 o; o.x = pk2(acc0[0] * scv[0].x * bflo(z.x), acc0[1] * scv[0].y * bfhi(z.x)); o.y = pk2(acc0[2] * scv[0].z * bflo(z.y), acc0[3] * scv[0].w * bfhi(z.y));
        o.z = pk2(acc1[0] * scv[1].x * bflo(z.z), acc1[1] * scv[1].y * bfhi(z.z)); o.w = pk2(acc1[2] * scv[1].z * bflo(z.w), acc1[3] * scv[1].w * bfhi(z.w));
        *(u32x4*)(BR0 + m * DM + c) = o;
    }
    __syncthreads();
}
__device__ __forceinline__ void sgu_part(const KArgs& a, LAS unsigned char* lds, int rt, int g) {
    int tid_ = threadIdx.x; asm volatile("" : "+v"(tid_));
    const int tid = tid_, lane = tid & 63, wv = tid >> 6, fr = lane & 15, fq = lane >> 4;
    const int m0 = rt * 128;
    const bf16* U = (const bf16*)(a.ws + WS_PROJ) + (size_t)2 * MP * DM; const bf16* V = U + (size_t)MP * DM; const bf16* SZ = V + (size_t)MP * DM;
    const bf16* SW = (const bf16*)(a.ws + WS_SW); const float* VSS = (const float*)(a.ws + WS_VSS); bf16* BR1 = (bf16*)(a.ws + WS_BR) + (size_t)MP * DM;
    LAS unsigned char* Vb = lds; LAS unsigned char* UZb = lds + 128 * RS; LAS float* rbuf = (LAS float*)(lds + 256 * RS);
    u32x4 tv[8], tu[8], tz[8];
#pragma unroll
    for (int i = 0; i < 8; ++i) { const int idx = tid + i * 512, s = idx >> 5, ch = idx & 31; const size_t o = (size_t)(m0 + s) * DM + g * 256 + ch * 8;
        tv[i] = __builtin_nontemporal_load((const u32x4*)(V + o)); tu[i] = __builtin_nontemporal_load((const u32x4*)(U + o)); tz[i] = __builtin_nontemporal_load((const u32x4*)(SZ + o)); }
    if (tid < 128) { const f32x4* p = (const f32x4*)(VSS + (size_t)(m0 + tid) * 16); const f32x4 p0 = p[0], p1 = p[1], p2 = p[2], p3 = p[3];
        const float s = ((p0.x + p0.y) + (p0.z + p0.w)) + ((p1.x + p1.y) + (p1.z + p1.w)) + ((p2.x + p2.y) + (p2.z + p2.w)) + ((p3.x + p3.y) + (p3.z + p3.w));
        rbuf[tid] = rsqrtf(s * (1.f / DM) + EPS); }
    const f32x4 gv0 = *(const f32x4*)(a.in[I_SGUNG] + g * 256 + wv * 32 + 8 * fq), gv1 = *(const f32x4*)(a.in[I_SGUNG] + g * 256 + wv * 32 + 8 * fq + 4);
    float biasv[8];
#pragma unroll
    for (int tb = 0; tb < 8; ++tb) biasv[tb] = a.in[I_SGUB][g * 128 + tb * 16 + fr];
    __syncthreads();
#pragma unroll
    for (int i = 0; i < 8; ++i) { const int idx = tid + i * 512, s = idx >> 5, ch = idx & 31; const float r = rbuf[s];
        u32x4 v; v.x = pk2(bflo(tv[i].x) * r, bfhi(tv[i].x) * r); v.y = pk2(bflo(tv[i].y) * r, bfhi(tv[i].y) * r); v.z = pk2(bflo(tv[i].z) * r, bfhi(tv[i].z) * r); v.w = pk2(bflo(tv[i].w) * r, bfhi(tv[i].w) * r);
        *(LAS u32x4*)(Vb + s * RS + ch * 16) = v;
        u32x4 q; q.x = pk2(bflo(tu[i].x) * bflo(tz[i].x), bfhi(tu[i].x) * bfhi(tz[i].x)); q.y = pk2(bflo(tu[i].y) * bflo(tz[i].y), bfhi(tu[i].y) * bfhi(tz[i].y));
        q.z = pk2(bflo(tu[i].z) * bflo(tz[i].z), bfhi(tu[i].z) * bfhi(tz[i].z)); q.w = pk2(bflo(tu[i].w) * bflo(tz[i].w), bfhi(tu[i].w) * bfhi(tz[i].w));
        *(LAS u32x4*)(UZb + s * RS + ch * 16) = q; }
    __syncthreads();
    const int q = fr >> 2, p = fr & 3;
    bf16x8 Vf[4][2];
#pragma unroll
    for (int ks = 0; ks < 4; ++ks)
#pragma unroll
        for (int nn = 0; nn < 2; ++nn) { const LAS unsigned char* a0 = Vb + (32 * ks + 8 * fq + q) * RS + (wv * 32 + 8 * p + 4 * nn) * 2; Vf[ks][nn] = tr_read2(a0, a0 + 4 * RS); }
#pragma unroll
    for (int tb = 0; tb < 8; ++tb) {
        f32x4 acc0 = (f32x4){0.f, 0.f, 0.f, 0.f}, acc1 = acc0;
        const int t = tb * 16 + fr;
#pragma unroll
        for (int ks = 0; ks < 4; ++ks) if (ks <= (tb >> 1)) {
            const bf16x8 A = *(const bf16x8*)(SW + (size_t)(g * 128 + t) * 128 + ks * 32 + fq * 8);
            acc0 = __builtin_amdgcn_mfma_f32_16x16x32_bf16(Vf[ks][0], A, acc0, 0, 0, 0); acc1 = __builtin_amdgcn_mfma_f32_16x16x32_bf16(Vf[ks][1], A, acc1, 0, 0, 0);
        }
        const size_t m = (size_t)(m0 + t); const float bias = biasv[tb];
        { const int cl = wv * 32 + 8 * fq; const u32x4 uz = *(const LAS u32x4*)(UZb + t * RS + cl * 2);
          u32x4 o; o.x = pk2((acc0[0] * gv0.x + bias) * bflo(uz.x), (acc0[1] * gv0.y + bias) * bfhi(uz.x)); o.y = pk2((acc0[2] * gv0.z + bias) * bflo(uz.y), (acc0[3] * gv0.w + bias) * bfhi(uz.y));
          o.z = pk2((acc1[0] * gv1.x + bias) * bflo(uz.z), (acc1[1] * gv1.y + bias) * bfhi(uz.z)); o.w = pk2((acc1[2] * gv1.z + bias) * bflo(uz.w), (acc1[3] * gv1.w + bias) * bfhi(uz.w));
          *(u32x4*)(BR1 + m * DM + g * 256 + cl) = o; }
    }
    __syncthreads();
}
__device__ __forceinline__ void attn_part(const KArgs& a, LAS unsigned char* lds, int rt, int g) {
    int tid_ = threadIdx.x; asm volatile("" : "+v"(tid_));
    const int tid = tid_, lane = tid & 63, wv = tid >> 6, fr = lane & 15, fq = lane >> 4;
    const int m0 = rt * 128, b = rt >> 4;
    const bf16* Q = (const bf16*)(a.ws + WS_PROJ) + (size_t)5 * MP * DM; const bf16* AZ = Q + (size_t)MP * DM;
    const bf16* KB = (const bf16*)(a.ws + WS_KB); const bf16* VB = (const bf16*)(a.ws + WS_VB); bf16* BR2 = (bf16*)(a.ws + WS_BR) + (size_t)2 * MP * DM;
    LAS unsigned char* Kb = lds;
    const size_t m = (size_t)(m0 + wv * 16 + fr);
    bf16x8 Qf[8];
    {
        u32x4 tk[16];
#pragma unroll
        for (int i = 0; i < 16; ++i) { const int idx = tid + i * 512, key = idx >> 5, ch = idx & 31; tk[i] = *(const u32x4*)(KB + (size_t)(b * 256 + key) * DM + g * 256 + ch * 8); }
#pragma unroll
        for (int ks = 0; ks < 8; ++ks) Qf[ks] = __builtin_nontemporal_load((const bf16x8*)(Q + m * DM + g * 256 + ks * 32 + fq * 8));
#pragma unroll
        for (int i = 0; i < 16; ++i) { const int idx = tid + i * 512, key = idx >> 5, ch = idx & 31; *(LAS u32x4*)(Kb + key * RS + ch * 16) = tk[i]; }
    }
    __syncthreads();
    u32x4 tvv[16];
#pragma unroll
    for (int i = 0; i < 16; ++i) { const int idx = tid + i * 512, key = idx >> 5, ch = idx & 31; tvv[i] = *(const u32x4*)(VB + (size_t)(b * 256 + key) * DM + g * 256 + ch * 8); }
    f32x4 sacc[16];
#pragma unroll
    for (int kb = 0; kb < 16; ++kb) { sacc[kb] = (f32x4){0.f, 0.f, 0.f, 0.f};
#pragma unroll
        for (int ks = 0; ks < 8; ++ks) { const bf16x8 Kf = *(const LAS bf16x8*)(Kb + (kb * 16 + fr) * RS + (ks * 32 + fq * 8) * 2);
            sacc[kb] = __builtin_amdgcn_mfma_f32_16x16x32_bf16(Kf, Qf[ks], sacc[kb], 0, 0, 0); }
        if (kb & 1) __builtin_amdgcn_sched_barrier(0); }
    float mx = -3.0e38f;
#pragma unroll
    for (int kb = 0; kb < 16; ++kb) mx = fmaxf(mx, fmaxf(fmaxf(sacc[kb][0], sacc[kb][1]), fmaxf(sacc[kb][2], sacc[kb][3])));
    mx = fmaxf(mx, __shfl_xor(mx, 16)); mx = fmaxf(mx, __shfl_xor(mx, 32));
    float sum = 0.f;
#pragma unroll
    for (int kb = 0; kb < 16; ++kb)
#pragma unroll
        for (int j = 0; j < 4; ++j) { const float pj = __expf((sacc[kb][j] - mx) * 0.0625f); sacc[kb][j] = pj; sum += pj; }
    sum += __shfl_xor(sum, 16); sum += __shfl_xor(sum, 32);
    const float isum = 1.f / sum;
    bf16x8 Pf[8];
#pragma unroll
    for (int k2 = 0; k2 < 8; ++k2) { u32x4 w; w.x = pk2(sacc[2 * k2][0], sacc[2 * k2][1]); w.y = pk2(sacc[2 * k2][2], sacc[2 * k2][3]);
        w.z = pk2(sacc[2 * k2 + 1][0], sacc[2 * k2 + 1][1]); w.w = pk2(sacc[2 * k2 + 1][2], sacc[2 * k2 + 1][3]); Pf[k2] = __builtin_bit_cast(bf16x8, w); }
    __syncthreads();
#pragma unroll
    for (int i = 0; i < 16; ++i) { const int idx = tid + i * 512, key = idx >> 5, ch = idx & 31; *(LAS u32x4*)(Kb + key * RSV + ch * 16) = tvv[i]; }
    u32x4 zf[8];
#pragma unroll
    for (int d2 = 0; d2 < 8; ++d2) zf[d2] = __builtin_nontemporal_load((const u32x4*)(AZ + m * DM + g * 256 + d2 * 32 + 8 * fq));
    __syncthreads();
    const int q = fr >> 2, p = fr & 3;
#pragma unroll
    for (int d2 = 0; d2 < 8; ++d2) {
        f32x4 o0 = (f32x4){0.f, 0.f, 0.f, 0.f}, o1 = o0;
#pragma unroll
        for (int k2 = 0; k2 < 8; ++k2) { const LAS unsigned char* a0 = Kb + (32 * k2 + 4 * fq + q) * RSV + (d2 * 32 + 8 * p) * 2;
            const bf16x8 Vf0 = tr_read2(a0, a0 + 16 * RSV), Vf1 = tr_read2(a0 + 8, a0 + 8 + 16 * RSV);
            o0 = __builtin_amdgcn_mfma_f32_16x16x32_bf16(Vf0, Pf[k2], o0, 0, 0, 0); o1 = __builtin_amdgcn_mfma_f32_16x16x32_bf16(Vf1, Pf[k2], o1, 0, 0, 0); }
        const int c = g * 256 + d2 * 32 + 8 * fq; const u32x4 z = zf[d2];
        u32x4 w; w.x = pk2(o0[0] * isum * bflo(z.x), o0[1] * isum * bfhi(z.x)); w.y = pk2(o0[2] * isum * bflo(z.y), o0[3] * isum * bfhi(z.y));
        w.z = pk2(o1[0] * isum * bflo(z.z), o1[1] * isum * bfhi(z.z)); w.w = pk2(o1[2] * isum * bflo(z.w), o1[3] * isum * bfhi(z.w));
        *(u32x4*)(BR2 + m * DM + c) = w;
        __builtin_amdgcn_sched_barrier(0);
    }
    __syncthreads();
}
__device__ __forceinline__ void sgu_sample(const KArgs& a, int g, int rb) {
    int tid_ = threadIdx.x; asm volatile("" : "+v"(tid_));
    const int tid = tid_;
    const bf16* U = (const bf16*)(a.ws + WS_PROJ) + (size_t)2 * MP * DM; const bf16* V = U + (size_t)MP * DM; const bf16* SZ = V + (size_t)MP * DM;
    const float* VSS = (const float*)(a.ws + WS_VSS); bf16* BR1 = (bf16*)(a.ws + WS_BR) + (size_t)MP * DM;
    const float w00 = a.in[I_SGUW][(size_t)g * 128 * 128], b0 = a.in[I_SGUB][g * 128];
    for (int idx = tid; idx < 16 * 64; idx += 512) {
        const int i = rb * 16 + (idx >> 6), c = g * 256 + (idx & 63) * 4; const size_t m = (size_t)(MPR + i);
        const float s = wave_sum((idx & 63) < 16 ? VSS[m * 16 + (idx & 63)] : 0.f);
        const float rs = rsqrtf(s * (1.f / DM) + EPS);
        const f32x4 gv = *(const f32x4*)(a.in[I_SGUNG] + c);
        const u32x2 v4 = *(const u32x2*)(V + m * DM + c), u4 = *(const u32x2*)(U + m * DM + c), z = *(const u32x2*)(SZ + m * DM + c);
        f32x4 vn; vn.x = bflo(v4.x) * rs * gv.x; vn.y = bfhi(v4.x) * rs * gv.y; vn.z = bflo(v4.y) * rs * gv.z; vn.w = bfhi(v4.y) * rs * gv.w;
        *(f32x4*)(a.out + O_SV + (size_t)i * DM + c) = vn;
        u32x2 o; o.x = pk2(bflo(u4.x) * (w00 * vn.x + b0) * bflo(z.x), bfhi(u4.x) * (w00 * vn.y + b0) * bfhi(z.x));
        o.y = pk2(bflo(u4.y) * (w00 * vn.z + b0) * bflo(z.y), bfhi(u4.y) * (w00 * vn.w + b0) * bfhi(z.y));
        *(u32x2*)(BR1 + m * DM + c) = o;
    }
}
__device__ __forceinline__ void attn_sample(const KArgs& a, LAS unsigned char* lds, int i, int h) {
    int tid_ = threadIdx.x; asm volatile("" : "+v"(tid_));
    const int tid = tid_, lane = tid & 63, wv = tid >> 6;
    const bf16* Q = (const bf16*)(a.ws + WS_PROJ) + (size_t)5 * MP * DM; const bf16* AZ = Q + (size_t)MP * DM; bf16* BR2 = (bf16*)(a.ws + WS_BR) + (size_t)2 * MP * DM;
    const size_t m = (size_t)(MPR + i);
    const float* Kc = a.in[I_CK] + ((size_t)i * NMEM * 4 + h) * 256 + lane * 4;
    const float* Vc = a.in[I_CV] + ((size_t)i * NMEM * 4 + h) * 256 + lane * 4;
    LAS float* sc = (LAS float*)lds; LAS float* part = (LAS float*)(lds + 1024);
    const u32x2 q2 = *(const u32x2*)(Q + m * DM + h * 256 + lane * 4);
    const f32x4 qv = (f32x4){bflo(q2.x), bfhi(q2.x), bflo(q2.y), bfhi(q2.y)};
    {
        f32x4 kv[32]; float pd[32];
#pragma unroll
        for (int j = 0; j < 32; ++j) kv[j] = __builtin_nontemporal_load((const f32x4*)(Kc + (size_t)(wv * 32 + j) * 1024));
#pragma unroll
        for (int j = 0; j < 32; ++j) pd[j] = (kv[j].x * qv.x + kv[j].y * qv.y) + (kv[j].z * qv.z + kv[j].w * qv.w);
#pragma unroll
        for (int j = 0; j < 32; ++j) { const float d = wave_sum(pd[j]); if (lane == 0) sc[wv * 32 + j] = d * 0.0625f; }
    }
    f32x4 vv[32];
#pragma unroll
    for (int j = 0; j < 32; ++j) vv[j] = __builtin_nontemporal_load((const f32x4*)(Vc + (size_t)(wv * 32 + j) * 1024));
    __syncthreads();
    const f32x4 s4 = *(const LAS f32x4*)(sc + lane * 4);
    const float mx = wave_max(fmaxf(fmaxf(s4.x, s4.y), fmaxf(s4.z, s4.w)));
    const float sum = wave_sum((__expf(s4.x - mx) + __expf(s4.y - mx)) + (__expf(s4.z - mx) + __expf(s4.w - mx)));
    f32x4 o = (f32x4){0.f, 0.f, 0.f, 0.f};
#pragma unroll
    for (int j = 0; j < 32; ++j) { const float pj = __expf(sc[wv * 32 + j] - mx); o += vv[j] * pj; }
    *(LAS f32x4*)(part + wv * 256 + lane * 4) = o;
    __syncthreads();
    if (tid < 256) { float t = 0.f;
#pragma unroll
        for (int w8 = 0; w8 < 8; ++w8) t += part[w8 * 256 + tid];
        const int c = h * 256 + tid; const unsigned short zb = AZ[m * DM + c]; const float z = __builtin_bit_cast(float, (unsigned)zb << 16);
        BR2[m * DM + c] = (bf16)f2bf(t / sum * z); }
    __syncthreads();
}
__device__ __forceinline__ void p2_mixers(const KArgs& a, LAS unsigned char* lds, int G) {
    constexpr int NU = 512 + 512 + 4 + 32;
    if (G == 256) {
        const int c = blockIdx.x;
        for (int k = 0; k < 4; ++k) { const int kk = (c & 1) ? (k ^ 2) : k;
            if (kk < 2) { const int u = c + kk * 256, rt = u >> 2, g = u & 3; pool_part(a, lds, rt, g); sgu_part(a, lds, rt, g); attn_part(a, lds, rt, g); }
            else { const int e = c + (kk - 2) * 256; attn_sample(a, lds, e >> 2, e & 3); } }
        if (c < 4) pool_part(a, lds, 128, c); else if (c >= 8 && c < 40) sgu_sample(a, (c - 8) >> 3, (c - 8) & 7);
        return;
    }
    for (int u = blockIdx.x; u < NU; u += G) {
        if (u < 512) { const int rt = u >> 2, g = u & 3; pool_part(a, lds, rt, g); sgu_part(a, lds, rt, g); attn_part(a, lds, rt, g); }
        else if (u < 1024) { const int e = u - 512; attn_sample(a, lds, e >> 2, e & 3); }
        else if (u < 1028) pool_part(a, lds, 128, u - 1024);
        else sgu_sample(a, (u - 1028) >> 3, (u - 1028) & 7);
    }
}
__device__ __forceinline__ void p5_norm(const KArgs& a, int G) {
    const int tid = threadIdx.x, lane = tid & 63, wave = tid >> 6;
    const int gw = blockIdx.x * 8 + wave, NGW = G * 8;
    const f32x4* gr = (const f32x4*)a.in[I_NORMF] + lane;
    for (int m = gw; m < MV; m += NGW) {
        f32x4* xr = (f32x4*)(a.out + (size_t)m * DM) + lane;
        f32x4 v[4]; float s = 0.f;
#pragma unroll
        for (int j = 0; j < 4; ++j) { v[j] = xr[64 * j]; s += (v[j].x * v[j].x + v[j].y * v[j].y) + (v[j].z * v[j].z + v[j].w * v[j].w); }
        const float rs = rsqrtf(wave_sum(s) * (1.f / DM) + EPS);
#pragma unroll
        for (int j = 0; j < 4; ++j) { const f32x4 g = gr[64 * j]; xr[64 * j] = (f32x4){v[j].x * rs * g.x, v[j].y * rs * g.y, v[j].z * rs * g.z, v[j].w * rs * g.w}; }
    }
}

__global__ void __launch_bounds__(512, 2) fwd_megakernel(KArgs a) {
    extern __shared__ __attribute__((aligned(16))) unsigned char lds_raw[];
    LAS unsigned char* lds = (LAS unsigned char*)lds_raw;
    cg::grid_group grid = cg::this_grid();
    const int G = gridDim.x;
    const int lo = a.ph_lo, hi = a.ph_hi;
    volatile LAS unsigned* bst = (volatile LAS unsigned*)(lds + LDS_BYTES - 64);
    if (threadIdx.x == 0) { bst[0] = 0u; bst[1] = 0u; }
    __syncthreads();
    const XcdBarrier bar = xcd_barrier_post((unsigned*)(a.ws + WS_CTL), bst);
#define IN(k) (lo <= (k) && (k) < hi)
#define SEAM(k) do { if (IN(k) && IN((k) + 1)) { if (a.cg_sync) grid.sync(); else xcd_barrier(bar); } } while (0)
    if (IN(0)) p0_prologue(a, lds, G);
    SEAM(0);
    if (IN(1)) {
        pg8::Gemm g{(const bf16*)(a.ws + WS_H), (const bf16*)(a.ws + WS_WIN), MP, INC, DM};
        P1Order S; S.init(G, (int)blockIdx.x);
        EpiProj E{(bf16*)(a.ws + WS_PROJ), (bf16*)(a.ws + WS_GATE), (float*)(a.ws + WS_VSS), (bf16*)(a.ws + WS_KB), (bf16*)(a.ws + WS_VB), a.out, (const float*)(a.ws + WS_HS), (bf16*)(a.ws + WS_DS)};
        pg8::gemm_phase<EpiProj, P1Order>(lds, g, S, E);
    }
    SEAM(1);
    if (IN(2)) p2_mixers(a, lds, G);
    SEAM(2);
    if (IN(3)) {
        pg8::Gemm g{(const bf16*)(a.ws + WS_BR), (const bf16*)(a.ws + WS_WD), MPR, 3 * DM, DM};
        P3Order S; S.init(G, (int)blockIdx.x);
        EpiGate E{(const bf16*)(a.ws + WS_GATE), (bf16*)(a.ws + WS_MG)};
        pg8::gemm_phase<EpiGate, P3Order>(lds, g, S, E);
        EpiS3 E3{(const bf16*)(a.ws + WS_GATE), (bf16*)(a.ws + WS_GYS)};
        skinny_gemm(lds, (const bf16*)(a.ws + WS_BR) + (size_t)MPR * DM, DM, (size_t)MP * DM, 64, 1, 0, (const bf16*)(a.ws + WS_WD), DM, DM, 192, (int)blockIdx.x, G, E3);
    }
    SEAM(3);
    if (IN(4)) {
        pg8::Gemm g{(const bf16*)(a.ws + WS_MG), (const bf16*)(a.ws + WS_WO3), MPR, DM, DM};
        pg8::StaticOrder S; S.init(MPR, DM, G, (int)blockIdx.x);
        unsigned* ctl = (unsigned*)(a.ws + WS_CTL);
        EpiOutNorm E{a.in[I_XP], a.in[I_NORMF], a.out, (float*)(a.ws + WS_VSS), ctl + CW_PANEL};
        pg8::gemm_phase<EpiOutNorm, pg8::StaticOrder>(lds, g, S, E);
        sample_out_split(a, lds, (int)blockIdx.x);
    }
#undef IN
#undef SEAM
}

extern "C" void kernel_launch(void* const* d_in, const int* in_sizes, int n_in, void* d_out, int out_size, void* d_ws, size_t ws_size, hipStream_t stream) {
    static int grid = 0;
    if (grid == 0) {
        if (n_in != 18 || (size_t)out_size != O_END || ws_size < WS_END) { fprintf(stderr, "kernel_launch: unexpected shapes (n_in %d out %d ws %zu, need %zu)\n", n_in, out_size, ws_size, (size_t)WS_END); grid = -1; return; }
        int dev = 0, cus = 0, per_cu = 0;
        hipGetDevice(&dev); hipDeviceGetAttribute(&cus, hipDeviceAttributeMultiprocessorCount, dev);
        if (hipFuncSetAttribute((const void*)fwd_megakernel, hipFuncAttributeMaxDynamicSharedMemorySize, LDS_BYTES) != hipSuccess) { fprintf(stderr, "kernel_launch: hipFuncSetAttribute failed\n"); grid = -1; return; }
        if (hipOccupancyMaxActiveBlocksPerMultiprocessor(&per_cu, (const void*)fwd_megakernel, 512, LDS_BYTES) != hipSuccess || per_cu < 1) { fprintf(stderr, "kernel_launch: occupancy query failed (%d)\n", per_cu); grid = -1; return; }
        if (cus != 256) { fprintf(stderr, "kernel_launch: built for a 256-CU device (one 256x256 tile per workgroup in the last two phases), got %d\n", cus); grid = -1; return; }
        grid = cus;
    }
    if (grid < 0) return;
    if (hipMemsetAsync((char*)d_ws + WS_CTL, 0, CTL_BYTES, stream) != hipSuccess) { fprintf(stderr, "kernel_launch: memset failed\n"); return; }
    KArgs a{};
    for (int i = 0; i < 18; ++i) a.in[i] = (const float*)d_in[i];
    a.out = (float*)d_out; a.ws = (unsigned char*)d_ws; a.ph_lo = 0; a.ph_hi = 5;
    void* args[] = {&a};
    hipError_t e = hipLaunchCooperativeKernel((const void*)fwd_megakernel, dim3(grid), dim3(512), args, LDS_BYTES, stream);
    if (e != hipSuccess) fprintf(stderr, "cooperative launch failed: %s (grid %d)\n", hipGetErrorString(e), grid);
}
```

```cpp
#include <hip/hip_runtime.h>
#include <hip/hip_cooperative_groups.h>
#include <cstdio>
#include <cstdint>
namespace cg = cooperative_groups;

#define LAS __attribute__((address_space(3)))
typedef unsigned short bf16;
typedef short bf16x8 __attribute__((ext_vector_type(8)));
typedef short s16x4 __attribute__((ext_vector_type(4)));
typedef float f32x4 __attribute__((ext_vector_type(4)));
typedef unsigned u32x4 __attribute__((ext_vector_type(4)));
typedef unsigned u32x2 __attribute__((ext_vector_type(2)));

constexpr int DM = 1024, NBATCH = 8, SEQ = 2048, NS = 128, NMEM = 256;
constexpr int MPR = NBATCH * SEQ;
constexpr int MV = MPR + NS;
constexpr int MP = MPR + 256;
constexpr int NPAN = MP / 256;
constexpr int INC = 10240;
constexpr float EPS = 1e-6f;
constexpr size_t O_YP = 0, O_YS = O_YP + (size_t)MPR * DM, O_POOLP = O_YS + (size_t)NS * DM, O_POOLS = O_POOLP + (size_t)NBATCH * 15 * DM,
                 O_MK = O_POOLS + (size_t)NS * 15 * DM, O_MV = O_MK + (size_t)NBATCH * NMEM * DM, O_SV = O_MV + (size_t)NBATCH * NMEM * DM, O_END = O_SV + (size_t)NS * DM;
constexpr size_t ROWB = (size_t)MP * DM * 2;
constexpr size_t WS_CTL = 0, CTL_BYTES = 40960;
constexpr size_t WS_VSS2 = CTL_BYTES;
constexpr size_t WS_DS = WS_VSS2 + 32768;
constexpr size_t WS_HS = WS_DS + 262144;
constexpr size_t WS_H = WS_HS + 524288;
constexpr size_t WS_WIN = WS_H + (size_t)(MP + 2048) * DM * 2;
constexpr size_t WS_WD = WS_WIN + (size_t)(INC + 2048) * DM * 2;
constexpr size_t WS_WO3 = WS_WD + (size_t)3 * DM * DM * 2;
constexpr size_t WS_PW = WS_WO3 + (size_t)3 * DM * DM * 2;
constexpr size_t WS_SW = WS_PW + (size_t)4 * 256 * 256 * 2;
constexpr size_t WS_VSS = WS_SW + (size_t)4 * 128 * 128 * 2;
constexpr size_t WS_KB = WS_VSS + (size_t)MP * 16 * 4;
constexpr size_t WS_VB = WS_KB + (size_t)2048 * DM * 2;
constexpr size_t WS_PROJ = WS_VB + (size_t)2048 * DM * 2;
constexpr size_t WS_GATE = WS_PROJ + 7 * ROWB;
constexpr size_t WS_BR = WS_GATE + 3 * ROWB;
constexpr size_t WS_MG = WS_PROJ;
constexpr size_t WS_GYS = WS_H;
constexpr size_t WS_END = WS_BR + 3 * ROWB;
constexpr int LDS_BYTES = 147456;
constexpr int CW_PANEL = 4096, CW_SAMPLE = 4096 + 64 * 64;

__device__ __forceinline__ unsigned f2bf(float f) { unsigned u = __builtin_bit_cast(unsigned, f); return (u + 0x7fffu + ((u >> 16) & 1u)) >> 16; }
__device__ __forceinline__ unsigned pk2(float lo, float hi) { unsigned r; asm volatile("v_cvt_pk_bf16_f32 %0, %1, %2" : "=v"(r) : "v"(lo), "v"(hi)); return r; }
__device__ __forceinline__ float bflo(unsigned w) { return __builtin_bit_cast(float, w << 16); }
__device__ __forceinline__ float bfhi(unsigned w) { return __builtin_bit_cast(float, w & 0xffff0000u); }
__device__ __forceinline__ float silu_f(float x) { return x * __builtin_amdgcn_rcpf(1.f + __expf(-x)); }
__device__ __forceinline__ float sigm_f(float x) { return __builtin_amdgcn_rcpf(1.f + __expf(-x)); }
__device__ __forceinline__ float wave_sum(float v) {
#pragma unroll
    for (int o = 1; o < 64; o <<= 1) v += __shfl_xor(v, o);
    return v;
}
__device__ __forceinline__ float wave_max(float v) {
#pragma unroll
    for (int o = 1; o < 64; o <<= 1) v = fmaxf(v, __shfl_xor(v, o));
    return v;
}
__device__ __forceinline__ bf16x8 tr_read2(const LAS unsigned char* a0, const LAS unsigned char* a1) {
    const s16x4 lo = __builtin_amdgcn_ds_read_tr16_b64_v4i16((LAS s16x4*)a0);
    const s16x4 hi = __builtin_amdgcn_ds_read_tr16_b64_v4i16((LAS s16x4*)a1);
    return (bf16x8){lo[0], lo[1], lo[2], lo[3], hi[0], hi[1], hi[2], hi[3]};
}

#define XB_TMO      128
#define XB_XCNT(j)  (256  + 64 * (j))
#define XB_XSUB(j)  (1280 + 64 * (j))
#define XB_XGEN(j)  (2304 + 64 * (j))
#define XB_TOP      3328
#define XB_TOPGEN   3392
#define XCD_BAR_WORDS 3456
#define XB_SPIN_CAP (1u << 18)

__device__ __forceinline__ unsigned xb_ld(unsigned* p)              { return __hip_atomic_load(p, __ATOMIC_RELAXED, __HIP_MEMORY_SCOPE_AGENT); }
__device__ __forceinline__ unsigned xb_add(unsigned* p, unsigned v) { return __hip_atomic_fetch_add(p, v, __ATOMIC_RELAXED, __HIP_MEMORY_SCOPE_AGENT); }
__device__ __forceinline__ unsigned xb_xcc_id() { return (unsigned)__builtin_amdgcn_s_getreg((3 << 11) | 20) & 0xFu; }
#define XB_SPIN(cond, bar) do { unsigned _sp = 0; while (cond) { __builtin_amdgcn_s_sleep(1); \
    if ((++_sp & 255u) == 0u) { if (xb_ld(&(bar)[XB_TMO])) break; if (_sp > XB_SPIN_CAP) { atomicAdd(&(bar)[XB_TMO], 1u); break; } } } } while (0)

struct XcdBarrier {
    unsigned* bar; unsigned x;
    volatile LAS unsigned* st;
};

__device__ __forceinline__ XcdBarrier xcd_barrier_post(unsigned* bar, volatile LAS unsigned* st) {
    XcdBarrier b; b.bar = bar; b.x = xb_xcc_id(); b.st = st;
    if (threadIdx.x == 0) (void)xb_add(&bar[XB_XCNT(b.x)], 1u);
    return b;
}
__device__ __forceinline__ void xcd_barrier_complete(unsigned* bar, unsigned x, unsigned& nloc, unsigned& nx) {
    const unsigned G = gridDim.x;
    unsigned sum, cnt, mine, sp = 0u;
    for (;;) {
        sum = 0u; cnt = 0u; mine = 0u;
#pragma unroll
        for (unsigned j = 0; j < 16; ++j) { const unsigned c = xb_ld(&bar[XB_XCNT(j)]); sum += c; cnt += (c > 0u) ? 1u : 0u; mine = (j == x) ? c : mine; }
        if (sum == G) break;
        __builtin_amdgcn_s_sleep(1);
        if ((++sp & 255u) == 0u) { if (xb_ld(&bar[XB_TMO])) break; if (sp > XB_SPIN_CAP) { atomicAdd(&bar[XB_TMO], 1u); break; } }
    }
    nloc = mine > 0u ? mine : 1u; nx = cnt > 0u ? cnt : 1u;
}

__device__ __forceinline__ void xcd_barrier(const XcdBarrier& b) {
    asm volatile("s_waitcnt vmcnt(0)" ::: "memory");
    __syncthreads();
    if (threadIdx.x == 0) {
        unsigned* bar = b.bar;
        __builtin_amdgcn_s_waitcnt(0);
        unsigned nloc = b.st[0], nx = b.st[1];
        if (nloc == 0u) { xcd_barrier_complete(bar, b.x, nloc, nx); b.st[0] = nloc; b.st[1] = nx; }
        const unsigned old = xb_add(&bar[XB_XSUB(b.x)], 1u);
        const unsigned gen = old / nloc;
        if (old + 1u == (gen + 1u) * nloc) {
            __builtin_amdgcn_fence(__ATOMIC_RELEASE, "agent");
            asm volatile("s_waitcnt vmcnt(0)" ::: "memory");
            const unsigned og = xb_add(&bar[XB_TOP], 1u);
            const unsigned tg = og / nx;
            if (og + 1u == (tg + 1u) * nx) xb_add(&bar[XB_TOPGEN], 1u);
            else XB_SPIN(xb_ld(&bar[XB_TOPGEN]) == tg, bar);
            __builtin_amdgcn_fence(__ATOMIC_ACQUIRE, "agent");
            xb_add(&bar[XB_XGEN(b.x)], 1u);
            asm volatile("s_waitcnt vmcnt(0)" ::: "memory");
        } else {
            XB_SPIN(xb_ld(&bar[XB_XGEN(b.x)]) == gen, bar);
            __builtin_amdgcn_fence(__ATOMIC_ACQUIRE, "agent");
            asm volatile("s_waitcnt vmcnt(0)" ::: "memory");
        }
    }
    __syncthreads();
}

namespace pg8 {
#define PG8_LAS __attribute__((address_space(3)))
typedef unsigned short bf16_t;
constexpr int BM = 256, BK = 64, HALF = 128, HTB = HALF * BK * 2, STAGE_BYTES = 8 * HTB, NXCD = 8, WGM = 8;
__host__ __device__ __forceinline__ int lds_byte(int r, int c) { const int st = (r >> 4) * 2 + (c >> 5), rr = r & 15, cc = c & 31, ob = rr * 64 + cc * 2; return st * 1024 + (ob ^ (((ob >> 9) & 1) << 5)); }
__host__ __device__ __forceinline__ void stage_rc(int b, int& R, int& C) { const int st = b / 1024, sb = b % 1024, swz = sb ^ (((sb >> 9) & 1) << 5); R = (st >> 1) * 16 + swz / 64; C = (st & 1) * 32 + (swz % 64) / 2; }
__host__ __device__ __forceinline__ int perm32(int rho) { const int n = rho >> 4, i = rho & 15; return 8 * (i >> 2) + 4 * n + (i & 3); }
struct Unit { int pm, pn; };
struct Gemm { const bf16_t* A; const bf16_t* Bt; int M, N, K; };
struct StaticOrder {
    int nM, nN, nwg, G, c;
    __host__ __device__ void init(int M, int N, int G_, int c_) { nM = M / BM; nN = N / BM; nwg = nM * nN; G = G_; c = c_; }
    __host__ __device__ bool next(int i, Unit& u) const {
        const long L = (long)i * G + c; if (L >= nwg) return false;
        int wgid = (int)L; { const int q = nwg / NXCD, r = nwg % NXCD, xcd = wgid % NXCD, off = wgid / NXCD; wgid = (xcd < r ? xcd * (q + 1) : r * (q + 1) + (xcd - r) * q) + off; }
        const int nig = WGM * nN, gid = wgid / nig, fm = gid * WGM, gsz = (nM - fm) < WGM ? (nM - fm) : WGM;
        u.pm = fm + ((wgid % nig) % gsz); u.pn = (wgid % nig) / gsz; return true;
    }
    __device__ __forceinline__ void a_ready(const Unit&) const {}
    __device__ __forceinline__ void done(const Unit&) const {}
};

template <class Epi, class Sched>
__device__ __forceinline__ void gemm_phase(PG8_LAS unsigned char* lds, const Gemm g, const Sched& S, const Epi& E) {
    const int tid = threadIdx.x, wid = __builtin_amdgcn_readfirstlane(tid >> 6), lane = tid & 63, wr = wid >> 2, wc = wid & 3, fr = lane & 15, fq = lane >> 4;
    const int K = g.K, nt = K / BK;
    unsigned voffA[2], voffB[2];
#pragma unroll
    for (int i = 0; i < 2; ++i) { int R, C; stage_rc(tid * 16 + i * 8192, R, C); const int Rb = Epi::PERM ? ((R & ~31) + perm32(R & 31)) : R;
        voffA[i] = (unsigned)(R * K + C) * 2u; voffB[i] = (unsigned)(Rb * K + C) * 2u; }
    const size_t kstep = (size_t)(BK * 2);
    const size_t hstep = (size_t)HALF * K * 2;
    const size_t tstep = 2 * hstep;
    const unsigned ldsw = (unsigned)wid * 1024u;
    const int aoff = lds_byte(wr * 64 + fr, fq * 8), boff = lds_byte(wc * 32 + fr, fq * 8);
#define PG8_SA(b, h) (((b) * 2 + (h)) * HTB)
#define PG8_SB(b, h) ((4 + (b) * 2 + (h)) * HTB)
#define PG8_STAGE(bufoff, gbase, voff) do { _Pragma("unroll") for (int _i = 0; _i < 2; ++_i) \
        __builtin_amdgcn_global_load_lds((const unsigned*)((const char*)(gbase) + (voff)[_i]), (PG8_LAS unsigned*)(lds + (bufoff) + ldsw + _i * 8192), 16, 0, 0); } while (0)
#define PG8_LDA(dst, b, h) do { _Pragma("unroll") for (int m = 0; m < 4; ++m) _Pragma("unroll") for (int k = 0; k < 2; ++k) dst[m][k] = *(const PG8_LAS bf16x8*)(lds + PG8_SA(b, h) + aoff + m * 2048 + k * 1024); } while (0)
#define PG8_LDB(dst, b, h) do { _Pragma("unroll") for (int n = 0; n < 2; ++n) _Pragma("unroll") for (int k = 0; k < 2; ++k) dst[n][k] = *(const PG8_LAS bf16x8*)(lds + PG8_SB(b, h) + boff + n * 2048 + k * 1024); } while (0)
#define PG8_MMA(ai, bj, At, Bt) do { __builtin_amdgcn_s_setprio(1); _Pragma("unroll") for (int m = 0; m < 4; ++m) _Pragma("unroll") for (int n = 0; n < 2; ++n) _Pragma("unroll") for (int k = 0; k < 2; ++k) \
        acc[ai][bj][m][n] = __builtin_amdgcn_mfma_f32_16x16x32_bf16(Bt[n][k], At[m][k], acc[ai][bj][m][n], 0, 0, 0); __builtin_amdgcn_s_setprio(0); } while (0)
#define PG8_WAIT_V(n) asm volatile("s_waitcnt vmcnt(" #n ")" ::: "memory")
#define PG8_WAIT_L(n) asm volatile("s_waitcnt lgkmcnt(" #n ")" ::: "memory")
#define PG8_BAR __builtin_amdgcn_s_barrier()
#define PG8_SCHED __builtin_amdgcn_sched_barrier(0)
    Unit cur, nxt; int ui = 0;
    if (!S.next(0, cur)) return;
    f32x4 acc[2][2][4][2];
#pragma unroll
    for (int a = 0; a < 2; ++a)
#pragma unroll
        for (int b = 0; b < 2; ++b)
#pragma unroll
            for (int m = 0; m < 4; ++m)
#pragma unroll
                for (int n = 0; n < 2; ++n) acc[a][b][m][n] = (f32x4){0.f, 0.f, 0.f, 0.f};
    bf16x8 At[4][2], B0[2][2], B1[2][2];
    const char* cA = (const char*)g.A + (size_t)cur.pm * tstep; const char* cB = (const char*)g.Bt + (size_t)cur.pn * tstep;
    S.a_ready(cur);
    PG8_STAGE(PG8_SB(0, 0), cB, voffB); PG8_STAGE(PG8_SA(0, 0), cA, voffA); PG8_STAGE(PG8_SB(0, 1), cB + hstep, voffB); PG8_STAGE(PG8_SA(0, 1), cA + hstep, voffA);
    if (wr == 1) PG8_BAR;
    PG8_WAIT_V(4); PG8_BAR;
    PG8_STAGE(PG8_SB(1, 0), cB + kstep, voffB); PG8_STAGE(PG8_SA(1, 0), cA + kstep, voffA); PG8_STAGE(PG8_SB(1, 1), cB + hstep + kstep, voffB);
    PG8_WAIT_V(6); PG8_BAR;
    for (;;) {
        const bool has_next = S.next(ui + 1, nxt);
        const char* nA = has_next ? (const char*)g.A + (size_t)nxt.pm * tstep : cA; const char* nB = has_next ? (const char*)g.Bt + (size_t)nxt.pn * tstep : cB;
        E.prefetch(cur, wid, lane, lds + STAGE_BYTES + wid * 1024);
        for (int t = 0; t < nt; t += 2) {
            const bool last = (t == nt - 2);
            const char* a1 = cA + (size_t)(t + 1) * kstep;
            const char* a2 = last ? nA : cA + (size_t)(t + 2) * kstep; const char* b2 = last ? nB : cB + (size_t)(t + 2) * kstep;
            const char* a3 = a2 + kstep; const char* b3 = b2 + kstep;
            if (last && has_next) S.a_ready(nxt);
            PG8_LDB(B0, 0, 0); PG8_SCHED; PG8_LDA(At, 0, 0); PG8_STAGE(PG8_SA(1, 1), a1 + hstep, voffA);
            PG8_WAIT_L(8); PG8_BAR; PG8_WAIT_L(0); PG8_MMA(0, 0, At, B0); PG8_BAR; PG8_SCHED;
            PG8_LDB(B1, 0, 1); PG8_STAGE(PG8_SB(0, 0), b2, voffB);
            PG8_BAR; PG8_WAIT_L(0); PG8_MMA(0, 1, At, B1); PG8_BAR;
            PG8_LDA(At, 0, 1); PG8_STAGE(PG8_SA(0, 0), a2, voffA);
            PG8_BAR; PG8_WAIT_L(0); PG8_MMA(1, 0, At, B0); PG8_BAR; PG8_SCHED;
            PG8_STAGE(PG8_SB(0, 1), b2 + hstep, voffB);
            PG8_WAIT_V(6); PG8_BAR; PG8_MMA(1, 1, At, B1); PG8_BAR;
            PG8_LDB(B0, 1, 0); PG8_SCHED; PG8_LDA(At, 1, 0); PG8_STAGE(PG8_SA(0, 1), a2 + hstep, voffA);
            PG8_WAIT_L(8); PG8_BAR; PG8_WAIT_L(0); PG8_MMA(0, 0, At, B0); PG8_BAR; PG8_SCHED;
            PG8_LDB(B1, 1, 1); PG8_STAGE(PG8_SB(1, 0), b3, voffB);
            PG8_BAR; PG8_WAIT_L(0); PG8_MMA(0, 1, At, B1); PG8_BAR;
            PG8_LDA(At, 1, 1); PG8_STAGE(PG8_SA(1, 0), a3, voffA);
            PG8_BAR; PG8_WAIT_L(0); PG8_MMA(1, 0, At, B0); PG8_BAR; PG8_SCHED;
            PG8_STAGE(PG8_SB(1, 1), b3 + hstep, voffB);
            PG8_WAIT_V(6); PG8_BAR; PG8_MMA(1, 1, At, B1); PG8_BAR;
        }
        if constexpr (!Epi::AFTER_DRAIN) { E(acc, cur, wr, wc, fr, fq); S.done(cur); }
        if (!has_next) break;
#pragma unroll
        for (int a = 0; a < 2; ++a)
#pragma unroll
            for (int b = 0; b < 2; ++b)
#pragma unroll
                for (int m = 0; m < 4; ++m)
#pragma unroll
                    for (int n = 0; n < 2; ++n) acc[a][b][m][n] = (f32x4){0.f, 0.f, 0.f, 0.f};
        cur = nxt; cA = nA; cB = nB; ++ui;
    }
    PG8_WAIT_V(0);
    if (wr == 0) PG8_BAR;
    PG8_BAR;
    if constexpr (Epi::AFTER_DRAIN) { E.fused(acc, cur, wr, wc, fr, fq); S.done(cur); }
#undef PG8_SA
#undef PG8_SB
#undef PG8_STAGE
#undef PG8_LDA
#undef PG8_LDB
#undef PG8_MMA
#undef PG8_WAIT_V
#undef PG8_WAIT_L
#undef PG8_BAR
#undef PG8_SCHED
}
}

struct KArgs {
    const float* in[18];
    float* out;
    unsigned char* ws;
    int ph_lo, ph_hi;
    int cg_sync, pad;
};
enum { I_XP = 0, I_XS, I_SPOOL, I_CK, I_CV, I_MEM, I_NORMG, I_WIN, I_POOLW, I_POOLSC, I_SGUNG, I_SGUW, I_SGUB, I_MEMNG, I_WKV, I_WDOWN, I_WOUT, I_NORMF };

struct P1Order {
    pg8::StaticOrder so; int G, c;
    __device__ void init(int G_, int c_) { so.init(MPR, INC, G_, c_); G = G_; c = c_; }
    __device__ bool next(int i, pg8::Unit& u) const {
        const long L = (long)i * G + c;
        if (L < so.nwg) return so.next(i, u);
        const int e = (int)(L - so.nwg); if (e >= 104) return false;
        if (e < 64) { u.pm = NPAN + (e >> 3); u.pn = 40 + (e & 7); } else { u.pm = 64; u.pn = e - 64; }
        return true;
    }
    __device__ __forceinline__ void a_ready(const pg8::Unit&) const {}
    __device__ __forceinline__ void done(const pg8::Unit&) const {}
};
struct EpiProj {
    static constexpr bool PERM = true, AFTER_DRAIN = false;
    bf16* proj; bf16* gate; float* vss; bf16* kb; bf16* vb; float* out; const float* hs; bf16* dsr;
    __device__ __forceinline__ void prefetch(const pg8::Unit&, int, int, LAS unsigned char*) const {}
    __device__ __forceinline__ void operator()(const f32x4 (&acc)[2][2][4][2], const pg8::Unit& u, int wr, int wc, int fr, int fq) const {
        if (u.pn < 40) {
            const int sec = u.pn >> 2;
            const int act = (sec == 1 || sec == 4 || sec == 6) ? 1 : (sec >= 7 ? 2 : 0);
            const int row0 = u.pm * 256 + wr * 64 + fr, cs0 = (u.pn & 3) * 256 + wc * 32 + 8 * fq;
            bf16* base; int ld;
            if (sec < 7) { base = proj + (size_t)sec * MP * DM; ld = DM; } else { base = gate + (sec - 7) * DM; ld = 3 * DM; }
            const bool poolrows = (sec == 0) && (((u.pm & 7) == 7) || u.pm == 64);
#pragma unroll
            for (int ai = 0; ai < 2; ++ai)
#pragma unroll
                for (int m = 0; m < 4; ++m) {
                    const int r = row0 + ai * 128 + m * 16; float ss = 0.f;
#pragma unroll
                    for (int bj = 0; bj < 2; ++bj) {
                        f32x4 v0 = acc[ai][bj][m][0], v1 = acc[ai][bj][m][1]; const int cs = cs0 + bj * 128;
                        if (sec == 3) ss += (v0[0] * v0[0] + v0[1] * v0[1]) + (v0[2] * v0[2] + v0[3] * v0[3]) + (v1[0] * v1[0] + v1[1] * v1[1]) + (v1[2] * v1[2] + v1[3] * v1[3]);
                        if (poolrows) {
                            float* dst = nullptr;
                            if (r < MPR) { const int t = r & (SEQ - 1); if (t >= SEQ - 15) dst = out + O_POOLP + ((size_t)(r >> 11) * 15 + (t - (SEQ - 15))) * DM + cs; }
                            else if (r < MV) { dst = out + O_POOLS + ((size_t)(r - MPR) * 15 + 14) * DM + cs;
                                const float* hp = hs + (size_t)(r - MPR) * DM + cs; const f32x4 h0 = *(const f32x4*)hp, h1 = *(const f32x4*)(hp + 4); const float inv = 1.f / (float)(2 << (cs >> 8));
                                u32x4 d; d.x = pk2((h0.x + v0[0]) * inv - v0[0], (h0.y + v0[1]) * inv - v0[1]); d.y = pk2((h0.z + v0[2]) * inv - v0[2], (h0.w + v0[3]) * inv - v0[3]);
                                d.z = pk2((h1.x + v1[0]) * inv - v1[0], (h1.y + v1[1]) * inv - v1[1]); d.w = pk2((h1.z + v1[2]) * inv - v1[2], (h1.w + v1[3]) * inv - v1[3]);
                                *(u32x4*)(dsr + (size_t)(r - MPR) * DM + cs) = d; }
                            if (dst) { *(f32x4*)dst = v0; *(f32x4*)(dst + 4) = v1; }
                        }
                        if (act == 1) {
#pragma unroll
                            for (int j = 0; j < 4; ++j) { v0[j] = silu_f(v0[j]); v1[j] = silu_f(v1[j]); } }
                        if (act == 2) {
#pragma unroll
                            for (int j = 0; j < 4; ++j) { v0[j] = sigm_f(v0[j]); v1[j] = sigm_f(v1[j]); } }
                        u32x4 w; w.x = pk2(v0[0], v0[1]); w.y = pk2(v0[2], v0[3]); w.z = pk2(v1[0], v1[1]); w.w = pk2(v1[2], v1[3]);
                        __builtin_nontemporal_store(w, (u32x4*)(base + (size_t)r * ld + cs));
                    }
                    if (sec == 3) { ss += __shfl_xor(ss, 16); ss += __shfl_xor(ss, 32); if (fq == 0) vss[(size_t)r * 16 + (u.pn & 3) * 4 + wc] = ss; }
                }
        } else {
            const int b = u.pm - NPAN, ct = (u.pn - 40) * 256;
            const bool isv = ct >= DM; const int cb = (isv ? ct - DM : ct) + wc * 32 + 8 * fq;
            float* of = out + (isv ? O_MV : O_MK); bf16* ob = isv ? vb : kb;
#pragma unroll
            for (int ai = 0; ai < 2; ++ai)
#pragma unroll
                for (int m = 0; m < 4; ++m) {
                    const size_t j = (size_t)b * 256 + ai * 128 + wr * 64 + m * 16 + fr;
#pragma unroll
                    for (int bj = 0; bj < 2; ++bj) {
                        const f32x4 v0 = acc[ai][bj][m][0], v1 = acc[ai][bj][m][1]; const int cs = cb + bj * 128;
                        __builtin_nontemporal_store(v0, (f32x4*)(of + j * DM + cs)); __builtin_nontemporal_store(v1, (f32x4*)(of + j * DM + cs + 4));
                        u32x4 w; w.x = pk2(v0[0], v0[1]); w.y = pk2(v0[2], v0[3]); w.z = pk2(v1[0], v1[1]); w.w = pk2(v1[2], v1[3]);
                        *(u32x4*)(ob + j * DM + cs) = w;
                    }
                }
        }
    }
};
struct P3Order {
    pg8::StaticOrder so;
    __device__ void init(int G_, int c_) { so.init(MPR, DM, G_, c_); }
    __device__ bool next(int i, pg8::Unit& u) const { const int rnd = i / 3, b = i - 3 * rnd; pg8::Unit t; if (!so.next(rnd, t)) return false; u.pm = b * NPAN + t.pm; u.pn = b * 4 + t.pn; return true; }
    __device__ __forceinline__ void a_ready(const pg8::Unit&) const {}
    __device__ __forceinline__ void done(const pg8::Unit&) const {}
};
struct EpiGate {
    static constexpr bool PERM = true, AFTER_DRAIN = false;
    const bf16* gate; bf16* mg;
    __device__ __forceinline__ void prefetch(const pg8::Unit& u, int wid, int lane, LAS unsigned char* scr) const {
        const int b = u.pn >> 2, pm = u.pm - b * NPAN, t = wid * 64 + lane;
#pragma unroll
        for (int j = 0; j < 2; ++j) { const int li = t + 512 * j, row = li >> 2, seg = li & 3; const size_t r = (size_t)(pm * 256 + row);
            __builtin_amdgcn_global_load_lds((const unsigned*)(gate + r * (3 * DM) + b * DM + (u.pn & 3) * 256 + seg * 64), (LAS unsigned*)(scr + j * 256), 4, 0, 0); }
    }
    __device__ __forceinline__ void operator()(const f32x4 (&acc)[2][2][4][2], const pg8::Unit& u, int wr, int wc, int fr, int fq) const {
        const int b = u.pn >> 2, pm = u.pm - b * NPAN;
        const int row0 = pm * 256 + wr * 64 + fr, c0 = (u.pn & 3) * 256 + wc * 32 + 8 * fq;
#pragma unroll
        for (int ai = 0; ai < 2; ++ai)
#pragma unroll
            for (int m = 0; m < 4; ++m) {
                const size_t r = (size_t)(row0 + ai * 128 + m * 16);
#pragma unroll
                for (int bj = 0; bj < 2; ++bj) {
                    const f32x4 v0 = acc[ai][bj][m][0], v1 = acc[ai][bj][m][1]; const int c = c0 + bj * 128;
                    const u32x4 g8 = *(const u32x4*)(gate + r * (3 * DM) + b * DM + c);
                    float o0 = v0[0] * bflo(g8.x), o1 = v0[1] * bfhi(g8.x), o2 = v0[2] * bflo(g8.y), o3 = v0[3] * bfhi(g8.y);
                    float o4 = v1[0] * bflo(g8.z), o5 = v1[1] * bfhi(g8.z), o6 = v1[2] * bflo(g8.w), o7 = v1[3] * bfhi(g8.w);
                    if (b > 0) { const u32x4 p = *(const u32x4*)(mg + r * DM + c);
                        o0 += bflo(p.x); o1 += bfhi(p.x); o2 += bflo(p.y); o3 += bfhi(p.y); o4 += bflo(p.z); o5 += bfhi(p.z); o6 += bflo(p.w); o7 += bfhi(p.w); }
                    u32x4 w; w.x = pk2(o0, o1); w.y = pk2(o2, o3); w.z = pk2(o4, o5); w.w = pk2(o6, o7);
                    if (b == 2) __builtin_nontemporal_store(w, (u32x4*)(mg + r * DM + c)); else *(u32x4*)(mg + r * DM + c) = w;
                }
            }
    }
};
__device__ __forceinline__ void st_agent(float* p, float v) { __hip_atomic_store((unsigned*)p, __builtin_bit_cast(unsigned, v), __ATOMIC_RELAXED, __HIP_MEMORY_SCOPE_AGENT); }
__device__ __forceinline__ float ld_agent(const float* p) { return __builtin_bit_cast(float, __hip_atomic_load((unsigned*)p, __ATOMIC_RELAXED, __HIP_MEMORY_SCOPE_AGENT)); }
__device__ __forceinline__ void wait_count(unsigned* w, unsigned want) {
    unsigned sp = 0;
    while ((unsigned)__builtin_amdgcn_readfirstlane(__hip_atomic_load(w, __ATOMIC_RELAXED, __HIP_MEMORY_SCOPE_AGENT)) < want) { __builtin_amdgcn_s_sleep(2); if (++sp > (1u << 22)) break; }
    __builtin_amdgcn_fence(__ATOMIC_ACQUIRE, "agent");
    asm volatile("s_waitcnt vmcnt(0)" ::: "memory");
}
struct EpiOutNorm {
    static constexpr bool PERM = false, AFTER_DRAIN = true;
    const float* xp; const float* gf; float* out; float* slots; unsigned* cnt;
    __device__ __forceinline__ void prefetch(const pg8::Unit& u, int wid, int lane, LAS unsigned char* scr) const {
        const int t = wid * 64 + lane;
#pragma unroll
        for (int j = 0; j < 4; ++j) { const int li = t + 512 * j, row = li >> 3, seg = li & 7;
            __builtin_amdgcn_global_load_lds((const unsigned*)(xp + (size_t)(u.pm * 256 + row) * DM + u.pn * 256 + seg * 32), (LAS unsigned*)(scr + j * 256), 4, 0, 0); }
    }
    __device__ __forceinline__ void operator()(const f32x4 (&)[2][2][4][2], const pg8::Unit&, int, int, int, int) const {}
    __device__ __forceinline__ void fused(f32x4 (&acc)[2][2][4][2], const pg8::Unit& u, int wr, int wc, int fr, int fq) const {
        const int row0 = u.pm * 256 + wr * 64 + fr, col0 = u.pn * 256 + wc * 32 + 4 * fq;
#pragma unroll
        for (int ai = 0; ai < 2; ++ai)
#pragma unroll
            for (int m = 0; m < 4; ++m) { const size_t r = (size_t)(row0 + ai * 128 + m * 16); float ss = 0.f;
#pragma unroll
                for (int bj = 0; bj < 2; ++bj)
#pragma unroll
                    for (int n = 0; n < 2; ++n) { const int c = col0 + bj * 128 + n * 16; const f32x4 v = acc[ai][bj][m][n] + __builtin_nontemporal_load((const f32x4*)(xp + r * DM + c)); acc[ai][bj][m][n] = v;
                        ss += (v.x * v.x + v.y * v.y) + (v.z * v.z + v.w * v.w); }
                ss += __shfl_xor(ss, 16); ss += __shfl_xor(ss, 32);
                if (fq == 0) st_agent(slots + r * 16 + u.pn * 4 + wc, ss); }
        asm volatile("s_waitcnt vmcnt(0)" ::: "memory");
        if (fr == 0 && fq == 0) __hip_atomic_fetch_add(cnt + 64 * u.pm, 1u, __ATOMIC_RELAXED, __HIP_MEMORY_SCOPE_AGENT);
        if (threadIdx.x < 64) wait_count(cnt + 64 * u.pm, 32u);
        __syncthreads();
#pragma unroll
        for (int ai = 0; ai < 2; ++ai)
#pragma unroll
            for (int m = 0; m < 4; ++m) { const size_t r = (size_t)(row0 + ai * 128 + m * 16); float tot = 0.f;
                { const f32x4* sp = (const f32x4*)(slots + r * 16); const f32x4 p0 = sp[0], p1 = sp[1], p2 = sp[2], p3 = sp[3];
                  tot = (((p0.x + p0.y) + (p0.z + p0.w)) + ((p1.x + p1.y) + (p1.z + p1.w))) + (((p2.x + p2.y) + (p2.z + p2.w)) + ((p3.x + p3.y) + (p3.z + p3.w))); }
                const float rs = rsqrtf(tot * (1.f / DM) + EPS);
#pragma unroll
                for (int bj = 0; bj < 2; ++bj)
#pragma unroll
                    for (int n = 0; n < 2; ++n) { const int c = col0 + bj * 128 + n * 16; const f32x4 g = *(const f32x4*)(gf + c); const f32x4 v = acc[ai][bj][m][n];
                        __builtin_nontemporal_store((f32x4){v.x * rs * g.x, v.y * rs * g.y, v.z * rs * g.z, v.w * rs * g.w}, (f32x4*)(out + O_YP + r * DM + c)); } }
    }
};

template <class Epi>
__device__ __forceinline__ void skinny_gemm(LAS unsigned char* lds, const bf16* A0, int lda, size_t a_grp_stride, int strips_per_grp, int nseg, int aseg,
                                            const bf16* Bt, int ldb, int K, int nstrips, int first, int step, const Epi& E) {
    int tid_ = threadIdx.x; asm volatile("" : "+v"(tid_));
    const int tid = tid_, lane = tid & 63, wv = tid >> 6, fr = lane & 15, fq = lane >> 4, rh = wv & 1, kq = wv >> 1;
    LAS float* part = (LAS float*)lds;
    const int nks = K / 128;
    for (int s = first; s < nstrips; s += step) {
        const bf16* A = A0 + (size_t)(s / strips_per_grp) * a_grp_stride + (size_t)(rh * 64 + fr) * lda + fq * 8;
        const bf16* B = Bt + (size_t)(16 * s + fr) * ldb + fq * 8;
        f32x4 acc[4];
#pragma unroll
        for (int rb = 0; rb < 4; ++rb) acc[rb] = (f32x4){0.f, 0.f, 0.f, 0.f};
        for (int seg = 0; seg < nseg; ++seg) {
#pragma unroll 4
            for (int k = 0; k < nks; ++k) {
                const int ko = (kq * nks + k) * 32;
                const bf16x8 bfr = *(const bf16x8*)(B + ko);
#pragma unroll
                for (int rb = 0; rb < 4; ++rb) { const bf16x8 afr = *(const bf16x8*)(A + (size_t)rb * 16 * lda + seg * aseg + ko);
                    acc[rb] = __builtin_amdgcn_mfma_f32_16x16x32_bf16(bfr, afr, acc[rb], 0, 0, 0); }
            }
        }
#pragma unroll
        for (int rb = 0; rb < 4; ++rb) *(LAS f32x4*)(part + ((kq * 128 + rh * 64 + rb * 16 + fr) * 16 + fq * 4)) = acc[rb];
        __syncthreads();
        { const int row = tid >> 2, cq = tid & 3; const LAS float* p = part + row * 16 + cq * 4;
          const f32x4 v = (*(const LAS f32x4*)p + *(const LAS f32x4*)(p + 2048)) + (*(const LAS f32x4*)(p + 4096) + *(const LAS f32x4*)(p + 6144));
          E(s, row, 16 * s + cq * 4, v, cq); }
        __syncthreads();
    }
}
struct EpiS1 {
    bf16* proj; bf16* gate; float* vss2; float* out; const float* hist; bf16* ds;
    __device__ __forceinline__ void operator()(int s, int row, int c, f32x4 v, int cq) const {
        const int sec = c >> 10, cs = c & 1023; const size_t m = (size_t)(MPR + row);
        if (sec == 0) { *(f32x4*)(out + O_POOLS + ((size_t)row * 15 + 14) * DM + cs) = v;
            const int w = 2 << (cs >> 8); f32x4 sm = v;
#pragma unroll
            for (int j = 0; j < 15; ++j) if (j < w - 1) sm = sm + *(const f32x4*)(hist + ((size_t)row * 15 + 14 - j) * DM + cs);
            const float inv = 1.f / (float)w;
            u32x2 d; d.x = pk2(sm.x * inv - v.x, sm.y * inv - v.y); d.y = pk2(sm.z * inv - v.z, sm.w * inv - v.w);
            *(u32x2*)(ds + (size_t)row * DM + cs) = d; }
        if (sec == 3) { float ss = (v.x * v.x + v.y * v.y) + (v.z * v.z + v.w * v.w); ss += __shfl_xor(ss, 1); ss += __shfl_xor(ss, 2); if (cq == 0) vss2[row * 64 + (s - 192)] = ss; }
        if (sec == 1 || sec == 4 || sec == 6) { v.x = silu_f(v.x); v.y = silu_f(v.y); v.z = silu_f(v.z); v.w = silu_f(v.w); }
        if (sec >= 7) { v.x = sigm_f(v.x); v.y = sigm_f(v.y); v.z = sigm_f(v.z); v.w = sigm_f(v.w); }
        u32x2 w; w.x = pk2(v.x, v.y); w.y = pk2(v.z, v.w);
        if (sec < 7) *(u32x2*)(proj + (size_t)sec * MP * DM + m * DM + cs) = w; else *(u32x2*)(gate + m * (3 * DM) + (sec - 7) * DM + cs) = w;
    }
};
struct EpiS3 {
    const bf16* gate; bf16* gys;
    __device__ __forceinline__ void operator()(int s, int row, int c, f32x4 v, int cq) const {
        const u32x2 g = *(const u32x2*)(gate + (size_t)(MPR + row) * (3 * DM) + c);
        u32x2 w; w.x = pk2(v.x * bflo(g.x), v.y * bfhi(g.x)); w.y = pk2(v.z * bflo(g.y), v.w * bfhi(g.y));
        *(u32x2*)(gys + (size_t)row * (3 * DM) + c) = w;
    }
};
struct EpiS4 {
    const float* xs; const float* gf; float* out; float* slots2; unsigned* cnt2;
    __device__ __forceinline__ void operator()(int s, int row, int c, f32x4 v, int cq) const {
        v = v + *(const f32x4*)(xs + (size_t)row * DM + c);
        float ss = (v.x * v.x + v.y * v.y) + (v.z * v.z + v.w * v.w); ss += __shfl_xor(ss, 1); ss += __shfl_xor(ss, 2);
        if (cq == 0) st_agent(slots2 + row * 64 + s, ss);
        asm volatile("s_waitcnt vmcnt(0)" ::: "memory");
        __syncthreads();
        if (threadIdx.x == 0) __hip_atomic_fetch_add(cnt2, 1u, __ATOMIC_RELAXED, __HIP_MEMORY_SCOPE_AGENT);
        if (threadIdx.x < 64) wait_count(cnt2, 64u);
        __syncthreads();
        float tot = 0.f;
        { const f32x4* sp = (const f32x4*)(slots2 + row * 64 + cq * 16); const f32x4 p0 = sp[0], p1 = sp[1], p2 = sp[2], p3 = sp[3];
          tot = (((p0.x + p0.y) + (p0.z + p0.w)) + ((p1.x + p1.y) + (p1.z + p1.w))) + (((p2.x + p2.y) + (p2.z + p2.w)) + ((p3.x + p3.y) + (p3.z + p3.w))); }
        tot += __shfl_xor(tot, 1); tot += __shfl_xor(tot, 2);
        const float rs = rsqrtf(tot * (1.f / DM) + EPS); const f32x4 g = *(const f32x4*)(gf + c);
        *(f32x4*)(out + O_YS + (size_t)row * DM + c) = (f32x4){v.x * rs * g.x, v.y * rs * g.y, v.z * rs * g.z, v.w * rs * g.w};
    }
};


__device__ __forceinline__ void sample_out_split(const KArgs& a, LAS unsigned char* lds, int item) {
    int tid_ = threadIdx.x; asm volatile("" : "+v"(tid_));
    const int tid = tid_, lane = tid & 63, wv = tid >> 6, fr = lane & 15, fq = lane >> 4, s = item >> 2, rq = item & 3;
    const bf16* A = (const bf16*)(a.ws + WS_GYS) + (size_t)(rq * 32 + fr) * (3 * DM) + fq * 8;
    const bf16* B = (const bf16*)(a.ws + WS_WO3) + (size_t)(16 * s + fr) * DM + fq * 8;
    f32x4 acc0 = (f32x4){0.f, 0.f, 0.f, 0.f}, acc1 = acc0;
#pragma unroll
    for (int kk = 0; kk < 12; ++kk) { const int k = 384 * wv + 32 * kk;
        const bf16x8 bfr = *(const bf16x8*)(B + (k & 1023)); const bf16x8 a0 = *(const bf16x8*)(A + k), a1 = *(const bf16x8*)(A + (size_t)16 * (3 * DM) + k);
        acc0 = __builtin_amdgcn_mfma_f32_16x16x32_bf16(bfr, a0, acc0, 0, 0, 0); acc1 = __builtin_amdgcn_mfma_f32_16x16x32_bf16(bfr, a1, acc1, 0, 0, 0); }
    LAS float* part = (LAS float*)lds;
    *(LAS f32x4*)(part + (wv * 32 + fr) * 16 + fq * 4) = acc0; *(LAS f32x4*)(part + (wv * 32 + 16 + fr) * 16 + fq * 4) = acc1;
    __syncthreads();
    const int row = tid >> 4, col = tid & 15, grow = rq * 32 + row, c = 16 * s + col;
    float v = 0.f;
#pragma unroll
    for (int w8 = 0; w8 < 8; ++w8) v += part[(w8 * 32 + row) * 16 + col];
    v += a.in[I_XS][(size_t)grow * DM + c];
    float ss = v * v; ss += __shfl_xor(ss, 1); ss += __shfl_xor(ss, 2); ss += __shfl_xor(ss, 4); ss += __shfl_xor(ss, 8);
    float* slots2 = (float*)(a.ws + WS_VSS2); unsigned* cnt = (unsigned*)(a.ws + WS_CTL) + CW_SAMPLE + 64 * rq;
    if (col == 0) st_agent(slots2 + grow * 64 + s, ss);
    asm volatile("s_waitcnt vmcnt(0)" ::: "memory");
    __syncthreads();
    if (tid == 0) __hip_atomic_fetch_add(cnt, 1u, __ATOMIC_RELAXED, __HIP_MEMORY_SCOPE_AGENT);
    if (tid < 64) wait_count(cnt, 64u);
    __syncthreads();
    const f32x4 p4 = *(const f32x4*)(slots2 + grow * 64 + col * 4);
    float tot = (p4.x + p4.y) + (p4.z + p4.w); tot += __shfl_xor(tot, 1); tot += __shfl_xor(tot, 2); tot += __shfl_xor(tot, 4); tot += __shfl_xor(tot, 8);
    a.out[O_YS + (size_t)grow * DM + c] = v * rsqrtf(tot * (1.f / DM) + EPS) * a.in[I_NORMF][c];
    __syncthreads();
}

__device__ __forceinline__ void p0_transpose_item(const float* W, int N, bf16* WT, int row_off, int ldo, int koff, LAS float* scr, int item, int lane) {
    const int nblk = N / 32, kb = item / nblk, nb = item % nblk, k0 = 64 * kb, n0 = 32 * nb;
    float wv_[32];
#pragma unroll
    for (int i = 0; i < 32; ++i) { const int kk = 2 * i + (lane >> 5); wv_[i] = __builtin_nontemporal_load(W + (size_t)(k0 + kk) * N + n0 + (lane & 31)); }
#pragma unroll
    for (int i = 0; i < 32; ++i) { const int kk = 2 * i + (lane >> 5); scr[kk * 33 + (lane & 31)] = wv_[i]; }
    asm volatile("s_waitcnt lgkmcnt(0)" ::: "memory");
    const int c = lane & 7;
#pragma unroll
    for (int j = 0; j < 4; ++j) { const int n = (lane >> 3) + 8 * j; const LAS float* s = scr + (8 * c) * 33 + n;
        u32x4 o; o.x = pk2(s[0 * 33], s[1 * 33]); o.y = pk2(s[2 * 33], s[3 * 33]); o.z = pk2(s[4 * 33], s[5 * 33]); o.w = pk2(s[6 * 33], s[7 * 33]);
        *(u32x4*)(WT + (size_t)(row_off + n0 + n) * ldo + koff + k0 + 8 * c) = o; }
    asm volatile("s_waitcnt lgkmcnt(0)" ::: "memory");
}
__device__ __forceinline__ void rms_row_to_bf16(const float* xrow, const float* gain, bf16* orow, int lane) {
    const f32x4* xr = (const f32x4*)xrow + lane; const f32x4* gr = (const f32x4*)gain + lane;
    f32x4 v[4]; float s = 0.f;
#pragma unroll
    for (int j = 0; j < 4; ++j) { v[j] = xr[64 * j]; s += (v[j].x * v[j].x + v[j].y * v[j].y) + (v[j].z * v[j].z + v[j].w * v[j].w); }
    const float rs = rsqrtf(wave_sum(s) * (1.f / DM) + EPS);
    u32x2* o8 = (u32x2*)orow + lane;
#pragma unroll
    for (int j = 0; j < 4; ++j) { const f32x4 g = gr[64 * j]; u32x2 w; w.x = pk2(v[j].x * rs * g.x, v[j].y * rs * g.y); w.y = pk2(v[j].z * rs * g.z, v[j].w * rs * g.w); o8[64 * j] = w; }
}
__device__ __forceinline__ void rms_row2_to_bf16(const float* x0, const float* x1, const float* gain, bf16* o0, bf16* o1, int lane) {
    const f32x4* xr0 = (const f32x4*)x0 + lane; const f32x4* xr1 = (const f32x4*)x1 + lane; const f32x4* gr = (const f32x4*)gain + lane;
    f32x4 v[4], w[4]; float s = 0.f, t = 0.f;
#pragma unroll
    for (int j = 0; j < 4; ++j) { v[j] = __builtin_nontemporal_load(xr0 + 64 * j); w[j] = __builtin_nontemporal_load(xr1 + 64 * j); }
#pragma unroll
    for (int j = 0; j < 4; ++j) { s += (v[j].x * v[j].x + v[j].y * v[j].y) + (v[j].z * v[j].z + v[j].w * v[j].w); t += (w[j].x * w[j].x + w[j].y * w[j].y) + (w[j].z * w[j].z + w[j].w * w[j].w); }
#pragma unroll
    for (int o = 1; o < 64; o <<= 1) { s += __shfl_xor(s, o); t += __shfl_xor(t, o); }
    const float rs = rsqrtf(s * (1.f / DM) + EPS), rt = rsqrtf(t * (1.f / DM) + EPS);
    u32x2* p0 = (u32x2*)o0 + lane; u32x2* p1 = (u32x2*)o1 + lane;
#pragma unroll
    for (int j = 0; j < 4; ++j) { const f32x4 g = gr[64 * j]; u32x2 a; a.x = pk2(v[j].x * rs * g.x, v[j].y * rs * g.y); a.y = pk2(v[j].z * rs * g.z, v[j].w * rs * g.w); p0[64 * j] = a;
        u32x2 b; b.x = pk2(w[j].x * rt * g.x, w[j].y * rt * g.y); b.y = pk2(w[j].z * rt * g.z, w[j].w * rt * g.w); p1[64 * j] = b; }
}
__device__ __forceinline__ void p0_prologue(const KArgs& a, LAS unsigned char* lds, int G) {
    const int tid = threadIdx.x, lane = tid & 63, wave = tid >> 6;
    LAS float* scr = (LAS float*)(lds + wave * 16384);
    const int gw = blockIdx.x * 8 + wave, NGW = G * 8;
    bf16* H = (bf16*)(a.ws + WS_H); bf16* WinT = (bf16*)(a.ws + WS_WIN); bf16* WdT = (bf16*)(a.ws + WS_WD); bf16* Wo3 = (bf16*)(a.ws + WS_WO3);
    bf16* PwT = (bf16*)(a.ws + WS_PW); bf16* SW = (bf16*)(a.ws + WS_SW);
    constexpr int I_IN = 16 * (INC / 32), I_KV = 16 * (2048 / 32), I_D = 16 * 32, I_O = 16 * 32, I_P = 4 * 8;
    constexpr int NITEMS = I_IN + I_KV + 3 * I_D + I_O + 4 * I_P;
    for (int it = gw; it < NITEMS; it += NGW) {
        int r = it;
        if (r < I_IN) { p0_transpose_item(a.in[I_WIN], INC, WinT, 0, DM, 0, scr, r, lane); continue; } r -= I_IN;
        if (r < I_KV) { p0_transpose_item(a.in[I_WKV], 2048, WinT, INC, DM, 0, scr, r, lane); continue; } r -= I_KV;
        if (r < 3 * I_D) { const int b = r / I_D; p0_transpose_item(a.in[I_WDOWN] + (size_t)b * DM * DM, DM, WdT, b * DM, DM, 0, scr, r % I_D, lane); continue; } r -= 3 * I_D;
        if (r < I_O) { p0_transpose_item(a.in[I_WOUT], DM, Wo3, 0, DM, 0, scr, r, lane); continue; } r -= I_O;
        { const int g = r / I_P; p0_transpose_item(a.in[I_POOLW] + (size_t)g * 256 * 256, 256, PwT, g * 256, 256, 0, scr, r % I_P, lane); }
    }
    for (int m = gw; m + NGW < MPR; m += 2 * NGW)
        rms_row2_to_bf16(a.in[I_XP] + (size_t)m * DM, a.in[I_XP] + (size_t)(m + NGW) * DM, a.in[I_NORMG], H + (size_t)m * DM, H + (size_t)(m + NGW) * DM, lane);
    const int mdone = (MPR / (2 * NGW)) * (2 * NGW);
    for (int m = mdone + gw; m < MP + 2048; m += NGW) {
        bf16* orow = H + (size_t)m * DM;
        if (m < MPR) rms_row_to_bf16(a.in[I_XP] + (size_t)m * DM, a.in[I_NORMG], orow, lane);
        else if (m < MV) rms_row_to_bf16(a.in[I_XS] + (size_t)(m - MPR) * DM, a.in[I_NORMG], orow, lane);
        else if (m < MP) { u32x2* o8 = (u32x2*)orow + lane;
#pragma unroll
            for (int j = 0; j < 4; ++j) o8[64 * j] = (u32x2){0u, 0u}; }
        else rms_row_to_bf16(a.in[I_MEM] + (size_t)(m - MP) * DM, a.in[I_MEMNG], orow, lane);
    }
    const size_t gt = (size_t)blockIdx.x * 512 + tid, NGT = (size_t)G * 512;
    for (size_t i = gt; i < (size_t)4 * 128 * 128; i += NGT) { const int s = (int)(i & 127), t = (int)((i >> 7) & 127); SW[i] = (bf16)(s <= t ? f2bf(a.in[I_SGUW][i]) : 0u); }
    for (size_t i = gt; i < (size_t)NS * 256; i += NGT) { const size_t smp = i >> 8, c = (i & 255) * 4; const int w = 2 << (int)(c >> 8); f32x4 sm = (f32x4){0.f, 0.f, 0.f, 0.f};
#pragma unroll
        for (int j = 0; j < 15; ++j) if (j < w - 1) sm = sm + *(const f32x4*)(a.in[I_SPOOL] + (smp * 15 + 14 - j) * DM + c);
        *(f32x4*)((float*)(a.ws + WS_HS) + smp * DM + c) = sm; }
    for (size_t i = gt; i < (size_t)NS * 14 * 256; i += NGT) { const size_t smp = i / (14 * 256), rem = i % (14 * 256), r = rem / 256, c4 = rem % 256;
        __builtin_nontemporal_store(*(const f32x4*)(a.in[I_SPOOL] + (smp * 15 + r + 1) * DM + c4 * 4), (f32x4*)(a.out + O_POOLS + (smp * 15 + r) * DM + c4 * 4)); }
}

constexpr int RSV = 544;
constexpr int RS = 528;
__device__ __forceinline__ void pool_part(const KArgs& a, LAS unsigned char* lds, int rt, int g) {
    int tid_ = threadIdx.x; asm volatile("" : "+v"(tid_));
    const int tid = tid_, lane = tid & 63, wv = tid >> 6, fr = lane & 15, fq = lane >> 4;
    const int m0 = rt * 128, w = 2 << g;
    const bf16* PIN = (const bf16*)(a.ws + WS_PROJ); const bf16* PZ = PIN + (size_t)MP * DM;
    const bf16* PwT = (const bf16*)(a.ws + WS_PW); bf16* BR0 = (bf16*)(a.ws + WS_BR);
    LAS unsigned char* Pb = lds; LAS unsigned char* Db = lds + 75520;
    u32x4 zf[8]; f32x4 scv[2]; bf16x8 Bf[2][8];
    const bf16* pw = PwT + (size_t)(g * 256 + wv * 32 + 8 * (fr >> 2) + (fr & 3)) * 256 + fq * 8;
    if (rt < 128) {
        const int t0 = (rt & 15) * 128;
        u32x4 tv[9];
#pragma unroll
        for (int i = 0; i < 9; ++i) { const int idx = tid + i * 512, row = idx >> 5, ch = idx & 31; tv[i] = (u32x4){0u, 0u, 0u, 0u};
            if (idx < 143 * 32 && !(t0 == 0 && row < 15)) tv[i] = *(const u32x4*)(PIN + (size_t)(m0 - 15 + row) * DM + g * 256 + ch * 8); }
#pragma unroll
        for (int rb = 0; rb < 8; ++rb) zf[rb] = __builtin_nontemporal_load((const u32x4*)(PZ + (size_t)(m0 + rb * 16 + fr) * DM + g * 256 + wv * 32 + 8 * fq));
#pragma unroll
        for (int nn = 0; nn < 2; ++nn) { scv[nn] = *(const f32x4*)(a.in[I_POOLSC] + g * 256 + wv * 32 + 8 * fq + 4 * nn);
#pragma unroll
            for (int ks = 0; ks < 8; ++ks) Bf[nn][ks] = *(const bf16x8*)(pw + nn * 4 * 256 + ks * 32); }
#pragma unroll
        for (int i = 0; i < 9; ++i) { const int idx = tid + i * 512, row = idx >> 5, ch = idx & 31; if (idx < 143 * 32) *(LAS u32x4*)(Pb + row * RS + ch * 16) = tv[i]; }
        __syncthreads();
        {
            const int ch = tid & 31, r0 = (tid >> 5) * 8;
            float s0 = 0.f, s1 = 0.f, s2 = 0.f, s3 = 0.f, s4 = 0.f, s5 = 0.f, s6 = 0.f, s7 = 0.f;
            for (int j = 1; j < w; ++j) { const u32x4 v = *(const LAS u32x4*)(Pb + (r0 + 15 - j) * RS + ch * 16);
                s0 += bflo(v.x); s1 += bfhi(v.x); s2 += bflo(v.y); s3 += bfhi(v.y); s4 += bflo(v.z); s5 += bfhi(v.z); s6 += bflo(v.w); s7 += bfhi(v.w); }
#pragma unroll
            for (int i = 0; i < 8; ++i) { const int r = r0 + i;
                const u32x4 own = *(const LAS u32x4*)(Pb + (r + 15) * RS + ch * 16); const u32x4 old = *(const LAS u32x4*)(Pb + (r + 16 - w) * RS + ch * 16);
                s0 += bflo(own.x); s1 += bfhi(own.x); s2 += bflo(own.y); s3 += bfhi(own.y); s4 += bflo(own.z); s5 += bfhi(own.z); s6 += bflo(own.w); s7 += bfhi(own.w);
                const int cnt = min(w, t0 + r + 1); const float inv = 1.f / (float)cnt;
                u32x4 d; d.x = pk2(s0 * inv - bflo(own.x), s1 * inv - bfhi(own.x)); d.y = pk2(s2 * inv - bflo(own.y), s3 * inv - bfhi(own.y));
                d.z = pk2(s4 * inv - bflo(own.z), s5 * inv - bfhi(own.z)); d.w = pk2(s6 * inv - bflo(own.w), s7 * inv - bfhi(own.w));
                *(LAS u32x4*)(Db + r * RS + ch * 16) = d;
                s0 -= bflo(old.x); s1 -= bfhi(old.x); s2 -= bflo(old.y); s3 -= bfhi(old.y); s4 -= bflo(old.z); s5 -= bfhi(old.z); s6 -= bflo(old.w); s7 -= bfhi(old.w); }
        }
    } else {
#pragma unroll
        for (int rb = 0; rb < 8; ++rb) zf[rb] = __builtin_nontemporal_load((const u32x4*)(PZ + (size_t)(m0 + rb * 16 + fr) * DM + g * 256 + wv * 32 + 8 * fq));
#pragma unroll
        for (int nn = 0; nn < 2; ++nn) { scv[nn] = *(const f32x4*)(a.in[I_POOLSC] + g * 256 + wv * 32 + 8 * fq + 4 * nn);
#pragma unroll
            for (int ks = 0; ks < 8; ++ks) Bf[nn][ks] = *(const bf16x8*)(pw + nn * 4 * 256 + ks * 32); }
        const bf16* DS = (const bf16*)(a.ws + WS_DS);
        u32x4 td[8];
#pragma unroll
        for (int i = 0; i < 8; ++i) { const int idx = tid + i * 512, r = idx >> 5, ch = idx & 31; td[i] = *(const u32x4*)(DS + (size_t)r * DM + g * 256 + ch * 8); }
#pragma unroll
        for (int i = 0; i < 8; ++i) { const int idx = tid + i * 512, r = idx >> 5, ch = idx & 31; *(LAS u32x4*)(Db + r * RS + ch * 16) = td[i]; }
    }
    __syncthreads();
#pragma unroll
    for (int rb = 0; rb < 8; ++rb) {
        f32x4 acc0 = (f32x4){0.f, 0.f, 0.f, 0.f}, acc1 = acc0;
#pragma unroll
        for (int ks = 0; ks < 8; ++ks) { const bf16x8 A = *(const LAS bf16x8*)(Db + (rb * 16 + fr) * RS + (ks * 32 + fq * 8) * 2);
            acc0 = __builtin_amdgcn_mfma_f32_16x16x32_bf16(Bf[0][ks], A, acc0, 0, 0, 0); acc1 = __builtin_amdgcn_mfma_f32_16x16x32_bf16(Bf[1][ks], A, acc1, 0, 0, 0); }
        const size_t m = (size_t)(m0 + rb * 16 + fr); const int c = g * 256 + wv * 32 + 8 * fq; const u32x4 z = zf[rb];
        u32x4 o; o.x = pk2(acc0[0] * scv[0].x * bflo(z.x), acc0[1] * scv[0].y * bfhi(z.x)); o.y = pk2(acc0[2] * scv[0].z * bflo(z.y), acc0[3] * scv[0].w * bfhi(z.y));
        o.z = pk2(acc1[0] * scv[1].x * bflo(z.z), acc1[1] * scv[1].y * bfhi(z.z)); o.w = pk2(acc1[2] * scv[1].z * bflo(z.w), acc1[3] * scv[1].w * bfhi(z.w));
        *(u32x4*)(BR0 + m * DM + c) = o;
    }
    __syncthreads();
}
__device__ __forceinline__ void sgu_part(const KArgs& a, LAS unsigned char* lds, int rt, int g) {
    int tid_ = threadIdx.x; asm volatile("" : "+v"(tid_));
    const int tid = tid_, lane = tid & 63, wv = tid >> 6, fr = lane & 15, fq = lane >> 4;
    const int m0 = rt * 128;
    const bf16* U = (const bf16*)(a.ws + WS_PROJ) + (size_t)2 * MP * DM; const bf16* V = U + (size_t)MP * DM; const bf16* SZ = V + (size_t)MP * DM;
    const bf16* SW = (const bf16*)(a.ws + WS_SW); const float* VSS = (const float*)(a.ws + WS_VSS); bf16* BR1 = (bf16*)(a.ws + WS_BR) + (size_t)MP * DM;
    LAS unsigned char* Vb = lds; LAS unsigned char* UZb = lds + 128 * RS; LAS float* rbuf = (LAS float*)(lds + 256 * RS);
    u32x4 tv[8], tu[8], tz[8];
#pragma unroll
    for (int i = 0; i < 8; ++i) { const int idx = tid + i * 512, s = idx >> 5, ch = idx & 31; const size_t o = (size_t)(m0 + s) * DM + g * 256 + ch * 8;
        tv[i] = __builtin_nontemporal_load((const u32x4*)(V + o)); tu[i] = __builtin_nontemporal_load((const u32x4*)(U + o)); tz[i] = __builtin_nontemporal_load((const u32x4*)(SZ + o)); }
    if (tid < 128) { const f32x4* p = (const f32x4*)(VSS + (size_t)(m0 + tid) * 16); const f32x4 p0 = p[0], p1 = p[1], p2 = p[2], p3 = p[3];
        const float s = ((p0.x + p0.y) + (p0.z + p0.w)) + ((p1.x + p1.y) + (p1.z + p1.w)) + ((p2.x + p2.y) + (p2.z + p2.w)) + ((p3.x + p3.y) + (p3.z + p3.w));
        rbuf[tid] = rsqrtf(s * (1.f / DM) + EPS); }
    const f32x4 gv0 = *(const f32x4*)(a.in[I_SGUNG] + g * 256 + wv * 32 + 8 * fq), gv1 = *(const f32x4*)(a.in[I_SGUNG] + g * 256 + wv * 32 + 8 * fq + 4);
    float biasv[8];
#pragma unroll
    for (int tb = 0; tb < 8; ++tb) biasv[tb] = a.in[I_SGUB][g * 128 + tb * 16 + fr];
    __syncthreads();
#pragma unroll
    for (int i = 0; i < 8; ++i) { const int idx = tid + i * 512, s = idx >> 5, ch = idx & 31; const float r = rbuf[s];
        u32x4 v; v.x = pk2(bflo(tv[i].x) * r, bfhi(tv[i].x) * r); v.y = pk2(bflo(tv[i].y) * r, bfhi(tv[i].y) * r); v.z = pk2(bflo(tv[i].z) * r, bfhi(tv[i].z) * r); v.w = pk2(bflo(tv[i].w) * r, bfhi(tv[i].w) * r);
        *(LAS u32x4*)(Vb + s * RS + ch * 16) = v;
        u32x4 q; q.x = pk2(bflo(tu[i].x) * bflo(tz[i].x), bfhi(tu[i].x) * bfhi(tz[i].x)); q.y = pk2(bflo(tu[i].y) * bflo(tz[i].y), bfhi(tu[i].y) * bfhi(tz[i].y));
        q.z = pk2(bflo(tu[i].z) * bflo(tz[i].z), bfhi(tu[i].z) * bfhi(tz[i].z)); q.w = pk2(bflo(tu[i].w) * bflo(tz[i].w), bfhi(tu[i].w) * bfhi(tz[i].w));
        *(LAS u32x4*)(UZb + s * RS + ch * 16) = q; }
    __syncthreads();
    const int q = fr >> 2, p = fr & 3;
    bf16x8 Vf[4][2];
#pragma unroll
    for (int ks = 0; ks < 4; ++ks)
#pragma unroll
        for (int nn = 0; nn < 2; ++nn) { const LAS unsigned char* a0 = Vb + (32 * ks + 8 * fq + q) * RS + (wv * 32 + 8 * p + 4 * nn) * 2; Vf[ks][nn] = tr_read2(a0, a0 + 4 * RS); }
#pragma unroll
    for (int tb = 0; tb < 8; ++tb) {
        f32x4 acc0 = (f32x4){0.f, 0.f, 0.f, 0.f}, acc1 = acc0;
        const int t = tb * 16 + fr;
#pragma unroll
        for (int ks = 0; ks < 4; ++ks) if (ks <= (tb >> 1)) {
            const bf16x8 A = *(const bf16x8*)(SW + (size_t)(g * 128 + t) * 128 + ks * 32 + fq * 8);
            acc0 = __builtin_amdgcn_mfma_f32_16x16x32_bf16(Vf[ks][0], A, acc0, 0, 0, 0); acc1 = __builtin_amdgcn_mfma_f32_16x16x32_bf16(Vf[ks][1], A, acc1, 0, 0, 0);
        }
        const size_t m = (size_t)(m0 + t); const float bias = biasv[tb];
        { const int cl = wv * 32 + 8 * fq; const u32x4 uz = *(const LAS u32x4*)(UZb + t * RS + cl * 2);
          u32x4 o; o.x = pk2((acc0[0] * gv0.x + bias) * bflo(uz.x), (acc0[1] * gv0.y + bias) * bfhi(uz.x)); o.y = pk2((acc0[2] * gv0.z + bias) * bflo(uz.y), (acc0[3] * gv0.w + bias) * bfhi(uz.y));
          o.z = pk2((acc1[0] * gv1.x + bias) * bflo(uz.z), (acc1[1] * gv1.y + bias) * bfhi(uz.z)); o.w = pk2((acc1[2] * gv1.z + bias) * bflo(uz.w), (acc1[3] * gv1.w + bias) * bfhi(uz.w));
          *(u32x4*)(BR1 + m * DM + g * 256 + cl) = o; }
    }
    __syncthreads();
}
__device__ __forceinline__ void attn_part(const KArgs& a, LAS unsigned char* lds, int rt, int g) {
    int tid_ = threadIdx.x; asm volatile("" : "+v"(tid_));
    const int tid = tid_, lane = tid & 63, wv = tid >> 6, fr = lane & 15, fq = lane >> 4;
    const int m0 = rt * 128, b = rt >> 4;
    const bf16* Q = (const bf16*)(a.ws + WS_PROJ) + (size_t)5 * MP * DM; const bf16* AZ = Q + (size_t)MP * DM;
    const bf16* KB = (const bf16*)(a.ws + WS_KB); const bf16* VB = (const bf16*)(a.ws + WS_VB); bf16* BR2 = (bf16*)(a.ws + WS_BR) + (size_t)2 * MP * DM;
    LAS unsigned char* Kb = lds;
    const size_t m = (size_t)(m0 + wv * 16 + fr);
    bf16x8 Qf[8];
    {
        u32x4 tk[16];
#pragma unroll
        for (int i = 0; i < 16; ++i) { const int idx = tid + i * 512, key = idx >> 5, ch = idx & 31; tk[i] = *(const u32x4*)(KB + (size_t)(b * 256 + key) * DM + g * 256 + ch * 8); }
#pragma unroll
        for (int ks = 0; ks < 8; ++ks) Qf[ks] = __builtin_nontemporal_load((const bf16x8*)(Q + m * DM + g * 256 + ks * 32 + fq * 8));
#pragma unroll
        for (int i = 0; i < 16; ++i) { const int idx = tid + i * 512, key = idx >> 5, ch = idx & 31; *(LAS u32x4*)(Kb + key * RS + ch * 16) = tk[i]; }
    }
    __syncthreads();
    u32x4 tvv[16];
#pragma unroll
    for (int i = 0; i < 16; ++i) { const int idx = tid + i * 512, key = idx >> 5, ch = idx & 31; tvv[i] = *(const u32x4*)(VB + (size_t)(b * 256 + key) * DM + g * 256 + ch * 8); }
    f32x4 sacc[16];
#pragma unroll
    for (int kb = 0; kb < 16; ++kb) { sacc[kb] = (f32x4){0.f, 0.f, 0.f, 0.f};
#pragma unroll
        for (int ks = 0; ks < 8; ++ks) { const bf16x8 Kf = *(const LAS bf16x8*)(Kb + (kb * 16 + fr) * RS + (ks * 32 + fq * 8) * 2);
            sacc[kb] = __builtin_amdgcn_mfma_f32_16x16x32_bf16(Kf, Qf[ks], sacc[kb], 0, 0, 0); }
        if (kb & 1) __builtin_amdgcn_sched_barrier(0); }
    float mx = -3.0e38f;
#pragma unroll
    for (int kb = 0; kb < 16; ++kb) mx = fmaxf(mx, fmaxf(fmaxf(sacc[kb][0], sacc[kb][1]), fmaxf(sacc[kb][2], sacc[kb][3])));
    mx = fmaxf(mx, __shfl_xor(mx, 16)); mx = fmaxf(mx, __shfl_xor(mx, 32));
    float sum = 0.f;
#pragma unroll
    for (int kb = 0; kb < 16; ++kb)
#pragma unroll
        for (int j = 0; j < 4; ++j) { const float pj = __expf((sacc[kb][j] - mx) * 0.0625f); sacc[kb][j] = pj; sum += pj; }
    sum += __shfl_xor(sum, 16); sum += __shfl_xor(sum, 32);
    const float isum = 1.f / sum;
    bf16x8 Pf[8];
#pragma unroll
    for (int k2 = 0; k2 < 8; ++k2) { u32x4 w; w.x = pk2(sacc[2 * k2][0], sacc[2 * k2][1]); w.y = pk2(sacc[2 * k2][2], sacc[2 * k2][3]);
        w.z = pk2(sacc[2 * k2 + 1][0], sacc[2 * k2 + 1][1]); w.w = pk2(sacc[2 * k2 + 1][2], sacc[2 * k2 + 1][3]); Pf[k2] = __builtin_bit_cast(bf16x8, w); }
    __syncthreads();
#pragma unroll
    for (int i = 0; i < 16; ++i) { const int idx = tid + i * 512, key = idx >> 5, ch = idx & 31; *(LAS u32x4*)(Kb + key * RSV + ch * 16) = tvv[i]; }
    u32x4 zf[8];
#pragma unroll
    for (int d2 = 0; d2 < 8; ++d2) zf[d2] = __builtin_nontemporal_load((const u32x4*)(AZ + m * DM + g * 256 + d2 * 32 + 8 * fq));
    __syncthreads();
    const int q = fr >> 2, p = fr & 3;
#pragma unroll
    for (int d2 = 0; d2 < 8; ++d2) {
        f32x4 o0 = (f32x4){0.f, 0.f, 0.f, 0.f}, o1 = o0;
#pragma unroll
        for (int k2 = 0; k2 < 8; ++k2) { const LAS unsigned char* a0 = Kb + (32 * k2 + 4 * fq + q) * RSV + (d2 * 32 + 8 * p) * 2;
            const bf16x8 Vf0 = tr_read2(a0, a0 + 16 * RSV), Vf1 = tr_read2(a0 + 8, a0 + 8 + 16 * RSV);
            o0 = __builtin_amdgcn_mfma_f32_16x16x32_bf16(Vf0, Pf[k2], o0, 0, 0, 0); o1 = __builtin_amdgcn_mfma_f32_16x16x32_bf16(Vf1, Pf[k2], o1, 0, 0, 0); }
        const int c = g * 256 + d2 * 32 + 8 * fq; const u32x4 z = zf[d2];
        u32x4 w; w.x = pk2(o0[0] * isum * bflo(z.x), o0[1] * isum * bfhi(z.x)); w.y = pk2(o0[2] * isum * bflo(z.y), o0[3] * isum * bfhi(z.y));
        w.z = pk2(o1[0] * isum * bflo(z.z), o1[1] * isum * bfhi(z.z)); w.w = pk2(o1[2] * isum * bflo(z.w), o1[3] * isum * bfhi(z.w));
        *(u32x4*)(BR2 + m * DM + c) = w;
        __builtin_amdgcn_sched_barrier(0);
    }
    __syncthreads();
}
__device__ __forceinline__ void sgu_sample(const KArgs& a, int g, int rb) {
    int tid_ = threadIdx.x; asm volatile("" : "+v"(tid_));
    const int tid = tid_;
    const bf16* U = (const bf16*)(a.ws + WS_PROJ) + (size_t)2 * MP * DM; const bf16* V = U + (size_t)MP * DM; const bf16* SZ = V + (size_t)MP * DM;
    const float* VSS = (const float*)(a.ws + WS_VSS); bf16* BR1 = (bf16*)(a.ws + WS_BR) + (size_t)MP * DM;
    const float w00 = a.in[I_SGUW][(size_t)g * 128 * 128], b0 = a.in[I_SGUB][g * 128];
    for (int idx = tid; idx < 16 * 64; idx += 512) {
        const int i = rb * 16 + (idx >> 6), c = g * 256 + (idx & 63) * 4; const size_t m = (size_t)(MPR + i);
        const float s = wave_sum((idx & 63) < 16 ? VSS[m * 16 + (idx & 63)] : 0.f);
        const float rs = rsqrtf(s * (1.f / DM) + EPS);
        const f32x4 gv = *(const f32x4*)(a.in[I_SGUNG] + c);
        const u32x2 v4 = *(const u32x2*)(V + m * DM + c), u4 = *(const u32x2*)(U + m * DM + c), z = *(const u32x2*)(SZ + m * DM + c);
        f32x4 vn; vn.x = bflo(v4.x) * rs * gv.x; vn.y = bfhi(v4.x) * rs * gv.y; vn.z = bflo(v4.y) * rs * gv.z; vn.w = bfhi(v4.y) * rs * gv.w;
        *(f32x4*)(a.out + O_SV + (size_t)i * DM + c) = vn;
        u32x2 o; o.x = pk2(bflo(u4.x) * (w00 * vn.x + b0) * bflo(z.x), bfhi(u4.x) * (w00 * vn.y + b0) * bfhi(z.x));
        o.y = pk2(bflo(u4.y) * (w00 * vn.z + b0) * bflo(z.y), bfhi(u4.y) * (w00 * vn.w + b0) * bfhi(z.y));
        *(u32x2*)(BR1 + m * DM + c) = o;
    }
}
__device__ __forceinline__ void attn_sample(const KArgs& a, LAS unsigned char* lds, int i, int h) {
    int tid_ = threadIdx.x; asm volatile("" : "+v"(tid_));
    const int tid = tid_, lane = tid & 63, wv = tid >> 6;
    const bf16* Q = (const bf16*)(a.ws + WS_PROJ) + (size_t)5 * MP * DM; const bf16* AZ = Q + (size_t)MP * DM; bf16* BR2 = (bf16*)(a.ws + WS_BR) + (size_t)2 * MP * DM;
    const size_t m = (size_t)(MPR + i);
    const float* Kc = a.in[I_CK] + ((size_t)i * NMEM * 4 + h) * 256 + lane * 4;
    const float* Vc = a.in[I_CV] + ((size_t)i * NMEM * 4 + h) * 256 + lane * 4;
    LAS float* sc = (LAS float*)lds; LAS float* part = (LAS float*)(lds + 1024);
    const u32x2 q2 = *(const u32x2*)(Q + m * DM + h * 256 + lane * 4);
    const f32x4 qv = (f32x4){bflo(q2.x), bfhi(q2.x), bflo(q2.y), bfhi(q2.y)};
    {
        f32x4 kv[32]; float pd[32];
#pragma unroll
        for (int j = 0; j < 32; ++j) kv[j] = __builtin_nontemporal_load((const f32x4*)(Kc + (size_t)(wv * 32 + j) * 1024));
#pragma unroll
        for (int j = 0; j < 32; ++j) pd[j] = (kv[j].x * qv.x + kv[j].y * qv.y) + (kv[j].z * qv.z + kv[j].w * qv.w);
#pragma unroll
        for (int j = 0; j < 32; ++j) { const float d = wave_sum(pd[j]); if (lane == 0) sc[wv * 32 + j] = d * 0.0625f; }
    }
    f32x4 vv[32];
#pragma unroll
    for (int j = 0; j < 32; ++j) vv[j] = __builtin_nontemporal_load((const f32x4*)(Vc + (size_t)(wv * 32 + j) * 1024));
    __syncthreads();
    const f32x4 s4 = *(const LAS f32x4*)(sc + lane * 4);
    const float mx = wave_max(fmaxf(fmaxf(s4.x, s4.y), fmaxf(s4.z, s4.w)));
    const float sum = wave_sum((__expf(s4.x - mx) + __expf(s4.y - mx)) + (__expf(s4.z - mx) + __expf(s4.w - mx)));
    f32x4 o = (f32x4){0.f, 0.f, 0.f, 0.f};
#pragma unroll
    for (int j = 0; j < 32; ++j) { const float pj = __expf(sc[wv * 32 + j] - mx); o += vv[j] * pj; }
    *(LAS f32x4*)(part + wv * 256 + lane * 4) = o;
    __syncthreads();
    if (tid < 256) { float t = 0.f;
#pragma unroll
        for (int w8 = 0; w8 < 8; ++w8) t += part[w8 * 256 + tid];
        const int c = h * 256 + tid; const unsigned short zb = AZ[m * DM + c]; const float z = __builtin_bit_cast(float, (unsigned)zb << 16);
        BR2[m * DM + c] = (bf16)f2bf(t / sum * z); }
    __syncthreads();
}
__device__ __forceinline__ void p2_mixers(const KArgs& a, LAS unsigned char* lds, int G) {
    constexpr int NU = 512 + 512 + 4 + 32;
    if (G == 256) {
        const int c = blockIdx.x;
        for (int k = 0; k < 4; ++k) { const int kk = (c & 1) ? (k ^ 2) : k;
            if (kk < 2) { const int u = c + kk * 256, rt = u >> 2, g = u & 3; pool_part(a, lds, rt, g); sgu_part(a, lds, rt, g); attn_part(a, lds, rt, g); }
            else { const int e = c + (kk - 2) * 256; attn_sample(a, lds, e >> 2, e & 3); } }
        if (c < 4) pool_part(a, lds, 128, c); else if (c >= 8 && c < 40) sgu_sample(a, (c - 8) >> 3, (c - 8) & 7);
        return;
    }
    for (int u = blockIdx.x; u < NU; u += G) {
        if (u < 512) { const int rt = u >> 2, g = u & 3; pool_part(a, lds, rt, g); sgu_part(a, lds, rt, g); attn_part(a, lds, rt, g); }
        else if (u < 1024) { const int e = u - 512; attn_sample(a, lds, e >> 2, e & 3); }
        else if (u < 1028) pool_part(a, lds, 128, u - 1024);
        else sgu_sample(a, (u - 1028) >> 3, (u - 1028) & 7);
    }
}
__device__ __forceinline__ void p5_norm(const KArgs& a, int G) {
    const int tid = threadIdx.x, lane = tid & 63, wave = tid >> 6;
    const int gw = blockIdx.x * 8 + wave, NGW = G * 8;
    const f32x4* gr = (const f32x4*)a.in[I_NORMF] + lane;
    for (int m = gw; m < MV; m += NGW) {
        f32x4* xr = (f32x4*)(a.out + (size_t)m * DM) + lane;
        f32x4 v[4]; float s = 0.f;
#pragma unroll
        for (int j = 0; j < 4; ++j) { v[j] = xr[64 * j]; s += (v[j].x * v[j].x + v[j].y * v[j].y) + (v[j].z * v[j].z + v[j].w * v[j].w); }
        const float rs = rsqrtf(wave_sum(s) * (1.f / DM) + EPS);
#pragma unroll
        for (int j = 0; j < 4; ++j) { const f32x4 g = gr[64 * j]; xr[64 * j] = (f32x4){v[j].x * rs * g.x, v[j].y * rs * g.y, v[j].z * rs * g.z, v[j].w * rs * g.w}; }
    }
}

__global__ void __launch_bounds__(512, 2) fwd_megakernel(KArgs a) {
    extern __shared__ __attribute__((aligned(16))) unsigned char lds_raw[];
    LAS unsigned char* lds = (LAS unsigned char*)lds_raw;
    cg::grid_group grid = cg::this_grid();
    const int G = gridDim.x;
    const int lo = a.ph_lo, hi = a.ph_hi;
    volatile LAS unsigned* bst = (volatile LAS unsigned*)(lds + LDS_BYTES - 64);
    if (threadIdx.x == 0) { bst[0] = 0u; bst[1] = 0u; }
    __syncthreads();
    const XcdBarrier bar = xcd_barrier_post((unsigned*)(a.ws + WS_CTL), bst);
#define IN(k) (lo <= (k) && (k) < hi)
#define SEAM(k) do { if (IN(k) && IN((k) + 1)) { if (a.cg_sync) grid.sync(); else xcd_barrier(bar); } } while (0)
    if (IN(0)) p0_prologue(a, lds, G);
    SEAM(0);
    if (IN(1)) {
        pg8::Gemm g{(const bf16*)(a.ws + WS_H), (const bf16*)(a.ws + WS_WIN), MP, INC, DM};
        P1Order S; S.init(G, (int)blockIdx.x);
        EpiProj E{(bf16*)(a.ws + WS_PROJ), (bf16*)(a.ws + WS_GATE), (float*)(a.ws + WS_VSS), (bf16*)(a.ws + WS_KB), (bf16*)(a.ws + WS_VB), a.out, (const float*)(a.ws + WS_HS), (bf16*)(a.ws + WS_DS)};
        pg8::gemm_phase<EpiProj, P1Order>(lds, g, S, E);
    }
    SEAM(1);
    if (IN(2)) p2_mixers(a, lds, G);
    SEAM(2);
    if (IN(3)) {
        pg8::Gemm g{(const bf16*)(a.ws + WS_BR), (const bf16*)(a.ws + WS_WD), MPR, 3 * DM, DM};
        P3Order S; S.init(G, (int)blockIdx.x);
        EpiGate E{(const bf16*)(a.ws + WS_GATE), (bf16*)(a.ws + WS_MG)};
        pg8::gemm_phase<EpiGate, P3Order>(lds, g, S, E);
        EpiS3 E3{(const bf16*)(a.ws + WS_GATE), (bf16*)(a.ws + WS_GYS)};
        skinny_gemm(lds, (const bf16*)(a.ws + WS_BR) + (size_t)MPR * DM, DM, (size_t)MP * DM, 64, 1, 0, (const bf16*)(a.ws + WS_WD), DM, DM, 192, (int)blockIdx.x, G, E3);
    }
    SEAM(3);
    if (IN(4)) {
        pg8::Gemm g{(const bf16*)(a.ws + WS_MG), (const bf16*)(a.ws + WS_WO3), MPR, DM, DM};
        pg8::StaticOrder S; S.init(MPR, DM, G, (int)blockIdx.x);
        unsigned* ctl = (unsigned*)(a.ws + WS_CTL);
        EpiOutNorm E{a.in[I_XP], a.in[I_NORMF], a.out, (float*)(a.ws + WS_VSS), ctl + CW_PANEL};
        pg8::gemm_phase<EpiOutNorm, pg8::StaticOrder>(lds, g, S, E);
        sample_out_split(a, lds, (int)blockIdx.x);
    }
#undef IN
#undef SEAM
}

extern "C" void kernel_launch(void* const* d_in, const int* in_sizes, int n_in, void* d_out, int out_size, void* d_ws, size_t ws_size, hipStream_t stream) {
    static int grid = 0;
    if (grid == 0) {
        if (n_in != 18 || (size_t)out_size != O_END || ws_size < WS_END) { fprintf(stderr, "kernel_launch: unexpected shapes (n_in %d out %d ws %zu, need %zu)\n", n_in, out_size, ws_size, (size_t)WS_END); grid = -1; return; }
        int dev = 0, cus = 0, per_cu = 0;
        hipGetDevice(&dev); hipDeviceGetAttribute(&cus, hipDeviceAttributeMultiprocessorCount, dev);
        if (hipFuncSetAttribute((const void*)fwd_megakernel, hipFuncAttributeMaxDynamicSharedMemorySize, LDS_BYTES) != hipSuccess) { fprintf(stderr, "kernel_launch: hipFuncSetAttribute failed\n"); grid = -1; return; }
        if (hipOccupancyMaxActiveBlocksPerMultiprocessor(&per_cu, (const void*)fwd_megakernel, 512, LDS_BYTES) != hipSuccess || per_cu < 1) { fprintf(stderr, "kernel_launch: occupancy query failed (%d)\n", per_cu); grid = -1; return; }
        if (cus != 256) { fprintf(stderr, "kernel_launch: built for a 256-CU device (one 256x256 tile per workgroup in the last two phases), got %d\n", cus); grid = -1; return; }
        grid = cus;
    }
    if (grid < 0) return;
    if (hipMemsetAsync((char*)d_ws + WS_CTL, 0, CTL_BYTES, stream) != hipSuccess) { fprintf(stderr, "kernel_launch: memset failed\n"); return; }
    KArgs a{};
    for (int i = 0; i < 18; ++i) a.in[i] = (const float*)d_in[i];
    a.out = (float*)d_out; a.ws = (unsigned char*)d_ws; a.ph_lo = 0; a.ph_hi = 5;
    void* args[] = {&a};
    hipError_t e = hipLaunchCooperativeKernel((const void*)fwd_megakernel, dim3(grid), dim3(512), args, LDS_BYTES, stream);
    if (e != hipSuccess) fprintf(stderr, "cooperative launch failed: %s (grid %d)\n", hipGetErrorString(e), grid);
}
```

```cpp
#include <hip/hip_runtime.h>
#include <hip/hip_cooperative_groups.h>
#include <cstdio>
#include <cstdint>
namespace cg = cooperative_groups;

#define LAS __attribute__((address_space(3)))
typedef unsigned short bf16;
typedef short bf16x8 __attribute__((ext_vector_type(8)));
typedef short s16x4 __attribute__((ext_vector_type(4)));
typedef float f32x4 __attribute__((ext_vector_type(4)));
typedef unsigned u32x4 __attribute__((ext_vector_type(4)));
typedef unsigned u32x2 __attribute__((ext_vector_type(2)));

constexpr int DM = 1024, NBATCH = 8, SEQ = 2048, NS = 128, NMEM = 256;
constexpr int MPR = NBATCH * SEQ;
constexpr int MV = MPR + NS;
constexpr int MP = MPR + 256;
constexpr int NPAN = MP / 256;
constexpr int INC = 10240;
constexpr float EPS = 1e-6f;
constexpr size_t O_YP = 0, O_YS = O_YP + (size_t)MPR * DM, O_POOLP = O_YS + (size_t)NS * DM, O_POOLS = O_POOLP + (size_t)NBATCH * 15 * DM,
                 O_MK = O_POOLS + (size_t)NS * 15 * DM, O_MV = O_MK + (size_t)NBATCH * NMEM * DM, O_SV = O_MV + (size_t)NBATCH * NMEM * DM, O_END = O_SV + (size_t)NS * DM;
constexpr size_t ROWB = (size_t)MP * DM * 2;
constexpr size_t WS_CTL = 0, CTL_BYTES = 40960;
constexpr size_t WS_VSS2 = CTL_BYTES;
constexpr size_t WS_DS = WS_VSS2 + 32768;
constexpr size_t WS_HS = WS_DS + 262144;
constexpr size_t WS_H = WS_HS + 524288;
constexpr size_t WS_WIN = WS_H + (size_t)(MP + 2048) * DM * 2;
constexpr size_t WS_WD = WS_WIN + (size_t)(INC + 2048) * DM * 2;
constexpr size_t WS_WO3 = WS_WD + (size_t)3 * DM * DM * 2;
constexpr size_t WS_PW = WS_WO3 + (size_t)3 * DM * DM * 2;
constexpr size_t WS_SW = WS_PW + (size_t)4 * 256 * 256 * 2;
constexpr size_t WS_VSS = WS_SW + (size_t)4 * 128 * 128 * 2;
constexpr size_t WS_KB = WS_VSS + (size_t)MP * 16 * 4;
constexpr size_t WS_VB = WS_KB + (size_t)2048 * DM * 2;
constexpr size_t WS_PROJ = WS_VB + (size_t)2048 * DM * 2;
constexpr size_t WS_GATE = WS_PROJ + 7 * ROWB;
constexpr size_t WS_BR = WS_GATE + 3 * ROWB;
constexpr size_t WS_MG = WS_PROJ;
constexpr size_t WS_GYS = WS_H;
constexpr size_t WS_END = WS_BR + 3 * ROWB;
constexpr int LDS_BYTES = 147456;
constexpr int CW_PANEL = 4096, CW_SAMPLE = 4096 + 64 * 64;

__device__ __forceinline__ unsigned f2bf(float f) { unsigned u = __builtin_bit_cast(unsigned, f); return (u + 0x7fffu + ((u >> 16) & 1u)) >> 16; }
__device__ __forceinline__ unsigned pk2(float lo, float hi) { unsigned r; asm volatile("v_cvt_pk_bf16_f32 %0, %1, %2" : "=v"(r) : "v"(lo), "v"(hi)); return r; }
__device__ __forceinline__ float bflo(unsigned w) { return __builtin_bit_cast(float, w << 16); }
__device__ __forceinline__ float bfhi(unsigned w) { return __builtin_bit_cast(float, w & 0xffff0000u); }
__device__ __forceinline__ float silu_f(float x) { return x * __builtin_amdgcn_rcpf(1.f + __expf(-x)); }
__device__ __forceinline__ float sigm_f(float x) { return __builtin_amdgcn_rcpf(1.f + __expf(-x)); }
__device__ __forceinline__ float wave_sum(float v) {
#pragma unroll
    for (int o = 1; o < 64; o <<= 1) v += __shfl_xor(v, o);
    return v;
}
__device__ __forceinline__ float wave_max(float v) {
#pragma unroll
    for (int o = 1; o < 64; o <<= 1) v = fmaxf(v, __shfl_xor(v, o));
    return v;
}
__device__ __forceinline__ bf16x8 tr_read2(const LAS unsigned char* a0, const LAS unsigned char* a1) {
    const s16x4 lo = __builtin_amdgcn_ds_read_tr16_b64_v4i16((LAS s16x4*)a0);
    const s16x4 hi = __builtin_amdgcn_ds_read_tr16_b64_v4i16((LAS s16x4*)a1);
    return (bf16x8){lo[0], lo[1], lo[2], lo[3], hi[0], hi[1], hi[2], hi[3]};
}

#define XB_TMO      128
#define XB_XCNT(j)  (256  + 64 * (j))
#define XB_XSUB(j)  (1280 + 64 * (j))
#define XB_XGEN(j)  (2304 + 64 * (j))
#define XB_TOP      3328
#define XB_TOPGEN   3392
#define XCD_BAR_WORDS 3456
#define XB_SPIN_CAP (1u << 18)

__device__ __forceinline__ unsigned xb_ld(unsigned* p)              { return __hip_atomic_load(p, __ATOMIC_RELAXED, __HIP_MEMORY_SCOPE_AGENT); }
__device__ __forceinline__ unsigned xb_add(unsigned* p, unsigned v) { return __hip_atomic_fetch_add(p, v, __ATOMIC_RELAXED, __HIP_MEMORY_SCOPE_AGENT); }
__device__ __forceinline__ unsigned xb_xcc_id() { return (unsigned)__builtin_amdgcn_s_getreg((3 << 11) | 20) & 0xFu; }
#define XB_SPIN(cond, bar) do { unsigned _sp = 0; while (cond) { __builtin_amdgcn_s_sleep(1); \
    if ((++_sp & 255u) == 0u) { if (xb_ld(&(bar)[XB_TMO])) break; if (_sp > XB_SPIN_CAP) { atomicAdd(&(bar)[XB_TMO], 1u); break; } } } } while (0)

struct XcdBarrier {
    unsigned* bar; unsigned x;
    volatile LAS unsigned* st;
};

__device__ __forceinline__ XcdBarrier xcd_barrier_post(unsigned* bar, volatile LAS unsigned* st) {
    XcdBarrier b; b.bar = bar; b.x = xb_xcc_id(); b.st = st;
    if (threadIdx.x == 0) (void)xb_add(&bar[XB_XCNT(b.x)], 1u);
    return b;
}
__device__ __forceinline__ void xcd_barrier_complete(unsigned* bar, unsigned x, unsigned& nloc, unsigned& nx) {
    const unsigned G = gridDim.x;
    unsigned sum, cnt, mine, sp = 0u;
    for (;;) {
        sum = 0u; cnt = 0u; mine = 0u;
#pragma unroll
        for (unsigned j = 0; j < 16; ++j) { const unsigned c = xb_ld(&bar[XB_XCNT(j)]); sum += c; cnt += (c > 0u) ? 1u : 0u; mine = (j == x) ? c : mine; }
        if (sum == G) break;
        __builtin_amdgcn_s_sleep(1);
        if ((++sp & 255u) == 0u) { if (xb_ld(&bar[XB_TMO])) break; if (sp > XB_SPIN_CAP) { atomicAdd(&bar[XB_TMO], 1u); break; } }
    }
    nloc = mine > 0u ? mine : 1u; nx = cnt > 0u ? cnt : 1u;
}

__device__ __forceinline__ void xcd_barrier(const XcdBarrier& b) {
    asm volatile("s_waitcnt vmcnt(0)" ::: "memory");
    __syncthreads();
    if (threadIdx.x == 0) {
        unsigned* bar = b.bar;
        __builtin_amdgcn_s_waitcnt(0);
        unsigned nloc = b.st[0], nx = b.st[1];
        if (nloc == 0u) { xcd_barrier_complete(bar, b.x, nloc, nx); b.st[0] = nloc; b.st[1] = nx; }
        const unsigned old = xb_add(&bar[XB_XSUB(b.x)], 1u);
        const unsigned gen = old / nloc;
        if (old + 1u == (gen + 1u) * nloc) {
            __builtin_amdgcn_fence(__ATOMIC_RELEASE, "agent");
            asm volatile("s_waitcnt vmcnt(0)" ::: "memory");
            const unsigned og = xb_add(&bar[XB_TOP], 1u);
            const unsigned tg = og / nx;
            if (og + 1u == (tg + 1u) * nx) xb_add(&bar[XB_TOPGEN], 1u);
            else XB_SPIN(xb_ld(&bar[XB_TOPGEN]) == tg, bar);
            __builtin_amdgcn_fence(__ATOMIC_ACQUIRE, "agent");
            xb_add(&bar[XB_XGEN(b.x)], 1u);
            asm volatile("s_waitcnt vmcnt(0)" ::: "memory");
        } else {
            XB_SPIN(xb_ld(&bar[XB_XGEN(b.x)]) == gen, bar);
            __builtin_amdgcn_fence(__ATOMIC_ACQUIRE, "agent");
            asm volatile("s_waitcnt vmcnt(0)" ::: "memory");
        }
    }
    __syncthreads();
}

namespace pg8 {
#define PG8_LAS __attribute__((address_space(3)))
typedef unsigned short bf16_t;
constexpr int BM = 256, BK = 64, HALF = 128, HTB = HALF * BK * 2, STAGE_BYTES = 8 * HTB, NXCD = 8, WGM = 8;
__host__ __device__ __forceinline__ int lds_byte(int r, int c) { const int st = (r >> 4) * 2 + (c >> 5), rr = r & 15, cc = c & 31, ob = rr * 64 + cc * 2; return st * 1024 + (ob ^ (((ob >> 9) & 1) << 5)); }
__host__ __device__ __forceinline__ void stage_rc(int b, int& R, int& C) { const int st = b / 1024, sb = b % 1024, swz = sb ^ (((sb >> 9) & 1) << 5); R = (st >> 1) * 16 + swz / 64; C = (st & 1) * 32 + (swz % 64) / 2; }
__host__ __device__ __forceinline__ int perm32(int rho) { const int n = rho >> 4, i = rho & 15; return 8 * (i >> 2) + 4 * n + (i & 3); }
struct Unit { int pm, pn; };
struct Gemm { const bf16_t* A; const bf16_t* Bt; int M, N, K; };
struct StaticOrder {
    int nM, nN, nwg, G, c;
    __host__ __device__ void init(int M, int N, int G_, int c_) { nM = M / BM; nN = N / BM; nwg = nM * nN; G = G_; c = c_; }
    __host__ __device__ bool next(int i, Unit& u) const {
        const long L = (long)i * G + c; if (L >= nwg) return false;
        int wgid = (int)L; { const int q = nwg / NXCD, r = nwg % NXCD, xcd = wgid % NXCD, off = wgid / NXCD; wgid = (xcd < r ? xcd * (q + 1) : r * (q + 1) + (xcd - r) * q) + off; }
        const int nig = WGM * nN, gid = wgid / nig, fm = gid * WGM, gsz = (nM - fm) < WGM ? (nM - fm) : WGM;
        u.pm = fm + ((wgid % nig) % gsz); u.pn = (wgid % nig) / gsz; return true;
    }
    __device__ __forceinline__ void a_ready(const Unit&) const {}
    __device__ __forceinline__ void done(const Unit&) const {}
};

template <class Epi, class Sched>
__device__ __forceinline__ void gemm_phase(PG8_LAS unsigned char* lds, const Gemm g, const Sched& S, const Epi& E) {
    const int tid = threadIdx.x, wid = __builtin_amdgcn_readfirstlane(tid >> 6), lane = tid & 63, wr = wid >> 2, wc = wid & 3, fr = lane & 15, fq = lane >> 4;
    const int K = g.K, nt = K / BK;
    unsigned voffA[2], voffB[2];
#pragma unroll
    for (int i = 0; i < 2; ++i) { int R, C; stage_rc(tid * 16 + i * 8192, R, C); const int Rb = Epi::PERM ? ((R >> 5) * 64 + perm32(R & 31)) : R;
        voffA[i] = (unsigned)(R * K + C) * 2u; voffB[i] = (unsigned)(Rb * K + C) * 2u; }
    const size_t kstep = (size_t)(BK * 2);
    const size_t hstep = (size_t)HALF * K * 2;
    const size_t hstepB = Epi::PERM ? (size_t)32 * K * 2 : hstep;
    const size_t tstep = 2 * hstep;
    const unsigned ldsw = (unsigned)wid * 1024u;
    const int aoff = lds_byte(wr * 64 + fr, fq * 8), boff = lds_byte(wc * 32 + fr, fq * 8);
#define PG8_SA(b, h) (((b) * 2 + (h)) * HTB)
#define PG8_SB(b, h) ((4 + (b) * 2 + (h)) * HTB)
#define PG8_STAGE(bufoff, gbase, voff) do { _Pragma("unroll") for (int _i = 0; _i < 2; ++_i) \
        __builtin_amdgcn_global_load_lds((const unsigned*)((const char*)(gbase) + (voff)[_i]), (PG8_LAS unsigned*)(lds + (bufoff) + ldsw + _i * 8192), 16, 0, 0); } while (0)
#define PG8_LDA(dst, b, h) do { _Pragma("unroll") for (int m = 0; m < 4; ++m) _Pragma("unroll") for (int k = 0; k < 2; ++k) dst[m][k] = *(const PG8_LAS bf16x8*)(lds + PG8_SA(b, h) + aoff + m * 2048 + k * 1024); } while (0)
#define PG8_LDB(dst, b, h) do { _Pragma("unroll") for (int n = 0; n < 2; ++n) _Pragma("unroll") for (int k = 0; k < 2; ++k) dst[n][k] = *(const PG8_LAS bf16x8*)(lds + PG8_SB(b, h) + boff + n * 2048 + k * 1024); } while (0)
#define PG8_MMA(ai, bj, At, Bt) do { __builtin_amdgcn_s_setprio(1); _Pragma("unroll") for (int m = 0; m < 4; ++m) _Pragma("unroll") for (int n = 0; n < 2; ++n) _Pragma("unroll") for (int k = 0; k < 2; ++k) \
        acc[ai][bj][m][n] = __builtin_amdgcn_mfma_f32_16x16x32_bf16(Bt[n][k], At[m][k], acc[ai][bj][m][n], 0, 0, 0); __builtin_amdgcn_s_setprio(0); } while (0)
#define PG8_WAIT_V(n) asm volatile("s_waitcnt vmcnt(" #n ")" ::: "memory")
#define PG8_WAIT_L(n) asm volatile("s_waitcnt lgkmcnt(" #n ")" ::: "memory")
#define PG8_BAR __builtin_amdgcn_s_barrier()
#define PG8_SCHED __builtin_amdgcn_sched_barrier(0)
    Unit cur, nxt; int ui = 0;
    if (!S.next(0, cur)) return;
    f32x4 acc[2][2][4][2];
#pragma unroll
    for (int a = 0; a < 2; ++a)
#pragma unroll
        for (int b = 0; b < 2; ++b)
#pragma unroll
            for (int m = 0; m < 4; ++m)
#pragma unroll
                for (int n = 0; n < 2; ++n) acc[a][b][m][n] = (f32x4){0.f, 0.f, 0.f, 0.f};
    bf16x8 At[4][2], B0[2][2], B1[2][2];
    const char* cA = (const char*)g.A + (size_t)cur.pm * tstep; const char* cB = (const char*)g.Bt + (size_t)cur.pn * tstep;
    S.a_ready(cur);
    PG8_STAGE(PG8_SB(0, 0), cB, voffB); PG8_STAGE(PG8_SA(0, 0), cA, voffA); PG8_STAGE(PG8_SB(0, 1), cB + hstepB, voffB); PG8_STAGE(PG8_SA(0, 1), cA + hstep, voffA);
    if (wr == 1) PG8_BAR;
    PG8_WAIT_V(4); PG8_BAR;
    PG8_STAGE(PG8_SB(1, 0), cB + kstep, voffB); PG8_STAGE(PG8_SA(1, 0), cA + kstep, voffA); PG8_STAGE(PG8_SB(1, 1), cB + hstepB + kstep, voffB);
    PG8_WAIT_V(6); PG8_BAR;
    for (;;) {
        const bool has_next = S.next(ui + 1, nxt);
        const char* nA = has_next ? (const char*)g.A + (size_t)nxt.pm * tstep : cA; const char* nB = has_next ? (const char*)g.Bt + (size_t)nxt.pn * tstep : cB;
        E.prefetch(cur, wid, lane, lds + STAGE_BYTES + wid * 1024);
        for (int t = 0; t < nt; t += 2) {
            const bool last = (t == nt - 2);
            const char* a1 = cA + (size_t)(t + 1) * kstep;
            const char* a2 = last ? nA : cA + (size_t)(t + 2) * kstep; const char* b2 = last ? nB : cB + (size_t)(t + 2) * kstep;
            const char* a3 = a2 + kstep; const char* b3 = b2 + kstep;
            if (last && has_next) S.a_ready(nxt);
            PG8_LDB(B0, 0, 0); PG8_SCHED; PG8_LDA(At, 0, 0); PG8_STAGE(PG8_SA(1, 1), a1 + hstep, voffA);
            PG8_WAIT_L(8); PG8_BAR; PG8_WAIT_L(0); PG8_MMA(0, 0, At, B0); PG8_BAR; PG8_SCHED;
            PG8_LDB(B1, 0, 1); PG8_STAGE(PG8_SB(0, 0), b2, voffB);
            PG8_BAR; PG8_WAIT_L(0); PG8_MMA(0, 1, At, B1); PG8_BAR;
            PG8_LDA(At, 0, 1); PG8_STAGE(PG8_SA(0, 0), a2, voffA);
            PG8_BAR; PG8_WAIT_L(0); PG8_MMA(1, 0, At, B0); PG8_BAR; PG8_SCHED;
            PG8_STAGE(PG8_SB(0, 1), b2 + hstepB, voffB);
            PG8_WAIT_V(6); PG8_BAR; PG8_MMA(1, 1, At, B1); PG8_BAR;
            PG8_LDB(B0, 1, 0); PG8_SCHED; PG8_LDA(At, 1, 0); PG8_STAGE(PG8_SA(0, 1), a2 + hstep, voffA);
            PG8_WAIT_L(8); PG8_BAR; PG8_WAIT_L(0); PG8_MMA(0, 0, At, B0); PG8_BAR; PG8_SCHED;
            PG8_LDB(B1, 1, 1); PG8_STAGE(PG8_SB(1, 0), b3, voffB);
            PG8_BAR; PG8_WAIT_L(0); PG8_MMA(0, 1, At, B1); PG8_BAR;
            PG8_LDA(At, 1, 1); PG8_STAGE(PG8_SA(1, 0), a3, voffA);
            PG8_BAR; PG8_WAIT_L(0); PG8_MMA(1, 0, At, B0); PG8_BAR; PG8_SCHED;
            PG8_STAGE(PG8_SB(1, 1), b3 + hstepB, voffB);
            PG8_WAIT_V(6); PG8_BAR; PG8_MMA(1, 1, At, B1); PG8_BAR;
        }
        if constexpr (!Epi::AFTER_DRAIN) { E(acc, cur, wr, wc, fr, fq); S.done(cur); }
        if (!has_next) break;
#pragma unroll
        for (int a = 0; a < 2; ++a)
#pragma unroll
            for (int b = 0; b < 2; ++b)
#pragma unroll
                for (int m = 0; m < 4; ++m)
#pragma unroll
                    for (int n = 0; n < 2; ++n) acc[a][b][m][n] = (f32x4){0.f, 0.f, 0.f, 0.f};
        cur = nxt; cA = nA; cB = nB; ++ui;
    }
    PG8_WAIT_V(0);
    if (wr == 0) PG8_BAR;
    PG8_BAR;
    if constexpr (Epi::AFTER_DRAIN) { E.fused(acc, cur, wr, wc, fr, fq); S.done(cur); }
#undef PG8_SA
#undef PG8_SB
#undef PG8_STAGE
#undef PG8_LDA
#undef PG8_LDB
#undef PG8_MMA
#undef PG8_WAIT_V
#undef PG8_WAIT_L
#undef PG8_BAR
#undef PG8_SCHED
}
}

struct KArgs {
    const float* in[18];
    float* out;
    unsigned char* ws;
    int ph_lo, ph_hi;
    int cg_sync, pad;
};
enum { I_XP = 0, I_XS, I_SPOOL, I_CK, I_CV, I_MEM, I_NORMG, I_WIN, I_POOLW, I_POOLSC, I_SGUNG, I_SGUW, I_SGUB, I_MEMNG, I_WKV, I_WDOWN, I_WOUT, I_NORMF };

struct P1Order {
    pg8::StaticOrder so; int G, c;
    __device__ void init(int G_, int c_) { so.init(MPR, INC, G_, c_); G = G_; c = c_; }
    __device__ bool next(int i, pg8::Unit& u) const {
        const long L = (long)i * G + c;
        if (L < so.nwg) return so.next(i, u);
        const int e = (int)(L - so.nwg); if (e >= 104) return false;
        if (e < 64) { u.pm = NPAN + (e >> 3); u.pn = 40 + (e & 7); } else { u.pm = 64; u.pn = e - 64; }
        return true;
    }
    __device__ __forceinline__ void a_ready(const pg8::Unit&) const {}
    __device__ __forceinline__ void done(const pg8::Unit&) const {}
};
struct EpiProj {
    static constexpr bool PERM = true, AFTER_DRAIN = false;
    bf16* proj; bf16* gate; float* vss; bf16* kb; bf16* vb; float* out; const float* hs; bf16* dsr;
    __device__ __forceinline__ void prefetch(const pg8::Unit&, int, int, LAS unsigned char*) const {}
    __device__ __forceinline__ void operator()(const f32x4 (&acc)[2][2][4][2], const pg8::Unit& u, int wr, int wc, int fr, int fq) const {
        if (u.pn < 40) {
            const int sec = u.pn >> 2;
            const int act = (sec == 1 || sec == 4 || sec == 6) ? 1 : (sec >= 7 ? 2 : 0);
            const int row0 = u.pm * 256 + wr * 64 + fr, cs0 = (u.pn & 3) * 256 + wc * 64 + 8 * fq;
            bf16* base; int ld;
            if (sec < 7) { base = proj + (size_t)sec * MP * DM; ld = DM; } else { base = gate + (sec - 7) * DM; ld = 3 * DM; }
            const bool poolrows = (sec == 0) && (((u.pm & 7) == 7) || u.pm == 64);
#pragma unroll
            for (int ai = 0; ai < 2; ++ai)
#pragma unroll
                for (int m = 0; m < 4; ++m) {
                    const int r = row0 + ai * 128 + m * 16; float ss = 0.f;
#pragma unroll
                    for (int bj = 0; bj < 2; ++bj) {
                        f32x4 v0 = acc[ai][bj][m][0], v1 = acc[ai][bj][m][1]; const int cs = cs0 + bj * 32;
                        if (sec == 3) ss += (v0[0] * v0[0] + v0[1] * v0[1]) + (v0[2] * v0[2] + v0[3] * v0[3]) + (v1[0] * v1[0] + v1[1] * v1[1]) + (v1[2] * v1[2] + v1[3] * v1[3]);
                        if (poolrows) {
                            float* dst = nullptr;
                            if (r < MPR) { const int t = r & (SEQ - 1); if (t >= SEQ - 15) dst = out + O_POOLP + ((size_t)(r >> 11) * 15 + (t - (SEQ - 15))) * DM + cs; }
                            else if (r < MV) { dst = out + O_POOLS + ((size_t)(r - MPR) * 15 + 14) * DM + cs;
                                const float* hp = hs + (size_t)(r - MPR) * DM + cs; const f32x4 h0 = *(const f32x4*)hp, h1 = *(const f32x4*)(hp + 4); const float inv = 1.f / (float)(2 << (cs >> 8));
                                u32x4 d; d.x = pk2((h0.x + v0[0]) * inv - v0[0], (h0.y + v0[1]) * inv - v0[1]); d.y = pk2((h0.z + v0[2]) * inv - v0[2], (h0.w + v0[3]) * inv - v0[3]);
                                d.z = pk2((h1.x + v1[0]) * inv - v1[0], (h1.y + v1[1]) * inv - v1[1]); d.w = pk2((h1.z + v1[2]) * inv - v1[2], (h1.w + v1[3]) * inv - v1[3]);
                                *(u32x4*)(dsr + (size_t)(r - MPR) * DM + cs) = d; }
                            if (dst) { *(f32x4*)dst = v0; *(f32x4*)(dst + 4) = v1; }
                        }
                        if (act == 1) {
#pragma unroll
                            for (int j = 0; j < 4; ++j) { v0[j] = silu_f(v0[j]); v1[j] = silu_f(v1[j]); } }
                        if (act == 2) {
#pragma unroll
                            for (int j = 0; j < 4; ++j) { v0[j] = sigm_f(v0[j]); v1[j] = sigm_f(v1[j]); } }
                        u32x4 w; w.x = pk2(v0[0], v0[1]); w.y = pk2(v0[2], v0[3]); w.z = pk2(v1[0], v1[1]); w.w = pk2(v1[2], v1[3]);
                        __builtin_nontemporal_store(w, (u32x4*)(base + (size_t)r * ld + cs));
                    }
                    if (sec == 3) { ss += __shfl_xor(ss, 16); ss += __shfl_xor(ss, 32); if (fq == 0) vss[(size_t)r * 16 + (u.pn & 3) * 4 + wc] = ss; }
                }
        } else {
            const int b = u.pm - NPAN, ct = (u.pn - 40) * 256;
            const bool isv = ct >= DM; const int cb = (isv ? ct - DM : ct) + wc * 64 + 8 * fq;
            float* of = out + (isv ? O_MV : O_MK); bf16* ob = isv ? vb : kb;
#pragma unroll
            for (int ai = 0; ai < 2; ++ai)
#pragma unroll
                for (int m = 0; m < 4; ++m) {
                    const size_t j = (size_t)b * 256 + ai * 128 + wr * 64 + m * 16 + fr;
#pragma unroll
                    for (int bj = 0; bj < 2; ++bj) {
                        const f32x4 v0 = acc[ai][bj][m][0], v1 = acc[ai][bj][m][1]; const int cs = cb + bj * 32;
                        __builtin_nontemporal_store(v0, (f32x4*)(of + j * DM + cs)); __builtin_nontemporal_store(v1, (f32x4*)(of + j * DM + cs + 4));
                        u32x4 w; w.x = pk2(v0[0], v0[1]); w.y = pk2(v0[2], v0[3]); w.z = pk2(v1[0], v1[1]); w.w = pk2(v1[2], v1[3]);
                        *(u32x4*)(ob + j * DM + cs) = w;
                    }
                }
        }
    }
};
struct P3Order {
    pg8::StaticOrder so;
    __device__ void init(int G_, int c_) { so.init(MPR, DM, G_, c_); }
    __device__ bool next(int i, pg8::Unit& u) const { const int rnd = i / 3, b = i - 3 * rnd; pg8::Unit t; if (!so.next(rnd, t)) return false; u.pm = b * NPAN + t.pm; u.pn = b * 4 + t.pn; return true; }
    __device__ __forceinline__ void a_ready(const pg8::Unit&) const {}
    __device__ __forceinline__ void done(const pg8::Unit&) const {}
};
struct EpiGate {
    static constexpr bool PERM = true, AFTER_DRAIN = false;
    const bf16* gate; bf16* mg;
    __device__ __forceinline__ void prefetch(const pg8::Unit& u, int wid, int lane, LAS unsigned char* scr) const {
        const int b = u.pn >> 2, pm = u.pm - b * NPAN, t = wid * 64 + lane;
#pragma unroll
        for (int j = 0; j < 2; ++j) { const int li = t + 512 * j, row = li >> 2, seg = li & 3; const size_t r = (size_t)(pm * 256 + row);
            __builtin_amdgcn_global_load_lds((const unsigned*)(gate + r * (3 * DM) + b * DM + (u.pn & 3) * 256 + seg * 64), (LAS unsigned*)(scr + j * 256), 4, 0, 0); }
    }
    __device__ __forceinline__ void operator()(const f32x4 (&acc)[2][2][4][2], const pg8::Unit& u, int wr, int wc, int fr, int fq) const {
        const int b = u.pn >> 2, pm = u.pm - b * NPAN;
        const int row0 = pm * 256 + wr * 64 + fr, c0 = (u.pn & 3) * 256 + wc * 64 + 8 * fq;
#pragma unroll
        for (int ai = 0; ai < 2; ++ai)
#pragma unroll
            for (int m = 0; m < 4; ++m) {
                const size_t r = (size_t)(row0 + ai * 128 + m * 16);
#pragma unroll
                for (int bj = 0; bj < 2; ++bj) {
                    const f32x4 v0 = acc[ai][bj][m][0], v1 = acc[ai][bj][m][1]; const int c = c0 + bj * 32;
                    const u32x4 g8 = *(const u32x4*)(gate + r * (3 * DM) + b * DM + c);
                    float o0 = v0[0] * bflo(g8.x), o1 = v0[1] * bfhi(g8.x), o2 = v0[2] * bflo(g8.y), o3 = v0[3] * bfhi(g8.y);
                    float o4 = v1[0] * bflo(g8.z), o5 = v1[1] * bfhi(g8.z), o6 = v1[2] * bflo(g8.w), o7 = v1[3] * bfhi(g8.w);
                    if (b > 0) { const u32x4 p = *(const u32x4*)(mg + r * DM + c);
                        o0 += bflo(p.x); o1 += bfhi(p.x); o2 += bflo(p.y); o3 += bfhi(p.y); o4 += bflo(p.z); o5 += bfhi(p.z); o6 += bflo(p.w); o7 += bfhi(p.w); }
                    u32x4 w; w.x = pk2(o0, o1); w.y = pk2(o2, o3); w.z = pk2(o4, o5); w.w = pk2(o6, o7);
                    if (b == 2) __builtin_nontemporal_store(w, (u32x4*)(mg + r * DM + c)); else *(u32x4*)(mg + r * DM + c) = w;
                }
            }
    }
};
__device__ __forceinline__ void st_agent(float* p, float v) { __hip_atomic_store((unsigned*)p, __builtin_bit_cast(unsigned, v), __ATOMIC_RELAXED, __HIP_MEMORY_SCOPE_AGENT); }
__device__ __forceinline__ float ld_agent(const float* p) { return __builtin_bit_cast(float, __hip_atomic_load((unsigned*)p, __ATOMIC_RELAXED, __HIP_MEMORY_SCOPE_AGENT)); }
__device__ __forceinline__ void wait_count(unsigned* w, unsigned want) {
    unsigned sp = 0;
    while ((unsigned)__builtin_amdgcn_readfirstlane(__hip_atomic_load(w, __ATOMIC_RELAXED, __HIP_MEMORY_SCOPE_AGENT)) < want) { __builtin_amdgcn_s_sleep(2); if (++sp > (1u << 22)) break; }
    __builtin_amdgcn_fence(__ATOMIC_ACQUIRE, "agent");
    asm volatile("s_waitcnt vmcnt(0)" ::: "memory");
}
struct EpiOutNorm {
    static constexpr bool PERM = false, AFTER_DRAIN = true;
    const float* xp; const float* gf; float* out; float* slots; unsigned* cnt;
    __device__ __forceinline__ void prefetch(const pg8::Unit& u, int wid, int lane, LAS unsigned char* scr) const {
        const int t = wid * 64 + lane;
#pragma unroll
        for (int j = 0; j < 4; ++j) { const int li = t + 512 * j, row = li >> 3, seg = li & 7;
            __builtin_amdgcn_global_load_lds((const unsigned*)(xp + (size_t)(u.pm * 256 + row) * DM + u.pn * 256 + seg * 32), (LAS unsigned*)(scr + j * 256), 4, 0, 0); }
    }
    __device__ __forceinline__ void operator()(const f32x4 (&)[2][2][4][2], const pg8::Unit&, int, int, int, int) const {}
    __device__ __forceinline__ void fused(f32x4 (&acc)[2][2][4][2], const pg8::Unit& u, int wr, int wc, int fr, int fq) const {
        const int row0 = u.pm * 256 + wr * 64 + fr, col0 = u.pn * 256 + wc * 32 + 4 * fq;
#pragma unroll
        for (int ai = 0; ai < 2; ++ai)
#pragma unroll
            for (int m = 0; m < 4; ++m) { const size_t r = (size_t)(row0 + ai * 128 + m * 16); float ss = 0.f;
#pragma unroll
                for (int bj = 0; bj < 2; ++bj)
#pragma unroll
                    for (int n = 0; n < 2; ++n) { const int c = col0 + bj * 128 + n * 16; const f32x4 v = acc[ai][bj][m][n] + __builtin_nontemporal_load((const f32x4*)(xp + r * DM + c)); acc[ai][bj][m][n] = v;
                        ss += (v.x * v.x + v.y * v.y) + (v.z * v.z + v.w * v.w); }
                ss += __shfl_xor(ss, 16); ss += __shfl_xor(ss, 32);
                if (fq == 0) st_agent(slots + r * 16 + u.pn * 4 + wc, ss); }
        asm volatile("s_waitcnt vmcnt(0)" ::: "memory");
        if (fr == 0 && fq == 0) __hip_atomic_fetch_add(cnt + 64 * u.pm, 1u, __ATOMIC_RELAXED, __HIP_MEMORY_SCOPE_AGENT);
        if (threadIdx.x < 64) wait_count(cnt + 64 * u.pm, 32u);
        __syncthreads();
#pragma unroll
        for (int ai = 0; ai < 2; ++ai)
#pragma unroll
            for (int m = 0; m < 4; ++m) { const size_t r = (size_t)(row0 + ai * 128 + m * 16); float tot = 0.f;
                { const f32x4* sp = (const f32x4*)(slots + r * 16); const f32x4 p0 = sp[0], p1 = sp[1], p2 = sp[2], p3 = sp[3];
                  tot = (((p0.x + p0.y) + (p0.z + p0.w)) + ((p1.x + p1.y) + (p1.z + p1.w))) + (((p2.x + p2.y) + (p2.z + p2.w)) + ((p3.x + p3.y) + (p3.z + p3.w))); }
                const float rs = rsqrtf(tot * (1.f / DM) + EPS);
#pragma unroll
                for (int bj = 0; bj < 2; ++bj)
#pragma unroll
                    for (int n = 0; n < 2; ++n) { const int c = col0 + bj * 128 + n * 16; const f32x4 g = *(const f32x4*)(gf + c); const f32x4 v = acc[ai][bj][m][n];
                        __builtin_nontemporal_store((f32x4){v.x * rs * g.x, v.y * rs * g.y, v.z * rs * g.z, v.w * rs * g.w}, (f32x4*)(out + O_YP + r * DM + c)); } }
    }
};

template <class Epi>
__device__ __forceinline__ void skinny_gemm(LAS unsigned char* lds, const bf16* A0, int lda, size_t a_grp_stride, int strips_per_grp, int nseg, int aseg,
                                            const bf16* Bt, int ldb, int K, int nstrips, int first, int step, const Epi& E) {
    int tid_ = threadIdx.x; asm volatile("" : "+v"(tid_));
    const int tid = tid_, lane = tid & 63, wv = tid >> 6, fr = lane & 15, fq = lane >> 4, rh = wv & 1, kq = wv >> 1;
    LAS float* part = (LAS float*)lds;
    const int nks = K / 128;
    for (int s = first; s < nstrips; s += step) {
        const bf16* A = A0 + (size_t)(s / strips_per_grp) * a_grp_stride + (size_t)(rh * 64 + fr) * lda + fq * 8;
        const bf16* B = Bt + (size_t)(16 * s + fr) * ldb + fq * 8;
        f32x4 acc[4];
#pragma unroll
        for (int rb = 0; rb < 4; ++rb) acc[rb] = (f32x4){0.f, 0.f, 0.f, 0.f};
        for (int seg = 0; seg < nseg; ++seg) {
#pragma unroll 4
            for (int k = 0; k < nks; ++k) {
                const int ko = (kq * nks + k) * 32;
                const bf16x8 bfr = *(const bf16x8*)(B + ko);
#pragma unroll
                for (int rb = 0; rb < 4; ++rb) { const bf16x8 afr = *(const bf16x8*)(A + (size_t)rb * 16 * lda + seg * aseg + ko);
                    acc[rb] = __builtin_amdgcn_mfma_f32_16x16x32_bf16(bfr, afr, acc[rb], 0, 0, 0); }
            }
        }
#pragma unroll
        for (int rb = 0; rb < 4; ++rb) *(LAS f32x4*)(part + ((kq * 128 + rh * 64 + rb * 16 + fr) * 16 + fq * 4)) = acc[rb];
        __syncthreads();
        { const int row = tid >> 2, cq = tid & 3; const LAS float* p = part + row * 16 + cq * 4;
          const f32x4 v = (*(const LAS f32x4*)p + *(const LAS f32x4*)(p + 2048)) + (*(const LAS f32x4*)(p + 4096) + *(const LAS f32x4*)(p + 6144));
          E(s, row, 16 * s + cq * 4, v, cq); }
        __syncthreads();
    }
}
struct EpiS1 {
    bf16* proj; bf16* gate; float* vss2; float* out; const float* hist; bf16* ds;
    __device__ __forceinline__ void operator()(int s, int row, int c, f32x4 v, int cq) const {
        const int sec = c >> 10, cs = c & 1023; const size_t m = (size_t)(MPR + row);
        if (sec == 0) { *(f32x4*)(out + O_POOLS + ((size_t)row * 15 + 14) * DM + cs) = v;
            const int w = 2 << (cs >> 8); f32x4 sm = v;
#pragma unroll
            for (int j = 0; j < 15; ++j) if (j < w - 1) sm = sm + *(const f32x4*)(hist + ((size_t)row * 15 + 14 - j) * DM + cs);
            const float inv = 1.f / (float)w;
            u32x2 d; d.x = pk2(sm.x * inv - v.x, sm.y * inv - v.y); d.y = pk2(sm.z * inv - v.z, sm.w * inv - v.w);
            *(u32x2*)(ds + (size_t)row * DM + cs) = d; }
        if (sec == 3) { float ss = (v.x * v.x + v.y * v.y) + (v.z * v.z + v.w * v.w); ss += __shfl_xor(ss, 1); ss += __shfl_xor(ss, 2); if (cq == 0) vss2[row * 64 + (s - 192)] = ss; }
        if (sec == 1 || sec == 4 || sec == 6) { v.x = silu_f(v.x); v.y = silu_f(v.y); v.z = silu_f(v.z); v.w = silu_f(v.w); }
        if (sec >= 7) { v.x = sigm_f(v.x); v.y = sigm_f(v.y); v.z = sigm_f(v.z); v.w = sigm_f(v.w); }
        u32x2 w; w.x = pk2(v.x, v.y); w.y = pk2(v.z, v.w);
        if (sec < 7) *(u32x2*)(proj + (size_t)sec * MP * DM + m * DM + cs) = w; else *(u32x2*)(gate + m * (3 * DM) + (sec - 7) * DM + cs) = w;
    }
};
struct EpiS3 {
    const bf16* gate; bf16* gys;
    __device__ __forceinline__ void operator()(int s, int row, int c, f32x4 v, int cq) const {
        const u32x2 g = *(const u32x2*)(gate + (size_t)(MPR + row) * (3 * DM) + c);
        u32x2 w; w.x = pk2(v.x * bflo(g.x), v.y * bfhi(g.x)); w.y = pk2(v.z * bflo(g.y), v.w * bfhi(g.y));
        *(u32x2*)(gys + (size_t)row * (3 * DM) + c) = w;
    }
};
struct EpiS4 {
    const float* xs; const float* gf; float* out; float* slots2; unsigned* cnt2;
    __device__ __forceinline__ void operator()(int s, int row, int c, f32x4 v, int cq) const {
        v = v + *(const f32x4*)(xs + (size_t)row * DM + c);
        float ss = (v.x * v.x + v.y * v.y) + (v.z * v.z + v.w * v.w); ss += __shfl_xor(ss, 1); ss += __shfl_xor(ss, 2);
        if (cq == 0) st_agent(slots2 + row * 64 + s, ss);
        asm volatile("s_waitcnt vmcnt(0)" ::: "memory");
        __syncthreads();
        if (threadIdx.x == 0) __hip_atomic_fetch_add(cnt2, 1u, __ATOMIC_RELAXED, __HIP_MEMORY_SCOPE_AGENT);
        if (threadIdx.x < 64) wait_count(cnt2, 64u);
        __syncthreads();
        float tot = 0.f;
        { const f32x4* sp = (const f32x4*)(slots2 + row * 64 + cq * 16); const f32x4 p0 = sp[0], p1 = sp[1], p2 = sp[2], p3 = sp[3];
          tot = (((p0.x + p0.y) + (p0.z + p0.w)) + ((p1.x + p1.y) + (p1.z + p1.w))) + (((p2.x + p2.y) + (p2.z + p2.w)) + ((p3.x + p3.y) + (p3.z + p3.w))); }
        tot += __shfl_xor(tot, 1); tot += __shfl_xor(tot, 2);
        const float rs = rsqrtf(tot * (1.f / DM) + EPS); const f32x4 g = *(const f32x4*)(gf + c);
        *(f32x4*)(out + O_YS + (size_t)row * DM + c) = (f32x4){v.x * rs * g.x, v.y * rs * g.y, v.z * rs * g.z, v.w * rs * g.w};
    }
};


__device__ __forceinline__ void sample_out_split(const KArgs& a, LAS unsigned char* lds, int item) {
    int tid_ = threadIdx.x; asm volatile("" : "+v"(tid_));
    const int tid = tid_, lane = tid & 63, wv = tid >> 6, fr = lane & 15, fq = lane >> 4, s = item >> 2, rq = item & 3;
    const bf16* A = (const bf16*)(a.ws + WS_GYS) + (size_t)(rq * 32 + fr) * (3 * DM) + fq * 8;
    const bf16* B = (const bf16*)(a.ws + WS_WO3) + (size_t)(16 * s + fr) * DM + fq * 8;
    f32x4 acc0 = (f32x4){0.f, 0.f, 0.f, 0.f}, acc1 = acc0;
#pragma unroll
    for (int kk = 0; kk < 12; ++kk) { const int k = 384 * wv + 32 * kk;
        const bf16x8 bfr = *(const bf16x8*)(B + (k & 1023)); const bf16x8 a0 = *(const bf16x8*)(A + k), a1 = *(const bf16x8*)(A + (size_t)16 * (3 * DM) + k);
        acc0 = __builtin_amdgcn_mfma_f32_16x16x32_bf16(bfr, a0, acc0, 0, 0, 0); acc1 = __builtin_amdgcn_mfma_f32_16x16x32_bf16(bfr, a1, acc1, 0, 0, 0); }
    LAS float* part = (LAS float*)lds;
    *(LAS f32x4*)(part + (wv * 32 + fr) * 16 + fq * 4) = acc0; *(LAS f32x4*)(part + (wv * 32 + 16 + fr) * 16 + fq * 4) = acc1;
    __syncthreads();
    const int row = tid >> 4, col = tid & 15, grow = rq * 32 + row, c = 16 * s + col;
    float v = 0.f;
#pragma unroll
    for (int w8 = 0; w8 < 8; ++w8) v += part[(w8 * 32 + row) * 16 + col];
    v += a.in[I_XS][(size_t)grow * DM + c];
    float ss = v * v; ss += __shfl_xor(ss, 1); ss += __shfl_xor(ss, 2); ss += __shfl_xor(ss, 4); ss += __shfl_xor(ss, 8);
    float* slots2 = (float*)(a.ws + WS_VSS2); unsigned* cnt = (unsigned*)(a.ws + WS_CTL) + CW_SAMPLE + 64 * rq;
    if (col == 0) st_agent(slots2 + grow * 64 + s, ss);
    asm volatile("s_waitcnt vmcnt(0)" ::: "memory");
    __syncthreads();
    if (tid == 0) __hip_atomic_fetch_add(cnt, 1u, __ATOMIC_RELAXED, __HIP_MEMORY_SCOPE_AGENT);
    if (tid < 64) wait_count(cnt, 64u);
    __syncthreads();
    const f32x4 p4 = *(const f32x4*)(slots2 + grow * 64 + col * 4);
    float tot = (p4.x + p4.y) + (p4.z + p4.w); tot += __shfl_xor(tot, 1); tot += __shfl_xor(tot, 2); tot += __shfl_xor(tot, 4); tot += __shfl_xor(tot, 8);
    a.out[O_YS + (size_t)grow * DM + c] = v * rsqrtf(tot * (1.f / DM) + EPS) * a.in[I_NORMF][c];
    __syncthreads();
}

__device__ __forceinline__ void p0_transpose_item(const float* W, int N, bf16* WT, int row_off, int ldo, int koff, LAS float* scr, int item, int lane) {
    const int nblk = N / 32, kb = item / nblk, nb = item % nblk, k0 = 64 * kb, n0 = 32 * nb;
    float wv_[32];
#pragma unroll
    for (int i = 0; i < 32; ++i) { const int kk = 2 * i + (lane >> 5); wv_[i] = __builtin_nontemporal_load(W + (size_t)(k0 + kk) * N + n0 + (lane & 31)); }
#pragma unroll
    for (int i = 0; i < 32; ++i) { const int kk = 2 * i + (lane >> 5); scr[kk * 33 + (lane & 31)] = wv_[i]; }
    asm volatile("s_waitcnt lgkmcnt(0)" ::: "memory");
    const int c = lane & 7;
#pragma unroll
    for (int j = 0; j < 4; ++j) { const int n = (lane >> 3) + 8 * j; const LAS float* s = scr + (8 * c) * 33 + n;
        u32x4 o; o.x = pk2(s[0 * 33], s[1 * 33]); o.y = pk2(s[2 * 33], s[3 * 33]); o.z = pk2(s[4 * 33], s[5 * 33]); o.w = pk2(s[6 * 33], s[7 * 33]);
        *(u32x4*)(WT + (size_t)(row_off + n0 + n) * ldo + koff + k0 + 8 * c) = o; }
    asm volatile("s_waitcnt lgkmcnt(0)" ::: "memory");
}
__device__ __forceinline__ void rms_row_to_bf16(const float* xrow, const float* gain, bf16* orow, int lane) {
    const f32x4* xr = (const f32x4*)xrow + lane; const f32x4* gr = (const f32x4*)gain + lane;
    f32x4 v[4]; float s = 0.f;
#pragma unroll
    for (int j = 0; j < 4; ++j) { v[j] = xr[64 * j]; s += (v[j].x * v[j].x + v[j].y * v[j].y) + (v[j].z * v[j].z + v[j].w * v[j].w); }
    const float rs = rsqrtf(wave_sum(s) * (1.f / DM) + EPS);
    u32x2* o8 = (u32x2*)orow + lane;
#pragma unroll
    for (int j = 0; j < 4; ++j) { const f32x4 g = gr[64 * j]; u32x2 w; w.x = pk2(v[j].x * rs * g.x, v[j].y * rs * g.y); w.y = pk2(v[j].z * rs * g.z, v[j].w * rs * g.w); o8[64 * j] = w; }
}
__device__ __forceinline__ void rms_row2_to_bf16(const float* x0, const float* x1, const float* gain, bf16* o0, bf16* o1, int lane) {
    const f32x4* xr0 = (const f32x4*)x0 + lane; const f32x4* xr1 = (const f32x4*)x1 + lane; const f32x4* gr = (const f32x4*)gain + lane;
    f32x4 v[4], w[4]; float s = 0.f, t = 0.f;
#pragma unroll
    for (int j = 0; j < 4; ++j) { v[j] = __builtin_nontemporal_load(xr0 + 64 * j); w[j] = __builtin_nontemporal_load(xr1 + 64 * j); }
#pragma unroll
    for (int j = 0; j < 4; ++j) { s += (v[j].x * v[j].x + v[j].y * v[j].y) + (v[j].z * v[j].z + v[j].w * v[j].w); t += (w[j].x * w[j].x + w[j].y * w[j].y) + (w[j].z * w[j].z + w[j].w * w[j].w); }
#pragma unroll
    for (int o = 1; o < 64; o <<= 1) { s += __shfl_xor(s, o); t += __shfl_xor(t, o); }
    const float rs = rsqrtf(s * (1.f / DM) + EPS), rt = rsqrtf(t * (1.f / DM) + EPS);
    u32x2* p0 = (u32x2*)o0 + lane; u32x2* p1 = (u32x2*)o1 + lane;
#pragma unroll
    for (int j = 0; j < 4; ++j) { const f32x4 g = gr[64 * j]; u32x2 a; a.x = pk2(v[j].x * rs * g.x, v[j].y * rs * g.y); a.y = pk2(v[j].z * rs * g.z, v[j].w * rs * g.w); p0[64 * j] = a;
        u32x2 b; b.x = pk2(w[j].x * rt * g.x, w[j].y * rt * g.y); b.y = pk2(w[j].z * rt * g.z, w[j].w * rt * g.w); p1[64 * j] = b; }
}
__device__ __forceinline__ void p0_prologue(const KArgs& a, LAS unsigned char* lds, int G) {
    const int tid = threadIdx.x, lane = tid & 63, wave = tid >> 6;
    LAS float* scr = (LAS float*)(lds + wave * 16384);
    const int gw = blockIdx.x * 8 + wave, NGW = G * 8;
    bf16* H = (bf16*)(a.ws + WS_H); bf16* WinT = (bf16*)(a.ws + WS_WIN); bf16* WdT = (bf16*)(a.ws + WS_WD); bf16* Wo3 = (bf16*)(a.ws + WS_WO3);
    bf16* PwT = (bf16*)(a.ws + WS_PW); bf16* SW = (bf16*)(a.ws + WS_SW);
    constexpr int I_IN = 16 * (INC / 32), I_KV = 16 * (2048 / 32), I_D = 16 * 32, I_O = 16 * 32, I_P = 4 * 8;
    constexpr int NITEMS = I_IN + I_KV + 3 * I_D + I_O + 4 * I_P;
    for (int it = gw; it < NITEMS; it += NGW) {
        int r = it;
        if (r < I_IN) { p0_transpose_item(a.in[I_WIN], INC, WinT, 0, DM, 0, scr, r, lane); continue; } r -= I_IN;
        if (r < I_KV) { p0_transpose_item(a.in[I_WKV], 2048, WinT, INC, DM, 0, scr, r, lane); continue; } r -= I_KV;
        if (r < 3 * I_D) { const int b = r / I_D; p0_transpose_item(a.in[I_WDOWN] + (size_t)b * DM * DM, DM, WdT, b * DM, DM, 0, scr, r % I_D, lane); continue; } r -= 3 * I_D;
        if (r < I_O) { p0_transpose_item(a.in[I_WOUT], DM, Wo3, 0, DM, 0, scr, r, lane); continue; } r -= I_O;
        { const int g = r / I_P; p0_transpose_item(a.in[I_POOLW] + (size_t)g * 256 * 256, 256, PwT, g * 256, 256, 0, scr, r % I_P, lane); }
    }
    for (int m = gw; m + NGW < MPR; m += 2 * NGW)
        rms_row2_to_bf16(a.in[I_XP] + (size_t)m * DM, a.in[I_XP] + (size_t)(m + NGW) * DM, a.in[I_NORMG], H + (size_t)m * DM, H + (size_t)(m + NGW) * DM, lane);
    const int mdone = (MPR / (2 * NGW)) * (2 * NGW);
    for (int m = mdone + gw; m < MP + 2048; m += NGW) {
        bf16* orow = H + (size_t)m * DM;
        if (m < MPR) rms_row_to_bf16(a.in[I_XP] + (size_t)m * DM, a.in[I_NORMG], orow, lane);
        else if (m < MV) rms_row_to_bf16(a.in[I_XS] + (size_t)(m - MPR) * DM, a.in[I_NORMG], orow, lane);
        else if (m < MP) { u32x2* o8 = (u32x2*)orow + lane;
#pragma unroll
            for (int j = 0; j < 4; ++j) o8[64 * j] = (u32x2){0u, 0u}; }
        else rms_row_to_bf16(a.in[I_MEM] + (size_t)(m - MP) * DM, a.in[I_MEMNG], orow, lane);
    }
    const size_t gt = (size_t)blockIdx.x * 512 + tid, NGT = (size_t)G * 512;
    for (size_t i = gt; i < (size_t)4 * 128 * 128; i += NGT) { const int s = (int)(i & 127), t = (int)((i >> 7) & 127); SW[i] = (bf16)(s <= t ? f2bf(a.in[I_SGUW][i]) : 0u); }
    for (size_t i = gt; i < (size_t)NS * 256; i += NGT) { const size_t smp = i >> 8, c = (i & 255) * 4; const int w = 2 << (int)(c >> 8); f32x4 sm = (f32x4){0.f, 0.f, 0.f, 0.f};
#pragma unroll
        for (int j = 0; j < 15; ++j) if (j < w - 1) sm = sm + *(const f32x4*)(a.in[I_SPOOL] + (smp * 15 + 14 - j) * DM + c);
        *(f32x4*)((float*)(a.ws + WS_HS) + smp * DM + c) = sm; }
    for (size_t i = gt; i < (size_t)NS * 14 * 256; i += NGT) { const size_t smp = i / (14 * 256), rem = i % (14 * 256), r = rem / 256, c4 = rem % 256;
        __builtin_nontemporal_store(*(const f32x4*)(a.in[I_SPOOL] + (smp * 15 + r + 1) * DM + c4 * 4), (f32x4*)(a.out + O_POOLS + (smp * 15 + r) * DM + c4 * 4)); }
}

constexpr int RSV = 544;
constexpr int RS = 528;
__device__ __forceinline__ void pool_part(const KArgs& a, LAS unsigned char* lds, int rt, int g) {
    int tid_ = threadIdx.x; asm volatile("" : "+v"(tid_));
    const int tid = tid_, lane = tid & 63, wv = tid >> 6, fr = lane & 15, fq = lane >> 4;
    const int m0 = rt * 128, w = 2 << g;
    const bf16* PIN = (const bf16*)(a.ws + WS_PROJ); const bf16* PZ = PIN + (size_t)MP * DM;
    const bf16* PwT = (const bf16*)(a.ws + WS_PW); bf16* BR0 = (bf16*)(a.ws + WS_BR);
    LAS unsigned char* Pb = lds; LAS unsigned char* Db = lds + 75520;
    u32x4 zf[8]; f32x4 scv[2]; bf16x8 Bf[2][8];
    const bf16* pw = PwT + (size_t)(g * 256 + wv * 32 + 8 * (fr >> 2) + (fr & 3)) * 256 + fq * 8;
    if (rt < 128) {
        const int t0 = (rt & 15) * 128;
        u32x4 tv[9];
#pragma unroll
        for (int i = 0; i < 9; ++i) { const int idx = tid + i * 512, row = idx >> 5, ch = idx & 31; tv[i] = (u32x4){0u, 0u, 0u, 0u};
            if (idx < 143 * 32 && !(t0 == 0 && row < 15)) tv[i] = *(const u32x4*)(PIN + (size_t)(m0 - 15 + row) * DM + g * 256 + ch * 8); }
#pragma unroll
        for (int rb = 0; rb < 8; ++rb) zf[rb] = __builtin_nontemporal_load((const u32x4*)(PZ + (size_t)(m0 + rb * 16 + fr) * DM + g * 256 + wv * 32 + 8 * fq));
#pragma unroll
        for (int nn = 0; nn < 2; ++nn) { scv[nn] = *(const f32x4*)(a.in[I_POOLSC] + g * 256 + wv * 32 + 8 * fq + 4 * nn);
#pragma unroll
            for (int ks = 0; ks < 8; ++ks) Bf[nn][ks] = *(const bf16x8*)(pw + nn * 4 * 256 + ks * 32); }
#pragma unroll
        for (int i = 0; i < 9; ++i) { const int idx = tid + i * 512, row = idx >> 5, ch = idx & 31; if (idx < 143 * 32) *(LAS u32x4*)(Pb + row * RS + ch * 16) = tv[i]; }
        __syncthreads();
        {
            const int ch = tid & 31, r0 = (tid >> 5) * 8;
            float s0 = 0.f, s1 = 0.f, s2 = 0.f, s3 = 0.f, s4 = 0.f, s5 = 0.f, s6 = 0.f, s7 = 0.f;
            for (int j = 1; j < w; ++j) { const u32x4 v = *(const LAS u32x4*)(Pb + (r0 + 15 - j) * RS + ch * 16);
                s0 += bflo(v.x); s1 += bfhi(v.x); s2 += bflo(v.y); s3 += bfhi(v.y); s4 += bflo(v.z); s5 += bfhi(v.z); s6 += bflo(v.w); s7 += bfhi(v.w); }
#pragma unroll
            for (int i = 0; i < 8; ++i) { const int r = r0 + i;
                const u32x4 own = *(const LAS u32x4*)(Pb + (r + 15) * RS + ch * 16); const u32x4 old = *(const LAS u32x4*)(Pb + (r + 16 - w) * RS + ch * 16);
                s0 += bflo(own.x); s1 += bfhi(own.x); s2 += bflo(own.y); s3 += bfhi(own.y); s4 += bflo(own.z); s5 += bfhi(own.z); s6 += bflo(own.w); s7 += bfhi(own.w);
                const int cnt = min(w, t0 + r + 1); const float inv = 1.f / (float)cnt;
                u32x4 d; d.x = pk2(s0 * inv - bflo(own.x), s1 * inv - bfhi(own.x)); d.y = pk2(s2 * inv - bflo(own.y), s3 * inv - bfhi(own.y));
                d.z = pk2(s4 * inv - bflo(own.z), s5 * inv - bfhi(own.z)); d.w = pk2(s6 * inv - bflo(own.w), s7 * inv - bfhi(own.w));
                *(LAS u32x4*)(Db + r * RS + ch * 16) = d;
                s0 -= bflo(old.x); s1 -= bfhi(old.x); s2 -= bflo(old.y); s3 -= bfhi(old.y); s4 -= bflo(old.z); s5 -= bfhi(old.z); s6 -= bflo(old.w); s7 -= bfhi(old.w); }
        }
    } else {
#pragma unroll
        for (int rb = 0; rb < 8; ++rb) zf[rb] = __builtin_nontemporal_load((const u32x4*)(PZ + (size_t)(m0 + rb * 16 + fr) * DM + g * 256 + wv * 32 + 8 * fq));
#pragma unroll
        for (int nn = 0; nn < 2; ++nn) { scv[nn] = *(const f32x4*)(a.in[I_POOLSC] + g * 256 + wv * 32 + 8 * fq + 4 * nn);
#pragma unroll
            for (int ks = 0; ks < 8; ++ks) Bf[nn][ks] = *(const bf16x8*)(pw + nn * 4 * 256 + ks * 32); }
        const bf16* DS = (const bf16*)(a.ws + WS_DS);
        u32x4 td[8];
#pragma unroll
        for (int i = 0; i < 8; ++i) { const int idx = tid + i * 512, r = idx >> 5, ch = idx & 31; td[i] = *(const u32x4*)(DS + (size_t)r * DM + g * 256 + ch * 8); }
#pragma unroll
        for (int i = 0; i < 8; ++i) { const int idx = tid + i * 512, r = idx >> 5, ch = idx & 31; *(LAS u32x4*)(Db + r * RS + ch * 16) = td[i]; }
    }
    __syncthreads();
#pragma unroll
    for (int rb = 0; rb < 8; ++rb) {
        f32x4 acc0 = (f32x4){0.f, 0.f, 0.f, 0.f}, acc1 = acc0;
#pragma unroll
        for (int ks = 0; ks < 8; ++ks) { const bf16x8 A = *(const LAS bf16x8*)(Db + (rb * 16 + fr) * RS + (ks * 32 + fq * 8) * 2);
            acc0 = __builtin_amdgcn_mfma_f32_16x16x32_bf16(Bf[0][ks], A, acc0, 0, 0, 0); acc1 = __builtin_amdgcn_mfma_f32_16x16x32_bf16(Bf[1][ks], A, acc1, 0, 0, 0); }
        const size_t m = (size_t)(m0 + rb * 16 + fr); const int c = g * 256 + wv * 32 + 8 * fq; const u32x4 z = zf[rb];
        u32x4 o; o.x = pk2(acc0[0] * scv[0].x * bflo(z.x), acc0[1] * scv[0].y * bfhi(z.x)); o.y = pk2(acc0[2] * scv[0].z * bflo(z.y), acc0[3] * scv[0].w * bfhi(z.y));
        o.z = pk2(acc1[0] * scv[1].x * bflo(z.z), acc1[1] * scv[1].y * bfhi(z.z)); o.w = pk2(acc1[2] * scv[1].z * bflo(z.w), acc1[3] * scv[1].w * bfhi(z.w));
        *(u32x4*)(BR0 + m * DM + c) = o;
    }
    __syncthreads();
}
__device__ __forceinline__ void sgu_part(const KArgs& a, LAS unsigned char* lds, int rt, int g) {
    int tid_ = threadIdx.x; asm volatile("" : "+v"(tid_));
    const int tid = tid_, lane = tid & 63, wv = tid >> 6, fr = lane & 15, fq = lane >> 4;
    const int m0 = rt * 128;
    const bf16* U = (const bf16*)(a.ws + WS_PROJ) + (size_t)2 * MP * DM; const bf16* V = U + (size_t)MP * DM; const bf16* SZ = V + (size_t)MP * DM;
    const bf16* SW = (const bf16*)(a.ws + WS_SW); const float* VSS = (const float*)(a.ws + WS_VSS); bf16* BR1 = (bf16*)(a.ws + WS_BR) + (size_t)MP * DM;
    LAS unsigned char* Vb = lds; LAS unsigned char* UZb = lds + 128 * RS; LAS float* rbuf = (LAS float*)(lds + 256 * RS);
    u32x4 tv[8], tu[8], tz[8];
#pragma unroll
    for (int i = 0; i < 8; ++i) { const int idx = tid + i * 512, s = idx >> 5, ch = idx & 31; const size_t o = (size_t)(m0 + s) * DM + g * 256 + ch * 8;
        tv[i] = __builtin_nontemporal_load((const u32x4*)(V + o)); tu[i] = __builtin_nontemporal_load((const u32x4*)(U + o)); tz[i] = __builtin_nontemporal_load((const u32x4*)(SZ + o)); }
    if (tid < 128) { const f32x4* p = (const f32x4*)(VSS + (size_t)(m0 + tid) * 16); const f32x4 p0 = p[0], p1 = p[1], p2 = p[2], p3 = p[3];
        const float s = ((p0.x + p0.y) + (p0.z + p0.w)) + ((p1.x + p1.y) + (p1.z + p1.w)) + ((p2.x + p2.y) + (p2.z + p2.w)) + ((p3.x + p3.y) + (p3.z + p3.w));
        rbuf[tid] = rsqrtf(s * (1.f / DM) + EPS); }
    const f32x4 gv0 = *(const f32x4*)(a.in[I_SGUNG] + g * 256 + wv * 32 + 8 * fq), gv1 = *(const f32x4*)(a.in[I_SGUNG] + g * 256 + wv * 32 + 8 * fq + 4);
    float biasv[8];
#pragma unroll
    for (int tb = 0; tb < 8; ++tb) biasv[tb] = a.in[I_SGUB][g * 128 + tb * 16 + fr];
    __syncthreads();
#pragma unroll
    for (int i = 0; i < 8; ++i) { const int idx = tid + i * 512, s = idx >> 5, ch = idx & 31; const float r = rbuf[s];
        u32x4 v; v.x = pk2(bflo(tv[i].x) * r, bfhi(tv[i].x) * r); v.y = pk2(bflo(tv[i].y) * r, bfhi(tv[i].y) * r); v.z = pk2(bflo(tv[i].z) * r, bfhi(tv[i].z) * r); v.w = pk2(bflo(tv[i].w) * r, bfhi(tv[i].w) * r);
        *(LAS u32x4*)(Vb + s * RS + ch * 16) = v;
        u32x4 q; q.x = pk2(bflo(tu[i].x) * bflo(tz[i].x), bfhi(tu[i].x) * bfhi(tz[i].x)); q.y = pk2(bflo(tu[i].y) * bflo(tz[i].y), bfhi(tu[i].y) * bfhi(tz[i].y));
        q.z = pk2(bflo(tu[i].z) * bflo(tz[i].z), bfhi(tu[i].z) * bfhi(tz[i].z)); q.w = pk2(bflo(tu[i].w) * bflo(tz[i].w), bfhi(tu[i].w) * bfhi(tz[i].w));
        *(LAS u32x4*)(UZb + s * RS + ch * 16) = q; }
    __syncthreads();
    const int q = fr >> 2, p = fr & 3;
    bf16x8 Vf[4][2];
#pragma unroll
    for (int ks = 0; ks < 4; ++ks)
#pragma unroll
        for (int nn = 0; nn < 2; ++nn) { const LAS unsigned char* a0 = Vb + (32 * ks + 8 * fq + q) * RS + (wv * 32 + 8 * p + 4 * nn) * 2; Vf[ks][nn] = tr_read2(a0, a0 + 4 * RS); }
#pragma unroll
    for (int tb = 0; tb < 8; ++tb) {
        f32x4 acc0 = (f32x4){0.f, 0.f, 0.f, 0.f}, acc1 = acc0;
        const int t = tb * 16 + fr;
#pragma unroll
        for (int ks = 0; ks < 4; ++ks) if (ks <= (tb >> 1)) {
            const bf16x8 A = *(const bf16x8*)(SW + (size_t)(g * 128 + t) * 128 + ks * 32 + fq * 8);
            acc0 = __builtin_amdgcn_mfma_f32_16x16x32_bf16(Vf[ks][0], A, acc0, 0, 0, 0); acc1 = __builtin_amdgcn_mfma_f32_16x16x32_bf16(Vf[ks][1], A, acc1, 0, 0, 0);
        }
        const size_t m = (size_t)(m0 + t); const float bias = biasv[tb];
        { const int cl = wv * 32 + 8 * fq; const u32x4 uz = *(const LAS u32x4*)(UZb + t * RS + cl * 2);
          u32x4 o; o.x = pk2((acc0[0] * gv0.x + bias) * bflo(uz.x), (acc0[1] * gv0.y + bias) * bfhi(uz.x)); o.y = pk2((acc0[2] * gv0.z + bias) * bflo(uz.y), (acc0[3] * gv0.w + bias) * bfhi(uz.y));
          o.z = pk2((acc1[0] * gv1.x + bias) * bflo(uz.z), (acc1[1] * gv1.y + bias) * bfhi(uz.z)); o.w = pk2((acc1[2] * gv1.z + bias) * bflo(uz.w), (acc1[3] * gv1.w + bias) * bfhi(uz.w));
          *(u32x4*)(BR1 + m * DM + g * 256 + cl) = o; }
    }
    __syncthreads();
}
__device__ __forceinline__ void attn_part(const KArgs& a, LAS unsigned char* lds, int rt, int g) {
    int tid_ = threadIdx.x; asm volatile("" : "+v"(tid_));
    const int tid = tid_, lane = tid & 63, wv = tid >> 6, fr = lane & 15, fq = lane >> 4;
    const int m0 = rt * 128, b = rt >> 4;
    const bf16* Q = (const bf16*)(a.ws + WS_PROJ) + (size_t)5 * MP * DM; const bf16* AZ = Q + (size_t)MP * DM;
    const bf16* KB = (const bf16*)(a.ws + WS_KB); const bf16* VB = (const bf16*)(a.ws + WS_VB); bf16* BR2 = (bf16*)(a.ws + WS_BR) + (size_t)2 * MP * DM;
    LAS unsigned char* Kb = lds;
    const size_t m = (size_t)(m0 + wv * 16 + fr);
    bf16x8 Qf[8];
    {
        u32x4 tk[16];
#pragma unroll
        for (int i = 0; i < 16; ++i) { const int idx = tid + i * 512, key = idx >> 5, ch = idx & 31; tk[i] = *(const u32x4*)(KB + (size_t)(b * 256 + key) * DM + g * 256 + ch * 8); }
#pragma unroll
        for (int ks = 0; ks < 8; ++ks) Qf[ks] = __builtin_nontemporal_load((const bf16x8*)(Q + m * DM + g * 256 + ks * 32 + fq * 8));
#pragma unroll
        for (int i = 0; i < 16; ++i) { const int idx = tid + i * 512, key = idx >> 5, ch = idx & 31; *(LAS u32x4*)(Kb + key * RS + ch * 16) = tk[i]; }
    }
    __syncthreads();
    u32x4 tvv[16];
#pragma unroll
    for (int i = 0; i < 16; ++i) { const int idx = tid + i * 512, key = idx >> 5, ch = idx & 31; tvv[i] = *(const u32x4*)(VB + (size_t)(b * 256 + key) * DM + g * 256 + ch * 8); }
    f32x4 sacc[16];
#pragma unroll
    for (int kb = 0; kb < 16; ++kb) { sacc[kb] = (f32x4){0.f, 0.f, 0.f, 0.f};
#pragma unroll
        for (int ks = 0; ks < 8; ++ks) { const bf16x8 Kf = *(const LAS bf16x8*)(Kb + (kb * 16 + fr) * RS + (ks * 32 + fq * 8) * 2);
            sacc[kb] = __builtin_amdgcn_mfma_f32_16x16x32_bf16(Kf, Qf[ks], sacc[kb], 0, 0, 0); }
        if (kb & 1) __builtin_amdgcn_sched_barrier(0); }
    float mx = -3.0e38f;
#pragma unroll
    for (int kb = 0; kb < 16; ++kb) mx = fmaxf(mx, fmaxf(fmaxf(sacc[kb][0], sacc[kb][1]), fmaxf(sacc[kb][2], sacc[kb][3])));
    mx = fmaxf(mx, __shfl_xor(mx, 16)); mx = fmaxf(mx, __shfl_xor(mx, 32));
    float sum = 0.f;
#pragma unroll
    for (int kb = 0; kb < 16; ++kb)
#pragma unroll
        for (int j = 0; j < 4; ++j) { const float pj = __expf((sacc[kb][j] - mx) * 0.0625f); sacc[kb][j] = pj; sum += pj; }
    sum += __shfl_xor(sum, 16); sum += __shfl_xor(sum, 32);
    const float isum = 1.f / sum;
    bf16x8 Pf[8];
#pragma unroll
    for (int k2 = 0; k2 < 8; ++k2) { u32x4 w; w.x = pk2(sacc[2 * k2][0], sacc[2 * k2][1]); w.y = pk2(sacc[2 * k2][2], sacc[2 * k2][3]);
        w.z = pk2(sacc[2 * k2 + 1][0], sacc[2 * k2 + 1][1]); w.w = pk2(sacc[2 * k2 + 1][2], sacc[2 * k2 + 1][3]); Pf[k2] = __builtin_bit_cast(bf16x8, w); }
    __syncthreads();
#pragma unroll
    for (int i = 0; i < 16; ++i) { const int idx = tid + i * 512, key = idx >> 5, ch = idx & 31; *(LAS u32x4*)(Kb + key * RSV + ch * 16) = tvv[i]; }
    u32x4 zf[8];
#pragma unroll
    for (int d2 = 0; d2 < 8; ++d2) zf[d2] = __builtin_nontemporal_load((const u32x4*)(AZ + m * DM + g * 256 + d2 * 32 + 8 * fq));
    __syncthreads();
    const int q = fr >> 2, p = fr & 3;
#pragma unroll
    for (int d2 = 0; d2 < 8; ++d2) {
        f32x4 o0 = (f32x4){0.f, 0.f, 0.f, 0.f}, o1 = o0;
#pragma unroll
        for (int k2 = 0; k2 < 8; ++k2) { const LAS unsigned char* a0 = Kb + (32 * k2 + 4 * fq + q) * RSV + (d2 * 32 + 8 * p) * 2;
            const bf16x8 Vf0 = tr_read2(a0, a0 + 16 * RSV), Vf1 = tr_read2(a0 + 8, a0 + 8 + 16 * RSV);
            o0 = __builtin_amdgcn_mfma_f32_16x16x32_bf16(Vf0, Pf[k2], o0, 0, 0, 0); o1 = __builtin_amdgcn_mfma_f32_16x16x32_bf16(Vf1, Pf[k2], o1, 0, 0, 0); }
        const int c = g * 256 + d2 * 32 + 8 * fq; const u32x4 z = zf[d2];
        u32x4 w; w.x = pk2(o0[0] * isum * bflo(z.x), o0[1] * isum * bfhi(z.x)); w.y = pk2(o0[2] * isum * bflo(z.y), o0[3] * isum * bfhi(z.y));
        w.z = pk2(o1[0] * isum * bflo(z.z), o1[1] * isum * bfhi(z.z)); w.w = pk2(o1[2] * isum * bflo(z.w), o1[3] * isum * bfhi(z.w));
        *(u32x4*)(BR2 + m * DM + c) = w;
        __builtin_amdgcn_sched_barrier(0);
    }
    __syncthreads();
}
__device__ __forceinline__ void sgu_sample(const KArgs& a, int g, int rb) {
    int tid_ = threadIdx.x; asm volatile("" : "+v"(tid_));
    const int tid = tid_;
    const bf16* U = (const bf16*)(a.ws + WS_PROJ) + (size_t)2 * MP * DM; const bf16* V = U + (size_t)MP * DM; const bf16* SZ = V + (size_t)MP * DM;
    const float* VSS = (const float*)(a.ws + WS_VSS); bf16* BR1 = (bf16*)(a.ws + WS_BR) + (size_t)MP * DM;
    const float w00 = a.in[I_SGUW][(size_t)g * 128 * 128], b0 = a.in[I_SGUB][g * 128];
    for (int idx = tid; idx < 16 * 64; idx += 512) {
        const int i = rb * 16 + (idx >> 6), c = g * 256 + (idx & 63) * 4; const size_t m = (size_t)(MPR + i);
        const float s = wave_sum((idx & 63) < 16 ? VSS[m * 16 + (idx & 63)] : 0.f);
        const float rs = rsqrtf(s * (1.f / DM) + EPS);
        const f32x4 gv = *(const f32x4*)(a.in[I_SGUNG] + c);
        const u32x2 v4 = *(const u32x2*)(V + m * DM + c), u4 = *(const u32x2*)(U + m * DM + c), z = *(const u32x2*)(SZ + m * DM + c);
        f32x4 vn; vn.x = bflo(v4.x) * rs * gv.x; vn.y = bfhi(v4.x) * rs * gv.y; vn.z = bflo(v4.y) * rs * gv.z; vn.w = bfhi(v4.y) * rs * gv.w;
        *(f32x4*)(a.out + O_SV + (size_t)i * DM + c) = vn;
        u32x2 o; o.x = pk2(bflo(u4.x) * (w00 * vn.x + b0) * bflo(z.x), bfhi(u4.x) * (w00 * vn.y + b0) * bfhi(z.x));
        o.y = pk2(bflo(u4.y) * (w00 * vn.z + b0) * bflo(z.y), bfhi(u4.y) * (w00 * vn.w + b0) * bfhi(z.y));
        *(u32x2*)(BR1 + m * DM + c) = o;
    }
}
__device__ __forceinline__ void attn_sample(const KArgs& a, LAS unsigned char* lds, int i, int h) {
    int tid_ = threadIdx.x; asm volatile("" : "+v"(tid_));
    const int tid = tid_, lane = tid & 63, wv = tid >> 6;
    const bf16* Q = (const bf16*)(a.ws + WS_PROJ) + (size_t)5 * MP * DM; const bf16* AZ = Q + (size_t)MP * DM; bf16* BR2 = (bf16*)(a.ws + WS_BR) + (size_t)2 * MP * DM;
    const size_t m = (size_t)(MPR + i);
    const float* Kc = a.in[I_CK] + ((size_t)i * NMEM * 4 + h) * 256 + lane * 4;
    const float* Vc = a.in[I_CV] + ((size_t)i * NMEM * 4 + h) * 256 + lane * 4;
    LAS float* sc = (LAS float*)lds; LAS float* part = (LAS float*)(lds + 1024);
    const u32x2 q2 = *(const u32x2*)(Q + m * DM + h * 256 + lane * 4);
    const f32x4 qv = (f32x4){bflo(q2.x), bfhi(q2.x), bflo(q2.y), bfhi(q2.y)};
    {
        f32x4 kv[32]; float pd[32];
#pragma unroll
        for (int j = 0; j < 32; ++j) kv[j] = __builtin_nontemporal_load((const f32x4*)(Kc + (size_t)(wv * 32 + j) * 1024));
#pragma unroll
        for (int j = 0; j < 32; ++j) pd[j] = (kv[j].x * qv.x + kv[j].y * qv.y) + (kv[j].z * qv.z + kv[j].w * qv.w);
#pragma unroll
        for (int j = 0; j < 32; ++j) { const float d = wave_sum(pd[j]); if (lane == 0) sc[wv * 32 + j] = d * 0.0625f; }
    }
    f32x4 vv[32];
#pragma unroll
    for (int j = 0; j < 32; ++j) vv[j] = __builtin_nontemporal_load((const f32x4*)(Vc + (size_t)(wv * 32 + j) * 1024));
    __syncthreads();
    const f32x4 s4 = *(const LAS f32x4*)(sc + lane * 4);
    const float mx = wave_max(fmaxf(fmaxf(s4.x, s4.y), fmaxf(s4.z, s4.w)));
    const float sum = wave_sum((__expf(s4.x - mx) + __expf(s4.y - mx)) + (__expf(s4.z - mx) + __expf(s4.w - mx)));
    f32x4 o = (f32x4){0.f, 0.f, 0.f, 0.f};
#pragma unroll
    for (int j = 0; j < 32; ++j) { const float pj = __expf(sc[wv * 32 + j] - mx); o += vv[j] * pj; }
    *(LAS f32x4*)(part + wv * 256 + lane * 4) = o;
    __syncthreads();
    if (tid < 256) { float t = 0.f;
#pragma unroll
        for (int w8 = 0; w8 < 8; ++w8) t += part[w8 * 256 + tid];
        const int c = h * 256 + tid; const unsigned short zb = AZ[m * DM + c]; const float z = __builtin_bit_cast(float, (unsigned)zb << 16);
        BR2[m * DM + c] = (bf16)f2bf(t / sum * z); }
    __syncthreads();
}
__device__ __forceinline__ void p2_mixers(const KArgs& a, LAS unsigned char* lds, int G) {
    constexpr int NU = 512 + 512 + 4 + 32;
    if (G == 256) {
        const int c = blockIdx.x;
        for (int k = 0; k < 4; ++k) { const int kk = (c & 1) ? (k ^ 2) : k;
            if (kk < 2) { const int u = c + kk * 256, rt = u >> 2, g = u & 3; pool_part(a, lds, rt, g); sgu_part(a, lds, rt, g); attn_part(a, lds, rt, g); }
            else { const int e = c + (kk - 2) * 256; attn_sample(a, lds, e >> 2, e & 3); } }
        if (c < 4) pool_part(a, lds, 128, c); else if (c >= 8 && c < 40) sgu_sample(a, (c - 8) >> 3, (c - 8) & 7);
        return;
    }
    for (int u = blockIdx.x; u < NU; u += G) {
        if (u < 512) { const int rt = u >> 2, g = u & 3; pool_part(a, lds, rt, g); sgu_part(a, lds, rt, g); attn_part(a, lds, rt, g); }
        else if (u < 1024) { const int e = u - 512; attn_sample(a, lds, e >> 2, e & 3); }
        else if (u < 1028) pool_part(a, lds, 128, u - 1024);
        else sgu_sample(a, (u - 1028) >> 3, (u - 1028) & 7);
    }
}
__device__ __forceinline__ void p5_norm(const KArgs& a, int G) {
    const int tid = threadIdx.x, lane = tid & 63, wave = tid >> 6;
    const int gw = blockIdx.x * 8 + wave, NGW = G * 8;
    const f32x4* gr = (const f32x4*)a.in[I_NORMF] + lane;
    for (int m = gw; m < MV; m += NGW) {
        f32x4* xr = (f32x4*)(a.out + (size_t)m * DM) + lane;
        f32x4 v[4]; float s = 0.f;
#pragma unroll
        for (int j = 0; j < 4; ++j) { v[j] = xr[64 * j]; s += (v[j].x * v[j].x + v[j].y * v[j].y) + (v[j].z * v[j].z + v[j].w * v[j].w); }
        const float rs = rsqrtf(wave_sum(s) * (1.f / DM) + EPS);
#pragma unroll
        for (int j = 0; j < 4; ++j) { const f32x4 g = gr[64 * j]; xr[64 * j] = (f32x4){v[j].x * rs * g.x, v[j].y * rs * g.y, v[j].z * rs * g.z, v[j].w * rs * g.w}; }
    }
}

__global__ void __launch_bounds__(512, 2) fwd_megakernel(KArgs a) {
    extern __shared__ __attribute__((aligned(16))) unsigned char lds_raw[];
    LAS unsigned char* lds = (LAS unsigned char*)lds_raw;
    cg::grid_group grid = cg::this_grid();
    const int G = gridDim.x;
    const int lo = a.ph_lo, hi = a.ph_hi;
    volatile LAS unsigned* bst = (volatile LAS unsigned*)(lds + LDS_BYTES - 64);
    if (threadIdx.x == 0) { bst[0] = 0u; bst[1] = 0u; }
    __syncthreads();
    const XcdBarrier bar = xcd_barrier_post((unsigned*)(a.ws + WS_CTL), bst);
#define IN(k) (lo <= (k) && (k) < hi)
#define SEAM(k) do { if (IN(k) && IN((k) + 1)) { if (a.cg_sync) grid.sync(); else xcd_barrier(bar); } } while (0)
    if (IN(0)) p0_prologue(a, lds, G);
    SEAM(0);
    if (IN(1)) {
        pg8::Gemm g{(const bf16*)(a.ws + WS_H), (const bf16*)(a.ws + WS_WIN), MP, INC, DM};
        P1Order S; S.init(G, (int)blockIdx.x);
        EpiProj E{(bf16*)(a.ws + WS_PROJ), (bf16*)(a.ws + WS_GATE), (float*)(a.ws + WS_VSS), (bf16*)(a.ws + WS_KB), (bf16*)(a.ws + WS_VB), a.out, (const float*)(a.ws + WS_HS), (bf16*)(a.ws + WS_DS)};
        pg8::gemm_phase<EpiProj, P1Order>(lds, g, S, E);
    }
    SEAM(1);
    if (IN(2)) p2_mixers(a, lds, G);
    SEAM(2);
    if (IN(3)) {
        pg8::Gemm g{(const bf16*)(a.ws + WS_BR), (const bf16*)(a.ws + WS_WD), MPR, 3 * DM, DM};
        P3Order S; S.init(G, (int)blockIdx.x);
        EpiGate E{(const bf16*)(a.ws + WS_GATE), (bf16*)(a.ws + WS_MG)};
        pg8::gemm_phase<EpiGate, P3Order>(lds, g, S, E);
        EpiS3 E3{(const bf16*)(a.ws + WS_GATE), (bf16*)(a.ws + WS_GYS)};
        skinny_gemm(lds, (const bf16*)(a.ws + WS_BR) + (size_t)MPR * DM, DM, (size_t)MP * DM, 64, 1, 0, (const bf16*)(a.ws + WS_WD), DM, DM, 192, (int)blockIdx.x, G, E3);
    }
    SEAM(3);
    if (IN(4)) {
        pg8::Gemm g{(const bf16*)(a.ws + WS_MG), (const bf16*)(a.ws + WS_WO3), MPR, DM, DM};
        pg8::StaticOrder S; S.init(MPR, DM, G, (int)blockIdx.x);
        unsigned* ctl = (unsigned*)(a.ws + WS_CTL);
        EpiOutNorm E{a.in[I_XP], a.in[I_NORMF], a.out, (float*)(a.ws + WS_VSS), ctl + CW_PANEL};
        pg8::gemm_phase<EpiOutNorm, pg8::StaticOrder>(lds, g, S, E);
        sample_out_split(a, lds, (int)blockIdx.x);
    }
#undef IN
#undef SEAM
}

extern "C" void kernel_launch(void* const* d_in, const int* in_sizes, int n_in, void* d_out, int out_size, void* d_ws, size_t ws_size, hipStream_t stream) {
    static int grid = 0;
    if (grid == 0) {
        if (n_in != 18 || (size_t)out_size != O_END || ws_size < WS_END) { fprintf(stderr, "kernel_launch: unexpected shapes (n_in %d out %d ws %zu, need %zu)\n", n_in, out_size, ws_size, (size_t)WS_END); grid = -1; return; }
        int dev = 0, cus = 0, per_cu = 0;
        hipGetDevice(&dev); hipDeviceGetAttribute(&cus, hipDeviceAttributeMultiprocessorCount, dev);
        if (hipFuncSetAttribute((const void*)fwd_megakernel, hipFuncAttributeMaxDynamicSharedMemorySize, LDS_BYTES) != hipSuccess) { fprintf(stderr, "kernel_launch: hipFuncSetAttribute failed\n"); grid = -1; return; }
        if (hipOccupancyMaxActiveBlocksPerMultiprocessor(&per_cu, (const void*)fwd_megakernel, 512, LDS_BYTES) != hipSuccess || per_cu < 1) { fprintf(stderr, "kernel_launch: occupancy query failed (%d)\n", per_cu); grid = -1; return; }
        if (cus != 256) { fprintf(stderr, "kernel_launch: built for a 256-CU device (one 256x256 tile per workgroup in the last two phases), got %d\n", cus); grid = -1; return; }
        grid = cus;
    }
    if (grid < 0) return;
    if (hipMemsetAsync((char*)d_ws + WS_CTL, 0, CTL_BYTES, stream) != hipSuccess) { fprintf(stderr, "kernel_launch: memset failed\n"); return; }
    KArgs a{};
    for (int i = 0; i < 18; ++i) a.in[i] = (const float*)d_in[i];
    a.out = (float*)d_out; a.ws = (unsigned char*)d_ws; a.ph_lo = 0; a.ph_hi = 5;
    void* args[] = {&a};
    hipError_t e = hipLaunchCooperativeKernel((const void*)fwd_megakernel, dim3(grid), dim3(512), args, LDS_BYTES, stream);
    if (e != hipSuccess) fprintf(stderr, "cooperative launch failed: %s (grid %d)\n", hipGetErrorString(e), grid);
}
```

```cpp
#include <hip/hip_runtime.h>
#include <hip/hip_cooperative_groups.h>
#include <cstdio>
#include <cstdint>
namespace cg = cooperative_groups;

#define LAS __attribute__((address_space(3)))
typedef unsigned short bf16;
typedef short bf16x8 __attribute__((ext_vector_type(8)));
typedef short s16x4 __attribute__((ext_vector_type(4)));
typedef float f32x4 __attribute__((ext_vector_type(4)));
typedef unsigned u32x4 __attribute__((ext_vector_type(4)));
typedef unsigned u32x2 __attribute__((ext_vector_type(2)));

constexpr int DM = 1024, NBATCH = 8, SEQ = 2048, NS = 128, NMEM = 256;
constexpr int MPR = NBATCH * SEQ;
constexpr int MV = MPR + NS;
constexpr int MP = MPR + 256;
constexpr int NPAN = MP / 256;
constexpr int INC = 10240;
constexpr float EPS = 1e-6f;
constexpr size_t O_YP = 0, O_YS = O_YP + (size_t)MPR * DM, O_POOLP = O_YS + (size_t)NS * DM, O_POOLS = O_POOLP + (size_t)NBATCH * 15 * DM,
                 O_MK = O_POOLS + (size_t)NS * 15 * DM, O_MV = O_MK + (size_t)NBATCH * NMEM * DM, O_SV = O_MV + (size_t)NBATCH * NMEM * DM, O_END = O_SV + (size_t)NS * DM;
constexpr size_t ROWB = (size_t)MP * DM * 2;
constexpr size_t WS_CTL = 0, CTL_BYTES = 40960;
constexpr size_t WS_VSS2 = CTL_BYTES;
constexpr size_t WS_DS = WS_VSS2 + 32768;
constexpr size_t WS_HS = WS_DS + 262144;
constexpr size_t WS_H = WS_HS + 524288;
constexpr size_t WS_WIN = WS_H + (size_t)(MP + 2048) * DM * 2;
constexpr size_t WS_WD = WS_WIN + (size_t)(INC + 2048) * DM * 2;
constexpr size_t WS_WO3 = WS_WD + (size_t)3 * DM * DM * 2;
constexpr size_t WS_PW = WS_WO3 + (size_t)3 * DM * DM * 2;
constexpr size_t WS_SW = WS_PW + (size_t)4 * 256 * 256 * 2;
constexpr size_t WS_VSS = WS_SW + (size_t)4 * 128 * 128 * 2;
constexpr size_t WS_KB = WS_VSS + (size_t)MP * 16 * 4;
constexpr size_t WS_VB = WS_KB + (size_t)2048 * DM * 2;
constexpr size_t WS_PROJ = WS_VB + (size_t)2048 * DM * 2;
constexpr size_t WS_GATE = WS_PROJ + 7 * ROWB;
constexpr size_t WS_BR = WS_GATE + 3 * ROWB;
constexpr size_t WS_MG = WS_PROJ;
constexpr size_t WS_GYS = WS_H;
constexpr size_t WS_END = WS_BR + 3 * ROWB;
constexpr int LDS_BYTES = 147456;
constexpr int CW_PANEL = 4096, CW_SAMPLE = 4096 + 64 * 64;

__device__ __forceinline__ unsigned f2bf(float f) { unsigned u = __builtin_bit_cast(unsigned, f); return (u + 0x7fffu + ((u >> 16) & 1u)) >> 16; }
__device__ __forceinline__ unsigned pk2(float lo, float hi) { unsigned r; asm volatile("v_cvt_pk_bf16_f32 %0, %1, %2" : "=v"(r) : "v"(lo), "v"(hi)); return r; }
__device__ __forceinline__ float bflo(unsigned w) { return __builtin_bit_cast(float, w << 16); }
__device__ __forceinline__ float bfhi(unsigned w) { return __builtin_bit_cast(float, w & 0xffff0000u); }
__device__ __forceinline__ float silu_f(float x) { return x * __builtin_amdgcn_rcpf(1.f + __expf(-x)); }
__device__ __forceinline__ float sigm_f(float x) { return __builtin_amdgcn_rcpf(1.f + __expf(-x)); }
__device__ __forceinline__ float wave_sum(float v) {
#pragma unroll
    for (int o = 1; o < 64; o <<= 1) v += __shfl_xor(v, o);
    return v;
}
__device__ __forceinline__ float wave_max(float v) {
#pragma unroll
    for (int o = 1; o < 64; o <<= 1) v = fmaxf(v, __shfl_xor(v, o));
    return v;
}
__device__ __forceinline__ bf16x8 tr_read2(const LAS unsigned char* a0, const LAS unsigned char* a1) {
    const s16x4 lo = __builtin_amdgcn_ds_read_tr16_b64_v4i16((LAS s16x4*)a0);
    const s16x4 hi = __builtin_amdgcn_ds_read_tr16_b64_v4i16((LAS s16x4*)a1);
    return (bf16x8){lo[0], lo[1], lo[2], lo[3], hi[0], hi[1], hi[2], hi[3]};
}

#define XB_TMO      128
#define XB_XCNT(j)  (256  + 64 * (j))
#define XB_XSUB(j)  (1280 + 64 * (j))
#define XB_XGEN(j)  (2304 + 64 * (j))
#define XB_TOP      3328
#define XB_TOPGEN   3392
#define XCD_BAR_WORDS 3456
#define XB_SPIN_CAP (1u << 18)

__device__ __forceinline__ unsigned xb_ld(unsigned* p)              { return __hip_atomic_load(p, __ATOMIC_RELAXED, __HIP_MEMORY_SCOPE_AGENT); }
__device__ __forceinline__ unsigned xb_add(unsigned* p, unsigned v) { return __hip_atomic_fetch_add(p, v, __ATOMIC_RELAXED, __HIP_MEMORY_SCOPE_AGENT); }
__device__ __forceinline__ unsigned xb_xcc_id() { return (unsigned)__builtin_amdgcn_s_getreg((3 << 11) | 20) & 0xFu; }
#define XB_SPIN(cond, bar) do { unsigned _sp = 0; while (cond) { __builtin_amdgcn_s_sleep(1); \
    if ((++_sp & 255u) == 0u) { if (xb_ld(&(bar)[XB_TMO])) break; if (_sp > XB_SPIN_CAP) { atomicAdd(&(bar)[XB_TMO], 1u); break; } } } } while (0)

struct XcdBarrier {
    unsigned* bar; unsigned x;
    volatile LAS unsigned* st;
};

__device__ __forceinline__ XcdBarrier xcd_barrier_post(unsigned* bar, volatile LAS unsigned* st) {
    XcdBarrier b; b.bar = bar; b.x = xb_xcc_id(); b.st = st;
    if (threadIdx.x == 0) (void)xb_add(&bar[XB_XCNT(b.x)], 1u);
    return b;
}
__device__ __forceinline__ void xcd_barrier_complete(unsigned* bar, unsigned x, unsigned& nloc, unsigned& nx) {
    const unsigned G = gridDim.x;
    unsigned sum, cnt, mine, sp = 0u;
    for (;;) {
        sum = 0u; cnt = 0u; mine = 0u;
#pragma unroll
        for (unsigned j = 0; j < 16; ++j) { const unsigned c = xb_ld(&bar[XB_XCNT(j)]); sum += c; cnt += (c > 0u) ? 1u : 0u; mine = (j == x) ? c : mine; }
        if (sum == G) break;
        __builtin_amdgcn_s_sleep(1);
        if ((++sp & 255u) == 0u) { if (xb_ld(&bar[XB_TMO])) break; if (sp > XB_SPIN_CAP) { atomicAdd(&bar[XB_TMO], 1u); break; } }
    }
    nloc = mine > 0u ? mine : 1u; nx = cnt > 0u ? cnt : 1u;
}

__device__ __forceinline__ void xcd_barrier(const XcdBarrier& b) {
    asm volatile("s_waitcnt vmcnt(0)" ::: "memory");
    __syncthreads();
    if (threadIdx.x == 0) {
        unsigned* bar = b.bar;
        __builtin_amdgcn_s_waitcnt(0);
        unsigned nloc = b.st[0], nx = b.st[1];
        if (nloc == 0u) { xcd_barrier_complete(bar, b.x, nloc, nx); b.st[0] = nloc; b.st[1] = nx; }
        const unsigned old = xb_add(&bar[XB_XSUB(b.x)], 1u);
        const unsigned gen = old / nloc;
        if (old + 1u == (gen + 1u) * nloc) {
            __builtin_amdgcn_fence(__ATOMIC_RELEASE, "agent");
            asm volatile("s_waitcnt vmcnt(0)" ::: "memory");
            const unsigned og = xb_add(&bar[XB_TOP], 1u);
            const unsigned tg = og / nx;
            if (og + 1u == (tg + 1u) * nx) xb_add(&bar[XB_TOPGEN], 1u);
            else XB_SPIN(xb_ld(&bar[XB_TOPGEN]) == tg, bar);
            __builtin_amdgcn_fence(__ATOMIC_ACQUIRE, "agent");
            xb_add(&bar[XB_XGEN(b.x)], 1u);
            asm volatile("s_waitcnt vmcnt(0)" ::: "memory");
        } else {
            XB_SPIN(xb_ld(&bar[XB_XGEN(b.x)]) == gen, bar);
            __builtin_amdgcn_fence(__ATOMIC_ACQUIRE, "agent");
            asm volatile("s_waitcnt vmcnt(0)" ::: "memory");
        }
    }
    __syncthreads();
}

namespace pg8 {
#define PG8_LAS __attribute__((address_space(3)))
typedef unsigned short bf16_t;
constexpr int BM = 256, BK = 64, HALF = 128, HTB = HALF * BK * 2, STAGE_BYTES = 8 * HTB, NXCD = 8, WGM = 8;
__host__ __device__ __forceinline__ int lds_byte(int r, int c) { const int st = (r >> 4) * 2 + (c >> 5), rr = r & 15, cc = c & 31, ob = rr * 64 + cc * 2; return st * 1024 + (ob ^ (((ob >> 9) & 1) << 5)); }
__host__ __device__ __forceinline__ void stage_rc(int b, int& R, int& C) { const int st = b / 1024, sb = b % 1024, swz = sb ^ (((sb >> 9) & 1) << 5); R = (st >> 1) * 16 + swz / 64; C = (st & 1) * 32 + (swz % 64) / 2; }
__host__ __device__ __forceinline__ int perm32(int rho) { const int n = rho >> 4, i = rho & 15; return 8 * (i >> 2) + 4 * n + (i & 3); }
struct Unit { int pm, pn; };
struct Gemm { const bf16_t* A; const bf16_t* Bt; int M, N, K; };
struct StaticOrder {
    int nM, nN, nwg, G, c;
    __host__ __device__ void init(int M, int N, int G_, int c_) { nM = M / BM; nN = N / BM; nwg = nM * nN; G = G_; c = c_; }
    __host__ __device__ bool next(int i, Unit& u) const {
        const long L = (long)i * G + c; if (L >= nwg) return false;
        int wgid = (int)L; { const int q = nwg / NXCD, r = nwg % NXCD, xcd = wgid % NXCD, off = wgid / NXCD; wgid = (xcd < r ? xcd * (q + 1) : r * (q + 1) + (xcd - r) * q) + off; }
        const int nig = WGM * nN, gid = wgid / nig, fm = gid * WGM, gsz = (nM - fm) < WGM ? (nM - fm) : WGM;
        u.pm = fm + ((wgid % nig) % gsz); u.pn = (wgid % nig) / gsz; return true;
    }
    __device__ __forceinline__ void a_ready(const Unit&) const {}
    __device__ __forceinline__ void done(const Unit&) const {}
};

template <class Epi, class Sched>
__device__ __forceinline__ void gemm_phase(PG8_LAS unsigned char* lds, const Gemm g, const Sched& S, const Epi& E) {
    const int tid = threadIdx.x, wid = __builtin_amdgcn_readfirstlane(tid >> 6), lane = tid & 63, wr = wid >> 2, wc = wid & 3, fr = lane & 15, fq = lane >> 4;
    const int K = g.K, nt = K / BK;
    unsigned voffA[2], voffB[2];
#pragma unroll
    for (int i = 0; i < 2; ++i) { int R, C; stage_rc(tid * 16 + i * 8192, R, C); const int Rb = Epi::PERM ? ((R >> 5) * 64 + perm32(R & 31)) : R;
        voffA[i] = (unsigned)(R * K + C) * 2u; voffB[i] = (unsigned)(Rb * K + C) * 2u; }
    const size_t kstep = (size_t)(BK * 2);
    const size_t hstep = (size_t)HALF * K * 2;
    const size_t hstepB = Epi::PERM ? (size_t)32 * K * 2 : hstep;
    const size_t tstep = 2 * hstep;
    const unsigned ldsw = (unsigned)wid * 1024u;
    const int aoff = lds_byte(wr * 64 + fr, fq * 8), boff = lds_byte(wc * 32 + fr, fq * 8);
#define PG8_SA(b, h) (((b) * 2 + (h)) * HTB)
#define PG8_SB(b, h) ((4 + (b) * 2 + (h)) * HTB)
#define PG8_STAGE(bufoff, gbase, voff) do { _Pragma("unroll") for (int _i = 0; _i < 2; ++_i) \
        __builtin_amdgcn_global_load_lds((const unsigned*)((const char*)(gbase) + (voff)[_i]), (PG8_LAS unsigned*)(lds + (bufoff) + ldsw + _i * 8192), 16, 0, 0); } while (0)
#define PG8_LDA(dst, b, h) do { _Pragma("unroll") for (int m = 0; m < 4; ++m) _Pragma("unroll") for (int k = 0; k < 2; ++k) dst[m][k] = *(const PG8_LAS bf16x8*)(lds + PG8_SA(b, h) + aoff + m * 2048 + k * 1024); } while (0)
#define PG8_LDB(dst, b, h) do { _Pragma("unroll") for (int n = 0; n < 2; ++n) _Pragma("unroll") for (int k = 0; k < 2; ++k) dst[n][k] = *(const PG8_LAS bf16x8*)(lds + PG8_SB(b, h) + boff + n * 2048 + k * 1024); } while (0)
#define PG8_MMA(ai, bj, At, Bt) do { __builtin_amdgcn_s_setprio(1); _Pragma("unroll") for (int m = 0; m < 4; ++m) _Pragma("unroll") for (int n = 0; n < 2; ++n) _Pragma("unroll") for (int k = 0; k < 2; ++k) \
        acc[ai][bj][m][n] = __builtin_amdgcn_mfma_f32_16x16x32_bf16(Bt[n][k], At[m][k], acc[ai][bj][m][n], 0, 0, 0); __builtin_amdgcn_s_setprio(0); } while (0)
#define PG8_WAIT_V(n) asm volatile("s_waitcnt vmcnt(" #n ")" ::: "memory")
#define PG8_WAIT_L(n) asm volatile("s_waitcnt lgkmcnt(" #n ")" ::: "memory")
#define PG8_BAR __builtin_amdgcn_s_barrier()
#define PG8_SCHED __builtin_amdgcn_sched_barrier(0)
    Unit cur, nxt; int ui = 0;
    if (!S.next(0, cur)) return;
    f32x4 acc[2][2][4][2];
#pragma unroll
    for (int a = 0; a < 2; ++a)
#pragma unroll
        for (int b = 0; b < 2; ++b)
#pragma unroll
            for (int m = 0; m < 4; ++m)
#pragma unroll
                for (int n = 0; n < 2; ++n) acc[a][b][m][n] = (f32x4){0.f, 0.f, 0.f, 0.f};
    bf16x8 At[4][2], B0[2][2], B1[2][2];
    const char* cA = (const char*)g.A + (size_t)cur.pm * tstep; const char* cB = (const char*)g.Bt + (size_t)cur.pn * tstep;
    S.a_ready(cur);
    PG8_STAGE(PG8_SB(0, 0), cB, voffB); PG8_STAGE(PG8_SA(0, 0), cA, voffA); PG8_STAGE(PG8_SB(0, 1), cB + hstepB, voffB); PG8_STAGE(PG8_SA(0, 1), cA + hstep, voffA);
    if (wr == 1) PG8_BAR;
    PG8_WAIT_V(4); PG8_BAR;
    PG8_STAGE(PG8_SB(1, 0), cB + kstep, voffB); PG8_STAGE(PG8_SA(1, 0), cA + kstep, voffA); PG8_STAGE(PG8_SB(1, 1), cB + hstepB + kstep, voffB);
    PG8_WAIT_V(6); PG8_BAR;
    for (;;) {
        const bool has_next = S.next(ui + 1, nxt);
        const char* nA = has_next ? (const char*)g.A + (size_t)nxt.pm * tstep : cA; const char* nB = has_next ? (const char*)g.Bt + (size_t)nxt.pn * tstep : cB;
        E.prefetch(cur, wid, lane, lds + STAGE_BYTES + wid * 1024);
        for (int t = 0; t < nt; t += 2) {
            const bool last = (t == nt - 2);
            const char* a1 = cA + (size_t)(t + 1) * kstep;
            const char* a2 = last ? nA : cA + (size_t)(t + 2) * kstep; const char* b2 = last ? nB : cB + (size_t)(t + 2) * kstep;
            const char* a3 = a2 + kstep; const char* b3 = b2 + kstep;
            if (last && has_next) S.a_ready(nxt);
            PG8_LDB(B0, 0, 0); PG8_SCHED; PG8_LDA(At, 0, 0); PG8_STAGE(PG8_SA(1, 1), a1 + hstep, voffA);
            PG8_WAIT_L(8); PG8_BAR; PG8_WAIT_L(0); PG8_MMA(0, 0, At, B0); PG8_BAR; PG8_SCHED;
            PG8_LDB(B1, 0, 1); PG8_STAGE(PG8_SB(0, 0), b2, voffB);
            PG8_BAR; PG8_WAIT_L(0); PG8_MMA(0, 1, At, B1); PG8_BAR;
            PG8_LDA(At, 0, 1); PG8_STAGE(PG8_SA(0, 0), a2, voffA);
            PG8_BAR; PG8_WAIT_L(0); PG8_MMA(1, 0, At, B0); PG8_BAR; PG8_SCHED;
            PG8_STAGE(PG8_SB(0, 1), b2 + hstepB, voffB);
            PG8_WAIT_V(6); PG8_BAR; PG8_MMA(1, 1, At, B1); PG8_BAR;
            PG8_LDB(B0, 1, 0); PG8_SCHED; PG8_LDA(At, 1, 0); PG8_STAGE(PG8_SA(0, 1), a2 + hstep, voffA);
            PG8_WAIT_L(8); PG8_BAR; PG8_WAIT_L(0); PG8_MMA(0, 0, At, B0); PG8_BAR; PG8_SCHED;
            PG8_LDB(B1, 1, 1); PG8_STAGE(PG8_SB(1, 0), b3, voffB);
            PG8_BAR; PG8_WAIT_L(0); PG8_MMA(0, 1, At, B1); PG8_BAR;
            PG8_LDA(At, 1, 1); PG8_STAGE(PG8_SA(1, 0), a3, voffA);
            PG8_BAR; PG8_WAIT_L(0); PG8_MMA(1, 0, At, B0); PG8_BAR; PG8_SCHED;
            PG8_STAGE(PG8_SB(1, 1), b3 + hstepB, voffB);
            PG8_WAIT_V(6); PG8_BAR; PG8_MMA(1, 1, At, B1); PG8_BAR;
        }
        if constexpr (!Epi::AFTER_DRAIN) { E(acc, cur, wr, wc, fr, fq); S.done(cur); }
        if (!has_next) break;
#pragma unroll
        for (int a = 0; a < 2; ++a)
#pragma unroll
            for (int b = 0; b < 2; ++b)
#pragma unroll
                for (int m = 0; m < 4; ++m)
#pragma unroll
                    for (int n = 0; n < 2; ++n) acc[a][b][m][n] = (f32x4){0.f, 0.f, 0.f, 0.f};
        cur = nxt; cA = nA; cB = nB; ++ui;
    }
    PG8_WAIT_V(0);
    if (wr == 0) PG8_BAR;
    PG8_BAR;
    if constexpr (Epi::AFTER_DRAIN) { E.fused(acc, cur, wr, wc, fr, fq); S.done(cur); }
#undef PG8_SA
#undef PG8_SB
#undef PG8_STAGE
#undef PG8_LDA
#undef PG8_LDB
#undef PG8_MMA
#undef PG8_WAIT_V
#undef PG8_WAIT_L
#undef PG8_BAR
#undef PG8_SCHED
}
}

struct KArgs {
    const float* in[18];
    float* out;
    unsigned char* ws;
    int ph_lo, ph_hi;
    int cg_sync, pad;
};
enum { I_XP = 0, I_XS, I_SPOOL, I_CK, I_CV, I_MEM, I_NORMG, I_WIN, I_POOLW, I_POOLSC, I_SGUNG, I_SGUW, I_SGUB, I_MEMNG, I_WKV, I_WDOWN, I_WOUT, I_NORMF };

struct P1Order {
    pg8::StaticOrder so; int G, c;
    __device__ void init(int G_, int c_) { so.init(MPR, INC, G_, c_); G = G_; c = c_; }
    __device__ bool next(int i, pg8::Unit& u) const {
        const long L = (long)i * G + c;
        if (L < so.nwg) return so.next(i, u);
        const int e = (int)(L - so.nwg); if (e >= 104) return false;
        if (e < 64) { u.pm = NPAN + (e >> 3); u.pn = 40 + (e & 7); } else { u.pm = 64; u.pn = e - 64; }
        return true;
    }
    __device__ __forceinline__ void a_ready(const pg8::Unit&) const {}
    __device__ __forceinline__ void done(const pg8::Unit&) const {}
};
struct EpiProj {
    static constexpr bool PERM = true, AFTER_DRAIN = false;
    bf16* proj; bf16* gate; float* vss; bf16* kb; bf16* vb; float* out; const float* hs; bf16* dsr;
    __device__ __forceinline__ void prefetch(const pg8::Unit&, int, int, LAS unsigned char*) const {}
    __device__ __forceinline__ void operator()(const f32x4 (&acc)[2][2][4][2], const pg8::Unit& u, int wr, int wc, int fr, int fq) const {
        if (u.pn < 40) {
            const int sec = u.pn >> 2;
            const int act = (sec == 1 || sec == 4 || sec == 6) ? 1 : (sec >= 7 ? 2 : 0);
            const int row0 = u.pm * 256 + wr * 64 + fr, cs0 = (u.pn & 3) * 256 + wc * 64 + 8 * fq;
            bf16* base; int ld;
            if (sec < 7) { base = proj + (size_t)sec * MP * DM; ld = DM; } else { base = gate + (sec - 7) * DM; ld = 3 * DM; }
            const bool poolrows = (sec == 0) && (((u.pm & 7) == 7) || u.pm == 64);
#pragma unroll
            for (int ai = 0; ai < 2; ++ai)
#pragma unroll
                for (int m = 0; m < 4; ++m) {
                    const int r = row0 + ai * 128 + m * 16; float ss = 0.f;
#pragma unroll
                    for (int bj = 0; bj < 2; ++bj) {
                        f32x4 v0 = acc[ai][bj][m][0], v1 = acc[ai][bj][m][1]; const int cs = cs0 + bj * 32;
                        if (sec == 3) ss += (v0[0] * v0[0] + v0[1] * v0[1]) + (v0[2] * v0[2] + v0[3] * v0[3]) + (v1[0] * v1[0] + v1[1] * v1[1]) + (v1[2] * v1[2] + v1[3] * v1[3]);
                        if (poolrows) {
                            float* dst = nullptr;
                            if (r < MPR) { const int t = r & (SEQ - 1); if (t >= SEQ - 15) dst = out + O_POOLP + ((size_t)(r >> 11) * 15 + (t - (SEQ - 15))) * DM + cs; }
                            else if (r < MV) { dst = out + O_POOLS + ((size_t)(r - MPR) * 15 + 14) * DM + cs;
                                const float* hp = hs + (size_t)(r - MPR) * DM + cs; const f32x4 h0 = *(const f32x4*)hp, h1 = *(const f32x4*)(hp + 4); const float inv = 1.f / (float)(2 << (cs >> 8));
                                u32x4 d; d.x = pk2((h0.x + v0[0]) * inv - v0[0], (h0.y + v0[1]) * inv - v0[1]); d.y = pk2((h0.z + v0[2]) * inv - v0[2], (h0.w + v0[3]) * inv - v0[3]);
                                d.z = pk2((h1.x + v1[0]) * inv - v1[0], (h1.y + v1[1]) * inv - v1[1]); d.w = pk2((h1.z + v1[2]) * inv - v1[2], (h1.w + v1[3]) * inv - v1[3]);
                                *(u32x4*)(dsr + (size_t)(r - MPR) * DM + cs) = d; }
                            if (dst) { *(f32x4*)dst = v0; *(f32x4*)(dst + 4) = v1; }
                        }
                        if (act == 1) {
#pragma unroll
                            for (int j = 0; j < 4; ++j) { v0[j] = silu_f(v0[j]); v1[j] = silu_f(v1[j]); } }
                        if (act == 2) {
#pragma unroll
                            for (int j = 0; j < 4; ++j) { v0[j] = sigm_f(v0[j]); v1[j] = sigm_f(v1[j]); } }
                        u32x4 w; w.x = pk2(v0[0], v0[1]); w.y = pk2(v0[2], v0[3]); w.z = pk2(v1[0], v1[1]); w.w = pk2(v1[2], v1[3]);
                        __builtin_nontemporal_store(w, (u32x4*)(base + (size_t)r * ld + cs));
                    }
                    if (sec == 3) { ss += __shfl_xor(ss, 16); ss += __shfl_xor(ss, 32); if (fq == 0) vss[(size_t)r * 16 + (u.pn & 3) * 4 + wc] = ss; }
                }
        } else {
            const int b = u.pm - NPAN, ct = (u.pn - 40) * 256;
            const bool isv = ct >= DM; const int cb = (isv ? ct - DM : ct) + wc * 64 + 8 * fq;
            float* of = out + (isv ? O_MV : O_MK); bf16* ob = isv ? vb : kb;
#pragma unroll
            for (int ai = 0; ai < 2; ++ai)
#pragma unroll
                for (int m = 0; m < 4; ++m) {
                    const size_t j = (size_t)b * 256 + ai * 128 + wr * 64 + m * 16 + fr;
#pragma unroll
                    for (int bj = 0; bj < 2; ++bj) {
                        const f32x4 v0 = acc[ai][bj][m][0], v1 = acc[ai][bj][m][1]; const int cs = cb + bj * 32;
                        __builtin_nontemporal_store(v0, (f32x4*)(of + j * DM + cs)); __builtin_nontemporal_store(v1, (f32x4*)(of + j * DM + cs + 4));
                        u32x4 w; w.x = pk2(v0[0], v0[1]); w.y = pk2(v0[2], v0[3]); w.z = pk2(v1[0], v1[1]); w.w = pk2(v1[2], v1[3]);
                        *(u32x4*)(ob + j * DM + cs) = w;
                    }
                }
        }
    }
};
struct P3Order {
    pg8::StaticOrder so;
    __device__ void init(int G_, int c_) { so.init(MPR, DM, G_, c_); }
    __device__ bool next(int i, pg8::Unit& u) const { const int rnd = i / 3, b = i - 3 * rnd; pg8::Unit t; if (!so.next(rnd, t)) return false; u.pm = b * NPAN + t.pm; u.pn = b * 4 + t.pn; return true; }
    __device__ __forceinline__ void a_ready(const pg8::Unit&) const {}
    __device__ __forceinline__ void done(const pg8::Unit&) const {}
};
struct EpiGate {
    static constexpr bool PERM = true, AFTER_DRAIN = false;
    const bf16* gate; bf16* mg;
    __device__ __forceinline__ void prefetch(const pg8::Unit& u, int wid, int lane, LAS unsigned char* scr) const {
        const int b = u.pn >> 2, pm = u.pm - b * NPAN, t = wid * 64 + lane;
#pragma unroll
        for (int j = 0; j < 2; ++j) { const int li = t + 512 * j, row = li >> 2, seg = li & 3; const size_t r = (size_t)(pm * 256 + row);
            __builtin_amdgcn_global_load_lds((const unsigned*)(gate + r * (3 * DM) + b * DM + (u.pn & 3) * 256 + seg * 64), (LAS unsigned*)(scr + j * 256), 4, 0, 0); }
    }
    __device__ __forceinline__ void operator()(const f32x4 (&acc)[2][2][4][2], const pg8::Unit& u, int wr, int wc, int fr, int fq) const {
        const int b = u.pn >> 2, pm = u.pm - b * NPAN;
        const int row0 = pm * 256 + wr * 64 + fr, c0 = (u.pn & 3) * 256 + wc * 64 + 8 * fq;
#pragma unroll
        for (int ai = 0; ai < 2; ++ai) {
            u32x4 g8[4][2], p8[4][2];
#pragma unroll
            for (int m = 0; m < 4; ++m)
#pragma unroll
                for (int bj = 0; bj < 2; ++bj) { const size_t r = (size_t)(row0 + ai * 128 + m * 16); const int c = c0 + bj * 32;
                    g8[m][bj] = *(const u32x4*)(gate + r * (3 * DM) + b * DM + c);
                    p8[m][bj] = (u32x4){0u, 0u, 0u, 0u}; if (b > 0) p8[m][bj] = *(const u32x4*)(mg + r * DM + c); }
            asm volatile("" ::: "memory");
#pragma unroll
            for (int m = 0; m < 4; ++m)
#pragma unroll
                for (int bj = 0; bj < 2; ++bj) { const size_t r = (size_t)(row0 + ai * 128 + m * 16); const int c = c0 + bj * 32;
                    const f32x4 v0 = acc[ai][bj][m][0], v1 = acc[ai][bj][m][1]; const u32x4 gq = g8[m][bj], p = p8[m][bj];
                    const float o0 = v0[0] * bflo(gq.x) + bflo(p.x), o1 = v0[1] * bfhi(gq.x) + bfhi(p.x), o2 = v0[2] * bflo(gq.y) + bflo(p.y), o3 = v0[3] * bfhi(gq.y) + bfhi(p.y);
                    const float o4 = v1[0] * bflo(gq.z) + bflo(p.z), o5 = v1[1] * bfhi(gq.z) + bfhi(p.z), o6 = v1[2] * bflo(gq.w) + bflo(p.w), o7 = v1[3] * bfhi(gq.w) + bfhi(p.w);
                    u32x4 w; w.x = pk2(o0, o1); w.y = pk2(o2, o3); w.z = pk2(o4, o5); w.w = pk2(o6, o7);
                    if (b == 2) __builtin_nontemporal_store(w, (u32x4*)(mg + r * DM + c)); else *(u32x4*)(mg + r * DM + c) = w; }
        }
    }
};
__device__ __forceinline__ void st_agent(float* p, float v) { __hip_atomic_store((unsigned*)p, __builtin_bit_cast(unsigned, v), __ATOMIC_RELAXED, __HIP_MEMORY_SCOPE_AGENT); }
__device__ __forceinline__ float ld_agent(const float* p) { return __builtin_bit_cast(float, __hip_atomic_load((unsigned*)p, __ATOMIC_RELAXED, __HIP_MEMORY_SCOPE_AGENT)); }
__device__ __forceinline__ void wait_count(unsigned* w, unsigned want) {
    unsigned sp = 0;
    while ((unsigned)__builtin_amdgcn_readfirstlane(__hip_atomic_load(w, __ATOMIC_RELAXED, __HIP_MEMORY_SCOPE_AGENT)) < want) { __builtin_amdgcn_s_sleep(2); if (++sp > (1u << 22)) break; }
    __builtin_amdgcn_fence(__ATOMIC_ACQUIRE, "agent");
    asm volatile("s_waitcnt vmcnt(0)" ::: "memory");
}
struct EpiOutNorm {
    static constexpr bool PERM = false, AFTER_DRAIN = true;
    const float* xp; const float* gf; float* out; float* slots; unsigned* cnt;
    __device__ __forceinline__ void prefetch(const pg8::Unit& u, int wid, int lane, LAS unsigned char* scr) const {
        const int t = wid * 64 + lane;
#pragma unroll
        for (int j = 0; j < 4; ++j) { const int li = t + 512 * j, row = li >> 3, seg = li & 7;
            __builtin_amdgcn_global_load_lds((const unsigned*)(xp + (size_t)(u.pm * 256 + row) * DM + u.pn * 256 + seg * 32), (LAS unsigned*)(scr + j * 256), 4, 0, 0); }
    }
    __device__ __forceinline__ void operator()(const f32x4 (&)[2][2][4][2], const pg8::Unit&, int, int, int, int) const {}
    __device__ __forceinline__ void fused(f32x4 (&acc)[2][2][4][2], const pg8::Unit& u, int wr, int wc, int fr, int fq) const {
        const int row0 = u.pm * 256 + wr * 64 + fr, col0 = u.pn * 256 + wc * 32 + 4 * fq;
#pragma unroll
        for (int ai = 0; ai < 2; ++ai)
#pragma unroll
            for (int m = 0; m < 4; ++m) { const size_t r = (size_t)(row0 + ai * 128 + m * 16); float ss = 0.f;
#pragma unroll
                for (int bj = 0; bj < 2; ++bj)
#pragma unroll
                    for (int n = 0; n < 2; ++n) { const int c = col0 + bj * 128 + n * 16; const f32x4 v = acc[ai][bj][m][n] + __builtin_nontemporal_load((const f32x4*)(xp + r * DM + c)); acc[ai][bj][m][n] = v;
                        ss += (v.x * v.x + v.y * v.y) + (v.z * v.z + v.w * v.w); }
                ss += __shfl_xor(ss, 16); ss += __shfl_xor(ss, 32);
                if (fq == 0) st_agent(slots + r * 16 + u.pn * 4 + wc, ss); }
        asm volatile("s_waitcnt vmcnt(0)" ::: "memory");
        if (fr == 0 && fq == 0) __hip_atomic_fetch_add(cnt + 64 * u.pm, 1u, __ATOMIC_RELAXED, __HIP_MEMORY_SCOPE_AGENT);
        if (threadIdx.x < 64) wait_count(cnt + 64 * u.pm, 32u);
        __syncthreads();
#pragma unroll
        for (int ai = 0; ai < 2; ++ai)
#pragma unroll
            for (int m = 0; m < 4; ++m) { const size_t r = (size_t)(row0 + ai * 128 + m * 16); float tot = 0.f;
                { const f32x4* sp = (const f32x4*)(slots + r * 16); const f32x4 p0 = sp[0], p1 = sp[1], p2 = sp[2], p3 = sp[3];
                  tot = (((p0.x + p0.y) + (p0.z + p0.w)) + ((p1.x + p1.y) + (p1.z + p1.w))) + (((p2.x + p2.y) + (p2.z + p2.w)) + ((p3.x + p3.y) + (p3.z + p3.w))); }
                const float rs = rsqrtf(tot * (1.f / DM) + EPS);
#pragma unroll
                for (int bj = 0; bj < 2; ++bj)
#pragma unroll
                    for (int n = 0; n < 2; ++n) { const int c = col0 + bj * 128 + n * 16; const f32x4 g = *(const f32x4*)(gf + c); const f32x4 v = acc[ai][bj][m][n];
                        __builtin_nontemporal_store((f32x4){v.x * rs * g.x, v.y * rs * g.y, v.z * rs * g.z, v.w * rs * g.w}, (f32x4*)(out + O_YP + r * DM + c)); } }
    }
};

template <class Epi>
__device__ __forceinline__ void skinny_gemm(LAS unsigned char* lds, const bf16* A0, int lda, size_t a_grp_stride, int strips_per_grp, int nseg, int aseg,
                                            const bf16* Bt, int ldb, int K, int nstrips, int first, int step, const Epi& E) {
    int tid_ = threadIdx.x; asm volatile("" : "+v"(tid_));
    const int tid = tid_, lane = tid & 63, wv = tid >> 6, fr = lane & 15, fq = lane >> 4, rh = wv & 1, kq = wv >> 1;
    LAS float* part = (LAS float*)lds;
    const int nks = K / 128;
    for (int s = first; s < nstrips; s += step) {
        const bf16* A = A0 + (size_t)(s / strips_per_grp) * a_grp_stride + (size_t)(rh * 64 + fr) * lda + fq * 8;
        const bf16* B = Bt + (size_t)(16 * s + fr) * ldb + fq * 8;
        f32x4 acc[4];
#pragma unroll
        for (int rb = 0; rb < 4; ++rb) acc[rb] = (f32x4){0.f, 0.f, 0.f, 0.f};
        for (int seg = 0; seg < nseg; ++seg) {
#pragma unroll 4
            for (int k = 0; k < nks; ++k) {
                const int ko = (kq * nks + k) * 32;
                const bf16x8 bfr = *(const bf16x8*)(B + ko);
#pragma unroll
                for (int rb = 0; rb < 4; ++rb) { const bf16x8 afr = *(const bf16x8*)(A + (size_t)rb * 16 * lda + seg * aseg + ko);
                    acc[rb] = __builtin_amdgcn_mfma_f32_16x16x32_bf16(bfr, afr, acc[rb], 0, 0, 0); }
            }
        }
#pragma unroll
        for (int rb = 0; rb < 4; ++rb) *(LAS f32x4*)(part + ((kq * 128 + rh * 64 + rb * 16 + fr) * 16 + fq * 4)) = acc[rb];
        __syncthreads();
        { const int row = tid >> 2, cq = tid & 3; const LAS float* p = part + row * 16 + cq * 4;
          const f32x4 v = (*(const LAS f32x4*)p + *(const LAS f32x4*)(p + 2048)) + (*(const LAS f32x4*)(p + 4096) + *(const LAS f32x4*)(p + 6144));
          E(s, row, 16 * s + cq * 4, v, cq); }
        __syncthreads();
    }
}
struct EpiS1 {
    bf16* proj; bf16* gate; float* vss2; float* out; const float* hist; bf16* ds;
    __device__ __forceinline__ void operator()(int s, int row, int c, f32x4 v, int cq) const {
        const int sec = c >> 10, cs = c & 1023; const size_t m = (size_t)(MPR + row);
        if (sec == 0) { *(f32x4*)(out + O_POOLS + ((size_t)row * 15 + 14) * DM + cs) = v;
            const int w = 2 << (cs >> 8); f32x4 sm = v;
#pragma unroll
            for (int j = 0; j < 15; ++j) if (j < w - 1) sm = sm + *(const f32x4*)(hist + ((size_t)row * 15 + 14 - j) * DM + cs);
            const float inv = 1.f / (float)w;
            u32x2 d; d.x = pk2(sm.x * inv - v.x, sm.y * inv - v.y); d.y = pk2(sm.z * inv - v.z, sm.w * inv - v.w);
            *(u32x2*)(ds + (size_t)row * DM + cs) = d; }
        if (sec == 3) { float ss = (v.x * v.x + v.y * v.y) + (v.z * v.z + v.w * v.w); ss += __shfl_xor(ss, 1); ss += __shfl_xor(ss, 2); if (cq == 0) vss2[row * 64 + (s - 192)] = ss; }
        if (sec == 1 || sec == 4 || sec == 6) { v.x = silu_f(v.x); v.y = silu_f(v.y); v.z = silu_f(v.z); v.w = silu_f(v.w); }
        if (sec >= 7) { v.x = sigm_f(v.x); v.y = sigm_f(v.y); v.z = sigm_f(v.z); v.w = sigm_f(v.w); }
        u32x2 w; w.x = pk2(v.x, v.y); w.y = pk2(v.z, v.w);
        if (sec < 7) *(u32x2*)(proj + (size_t)sec * MP * DM + m * DM + cs) = w; else *(u32x2*)(gate + m * (3 * DM) + (sec - 7) * DM + cs) = w;
    }
};
struct EpiS3 {
    const bf16* gate; bf16* gys;
    __device__ __forceinline__ void operator()(int s, int row, int c, f32x4 v, int cq) const {
        const u32x2 g = *(const u32x2*)(gate + (size_t)(MPR + row) * (3 * DM) + c);
        u32x2 w; w.x = pk2(v.x * bflo(g.x), v.y * bfhi(g.x)); w.y = pk2(v.z * bflo(g.y), v.w * bfhi(g.y));
        *(u32x2*)(gys + (size_t)row * (3 * DM) + c) = w;
    }
};
struct EpiS4 {
    const float* xs; const float* gf; float* out; float* slots2; unsigned* cnt2;
    __device__ __forceinline__ void operator()(int s, int row, int c, f32x4 v, int cq) const {
        v = v + *(const f32x4*)(xs + (size_t)row * DM + c);
        float ss = (v.x * v.x + v.y * v.y) + (v.z * v.z + v.w * v.w); ss += __shfl_xor(ss, 1); ss += __shfl_xor(ss, 2);
        if (cq == 0) st_agent(slots2 + row * 64 + s, ss);
        asm volatile("s_waitcnt vmcnt(0)" ::: "memory");
        __syncthreads();
        if (threadIdx.x == 0) __hip_atomic_fetch_add(cnt2, 1u, __ATOMIC_RELAXED, __HIP_MEMORY_SCOPE_AGENT);
        if (threadIdx.x < 64) wait_count(cnt2, 64u);
        __syncthreads();
        float tot = 0.f;
        { const f32x4* sp = (const f32x4*)(slots2 + row * 64 + cq * 16); const f32x4 p0 = sp[0], p1 = sp[1], p2 = sp[2], p3 = sp[3];
          tot = (((p0.x + p0.y) + (p0.z + p0.w)) + ((p1.x + p1.y) + (p1.z + p1.w))) + (((p2.x + p2.y) + (p2.z + p2.w)) + ((p3.x + p3.y) + (p3.z + p3.w))); }
        tot += __shfl_xor(tot, 1); tot += __shfl_xor(tot, 2);
        const float rs = rsqrtf(tot * (1.f / DM) + EPS); const f32x4 g = *(const f32x4*)(gf + c);
        *(f32x4*)(out + O_YS + (size_t)row * DM + c) = (f32x4){v.x * rs * g.x, v.y * rs * g.y, v.z * rs * g.z, v.w * rs * g.w};
    }
};


__device__ __forceinline__ void sample_out_split(const KArgs& a, LAS unsigned char* lds, int item) {
    int tid_ = threadIdx.x; asm volatile("" : "+v"(tid_));
    const int tid = tid_, lane = tid & 63, wv = tid >> 6, fr = lane & 15, fq = lane >> 4, s = item >> 2, rq = item & 3;
    const bf16* A = (const bf16*)(a.ws + WS_GYS) + (size_t)(rq * 32 + fr) * (3 * DM) + fq * 8;
    const bf16* B = (const bf16*)(a.ws + WS_WO3) + (size_t)(16 * s + fr) * DM + fq * 8;
    f32x4 acc0 = (f32x4){0.f, 0.f, 0.f, 0.f}, acc1 = acc0;
#pragma unroll
    for (int kk = 0; kk < 12; ++kk) { const int k = 384 * wv + 32 * kk;
        const bf16x8 bfr = *(const bf16x8*)(B + (k & 1023)); const bf16x8 a0 = *(const bf16x8*)(A + k), a1 = *(const bf16x8*)(A + (size_t)16 * (3 * DM) + k);
        acc0 = __builtin_amdgcn_mfma_f32_16x16x32_bf16(bfr, a0, acc0, 0, 0, 0); acc1 = __builtin_amdgcn_mfma_f32_16x16x32_bf16(bfr, a1, acc1, 0, 0, 0); }
    LAS float* part = (LAS float*)lds;
    *(LAS f32x4*)(part + (wv * 32 + fr) * 16 + fq * 4) = acc0; *(LAS f32x4*)(part + (wv * 32 + 16 + fr) * 16 + fq * 4) = acc1;
    __syncthreads();
    const int row = tid >> 4, col = tid & 15, grow = rq * 32 + row, c = 16 * s + col;
    float v = 0.f;
#pragma unroll
    for (int w8 = 0; w8 < 8; ++w8) v += part[(w8 * 32 + row) * 16 + col];
    v += a.in[I_XS][(size_t)grow * DM + c];
    float ss = v * v; ss += __shfl_xor(ss, 1); ss += __shfl_xor(ss, 2); ss += __shfl_xor(ss, 4); ss += __shfl_xor(ss, 8);
    float* slots2 = (float*)(a.ws + WS_VSS2); unsigned* cnt = (unsigned*)(a.ws + WS_CTL) + CW_SAMPLE + 64 * rq;
    if (col == 0) st_agent(slots2 + grow * 64 + s, ss);
    asm volatile("s_waitcnt vmcnt(0)" ::: "memory");
    __syncthreads();
    if (tid == 0) __hip_atomic_fetch_add(cnt, 1u, __ATOMIC_RELAXED, __HIP_MEMORY_SCOPE_AGENT);
    if (tid < 64) wait_count(cnt, 64u);
    __syncthreads();
    const f32x4 p4 = *(const f32x4*)(slots2 + grow * 64 + col * 4);
    float tot = (p4.x + p4.y) + (p4.z + p4.w); tot += __shfl_xor(tot, 1); tot += __shfl_xor(tot, 2); tot += __shfl_xor(tot, 4); tot += __shfl_xor(tot, 8);
    a.out[O_YS + (size_t)grow * DM + c] = v * rsqrtf(tot * (1.f / DM) + EPS) * a.in[I_NORMF][c];
    __syncthreads();
}

__device__ __forceinline__ void p0_transpose_item(const float* W, int N, bf16* WT, int row_off, int ldo, int koff, LAS float* scr, int item, int lane) {
    const int nblk = N / 32, kb = item / nblk, nb = item % nblk, k0 = 64 * kb, n0 = 32 * nb;
    float wv_[32];
#pragma unroll
    for (int i = 0; i < 32; ++i) { const int kk = 2 * i + (lane >> 5); wv_[i] = __builtin_nontemporal_load(W + (size_t)(k0 + kk) * N + n0 + (lane & 31)); }
#pragma unroll
    for (int i = 0; i < 32; ++i) { const int kk = 2 * i + (lane >> 5); scr[kk * 33 + (lane & 31)] = wv_[i]; }
    asm volatile("s_waitcnt lgkmcnt(0)" ::: "memory");
    const int c = lane & 7;
#pragma unroll
    for (int j = 0; j < 4; ++j) { const int n = (lane >> 3) + 8 * j; const LAS float* s = scr + (8 * c) * 33 + n;
        u32x4 o; o.x = pk2(s[0 * 33], s[1 * 33]); o.y = pk2(s[2 * 33], s[3 * 33]); o.z = pk2(s[4 * 33], s[5 * 33]); o.w = pk2(s[6 * 33], s[7 * 33]);
        *(u32x4*)(WT + (size_t)(row_off + n0 + n) * ldo + koff + k0 + 8 * c) = o; }
    asm volatile("s_waitcnt lgkmcnt(0)" ::: "memory");
}
__device__ __forceinline__ void rms_row_to_bf16(const float* xrow, const float* gain, bf16* orow, int lane) {
    const f32x4* xr = (const f32x4*)xrow + lane; const f32x4* gr = (const f32x4*)gain + lane;
    f32x4 v[4]; float s = 0.f;
#pragma unroll
    for (int j = 0; j < 4; ++j) { v[j] = xr[64 * j]; s += (v[j].x * v[j].x + v[j].y * v[j].y) + (v[j].z * v[j].z + v[j].w * v[j].w); }
    const float rs = rsqrtf(wave_sum(s) * (1.f / DM) + EPS);
    u32x2* o8 = (u32x2*)orow + lane;
#pragma unroll
    for (int j = 0; j < 4; ++j) { const f32x4 g = gr[64 * j]; u32x2 w; w.x = pk2(v[j].x * rs * g.x, v[j].y * rs * g.y); w.y = pk2(v[j].z * rs * g.z, v[j].w * rs * g.w); o8[64 * j] = w; }
}
__device__ __forceinline__ void rms_row2_to_bf16(const float* x0, const float* x1, const float* gain, bf16* o0, bf16* o1, int lane) {
    const f32x4* xr0 = (const f32x4*)x0 + lane; const f32x4* xr1 = (const f32x4*)x1 + lane; const f32x4* gr = (const f32x4*)gain + lane;
    f32x4 v[4], w[4]; float s = 0.f, t = 0.f;
#pragma unroll
    for (int j = 0; j < 4; ++j) { v[j] = __builtin_nontemporal_load(xr0 + 64 * j); w[j] = __builtin_nontemporal_load(xr1 + 64 * j); }
#pragma unroll
    for (int j = 0; j < 4; ++j) { s += (v[j].x * v[j].x + v[j].y * v[j].y) + (v[j].z * v[j].z + v[j].w * v[j].w); t += (w[j].x * w[j].x + w[j].y * w[j].y) + (w[j].z * w[j].z + w[j].w * w[j].w); }
#pragma unroll
    for (int o = 1; o < 64; o <<= 1) { s += __shfl_xor(s, o); t += __shfl_xor(t, o); }
    const float rs = rsqrtf(s * (1.f / DM) + EPS), rt = rsqrtf(t * (1.f / DM) + EPS);
    u32x2* p0 = (u32x2*)o0 + lane; u32x2* p1 = (u32x2*)o1 + lane;
#pragma unroll
    for (int j = 0; j < 4; ++j) { const f32x4 g = gr[64 * j]; u32x2 a; a.x = pk2(v[j].x * rs * g.x, v[j].y * rs * g.y); a.y = pk2(v[j].z * rs * g.z, v[j].w * rs * g.w); p0[64 * j] = a;
        u32x2 b; b.x = pk2(w[j].x * rt * g.x, w[j].y * rt * g.y); b.y = pk2(w[j].z * rt * g.z, w[j].w * rt * g.w); p1[64 * j] = b; }
}
__device__ __forceinline__ void p0_prologue(const KArgs& a, LAS unsigned char* lds, int G) {
    const int tid = threadIdx.x, lane = tid & 63, wave = tid >> 6;
    LAS float* scr = (LAS float*)(lds + wave * 16384);
    const int gw = blockIdx.x * 8 + wave, NGW = G * 8;
    bf16* H = (bf16*)(a.ws + WS_H); bf16* WinT = (bf16*)(a.ws + WS_WIN); bf16* WdT = (bf16*)(a.ws + WS_WD); bf16* Wo3 = (bf16*)(a.ws + WS_WO3);
    bf16* PwT = (bf16*)(a.ws + WS_PW); bf16* SW = (bf16*)(a.ws + WS_SW);
    constexpr int I_IN = 16 * (INC / 32), I_KV = 16 * (2048 / 32), I_D = 16 * 32, I_O = 16 * 32, I_P = 4 * 8;
    constexpr int NITEMS = I_IN + I_KV + 3 * I_D + I_O + 4 * I_P;
    for (int it = gw; it < NITEMS; it += NGW) {
        int r = it;
        if (r < I_IN) { p0_transpose_item(a.in[I_WIN], INC, WinT, 0, DM, 0, scr, r, lane); continue; } r -= I_IN;
        if (r < I_KV) { p0_transpose_item(a.in[I_WKV], 2048, WinT, INC, DM, 0, scr, r, lane); continue; } r -= I_KV;
        if (r < 3 * I_D) { const int b = r / I_D; p0_transpose_item(a.in[I_WDOWN] + (size_t)b * DM * DM, DM, WdT, b * DM, DM, 0, scr, r % I_D, lane); continue; } r -= 3 * I_D;
        if (r < I_O) { p0_transpose_item(a.in[I_WOUT], DM, Wo3, 0, DM, 0, scr, r, lane); continue; } r -= I_O;
        { const int g = r / I_P; p0_transpose_item(a.in[I_POOLW] + (size_t)g * 256 * 256, 256, PwT, g * 256, 256, 0, scr, r % I_P, lane); }
    }
    for (int m = gw; m + NGW < MPR; m += 2 * NGW)
        rms_row2_to_bf16(a.in[I_XP] + (size_t)m * DM, a.in[I_XP] + (size_t)(m + NGW) * DM, a.in[I_NORMG], H + (size_t)m * DM, H + (size_t)(m + NGW) * DM, lane);
    const int mdone = (MPR / (2 * NGW)) * (2 * NGW);
    for (int m = mdone + gw; m < MP + 2048; m += NGW) {
        bf16* orow = H + (size_t)m * DM;
        if (m < MPR) rms_row_to_bf16(a.in[I_XP] + (size_t)m * DM, a.in[I_NORMG], orow, lane);
        else if (m < MV) rms_row_to_bf16(a.in[I_XS] + (size_t)(m - MPR) * DM, a.in[I_NORMG], orow, lane);
        else if (m < MP) { u32x2* o8 = (u32x2*)orow + lane;
#pragma unroll
            for (int j = 0; j < 4; ++j) o8[64 * j] = (u32x2){0u, 0u}; }
        else rms_row_to_bf16(a.in[I_MEM] + (size_t)(m - MP) * DM, a.in[I_MEMNG], orow, lane);
    }
    const size_t gt = (size_t)blockIdx.x * 512 + tid, NGT = (size_t)G * 512;
    for (size_t i = gt; i < (size_t)4 * 128 * 128; i += NGT) { const int s = (int)(i & 127), t = (int)((i >> 7) & 127); SW[i] = (bf16)(s <= t ? f2bf(a.in[I_SGUW][i]) : 0u); }
    for (size_t i = gt; i < (size_t)NS * 256; i += NGT) { const size_t smp = i >> 8, c = (i & 255) * 4; const int w = 2 << (int)(c >> 8); f32x4 sm = (f32x4){0.f, 0.f, 0.f, 0.f};
#pragma unroll
        for (int j = 0; j < 15; ++j) if (j < w - 1) sm = sm + *(const f32x4*)(a.in[I_SPOOL] + (smp * 15 + 14 - j) * DM + c);
        *(f32x4*)((float*)(a.ws + WS_HS) + smp * DM + c) = sm; }
    for (size_t i = gt; i < (size_t)NS * 14 * 256; i += NGT) { const size_t smp = i / (14 * 256), rem = i % (14 * 256), r = rem / 256, c4 = rem % 256;
        __builtin_nontemporal_store(*(const f32x4*)(a.in[I_SPOOL] + (smp * 15 + r + 1) * DM + c4 * 4), (f32x4*)(a.out + O_POOLS + (smp * 15 + r) * DM + c4 * 4)); }
}

constexpr int RSV = 544;
constexpr int RS = 528;
__device__ __forceinline__ void pool_part(const KArgs& a, LAS unsigned char* lds, int rt, int g) {
    int tid_ = threadIdx.x; asm volatile("" : "+v"(tid_));
    const int tid = tid_, lane = tid & 63, wv = tid >> 6, fr = lane & 15, fq = lane >> 4;
    const int m0 = rt * 128, w = 2 << g;
    const bf16* PIN = (const bf16*)(a.ws + WS_PROJ); const bf16* PZ = PIN + (size_t)MP * DM;
    const bf16* PwT = (const bf16*)(a.ws + WS_PW); bf16* BR0 = (bf16*)(a.ws + WS_BR);
    LAS unsigned char* Pb = lds; LAS unsigned char* Db = lds + 75520;
    u32x4 zf[8]; f32x4 scv[2]; bf16x8 Bf[2][8];
    const bf16* pw = PwT + (size_t)(g * 256 + wv * 32 + 8 * (fr >> 2) + (fr & 3)) * 256 + fq * 8;
    if (rt < 128) {
        const int t0 = (rt & 15) * 128;
        u32x4 tv[9];
#pragma unroll
        for (int i = 0; i < 9; ++i) { const int idx = tid + i * 512, row = idx >> 5, ch = idx & 31; tv[i] = (u32x4){0u, 0u, 0u, 0u};
            if (idx < 143 * 32 && !(t0 == 0 && row < 15)) tv[i] = *(const u32x4*)(PIN + (size_t)(m0 - 15 + row) * DM + g * 256 + ch * 8); }
#pragma unroll
        for (int rb = 0; rb < 8; ++rb) zf[rb] = __builtin_nontemporal_load((const u32x4*)(PZ + (size_t)(m0 + rb * 16 + fr) * DM + g * 256 + wv * 32 + 8 * fq));
#pragma unroll
        for (int nn = 0; nn < 2; ++nn) { scv[nn] = *(const f32x4*)(a.in[I_POOLSC] + g * 256 + wv * 32 + 8 * fq + 4 * nn);
#pragma unroll
            for (int ks = 0; ks < 8; ++ks) Bf[nn][ks] = *(const bf16x8*)(pw + nn * 4 * 256 + ks * 32); }
#pragma unroll
        for (int i = 0; i < 9; ++i) { const int idx = tid + i * 512, row = idx >> 5, ch = idx & 31; if (idx < 143 * 32) *(LAS u32x4*)(Pb + row * RS + ch * 16) = tv[i]; }
        __syncthreads();
        {
            const int ch = tid & 31, r0 = (tid >> 5) * 8;
            float s0 = 0.f, s1 = 0.f, s2 = 0.f, s3 = 0.f, s4 = 0.f, s5 = 0.f, s6 = 0.f, s7 = 0.f;
            for (int j = 1; j < w; ++j) { const u32x4 v = *(const LAS u32x4*)(Pb + (r0 + 15 - j) * RS + ch * 16);
                s0 += bflo(v.x); s1 += bfhi(v.x); s2 += bflo(v.y); s3 += bfhi(v.y); s4 += bflo(v.z); s5 += bfhi(v.z); s6 += bflo(v.w); s7 += bfhi(v.w); }
#pragma unroll
            for (int i = 0; i < 8; ++i) { const int r = r0 + i;
                const u32x4 own = *(const LAS u32x4*)(Pb + (r + 15) * RS + ch * 16); const u32x4 old = *(const LAS u32x4*)(Pb + (r + 16 - w) * RS + ch * 16);
                s0 += bflo(own.x); s1 += bfhi(own.x); s2 += bflo(own.y); s3 += bfhi(own.y); s4 += bflo(own.z); s5 += bfhi(own.z); s6 += bflo(own.w); s7 += bfhi(own.w);
                const int cnt = min(w, t0 + r + 1); const float inv = 1.f / (float)cnt;
                u32x4 d; d.x = pk2(s0 * inv - bflo(own.x), s1 * inv - bfhi(own.x)); d.y = pk2(s2 * inv - bflo(own.y), s3 * inv - bfhi(own.y));
                d.z = pk2(s4 * inv - bflo(own.z), s5 * inv - bfhi(own.z)); d.w = pk2(s6 * inv - bflo(own.w), s7 * inv - bfhi(own.w));
                *(LAS u32x4*)(Db + r * RS + ch * 16) = d;
                s0 -= bflo(old.x); s1 -= bfhi(old.x); s2 -= bflo(old.y); s3 -= bfhi(old.y); s4 -= bflo(old.z); s5 -= bfhi(old.z); s6 -= bflo(old.w); s7 -= bfhi(old.w); }
        }
    } else {
#pragma unroll
        for (int rb = 0; rb < 8; ++rb) zf[rb] = __builtin_nontemporal_load((const u32x4*)(PZ + (size_t)(m0 + rb * 16 + fr) * DM + g * 256 + wv * 32 + 8 * fq));
#pragma unroll
        for (int nn = 0; nn < 2; ++nn) { scv[nn] = *(const f32x4*)(a.in[I_POOLSC] + g * 256 + wv * 32 + 8 * fq + 4 * nn);
#pragma unroll
            for (int ks = 0; ks < 8; ++ks) Bf[nn][ks] = *(const bf16x8*)(pw + nn * 4 * 256 + ks * 32); }
        const bf16* DS = (const bf16*)(a.ws + WS_DS);
        u32x4 td[8];
#pragma unroll
        for (int i = 0; i < 8; ++i) { const int idx = tid + i * 512, r = idx >> 5, ch = idx & 31; td[i] = *(const u32x4*)(DS + (size_t)r * DM + g * 256 + ch * 8); }
#pragma unroll
        for (int i = 0; i < 8; ++i) { const int idx = tid + i * 512, r = idx >> 5, ch = idx & 31; *(LAS u32x4*)(Db + r * RS + ch * 16) = td[i]; }
    }
    __syncthreads();
#pragma unroll
    for (int rb = 0; rb < 8; ++rb) {
        f32x4 acc0 = (f32x4){0.f, 0.f, 0.f, 0.f}, acc1 = acc0;
#pragma unroll
        for (int ks = 0; ks < 8; ++ks) { const bf16x8 A = *(const LAS bf16x8*)(Db + (rb * 16 + fr) * RS + (ks * 32 + fq * 8) * 2);
            acc0 = __builtin_amdgcn_mfma_f32_16x16x32_bf16(Bf[0][ks], A, acc0, 0, 0, 0); acc1 = __builtin_amdgcn_mfma_f32_16x16x32_bf16(Bf[1][ks], A, acc1, 0, 0, 0); }
        const size_t m = (size_t)(m0 + rb * 16 + fr); const int c = g * 256 + wv * 32 + 8 * fq; const u32x4 z = zf[rb];
        u32x4 o; o.x = pk2(acc0[0] * scv[0].x * bflo(z.x), acc0[1] * scv[0].y * bfhi(z.x)); o.y = pk2(acc0[2] * scv[0].z * bflo(z.y), acc0[3] * scv[0].w * bfhi(z.y));
        o.z = pk2(acc1[0] * scv[1].x * bflo(z.z), acc1[1] * scv[1].y * bfhi(z.z)); o.w = pk2(acc1[2] * scv[1].z * bflo(z.w), acc1[3] * scv[1].w * bfhi(z.w));
        *(u32x4*)(BR0 + m * DM + c) = o;
    }
    __syncthreads();
}
__device__ __forceinline__ void sgu_part(const KArgs& a, LAS unsigned char* lds, int rt, int g) {
    int tid_ = threadIdx.x; asm volatile("" : "+v"(tid_));
    const int tid = tid_, lane = tid & 63, wv = tid >> 6, fr = lane & 15, fq = lane >> 4;
    const int m0 = rt * 128;
    const bf16* U = (const bf16*)(a.ws + WS_PROJ) + (size_t)2 * MP * DM; const bf16* V = U + (size_t)MP * DM; const bf16* SZ = V + (size_t)MP * DM;
    const bf16* SW = (const bf16*)(a.ws + WS_SW); const float* VSS = (const float*)(a.ws + WS_VSS); bf16* BR1 = (bf16*)(a.ws + WS_BR) + (size_t)MP * DM;
    LAS unsigned char* Vb = lds; LAS unsigned char* UZb = lds + 128 * RS; LAS float* rbuf = (LAS float*)(lds + 256 * RS);
    u32x4 tv[8], tu[8], tz[8];
#pragma unroll
    for (int i = 0; i < 8; ++i) { const int idx = tid + i * 512, s = idx >> 5, ch = idx & 31; const size_t o = (size_t)(m0 + s) * DM + g * 256 + ch * 8;
        tv[i] = __builtin_nontemporal_load((const u32x4*)(V + o)); tu[i] = __builtin_nontemporal_load((const u32x4*)(U + o)); tz[i] = __builtin_nontemporal_load((const u32x4*)(SZ + o)); }
    if (tid < 128) { const f32x4* p = (const f32x4*)(VSS + (size_t)(m0 + tid) * 16); const f32x4 p0 = p[0], p1 = p[1], p2 = p[2], p3 = p[3];
        const float s = ((p0.x + p0.y) + (p0.z + p0.w)) + ((p1.x + p1.y) + (p1.z + p1.w)) + ((p2.x + p2.y) + (p2.z + p2.w)) + ((p3.x + p3.y) + (p3.z + p3.w));
        rbuf[tid] = rsqrtf(s * (1.f / DM) + EPS); }
    const f32x4 gv0 = *(const f32x4*)(a.in[I_SGUNG] + g * 256 + wv * 32 + 8 * fq), gv1 = *(const f32x4*)(a.in[I_SGUNG] + g * 256 + wv * 32 + 8 * fq + 4);
    float biasv[8];
#pragma unroll
    for (int tb = 0; tb < 8; ++tb) biasv[tb] = a.in[I_SGUB][g * 128 + tb * 16 + fr];
    __syncthreads();
#pragma unroll
    for (int i = 0; i < 8; ++i) { const int idx = tid + i * 512, s = idx >> 5, ch = idx & 31; const float r = rbuf[s];
        u32x4 v; v.x = pk2(bflo(tv[i].x) * r, bfhi(tv[i].x) * r); v.y = pk2(bflo(tv[i].y) * r, bfhi(tv[i].y) * r); v.z = pk2(bflo(tv[i].z) * r, bfhi(tv[i].z) * r); v.w = pk2(bflo(tv[i].w) * r, bfhi(tv[i].w) * r);
        *(LAS u32x4*)(Vb + s * RS + ch * 16) = v;
        u32x4 q; q.x = pk2(bflo(tu[i].x) * bflo(tz[i].x), bfhi(tu[i].x) * bfhi(tz[i].x)); q.y = pk2(bflo(tu[i].y) * bflo(tz[i].y), bfhi(tu[i].y) * bfhi(tz[i].y));
        q.z = pk2(bflo(tu[i].z) * bflo(tz[i].z), bfhi(tu[i].z) * bfhi(tz[i].z)); q.w = pk2(bflo(tu[i].w) * bflo(tz[i].w), bfhi(tu[i].w) * bfhi(tz[i].w));
        *(LAS u32x4*)(UZb + s * RS + ch * 16) = q; }
    __syncthreads();
    const int q = fr >> 2, p = fr & 3;
    bf16x8 Vf[4][2];
#pragma unroll
    for (int ks = 0; ks < 4; ++ks)
#pragma unroll
        for (int nn = 0; nn < 2; ++nn) { const LAS unsigned char* a0 = Vb + (32 * ks + 8 * fq + q) * RS + (wv * 32 + 8 * p + 4 * nn) * 2; Vf[ks][nn] = tr_read2(a0, a0 + 4 * RS); }
#pragma unroll
    for (int tb = 0; tb < 8; ++tb) {
        f32x4 acc0 = (f32x4){0.f, 0.f, 0.f, 0.f}, acc1 = acc0;
        const int t = tb * 16 + fr;
#pragma unroll
        for (int ks = 0; ks < 4; ++ks) if (ks <= (tb >> 1)) {
            const bf16x8 A = *(const bf16x8*)(SW + (size_t)(g * 128 + t) * 128 + ks * 32 + fq * 8);
            acc0 = __builtin_amdgcn_mfma_f32_16x16x32_bf16(Vf[ks][0], A, acc0, 0, 0, 0); acc1 = __builtin_amdgcn_mfma_f32_16x16x32_bf16(Vf[ks][1], A, acc1, 0, 0, 0);
        }
        const size_t m = (size_t)(m0 + t); const float bias = biasv[tb];
        { const int cl = wv * 32 + 8 * fq; const u32x4 uz = *(const LAS u32x4*)(UZb + t * RS + cl * 2);
          u32x4 o; o.x = pk2((acc0[0] * gv0.x + bias) * bflo(uz.x), (acc0[1] * gv0.y + bias) * bfhi(uz.x)); o.y = pk2((acc0[2] * gv0.z + bias) * bflo(uz.y), (acc0[3] * gv0.w + bias) * bfhi(uz.y));
          o.z = pk2((acc1[0] * gv1.x + bias) * bflo(uz.z), (acc1[1] * gv1.y + bias) * bfhi(uz.z)); o.w = pk2((acc1[2] * gv1.z + bias) * bflo(uz.w), (acc1[3] * gv1.w + bias) * bfhi(uz.w));
          *(u32x4*)(BR1 + m * DM + g * 256 + cl) = o; }
    }
    __syncthreads();
}
__device__ __forceinline__ void attn_part(const KArgs& a, LAS unsigned char* lds, int rt, int g) {
    int tid_ = threadIdx.x; asm volatile("" : "+v"(tid_));
    const int tid = tid_, lane = tid & 63, wv = tid >> 6, fr = lane & 15, fq = lane >> 4;
    const int m0 = rt * 128, b = rt >> 4;
    const bf16* Q = (const bf16*)(a.ws + WS_PROJ) + (size_t)5 * MP * DM; const bf16* AZ = Q + (size_t)MP * DM;
    const bf16* KB = (const bf16*)(a.ws + WS_KB); const bf16* VB = (const bf16*)(a.ws + WS_VB); bf16* BR2 = (bf16*)(a.ws + WS_BR) + (size_t)2 * MP * DM;
    LAS unsigned char* Kb = lds;
    const size_t m = (size_t)(m0 + wv * 16 + fr);
    bf16x8 Qf[8];
    {
        u32x4 tk[16];
#pragma unroll
        for (int i = 0; i < 16; ++i) { const int idx = tid + i * 512, key = idx >> 5, ch = idx & 31; tk[i] = *(const u32x4*)(KB + (size_t)(b * 256 + key) * DM + g * 256 + ch * 8); }
#pragma unroll
        for (int ks = 0; ks < 8; ++ks) Qf[ks] = __builtin_nontemporal_load((const bf16x8*)(Q + m * DM + g * 256 + ks * 32 + fq * 8));
#pragma unroll
        for (int i = 0; i < 16; ++i) { const int idx = tid + i * 512, key = idx >> 5, ch = idx & 31; *(LAS u32x4*)(Kb + key * RS + ch * 16) = tk[i]; }
    }
    __syncthreads();
    u32x4 tvv[16];
#pragma unroll
    for (int i = 0; i < 16; ++i) { const int idx = tid + i * 512, key = idx >> 5, ch = idx & 31; tvv[i] = *(const u32x4*)(VB + (size_t)(b * 256 + key) * DM + g * 256 + ch * 8); }
    f32x4 sacc[16];
#pragma unroll
    for (int kb = 0; kb < 16; ++kb) { sacc[kb] = (f32x4){0.f, 0.f, 0.f, 0.f};
#pragma unroll
        for (int ks = 0; ks < 8; ++ks) { const bf16x8 Kf = *(const LAS bf16x8*)(Kb + (kb * 16 + fr) * RS + (ks * 32 + fq * 8) * 2);
            sacc[kb] = __builtin_amdgcn_mfma_f32_16x16x32_bf16(Kf, Qf[ks], sacc[kb], 0, 0, 0); }
        if (kb & 1) __builtin_amdgcn_sched_barrier(0); }
    float mx = -3.0e38f;
#pragma unroll
    for (int kb = 0; kb < 16; ++kb) mx = fmaxf(mx, fmaxf(fmaxf(sacc[kb][0], sacc[kb][1]), fmaxf(sacc[kb][2], sacc[kb][3])));
    mx = fmaxf(mx, __shfl_xor(mx, 16)); mx = fmaxf(mx, __shfl_xor(mx, 32));
    float sum = 0.f;
#pragma unroll
    for (int kb = 0; kb < 16; ++kb)
#pragma unroll
        for (int j = 0; j < 4; ++j) { const float pj = __expf((sacc[kb][j] - mx) * 0.0625f); sacc[kb][j] = pj; sum += pj; }
    sum += __shfl_xor(sum, 16); sum += __shfl_xor(sum, 32);
    const float isum = 1.f / sum;
    bf16x8 Pf[8];
#pragma unroll
    for (int k2 = 0; k2 < 8; ++k2) { u32x4 w; w.x = pk2(sacc[2 * k2][0], sacc[2 * k2][1]); w.y = pk2(sacc[2 * k2][2], sacc[2 * k2][3]);
        w.z = pk2(sacc[2 * k2 + 1][0], sacc[2 * k2 + 1][1]); w.w = pk2(sacc[2 * k2 + 1][2], sacc[2 * k2 + 1][3]); Pf[k2] = __builtin_bit_cast(bf16x8, w); }
    __syncthreads();
#pragma unroll
    for (int i = 0; i < 16; ++i) { const int idx = tid + i * 512, key = idx >> 5, ch = idx & 31; *(LAS u32x4*)(Kb + key * RSV + ch * 16) = tvv[i]; }
    u32x4 zf[8];
#pragma unroll
    for (int d2 = 0; d2 < 8; ++d2) zf[d2] = __builtin_nontemporal_load((const u32x4*)(AZ + m * DM + g * 256 + d2 * 32 + 8 * fq));
    __syncthreads();
    const int q = fr >> 2, p = fr & 3;
#pragma unroll
    for (int d2 = 0; d2 < 8; ++d2) {
        f32x4 o0 = (f32x4){0.f, 0.f, 0.f, 0.f}, o1 = o0;
#pragma unroll
        for (int k2 = 0; k2 < 8; ++k2) { const LAS unsigned char* a0 = Kb + (32 * k2 + 4 * fq + q) * RSV + (d2 * 32 + 8 * p) * 2;
            const bf16x8 Vf0 = tr_read2(a0, a0 + 16 * RSV), Vf1 = tr_read2(a0 + 8, a0 + 8 + 16 * RSV);
            o0 = __builtin_amdgcn_mfma_f32_16x16x32_bf16(Vf0, Pf[k2], o0, 0, 0, 0); o1 = __builtin_amdgcn_mfma_f32_16x16x32_bf16(Vf1, Pf[k2], o1, 0, 0, 0); }
        const int c = g * 256 + d2 * 32 + 8 * fq; const u32x4 z = zf[d2];
        u32x4 w; w.x = pk2(o0[0] * isum * bflo(z.x), o0[1] * isum * bfhi(z.x)); w.y = pk2(o0[2] * isum * bflo(z.y), o0[3] * isum * bfhi(z.y));
        w.z = pk2(o1[0] * isum * bflo(z.z), o1[1] * isum * bfhi(z.z)); w.w = pk2(o1[2] * isum * bflo(z.w), o1[3] * isum * bfhi(z.w));
        *(u32x4*)(BR2 + m * DM + c) = w;
        __builtin_amdgcn_sched_barrier(0);
    }
    __syncthreads();
}
__device__ __forceinline__ void sgu_sample(const KArgs& a, int g, int rb) {
    int tid_ = threadIdx.x; asm volatile("" : "+v"(tid_));
    const int tid = tid_;
    const bf16* U = (const bf16*)(a.ws + WS_PROJ) + (size_t)2 * MP * DM; const bf16* V = U + (size_t)MP * DM; const bf16* SZ = V + (size_t)MP * DM;
    const float* VSS = (const float*)(a.ws + WS_VSS); bf16* BR1 = (bf16*)(a.ws + WS_BR) + (size_t)MP * DM;
    const float w00 = a.in[I_SGUW][(size_t)g * 128 * 128], b0 = a.in[I_SGUB][g * 128];
    for (int idx = tid; idx < 16 * 64; idx += 512) {
        const int i = rb * 16 + (idx >> 6), c = g * 256 + (idx & 63) * 4; const size_t m = (size_t)(MPR + i);
        const float s = wave_sum((idx & 63) < 16 ? VSS[m * 16 + (idx & 63)] : 0.f);
        const float rs = rsqrtf(s * (1.f / DM) + EPS);
        const f32x4 gv = *(const f32x4*)(a.in[I_SGUNG] + c);
        const u32x2 v4 = *(const u32x2*)(V + m * DM + c), u4 = *(const u32x2*)(U + m * DM + c), z = *(const u32x2*)(SZ + m * DM + c);
        f32x4 vn; vn.x = bflo(v4.x) * rs * gv.x; vn.y = bfhi(v4.x) * rs * gv.y; vn.z = bflo(v4.y) * rs * gv.z; vn.w = bfhi(v4.y) * rs * gv.w;
        *(f32x4*)(a.out + O_SV + (size_t)i * DM + c) = vn;
        u32x2 o; o.x = pk2(bflo(u4.x) * (w00 * vn.x + b0) * bflo(z.x), bfhi(u4.x) * (w00 * vn.y + b0) * bfhi(z.x));
        o.y = pk2(bflo(u4.y) * (w00 * vn.z + b0) * bflo(z.y), bfhi(u4.y) * (w00 * vn.w + b0) * bfhi(z.y));
        *(u32x2*)(BR1 + m * DM + c) = o;
    }
}
__device__ __forceinline__ void attn_sample(const KArgs& a, LAS unsigned char* lds, int i, int h) {
    int tid_ = threadIdx.x; asm volatile("" : "+v"(tid_));
    const int tid = tid_, lane = tid & 63, wv = tid >> 6;
    const bf16* Q = (const bf16*)(a.ws + WS_PROJ) + (size_t)5 * MP * DM; const bf16* AZ = Q + (size_t)MP * DM; bf16* BR2 = (bf16*)(a.ws + WS_BR) + (size_t)2 * MP * DM;
    const size_t m = (size_t)(MPR + i);
    const float* Kc = a.in[I_CK] + ((size_t)i * NMEM * 4 + h) * 256 + lane * 4;
    const float* Vc = a.in[I_CV] + ((size_t)i * NMEM * 4 + h) * 256 + lane * 4;
    LAS float* sc = (LAS float*)lds; LAS float* part = (LAS float*)(lds + 1024);
    const u32x2 q2 = *(const u32x2*)(Q + m * DM + h * 256 + lane * 4);
    const f32x4 qv = (f32x4){bflo(q2.x), bfhi(q2.x), bflo(q2.y), bfhi(q2.y)};
    {
        f32x4 kv[32]; float pd[32];
#pragma unroll
        for (int j = 0; j < 32; ++j) kv[j] = __builtin_nontemporal_load((const f32x4*)(Kc + (size_t)(wv * 32 + j) * 1024));
#pragma unroll
        for (int j = 0; j < 32; ++j) pd[j] = (kv[j].x * qv.x + kv[j].y * qv.y) + (kv[j].z * qv.z + kv[j].w * qv.w);
#pragma unroll
        for (int j = 0; j < 32; ++j) { const float d = wave_sum(pd[j]); if (lane == 0) sc[wv * 32 + j] = d * 0.0625f; }
    }
    f32x4 vv[32];
#pragma unroll
    for (int j = 0; j < 32; ++j) vv[j] = __builtin_nontemporal_load((const f32x4*)(Vc + (size_t)(wv * 32 + j) * 1024));
    __syncthreads();
    const f32x4 s4 = *(const LAS f32x4*)(sc + lane * 4);
    const float mx = wave_max(fmaxf(fmaxf(s4.x, s4.y), fmaxf(s4.z, s4.w)));
    const float sum = wave_sum((__expf(s4.x - mx) + __expf(s4.y - mx)) + (__expf(s4.z - mx) + __expf(s4.w - mx)));
    f32x4 o = (f32x4){0.f, 0.f, 0.f, 0.f};
#pragma unroll
    for (int j = 0; j < 32; ++j) { const float pj = __expf(sc[wv * 32 + j] - mx); o += vv[j] * pj; }
    *(LAS f32x4*)(part + wv * 256 + lane * 4) = o;
    __syncthreads();
    if (tid < 256) { float t = 0.f;
#pragma unroll
        for (int w8 = 0; w8 < 8; ++w8) t += part[w8 * 256 + tid];
        const int c = h * 256 + tid; const unsigned short zb = AZ[m * DM + c]; const float z = __builtin_bit_cast(float, (unsigned)zb << 16);
        BR2[m * DM + c] = (bf16)f2bf(t / sum * z); }
    __syncthreads();
}
__device__ __forceinline__ void p2_mixers(const KArgs& a, LAS unsigned char* lds, int G) {
    constexpr int NU = 512 + 512 + 4 + 32;
    if (G == 256) {
        const int c = blockIdx.x;
        for (int k = 0; k < 4; ++k) { const int kk = (c & 1) ? (k ^ 2) : k;
            if (kk < 2) { const int u = c + kk * 256, rt = u >> 2, g = u & 3; pool_part(a, lds, rt, g); sgu_part(a, lds, rt, g); attn_part(a, lds, rt, g); }
            else { const int e = c + (kk - 2) * 256; attn_sample(a, lds, e >> 2, e & 3); } }
        if (c < 4) pool_part(a, lds, 128, c); else if (c >= 8 && c < 40) sgu_sample(a, (c - 8) >> 3, (c - 8) & 7);
        return;
    }
    for (int u = blockIdx.x; u < NU; u += G) {
        if (u < 512) { const int rt = u >> 2, g = u & 3; pool_part(a, lds, rt, g); sgu_part(a, lds, rt, g); attn_part(a, lds, rt, g); }
        else if (u < 1024) { const int e = u - 512; attn_sample(a, lds, e >> 2, e & 3); }
        else if (u < 1028) pool_part(a, lds, 128, u - 1024);
        else sgu_sample(a, (u - 1028) >> 3, (u - 1028) & 7);
    }
}
__device__ __forceinline__ void p5_norm(const KArgs& a, int G) {
    const int tid = threadIdx.x, lane = tid & 63, wave = tid >> 6;
    const int gw = blockIdx.x * 8 + wave, NGW = G * 8;
    const f32x4* gr = (const f32x4*)a.in[I_NORMF] + lane;
    for (int m = gw; m < MV; m += NGW) {
        f32x4* xr = (f32x4*)(a.out + (size_t)m * DM) + lane;
        f32x4 v[4]; float s = 0.f;
#pragma unroll
        for (int j = 0; j < 4; ++j) { v[j] = xr[64 * j]; s += (v[j].x * v[j].x + v[j].y * v[j].y) + (v[j].z * v[j].z + v[j].w * v[j].w); }
        const float rs = rsqrtf(wave_sum(s) * (1.f / DM) + EPS);
#pragma unroll
        for (int j = 0; j < 4; ++j) { const f32x4 g = gr[64 * j]; xr[64 * j] = (f32x4){v[j].x * rs * g.x, v[j].y * rs * g.y, v[j].z * rs * g.z, v[j].w * rs * g.w}; }
    }
}

__global__ void __launch_bounds__(512, 2) fwd_megakernel(KArgs a) {
    extern __shared__ __attribute__((aligned(16))) unsigned char lds_raw[];
    LAS unsigned char* lds = (LAS unsigned char*)lds_raw;
    cg::grid_group grid = cg::this_grid();
    const int G = gridDim.x;
    const int lo = a.ph_lo, hi = a.ph_hi;
    volatile LAS unsigned* bst = (volatile LAS unsigned*)(lds + LDS_BYTES - 64);
    if (threadIdx.x == 0) { bst[0] = 0u; bst[1] = 0u; }
    __syncthreads();
    const XcdBarrier bar = xcd_barrier_post((unsigned*)(a.ws + WS_CTL), bst);
#define IN(k) (lo <= (k) && (k) < hi)
#define SEAM(k) do { if (IN(k) && IN((k) + 1)) { if (a.cg_sync) grid.sync(); else xcd_barrier(bar); } } while (0)
    if (IN(0)) p0_prologue(a, lds, G);
    SEAM(0);
    if (IN(1)) {
        pg8::Gemm g{(const bf16*)(a.ws + WS_H), (const bf16*)(a.ws + WS_WIN), MP, INC, DM};
        P1Order S; S.init(G, (int)blockIdx.x);
        EpiProj E{(bf16*)(a.ws + WS_PROJ), (bf16*)(a.ws + WS_GATE), (float*)(a.ws + WS_VSS), (bf16*)(a.ws + WS_KB), (bf16*)(a.ws + WS_VB), a.out, (const float*)(a.ws + WS_HS), (bf16*)(a.ws + WS_DS)};
        pg8::gemm_phase<EpiProj, P1Order>(lds, g, S, E);
    }
    SEAM(1);
    if (IN(2)) p2_mixers(a, lds, G);
    SEAM(2);
    if (IN(3)) {
        pg8::Gemm g{(const bf16*)(a.ws + WS_BR), (const bf16*)(a.ws + WS_WD), MPR, 3 * DM, DM};
        P3Order S; S.init(G, (int)blockIdx.x);
        EpiGate E{(const bf16*)(a.ws + WS_GATE), (bf16*)(a.ws + WS_MG)};
        pg8::gemm_phase<EpiGate, P3Order>(lds, g, S, E);
        EpiS3 E3{(const bf16*)(a.ws + WS_GATE), (bf16*)(a.ws + WS_GYS)};
        skinny_gemm(lds, (const bf16*)(a.ws + WS_BR) + (size_t)MPR * DM, DM, (size_t)MP * DM, 64, 1, 0, (const bf16*)(a.ws + WS_WD), DM, DM, 192, (int)blockIdx.x, G, E3);
    }
    SEAM(3);
    if (IN(4)) {
        pg8::Gemm g{(const bf16*)(a.ws + WS_MG), (const bf16*)(a.ws + WS_WO3), MPR, DM, DM};
        pg8::StaticOrder S; S.init(MPR, DM, G, (int)blockIdx.x);
        unsigned* ctl = (unsigned*)(a.ws + WS_CTL);
        EpiOutNorm E{a.in[I_XP], a.in[I_NORMF], a.out, (float*)(a.ws + WS_VSS), ctl + CW_PANEL};
        pg8::gemm_phase<EpiOutNorm, pg8::StaticOrder>(lds, g, S, E);
        sample_out_split(a, lds, (int)blockIdx.x);
    }
#undef IN
#undef SEAM
}

extern "C" void kernel_launch(void* const* d_in, const int* in_sizes, int n_in, void* d_out, int out_size, void* d_ws, size_t ws_size, hipStream_t stream) {
    static int grid = 0;
    if (grid == 0) {
        if (n_in != 18 || (size_t)out_size != O_END || ws_size < WS_END) { fprintf(stderr, "kernel_launch: unexpected shapes (n_in %d out %d ws %zu, need %zu)\n", n_in, out_size, ws_size, (size_t)WS_END); grid = -1; return; }
        int dev = 0, cus = 0, per_cu = 0;
        hipGetDevice(&dev); hipDeviceGetAttribute(&cus, hipDeviceAttributeMultiprocessorCount, dev);
        if (hipFuncSetAttribute((const void*)fwd_megakernel, hipFuncAttributeMaxDynamicSharedMemorySize, LDS_BYTES) != hipSuccess) { fprintf(stderr, "kernel_launch: hipFuncSetAttribute failed\n"); grid = -1; return; }
        if (hipOccupancyMaxActiveBlocksPerMultiprocessor(&per_cu, (const void*)fwd_megakernel, 512, LDS_BYTES) != hipSuccess || per_cu < 1) { fprintf(stderr, "kernel_launch: occupancy query failed (%d)\n", per_cu); grid = -1; return; }
        if (cus != 256) { fprintf(stderr, "kernel_launch: built for a 256-CU device (one 256x256 tile per workgroup in the last two phases), got %d\n", cus); grid = -1; return; }
        grid = cus;
    }
    if (grid < 0) return;
    if (hipMemsetAsync((char*)d_ws + WS_CTL, 0, CTL_BYTES, stream) != hipSuccess) { fprintf(stderr, "kernel_launch: memset failed\n"); return; }
    KArgs a{};
    for (int i = 0; i < 18; ++i) a.in[i] = (const float*)d_in[i];
    a.out = (float*)d_out; a.ws = (unsigned char*)d_ws; a.ph_lo = 0; a.ph_hi = 5;
    void* args[] = {&a};
    hipError_t e = hipLaunchCooperativeKernel((const void*)fwd_megakernel, dim3(grid), dim3(512), args, LDS_BYTES, stream);
    if (e != hipSuccess) fprintf(stderr, "cooperative launch failed: %s (grid %d)\n", hipGetErrorString(e), grid);
}
```

```cpp
#include <hip/hip_runtime.h>
#include <hip/hip_cooperative_groups.h>
#include <cstdio>
#include <cstdint>
namespace cg = cooperative_groups;

#define LAS __attribute__((address_space(3)))
typedef unsigned short bf16;
typedef short bf16x8 __attribute__((ext_vector_type(8)));
typedef short s16x4 __attribute__((ext_vector_type(4)));
typedef float f32x4 __attribute__((ext_vector_type(4)));
typedef unsigned u32x4 __attribute__((ext_vector_type(4)));
typedef unsigned u32x2 __attribute__((ext_vector_type(2)));

constexpr int DM = 1024, NBATCH = 8, SEQ = 2048, NS = 128, NMEM = 256;
constexpr int MPR = NBATCH * SEQ;
constexpr int MV = MPR + NS;
constexpr int MP = MPR + 256;
constexpr int NPAN = MP / 256;
constexpr int INC = 10240;
constexpr float EPS = 1e-6f;
constexpr size_t O_YP = 0, O_YS = O_YP + (size_t)MPR * DM, O_POOLP = O_YS + (size_t)NS * DM, O_POOLS = O_POOLP + (size_t)NBATCH * 15 * DM,
                 O_MK = O_POOLS + (size_t)NS * 15 * DM, O_MV = O_MK + (size_t)NBATCH * NMEM * DM, O_SV = O_MV + (size_t)NBATCH * NMEM * DM, O_END = O_SV + (size_t)NS * DM;
constexpr size_t ROWB = (size_t)MP * DM * 2;
constexpr size_t WS_CTL = 0, CTL_BYTES = 40960;
constexpr size_t WS_VSS2 = CTL_BYTES;
constexpr size_t WS_DS = WS_VSS2 + 32768;
constexpr size_t WS_HS = WS_DS + 262144;
constexpr size_t WS_H = WS_HS + 524288;
constexpr size_t WS_WIN = WS_H + (size_t)(MP + 2048) * DM * 2;
constexpr size_t WS_WD = WS_WIN + (size_t)(INC + 2048) * DM * 2;
constexpr size_t WS_WO3 = WS_WD + (size_t)3 * DM * DM * 2;
constexpr size_t WS_PW = WS_WO3 + (size_t)3 * DM * DM * 2;
constexpr size_t WS_SW = WS_PW + (size_t)4 * 256 * 256 * 2;
constexpr size_t WS_VSS = WS_SW + (size_t)4 * 128 * 128 * 2;
constexpr size_t WS_KB = WS_VSS + (size_t)MP * 16 * 4;
constexpr size_t WS_VB = WS_KB + (size_t)2048 * DM * 2;
constexpr size_t WS_PROJ = WS_VB + (size_t)2048 * DM * 2;
constexpr size_t WS_GATE = WS_PROJ + 7 * ROWB;
constexpr size_t WS_BR = WS_GATE + 3 * ROWB;
constexpr size_t WS_MG = WS_PROJ;
constexpr size_t WS_GYS = WS_H;
constexpr size_t WS_END = WS_BR + 3 * ROWB;
constexpr int LDS_BYTES = 147456;
constexpr int CW_PANEL = 4096, CW_SAMPLE = 4096 + 64 * 64;

__device__ __forceinline__ unsigned f2bf(float f) { unsigned u = __builtin_bit_cast(unsigned, f); return (u + 0x7fffu + ((u >> 16) & 1u)) >> 16; }
__device__ __forceinline__ unsigned pk2(float lo, float hi) { unsigned r; asm volatile("v_cvt_pk_bf16_f32 %0, %1, %2" : "=v"(r) : "v"(lo), "v"(hi)); return r; }
__device__ __forceinline__ float bflo(unsigned w) { return __builtin_bit_cast(float, w << 16); }
__device__ __forceinline__ float bfhi(unsigned w) { return __builtin_bit_cast(float, w & 0xffff0000u); }
__device__ __forceinline__ float silu_f(float x) { return x * __builtin_amdgcn_rcpf(1.f + __expf(-x)); }
__device__ __forceinline__ float sigm_f(float x) { return __builtin_amdgcn_rcpf(1.f + __expf(-x)); }
__device__ __forceinline__ float wave_sum(float v) {
#pragma unroll
    for (int o = 1; o < 64; o <<= 1) v += __shfl_xor(v, o);
    return v;
}
__device__ __forceinline__ float wave_max(float v) {
#pragma unroll
    for (int o = 1; o < 64; o <<= 1) v = fmaxf(v, __shfl_xor(v, o));
    return v;
}
__device__ __forceinline__ bf16x8 tr_read2(const LAS unsigned char* a0, const LAS unsigned char* a1) {
    const s16x4 lo = __builtin_amdgcn_ds_read_tr16_b64_v4i16((LAS s16x4*)a0);
    const s16x4 hi = __builtin_amdgcn_ds_read_tr16_b64_v4i16((LAS s16x4*)a1);
    return (bf16x8){lo[0], lo[1], lo[2], lo[3], hi[0], hi[1], hi[2], hi[3]};
}

#define XB_TMO      128
#define XB_XCNT(j)  (256  + 64 * (j))
#define XB_XSUB(j)  (1280 + 64 * (j))
#define XB_XGEN(j)  (2304 + 64 * (j))
#define XB_TOP      3328
#define XB_TOPGEN   3392
#define XCD_BAR_WORDS 3456
#define XB_SPIN_CAP (1u << 18)

__device__ __forceinline__ unsigned xb_ld(unsigned* p)              { return __hip_atomic_load(p, __ATOMIC_RELAXED, __HIP_MEMORY_SCOPE_AGENT); }
__device__ __forceinline__ unsigned xb_add(unsigned* p, unsigned v) { return __hip_atomic_fetch_add(p, v, __ATOMIC_RELAXED, __HIP_MEMORY_SCOPE_AGENT); }
__device__ __forceinline__ unsigned xb_xcc_id() { return (unsigned)__builtin_amdgcn_s_getreg((3 << 11) | 20) & 0xFu; }
#define XB_SPIN(cond, bar) do { unsigned _sp = 0; while (cond) { __builtin_amdgcn_s_sleep(1); \
    if ((++_sp & 255u) == 0u) { if (xb_ld(&(bar)[XB_TMO])) break; if (_sp > XB_SPIN_CAP) { atomicAdd(&(bar)[XB_TMO], 1u); break; } } } } while (0)

struct XcdBarrier {
    unsigned* bar; unsigned x;
    volatile LAS unsigned* st;
};

__device__ __forceinline__ XcdBarrier xcd_barrier_post(unsigned* bar, volatile LAS unsigned* st) {
    XcdBarrier b; b.bar = bar; b.x = xb_xcc_id(); b.st = st;
    if (threadIdx.x == 0) (void)xb_add(&bar[XB_XCNT(b.x)], 1u);
    return b;
}
__device__ __forceinline__ void xcd_barrier_complete(unsigned* bar, unsigned x, unsigned& nloc, unsigned& nx) {
    const unsigned G = gridDim.x;
    unsigned sum, cnt, mine, sp = 0u;
    for (;;) {
        sum = 0u; cnt = 0u; mine = 0u;
#pragma unroll
        for (unsigned j = 0; j < 16; ++j) { const unsigned c = xb_ld(&bar[XB_XCNT(j)]); sum += c; cnt += (c > 0u) ? 1u : 0u; mine = (j == x) ? c : mine; }
        if (sum == G) break;
        __builtin_amdgcn_s_sleep(1);
        if ((++sp & 255u) == 0u) { if (xb_ld(&bar[XB_TMO])) break; if (sp > XB_SPIN_CAP) { atomicAdd(&bar[XB_TMO], 1u); break; } }
    }
    nloc = mine > 0u ? mine : 1u; nx = cnt > 0u ? cnt : 1u;
}

__device__ __forceinline__ void xcd_barrier(const XcdBarrier& b) {
    asm volatile("s_waitcnt vmcnt(0)" ::: "memory");
    __syncthreads();
    if (threadIdx.x == 0) {
        unsigned* bar = b.bar;
        __builtin_amdgcn_s_waitcnt(0);
        unsigned nloc = b.st[0], nx = b.st[1];
        if (nloc == 0u) { xcd_barrier_complete(bar, b.x, nloc, nx); b.st[0] = nloc; b.st[1] = nx; }
        const unsigned old = xb_add(&bar[XB_XSUB(b.x)], 1u);
        const unsigned gen = old / nloc;
        if (old + 1u == (gen + 1u) * nloc) {
            __builtin_amdgcn_fence(__ATOMIC_RELEASE, "agent");
            asm volatile("s_waitcnt vmcnt(0)" ::: "memory");
            const unsigned og = xb_add(&bar[XB_TOP], 1u);
            const unsigned tg = og / nx;
            if (og + 1u == (tg + 1u) * nx) xb_add(&bar[XB_TOPGEN], 1u);
            else XB_SPIN(xb_ld(&bar[XB_TOPGEN]) == tg, bar);
            __builtin_amdgcn_fence(__ATOMIC_ACQUIRE, "agent");
            xb_add(&bar[XB_XGEN(b.x)], 1u);
            asm volatile("s_waitcnt vmcnt(0)" ::: "memory");
        } else {
            XB_SPIN(xb_ld(&bar[XB_XGEN(b.x)]) == gen, bar);
            __builtin_amdgcn_fence(__ATOMIC_ACQUIRE, "agent");
            asm volatile("s_waitcnt vmcnt(0)" ::: "memory");
        }
    }
    __syncthreads();
}

namespace pg8 {
#define PG8_LAS __attribute__((address_space(3)))
typedef unsigned short bf16_t;
constexpr int BM = 256, BK = 64, HALF = 128, HTB = HALF * BK * 2, STAGE_BYTES = 8 * HTB, NXCD = 8, WGM = 8;
__host__ __device__ __forceinline__ int lds_byte(int r, int c) { const int st = (r >> 4) * 2 + (c >> 5), rr = r & 15, cc = c & 31, ob = rr * 64 + cc * 2; return st * 1024 + (ob ^ (((ob >> 9) & 1) << 5)); }
__host__ __device__ __forceinline__ void stage_rc(int b, int& R, int& C) { const int st = b / 1024, sb = b % 1024, swz = sb ^ (((sb >> 9) & 1) << 5); R = (st >> 1) * 16 + swz / 64; C = (st & 1) * 32 + (swz % 64) / 2; }
__host__ __device__ __forceinline__ int perm32(int rho) { const int n = rho >> 4, i = rho & 15; return 8 * (i >> 2) + 4 * n + (i & 3); }
struct Unit { int pm, pn; int brow, fz; };
struct Gemm { const bf16_t* A; const bf16_t* Bt; int M, N, K; };
struct StaticOrder {
    int nM, nN, nwg, G, c;
    __host__ __device__ void init(int M, int N, int G_, int c_) { nM = M / BM; nN = N / BM; nwg = nM * nN; G = G_; c = c_; }
    __host__ __device__ bool next(int i, Unit& u) const {
        const long L = (long)i * G + c; if (L >= nwg) return false;
        int wgid = (int)L; { const int q = nwg / NXCD, r = nwg % NXCD, xcd = wgid % NXCD, off = wgid / NXCD; wgid = (xcd < r ? xcd * (q + 1) : r * (q + 1) + (xcd - r) * q) + off; }
        const int nig = WGM * nN, gid = wgid / nig, fm = gid * WGM, gsz = (nM - fm) < WGM ? (nM - fm) : WGM;
        u.pm = fm + ((wgid % nig) % gsz); u.pn = (wgid % nig) / gsz; u.brow = u.pn * BM; u.fz = 0; return true;
    }
    __device__ __forceinline__ void a_ready(const Unit&) const {}
    __device__ __forceinline__ void done(const Unit&) const {}
};

template <class Epi, class Sched>
__device__ __forceinline__ void gemm_phase(PG8_LAS unsigned char* lds, const Gemm g, const Sched& S, const Epi& E) {
    const int tid = threadIdx.x, wid = __builtin_amdgcn_readfirstlane(tid >> 6), lane = tid & 63, wr = wid >> 2, wc = wid & 3, fr = lane & 15, fq = lane >> 4;
    const int K = g.K, nt = K / BK;
    unsigned voffA[2], voffB[2], voffBf[2];
#pragma unroll
    for (int i = 0; i < 2; ++i) { int R, C; stage_rc(tid * 16 + i * 8192, R, C); const int Rb = Epi::PERM ? ((R >> 5) * 64 + perm32(R & 31)) : R;
        voffA[i] = (unsigned)(R * K + C) * 2u; voffB[i] = (unsigned)(Rb * K + C) * 2u; voffBf[i] = (unsigned)((Rb - (R >> 5) * 32) * K + C) * 2u; }
    const size_t kstep = (size_t)(BK * 2);
    const size_t hstep = (size_t)HALF * K * 2;
    const size_t hstepB = Epi::PERM ? (size_t)32 * K * 2 : hstep;
    const size_t tstep = 2 * hstep;
    const unsigned ldsw = (unsigned)wid * 1024u;
    const int aoff = lds_byte(wr * 64 + fr, fq * 8), boff = lds_byte(wc * 32 + fr, fq * 8);
#define PG8_SA(b, h) (((b) * 2 + (h)) * HTB)
#define PG8_SB(b, h) ((4 + (b) * 2 + (h)) * HTB)
#define PG8_STAGE(bufoff, gbase, voff) do { _Pragma("unroll") for (int _i = 0; _i < 2; ++_i) \
        __builtin_amdgcn_global_load_lds((const unsigned*)((const char*)(gbase) + (voff)[_i]), (PG8_LAS unsigned*)(lds + (bufoff) + ldsw + _i * 8192), 16, 0, 0); } while (0)
#define PG8_LDA(dst, b, h) do { _Pragma("unroll") for (int m = 0; m < 4; ++m) _Pragma("unroll") for (int k = 0; k < 2; ++k) dst[m][k] = *(const PG8_LAS bf16x8*)(lds + PG8_SA(b, h) + aoff + m * 2048 + k * 1024); } while (0)
#define PG8_LDB(dst, b, h) do { _Pragma("unroll") for (int n = 0; n < 2; ++n) _Pragma("unroll") for (int k = 0; k < 2; ++k) dst[n][k] = *(const PG8_LAS bf16x8*)(lds + PG8_SB(b, h) + boff + n * 2048 + k * 1024); } while (0)
#define PG8_MMA(ai, bj, At, Bt) do { __builtin_amdgcn_s_setprio(1); _Pragma("unroll") for (int m = 0; m < 4; ++m) _Pragma("unroll") for (int n = 0; n < 2; ++n) _Pragma("unroll") for (int k = 0; k < 2; ++k) \
        acc[ai][bj][m][n] = __builtin_amdgcn_mfma_f32_16x16x32_bf16(Bt[n][k], At[m][k], acc[ai][bj][m][n], 0, 0, 0); __builtin_amdgcn_s_setprio(0); } while (0)
#define PG8_WAIT_V(n) asm volatile("s_waitcnt vmcnt(" #n ")" ::: "memory")
#define PG8_WAIT_L(n) asm volatile("s_waitcnt lgkmcnt(" #n ")" ::: "memory")
#define PG8_BAR __builtin_amdgcn_s_barrier()
#define PG8_SCHED __builtin_amdgcn_sched_barrier(0)
    Unit cur, nxt; int ui = 0;
    if (!S.next(0, cur)) return;
    f32x4 acc[2][2][4][2];
#pragma unroll
    for (int a = 0; a < 2; ++a)
#pragma unroll
        for (int b = 0; b < 2; ++b)
#pragma unroll
            for (int m = 0; m < 4; ++m)
#pragma unroll
                for (int n = 0; n < 2; ++n) acc[a][b][m][n] = (f32x4){0.f, 0.f, 0.f, 0.f};
    bf16x8 At[4][2], B0[2][2], B1[2][2];
    const size_t rowB = (size_t)K * 2, hstepBf = (size_t)2048 * K * 2;
    const char* cA = (const char*)g.A + (size_t)cur.pm * tstep; const char* cB = (const char*)g.Bt + (size_t)cur.brow * rowB;
    S.a_ready(cur);
    { unsigned vB[2] = {cur.fz ? voffBf[0] : voffB[0], cur.fz ? voffBf[1] : voffB[1]}; const size_t hB = cur.fz ? hstepBf : hstepB;
    PG8_STAGE(PG8_SB(0, 0), cB, vB); PG8_STAGE(PG8_SA(0, 0), cA, voffA); PG8_STAGE(PG8_SB(0, 1), cB + hB, vB); PG8_STAGE(PG8_SA(0, 1), cA + hstep, voffA);
    if (wr == 1) PG8_BAR;
    PG8_WAIT_V(4); PG8_BAR;
    PG8_STAGE(PG8_SB(1, 0), cB + kstep, vB); PG8_STAGE(PG8_SA(1, 0), cA + kstep, voffA); PG8_STAGE(PG8_SB(1, 1), cB + hB + kstep, vB);
    PG8_WAIT_V(6); PG8_BAR; }
    for (;;) {
        const bool has_next = S.next(ui + 1, nxt);
        const char* nA = has_next ? (const char*)g.A + (size_t)nxt.pm * tstep : cA; const char* nB = has_next ? (const char*)g.Bt + (size_t)nxt.brow * rowB : cB;
        const int nfz = has_next ? nxt.fz : cur.fz;
        E.prefetch(cur, wid, lane, lds + STAGE_BYTES + wid * 1024);
        for (int t = 0; t < nt; t += 2) {
            const bool last = (t == nt - 2);
            const char* a1 = cA + (size_t)(t + 1) * kstep;
            const char* a2 = last ? nA : cA + (size_t)(t + 2) * kstep; const char* b2 = last ? nB : cB + (size_t)(t + 2) * kstep;
            const char* a3 = a2 + kstep; const char* b3 = b2 + kstep;
            const int fzt = last ? nfz : cur.fz; unsigned vB[2] = {fzt ? voffBf[0] : voffB[0], fzt ? voffBf[1] : voffB[1]}; const size_t hB = fzt ? hstepBf : hstepB;
            if (last && has_next) S.a_ready(nxt);
            PG8_LDB(B0, 0, 0); PG8_SCHED; PG8_LDA(At, 0, 0); PG8_STAGE(PG8_SA(1, 1), a1 + hstep, voffA);
            PG8_WAIT_L(8); PG8_BAR; PG8_WAIT_L(0); PG8_MMA(0, 0, At, B0); PG8_BAR; PG8_SCHED;
            PG8_LDB(B1, 0, 1); PG8_STAGE(PG8_SB(0, 0), b2, vB);
            PG8_BAR; PG8_WAIT_L(0); PG8_MMA(0, 1, At, B1); PG8_BAR;
            PG8_LDA(At, 0, 1); PG8_STAGE(PG8_SA(0, 0), a2, voffA);
            PG8_BAR; PG8_WAIT_L(0); PG8_MMA(1, 0, At, B0); PG8_BAR; PG8_SCHED;
            PG8_STAGE(PG8_SB(0, 1), b2 + hB, vB);
            PG8_WAIT_V(6); PG8_BAR; PG8_MMA(1, 1, At, B1); PG8_BAR;
            PG8_LDB(B0, 1, 0); PG8_SCHED; PG8_LDA(At, 1, 0); PG8_STAGE(PG8_SA(0, 1), a2 + hstep, voffA);
            PG8_WAIT_L(8); PG8_BAR; PG8_WAIT_L(0); PG8_MMA(0, 0, At, B0); PG8_BAR; PG8_SCHED;
            PG8_LDB(B1, 1, 1); PG8_STAGE(PG8_SB(1, 0), b3, vB);
            PG8_BAR; PG8_WAIT_L(0); PG8_MMA(0, 1, At, B1); PG8_BAR;
            PG8_LDA(At, 1, 1); PG8_STAGE(PG8_SA(1, 0), a3, voffA);
            PG8_BAR; PG8_WAIT_L(0); PG8_MMA(1, 0, At, B0); PG8_BAR; PG8_SCHED;
            PG8_STAGE(PG8_SB(1, 1), b3 + hB, vB);
            PG8_WAIT_V(6); PG8_BAR; PG8_MMA(1, 1, At, B1); PG8_BAR;
        }
        if constexpr (!Epi::AFTER_DRAIN) { E(acc, cur, wr, wc, fr, fq); S.done(cur); }
        if (!has_next) break;
#pragma unroll
        for (int a = 0; a < 2; ++a)
#pragma unroll
            for (int b = 0; b < 2; ++b)
#pragma unroll
                for (int m = 0; m < 4; ++m)
#pragma unroll
                    for (int n = 0; n < 2; ++n) acc[a][b][m][n] = (f32x4){0.f, 0.f, 0.f, 0.f};
        cur = nxt; cA = nA; cB = nB; ++ui;
    }
    PG8_WAIT_V(0);
    if (wr == 0) PG8_BAR;
    PG8_BAR;
    if constexpr (Epi::AFTER_DRAIN) { E.fused(acc, cur, wr, wc, fr, fq); S.done(cur); }
#undef PG8_SA
#undef PG8_SB
#undef PG8_STAGE
#undef PG8_LDA
#undef PG8_LDB
#undef PG8_MMA
#undef PG8_WAIT_V
#undef PG8_WAIT_L
#undef PG8_BAR
#undef PG8_SCHED
}
}

struct KArgs {
    const float* in[18];
    float* out;
    unsigned char* ws;
    int ph_lo, ph_hi;
    int cg_sync, pad;
};
enum { I_XP = 0, I_XS, I_SPOOL, I_CK, I_CV, I_MEM, I_NORMG, I_WIN, I_POOLW, I_POOLSC, I_SGUNG, I_SGUW, I_SGUB, I_MEMNG, I_WKV, I_WDOWN, I_WOUT, I_NORMF };

struct P1Order {
    pg8::StaticOrder so; int G, c;
    __device__ void init(int G_, int c_) { so.init(MPR, INC, G_, c_); G = G_; c = c_; }
    __device__ bool next(int i, pg8::Unit& u) const {
        const long L = (long)i * G + c;
        if (L < so.nwg) so.next(i, u);
        else { const int e = (int)(L - so.nwg); if (e >= 104) return false;
            if (e < 64) { u.pm = NPAN + (e >> 3); u.pn = 40 + (e & 7); } else { u.pm = 64; u.pn = e - 64; } }
        u.brow = u.pn * 256; u.fz = 0;
        if (u.pn >= 8 && u.pn < 12) { u.brow = 2 * DM + 128 * (u.pn - 8); u.fz = 1; } else if (u.pn >= 16 && u.pn < 20) { u.brow = 2 * DM + 128 * (4 + u.pn - 16); u.fz = 1; }
        return true;
    }
    __device__ __forceinline__ void a_ready(const pg8::Unit&) const {}
    __device__ __forceinline__ void done(const pg8::Unit&) const {}
};
struct EpiProj {
    static constexpr bool PERM = true, AFTER_DRAIN = false;
    bf16* proj; bf16* gate; float* vss; bf16* kb; bf16* vb; float* out; const float* hs; bf16* dsr;
    __device__ __forceinline__ void prefetch(const pg8::Unit&, int, int, LAS unsigned char*) const {}
    __device__ __forceinline__ void operator()(const f32x4 (&acc)[2][2][4][2], const pg8::Unit& u, int wr, int wc, int fr, int fq) const {
        if (u.fz) {
            const int j = (u.pn < 12) ? u.pn - 8 : 4 + u.pn - 16; bf16* uz = proj + (size_t)2 * MP * DM;
            const int row0 = u.pm * 256 + wr * 64 + fr, c = 128 * j + wc * 32 + 8 * fq;
#pragma unroll
            for (int ai = 0; ai < 2; ++ai)
#pragma unroll
                for (int m = 0; m < 4; ++m) { const size_t r = (size_t)(row0 + ai * 128 + m * 16);
                    const f32x4 u0 = acc[ai][0][m][0], u1 = acc[ai][0][m][1], z0 = acc[ai][1][m][0], z1 = acc[ai][1][m][1];
                    u32x4 w; w.x = pk2(u0[0] * silu_f(z0[0]), u0[1] * silu_f(z0[1])); w.y = pk2(u0[2] * silu_f(z0[2]), u0[3] * silu_f(z0[3]));
                    w.z = pk2(u1[0] * silu_f(z1[0]), u1[1] * silu_f(z1[1])); w.w = pk2(u1[2] * silu_f(z1[2]), u1[3] * silu_f(z1[3]));
                    __builtin_nontemporal_store(w, (u32x4*)(uz + r * DM + c)); }
        } else if (u.pn < 40) {
            const int sec = u.pn >> 2;
            const int act = (sec == 1 || sec == 4 || sec == 6) ? 1 : (sec >= 7 ? 2 : 0);
            const int row0 = u.pm * 256 + wr * 64 + fr, cs0 = (u.pn & 3) * 256 + wc * 64 + 8 * fq;
            bf16* base; int ld;
            if (sec < 7) { base = proj + (size_t)sec * MP * DM; ld = DM; } else { base = gate + (sec - 7) * DM; ld = 3 * DM; }
            const bool poolrows = (sec == 0) && (((u.pm & 7) == 7) || u.pm == 64);
#pragma unroll
            for (int ai = 0; ai < 2; ++ai)
#pragma unroll
                for (int m = 0; m < 4; ++m) {
                    const int r = row0 + ai * 128 + m * 16; float ss = 0.f;
#pragma unroll
                    for (int bj = 0; bj < 2; ++bj) {
                        f32x4 v0 = acc[ai][bj][m][0], v1 = acc[ai][bj][m][1]; const int cs = cs0 + bj * 32;
                        if (sec == 3) ss += (v0[0] * v0[0] + v0[1] * v0[1]) + (v0[2] * v0[2] + v0[3] * v0[3]) + (v1[0] * v1[0] + v1[1] * v1[1]) + (v1[2] * v1[2] + v1[3] * v1[3]);
                        if (poolrows) {
                            float* dst = nullptr;
                            if (r < MPR) { const int t = r & (SEQ - 1); if (t >= SEQ - 15) dst = out + O_POOLP + ((size_t)(r >> 11) * 15 + (t - (SEQ - 15))) * DM + cs; }
                            else if (r < MV) { dst = out + O_POOLS + ((size_t)(r - MPR) * 15 + 14) * DM + cs;
                                const float* hp = hs + (size_t)(r - MPR) * DM + cs; const f32x4 h0 = *(const f32x4*)hp, h1 = *(const f32x4*)(hp + 4); const float inv = 1.f / (float)(2 << (cs >> 8));
                                u32x4 d; d.x = pk2((h0.x + v0[0]) * inv - v0[0], (h0.y + v0[1]) * inv - v0[1]); d.y = pk2((h0.z + v0[2]) * inv - v0[2], (h0.w + v0[3]) * inv - v0[3]);
                                d.z = pk2((h1.x + v1[0]) * inv - v1[0], (h1.y + v1[1]) * inv - v1[1]); d.w = pk2((h1.z + v1[2]) * inv - v1[2], (h1.w + v1[3]) * inv - v1[3]);
                                *(u32x4*)(dsr + (size_t)(r - MPR) * DM + cs) = d; }
                            if (dst) { *(f32x4*)dst = v0; *(f32x4*)(dst + 4) = v1; }
                        }
                        if (act == 1) {
#pragma unroll
                            for (int j = 0; j < 4; ++j) { v0[j] = silu_f(v0[j]); v1[j] = silu_f(v1[j]); } }
                        if (act == 2) {
#pragma unroll
                            for (int j = 0; j < 4; ++j) { v0[j] = sigm_f(v0[j]); v1[j] = sigm_f(v1[j]); } }
                        u32x4 w; w.x = pk2(v0[0], v0[1]); w.y = pk2(v0[2], v0[3]); w.z = pk2(v1[0], v1[1]); w.w = pk2(v1[2], v1[3]);
                        __builtin_nontemporal_store(w, (u32x4*)(base + (size_t)r * ld + cs));
                    }
                    if (sec == 3) { ss += __shfl_xor(ss, 16); ss += __shfl_xor(ss, 32); if (fq == 0) vss[(size_t)r * 16 + (u.pn & 3) * 4 + wc] = ss; }
                }
        } else {
            const int b = u.pm - NPAN, ct = (u.pn - 40) * 256;
            const bool isv = ct >= DM; const int cb = (isv ? ct - DM : ct) + wc * 64 + 8 * fq;
            float* of = out + (isv ? O_MV : O_MK); bf16* ob = isv ? vb : kb;
#pragma unroll
            for (int ai = 0; ai < 2; ++ai)
#pragma unroll
                for (int m = 0; m < 4; ++m) {
                    const size_t j = (size_t)b * 256 + ai * 128 + wr * 64 + m * 16 + fr;
#pragma unroll
                    for (int bj = 0; bj < 2; ++bj) {
                        const f32x4 v0 = acc[ai][bj][m][0], v1 = acc[ai][bj][m][1]; const int cs = cb + bj * 32;
                        __builtin_nontemporal_store(v0, (f32x4*)(of + j * DM + cs)); __builtin_nontemporal_store(v1, (f32x4*)(of + j * DM + cs + 4));
                        u32x4 w; w.x = pk2(v0[0], v0[1]); w.y = pk2(v0[2], v0[3]); w.z = pk2(v1[0], v1[1]); w.w = pk2(v1[2], v1[3]);
                        *(u32x4*)(ob + j * DM + cs) = w;
                    }
                }
        }
    }
};
struct P3Order {
    pg8::StaticOrder so;
    __device__ void init(int G_, int c_) { so.init(MPR, DM, G_, c_); }
    __device__ bool next(int i, pg8::Unit& u) const { const int rnd = i / 3, b = i - 3 * rnd; pg8::Unit t; if (!so.next(rnd, t)) return false; u.pm = b * NPAN + t.pm; u.pn = b * 4 + t.pn; u.brow = u.pn * 256; u.fz = 0; return true; }
    __device__ __forceinline__ void a_ready(const pg8::Unit&) const {}
    __device__ __forceinline__ void done(const pg8::Unit&) const {}
};
struct EpiGate {
    static constexpr bool PERM = true, AFTER_DRAIN = false;
    const bf16* gate; bf16* mg;
    __device__ __forceinline__ void prefetch(const pg8::Unit& u, int wid, int lane, LAS unsigned char* scr) const {
        const int b = u.pn >> 2, pm = u.pm - b * NPAN, t = wid * 64 + lane;
#pragma unroll
        for (int j = 0; j < 2; ++j) { const int li = t + 512 * j, row = li >> 2, seg = li & 3; const size_t r = (size_t)(pm * 256 + row);
            __builtin_amdgcn_global_load_lds((const unsigned*)(gate + r * (3 * DM) + b * DM + (u.pn & 3) * 256 + seg * 64), (LAS unsigned*)(scr + j * 256), 4, 0, 0); }
    }
    __device__ __forceinline__ void operator()(const f32x4 (&acc)[2][2][4][2], const pg8::Unit& u, int wr, int wc, int fr, int fq) const {
        const int b = u.pn >> 2, pm = u.pm - b * NPAN;
        const int row0 = pm * 256 + wr * 64 + fr, c0 = (u.pn & 3) * 256 + wc * 64 + 8 * fq;
#pragma unroll
        for (int ai = 0; ai < 2; ++ai) {
            u32x4 g8[4][2], p8[4][2];
#pragma unroll
            for (int m = 0; m < 4; ++m)
#pragma unroll
                for (int bj = 0; bj < 2; ++bj) { const size_t r = (size_t)(row0 + ai * 128 + m * 16); const int c = c0 + bj * 32;
                    g8[m][bj] = *(const u32x4*)(gate + r * (3 * DM) + b * DM + c);
                    p8[m][bj] = (u32x4){0u, 0u, 0u, 0u}; if (b > 0) p8[m][bj] = *(const u32x4*)(mg + r * DM + c); }
            asm volatile("" ::: "memory");
#pragma unroll
            for (int m = 0; m < 4; ++m)
#pragma unroll
                for (int bj = 0; bj < 2; ++bj) { const size_t r = (size_t)(row0 + ai * 128 + m * 16); const int c = c0 + bj * 32;
                    const f32x4 v0 = acc[ai][bj][m][0], v1 = acc[ai][bj][m][1]; const u32x4 gq = g8[m][bj], p = p8[m][bj];
                    const float o0 = v0[0] * bflo(gq.x) + bflo(p.x), o1 = v0[1] * bfhi(gq.x) + bfhi(p.x), o2 = v0[2] * bflo(gq.y) + bflo(p.y), o3 = v0[3] * bfhi(gq.y) + bfhi(p.y);
                    const float o4 = v1[0] * bflo(gq.z) + bflo(p.z), o5 = v1[1] * bfhi(gq.z) + bfhi(p.z), o6 = v1[2] * bflo(gq.w) + bflo(p.w), o7 = v1[3] * bfhi(gq.w) + bfhi(p.w);
                    u32x4 w; w.x = pk2(o0, o1); w.y = pk2(o2, o3); w.z = pk2(o4, o5); w.w = pk2(o6, o7);
                    if (b == 2) __builtin_nontemporal_store(w, (u32x4*)(mg + r * DM + c)); else *(u32x4*)(mg + r * DM + c) = w; }
        }
    }
};
__device__ __forceinline__ void st_agent(float* p, float v) { __hip_atomic_store((unsigned*)p, __builtin_bit_cast(unsigned, v), __ATOMIC_RELAXED, __HIP_MEMORY_SCOPE_AGENT); }
__device__ __forceinline__ float ld_agent(const float* p) { return __builtin_bit_cast(float, __hip_atomic_load((unsigned*)p, __ATOMIC_RELAXED, __HIP_MEMORY_SCOPE_AGENT)); }
__device__ __forceinline__ void wait_count(unsigned* w, unsigned want) {
    unsigned sp = 0;
    while ((unsigned)__builtin_amdgcn_readfirstlane(__hip_atomic_load(w, __ATOMIC_RELAXED, __HIP_MEMORY_SCOPE_AGENT)) < want) { __builtin_amdgcn_s_sleep(2); if (++sp > (1u << 22)) break; }
    __builtin_amdgcn_fence(__ATOMIC_ACQUIRE, "agent");
    asm volatile("s_waitcnt vmcnt(0)" ::: "memory");
}
struct EpiOutNorm {
    static constexpr bool PERM = false, AFTER_DRAIN = true;
    const float* xp; const float* gf; float* out; float* slots; unsigned* cnt;
    __device__ __forceinline__ void prefetch(const pg8::Unit& u, int wid, int lane, LAS unsigned char* scr) const {
        const int t = wid * 64 + lane;
#pragma unroll
        for (int j = 0; j < 4; ++j) { const int li = t + 512 * j, row = li >> 3, seg = li & 7;
            __builtin_amdgcn_global_load_lds((const unsigned*)(xp + (size_t)(u.pm * 256 + row) * DM + u.pn * 256 + seg * 32), (LAS unsigned*)(scr + j * 256), 4, 0, 0); }
    }
    __device__ __forceinline__ void operator()(const f32x4 (&)[2][2][4][2], const pg8::Unit&, int, int, int, int) const {}
    __device__ __forceinline__ void fused(f32x4 (&acc)[2][2][4][2], const pg8::Unit& u, int wr, int wc, int fr, int fq) const {
        const int row0 = u.pm * 256 + wr * 64 + fr, col0 = u.pn * 256 + wc * 32 + 4 * fq;
#pragma unroll
        for (int ai = 0; ai < 2; ++ai)
#pragma unroll
            for (int m = 0; m < 4; ++m) { const size_t r = (size_t)(row0 + ai * 128 + m * 16); float ss = 0.f;
#pragma unroll
                for (int bj = 0; bj < 2; ++bj)
#pragma unroll
                    for (int n = 0; n < 2; ++n) { const int c = col0 + bj * 128 + n * 16; const f32x4 v = acc[ai][bj][m][n] + __builtin_nontemporal_load((const f32x4*)(xp + r * DM + c)); acc[ai][bj][m][n] = v;
                        ss += (v.x * v.x + v.y * v.y) + (v.z * v.z + v.w * v.w); }
                ss += __shfl_xor(ss, 16); ss += __shfl_xor(ss, 32);
                if (fq == 0) st_agent(slots + r * 16 + u.pn * 4 + wc, ss); }
        asm volatile("s_waitcnt vmcnt(0)" ::: "memory");
        if (fr == 0 && fq == 0) __hip_atomic_fetch_add(cnt + 64 * u.pm, 1u, __ATOMIC_RELAXED, __HIP_MEMORY_SCOPE_AGENT);
        if (threadIdx.x < 64) wait_count(cnt + 64 * u.pm, 32u);
        __syncthreads();
#pragma unroll
        for (int ai = 0; ai < 2; ++ai)
#pragma unroll
            for (int m = 0; m < 4; ++m) { const size_t r = (size_t)(row0 + ai * 128 + m * 16); float tot = 0.f;
                { const f32x4* sp = (const f32x4*)(slots + r * 16); const f32x4 p0 = sp[0], p1 = sp[1], p2 = sp[2], p3 = sp[3];
                  tot = (((p0.x + p0.y) + (p0.z + p0.w)) + ((p1.x + p1.y) + (p1.z + p1.w))) + (((p2.x + p2.y) + (p2.z + p2.w)) + ((p3.x + p3.y) + (p3.z + p3.w))); }
                const float rs = rsqrtf(tot * (1.f / DM) + EPS);
#pragma unroll
                for (int bj = 0; bj < 2; ++bj)
#pragma unroll
                    for (int n = 0; n < 2; ++n) { const int c = col0 + bj * 128 + n * 16; const f32x4 g = *(const f32x4*)(gf + c); const f32x4 v = acc[ai][bj][m][n];
                        __builtin_nontemporal_store((f32x4){v.x * rs * g.x, v.y * rs * g.y, v.z * rs * g.z, v.w * rs * g.w}, (f32x4*)(out + O_YP + r * DM + c)); } }
    }
};

template <class Epi>
__device__ __forceinline__ void skinny_gemm(LAS unsigned char* lds, const bf16* A0, int lda, size_t a_grp_stride, int strips_per_grp, int nseg, int aseg,
                                            const bf16* Bt, int ldb, int K, int nstrips, int first, int step, const Epi& E) {
    int tid_ = threadIdx.x; asm volatile("" : "+v"(tid_));
    const int tid = tid_, lane = tid & 63, wv = tid >> 6, fr = lane & 15, fq = lane >> 4, rh = wv & 1, kq = wv >> 1;
    LAS float* part = (LAS float*)lds;
    const int nks = K / 128;
    for (int s = first; s < nstrips; s += step) {
        const bf16* A = A0 + (size_t)(s / strips_per_grp) * a_grp_stride + (size_t)(rh * 64 + fr) * lda + fq * 8;
        const bf16* B = Bt + (size_t)(16 * s + fr) * ldb + fq * 8;
        f32x4 acc[4];
#pragma unroll
        for (int rb = 0; rb < 4; ++rb) acc[rb] = (f32x4){0.f, 0.f, 0.f, 0.f};
        for (int seg = 0; seg < nseg; ++seg) {
#pragma unroll 4
            for (int k = 0; k < nks; ++k) {
                const int ko = (kq * nks + k) * 32;
                const bf16x8 bfr = *(const bf16x8*)(B + ko);
#pragma unroll
                for (int rb = 0; rb < 4; ++rb) { const bf16x8 afr = *(const bf16x8*)(A + (size_t)rb * 16 * lda + seg * aseg + ko);
                    acc[rb] = __builtin_amdgcn_mfma_f32_16x16x32_bf16(bfr, afr, acc[rb], 0, 0, 0); }
            }
        }
#pragma unroll
        for (int rb = 0; rb < 4; ++rb) *(LAS f32x4*)(part + ((kq * 128 + rh * 64 + rb * 16 + fr) * 16 + fq * 4)) = acc[rb];
        __syncthreads();
        { const int row = tid >> 2, cq = tid & 3; const LAS float* p = part + row * 16 + cq * 4;
          const f32x4 v = (*(const LAS f32x4*)p + *(const LAS f32x4*)(p + 2048)) + (*(const LAS f32x4*)(p + 4096) + *(const LAS f32x4*)(p + 6144));
          E(s, row, 16 * s + cq * 4, v, cq); }
        __syncthreads();
    }
}
struct EpiS1 {
    bf16* proj; bf16* gate; float* vss2; float* out; const float* hist; bf16* ds;
    __device__ __forceinline__ void operator()(int s, int row, int c, f32x4 v, int cq) const {
        const int sec = c >> 10, cs = c & 1023; const size_t m = (size_t)(MPR + row);
        if (sec == 0) { *(f32x4*)(out + O_POOLS + ((size_t)row * 15 + 14) * DM + cs) = v;
            const int w = 2 << (cs >> 8); f32x4 sm = v;
#pragma unroll
            for (int j = 0; j < 15; ++j) if (j < w - 1) sm = sm + *(const f32x4*)(hist + ((size_t)row * 15 + 14 - j) * DM + cs);
            const float inv = 1.f / (float)w;
            u32x2 d; d.x = pk2(sm.x * inv - v.x, sm.y * inv - v.y); d.y = pk2(sm.z * inv - v.z, sm.w * inv - v.w);
            *(u32x2*)(ds + (size_t)row * DM + cs) = d; }
        if (sec == 3) { float ss = (v.x * v.x + v.y * v.y) + (v.z * v.z + v.w * v.w); ss += __shfl_xor(ss, 1); ss += __shfl_xor(ss, 2); if (cq == 0) vss2[row * 64 + (s - 192)] = ss; }
        if (sec == 1 || sec == 4 || sec == 6) { v.x = silu_f(v.x); v.y = silu_f(v.y); v.z = silu_f(v.z); v.w = silu_f(v.w); }
        if (sec >= 7) { v.x = sigm_f(v.x); v.y = sigm_f(v.y); v.z = sigm_f(v.z); v.w = sigm_f(v.w); }
        u32x2 w; w.x = pk2(v.x, v.y); w.y = pk2(v.z, v.w);
        if (sec < 7) *(u32x2*)(proj + (size_t)sec * MP * DM + m * DM + cs) = w; else *(u32x2*)(gate + m * (3 * DM) + (sec - 7) * DM + cs) = w;
    }
};
struct EpiS3 {
    const bf16* gate; bf16* gys;
    __device__ __forceinline__ void operator()(int s, int row, int c, f32x4 v, int cq) const {
        const u32x2 g = *(const u32x2*)(gate + (size_t)(MPR + row) * (3 * DM) + c);
        u32x2 w; w.x = pk2(v.x * bflo(g.x), v.y * bfhi(g.x)); w.y = pk2(v.z * bflo(g.y), v.w * bfhi(g.y));
        *(u32x2*)(gys + (size_t)row * (3 * DM) + c) = w;
    }
};
struct EpiS4 {
    const float* xs; const float* gf; float* out; float* slots2; unsigned* cnt2;
    __device__ __forceinline__ void operator()(int s, int row, int c, f32x4 v, int cq) const {
        v = v + *(const f32x4*)(xs + (size_t)row * DM + c);
        float ss = (v.x * v.x + v.y * v.y) + (v.z * v.z + v.w * v.w); ss += __shfl_xor(ss, 1); ss += __shfl_xor(ss, 2);
        if (cq == 0) st_agent(slots2 + row * 64 + s, ss);
        asm volatile("s_waitcnt vmcnt(0)" ::: "memory");
        __syncthreads();
        if (threadIdx.x == 0) __hip_atomic_fetch_add(cnt2, 1u, __ATOMIC_RELAXED, __HIP_MEMORY_SCOPE_AGENT);
        if (threadIdx.x < 64) wait_count(cnt2, 64u);
        __syncthreads();
        float tot = 0.f;
        { const f32x4* sp = (const f32x4*)(slots2 + row * 64 + cq * 16); const f32x4 p0 = sp[0], p1 = sp[1], p2 = sp[2], p3 = sp[3];
          tot = (((p0.x + p0.y) + (p0.z + p0.w)) + ((p1.x + p1.y) + (p1.z + p1.w))) + (((p2.x + p2.y) + (p2.z + p2.w)) + ((p3.x + p3.y) + (p3.z + p3.w))); }
        tot += __shfl_xor(tot, 1); tot += __shfl_xor(tot, 2);
        const float rs = rsqrtf(tot * (1.f / DM) + EPS); const f32x4 g = *(const f32x4*)(gf + c);
        *(f32x4*)(out + O_YS + (size_t)row * DM + c) = (f32x4){v.x * rs * g.x, v.y * rs * g.y, v.z * rs * g.z, v.w * rs * g.w};
    }
};


__device__ __forceinline__ void sample_out_split(const KArgs& a, LAS unsigned char* lds, int item) {
    int tid_ = threadIdx.x; asm volatile("" : "+v"(tid_));
    const int tid = tid_, lane = tid & 63, wv = tid >> 6, fr = lane & 15, fq = lane >> 4, s = item >> 2, rq = item & 3;
    const bf16* A = (const bf16*)(a.ws + WS_GYS) + (size_t)(rq * 32 + fr) * (3 * DM) + fq * 8;
    const bf16* B = (const bf16*)(a.ws + WS_WO3) + (size_t)(16 * s + fr) * DM + fq * 8;
    f32x4 acc0 = (f32x4){0.f, 0.f, 0.f, 0.f}, acc1 = acc0;
#pragma unroll
    for (int kk = 0; kk < 12; ++kk) { const int k = 384 * wv + 32 * kk;
        const bf16x8 bfr = *(const bf16x8*)(B + (k & 1023)); const bf16x8 a0 = *(const bf16x8*)(A + k), a1 = *(const bf16x8*)(A + (size_t)16 * (3 * DM) + k);
        acc0 = __builtin_amdgcn_mfma_f32_16x16x32_bf16(bfr, a0, acc0, 0, 0, 0); acc1 = __builtin_amdgcn_mfma_f32_16x16x32_bf16(bfr, a1, acc1, 0, 0, 0); }
    LAS float* part = (LAS float*)lds;
    *(LAS f32x4*)(part + (wv * 32 + fr) * 16 + fq * 4) = acc0; *(LAS f32x4*)(part + (wv * 32 + 16 + fr) * 16 + fq * 4) = acc1;
    __syncthreads();
    const int row = tid >> 4, col = tid & 15, grow = rq * 32 + row, c = 16 * s + col;
    float v = 0.f;
#pragma unroll
    for (int w8 = 0; w8 < 8; ++w8) v += part[(w8 * 32 + row) * 16 + col];
    v += a.in[I_XS][(size_t)grow * DM + c];
    float ss = v * v; ss += __shfl_xor(ss, 1); ss += __shfl_xor(ss, 2); ss += __shfl_xor(ss, 4); ss += __shfl_xor(ss, 8);
    float* slots2 = (float*)(a.ws + WS_VSS2); unsigned* cnt = (unsigned*)(a.ws + WS_CTL) + CW_SAMPLE + 64 * rq;
    if (col == 0) st_agent(slots2 + grow * 64 + s, ss);
    asm volatile("s_waitcnt vmcnt(0)" ::: "memory");
    __syncthreads();
    if (tid == 0) __hip_atomic_fetch_add(cnt, 1u, __ATOMIC_RELAXED, __HIP_MEMORY_SCOPE_AGENT);
    if (tid < 64) wait_count(cnt, 64u);
    __syncthreads();
    const f32x4 p4 = *(const f32x4*)(slots2 + grow * 64 + col * 4);
    float tot = (p4.x + p4.y) + (p4.z + p4.w); tot += __shfl_xor(tot, 1); tot += __shfl_xor(tot, 2); tot += __shfl_xor(tot, 4); tot += __shfl_xor(tot, 8);
    a.out[O_YS + (size_t)grow * DM + c] = v * rsqrtf(tot * (1.f / DM) + EPS) * a.in[I_NORMF][c];
    __syncthreads();
}

__device__ __forceinline__ void p0_transpose_item(const float* W, int N, bf16* WT, int row_off, int ldo, int koff, LAS float* scr, int item, int lane) {
    const int nblk = N / 32, kb = item / nblk, nb = item % nblk, k0 = 64 * kb, n0 = 32 * nb;
    float wv_[32];
#pragma unroll
    for (int i = 0; i < 32; ++i) { const int kk = 2 * i + (lane >> 5); wv_[i] = __builtin_nontemporal_load(W + (size_t)(k0 + kk) * N + n0 + (lane & 31)); }
#pragma unroll
    for (int i = 0; i < 32; ++i) { const int kk = 2 * i + (lane >> 5); scr[kk * 33 + (lane & 31)] = wv_[i]; }
    asm volatile("s_waitcnt lgkmcnt(0)" ::: "memory");
    const int c = lane & 7;
#pragma unroll
    for (int j = 0; j < 4; ++j) { const int n = (lane >> 3) + 8 * j; const LAS float* s = scr + (8 * c) * 33 + n;
        u32x4 o; o.x = pk2(s[0 * 33], s[1 * 33]); o.y = pk2(s[2 * 33], s[3 * 33]); o.z = pk2(s[4 * 33], s[5 * 33]); o.w = pk2(s[6 * 33], s[7 * 33]);
        *(u32x4*)(WT + (size_t)(row_off + n0 + n) * ldo + koff + k0 + 8 * c) = o; }
    asm volatile("s_waitcnt lgkmcnt(0)" ::: "memory");
}
__device__ __forceinline__ void rms_row_to_bf16(const float* xrow, const float* gain, bf16* orow, int lane) {
    const f32x4* xr = (const f32x4*)xrow + lane; const f32x4* gr = (const f32x4*)gain + lane;
    f32x4 v[4]; float s = 0.f;
#pragma unroll
    for (int j = 0; j < 4; ++j) { v[j] = xr[64 * j]; s += (v[j].x * v[j].x + v[j].y * v[j].y) + (v[j].z * v[j].z + v[j].w * v[j].w); }
    const float rs = rsqrtf(wave_sum(s) * (1.f / DM) + EPS);
    u32x2* o8 = (u32x2*)orow + lane;
#pragma unroll
    for (int j = 0; j < 4; ++j) { const f32x4 g = gr[64 * j]; u32x2 w; w.x = pk2(v[j].x * rs * g.x, v[j].y * rs * g.y); w.y = pk2(v[j].z * rs * g.z, v[j].w * rs * g.w); o8[64 * j] = w; }
}
__device__ __forceinline__ void rms_row2_to_bf16(const float* x0, const float* x1, const float* gain, bf16* o0, bf16* o1, int lane) {
    const f32x4* xr0 = (const f32x4*)x0 + lane; const f32x4* xr1 = (const f32x4*)x1 + lane; const f32x4* gr = (const f32x4*)gain + lane;
    f32x4 v[4], w[4]; float s = 0.f, t = 0.f;
#pragma unroll
    for (int j = 0; j < 4; ++j) { v[j] = __builtin_nontemporal_load(xr0 + 64 * j); w[j] = __builtin_nontemporal_load(xr1 + 64 * j); }
#pragma unroll
    for (int j = 0; j < 4; ++j) { s += (v[j].x * v[j].x + v[j].y * v[j].y) + (v[j].z * v[j].z + v[j].w * v[j].w); t += (w[j].x * w[j].x + w[j].y * w[j].y) + (w[j].z * w[j].z + w[j].w * w[j].w); }
#pragma unroll
    for (int o = 1; o < 64; o <<= 1) { s += __shfl_xor(s, o); t += __shfl_xor(t, o); }
    const float rs = rsqrtf(s * (1.f / DM) + EPS), rt = rsqrtf(t * (1.f / DM) + EPS);
    u32x2* p0 = (u32x2*)o0 + lane; u32x2* p1 = (u32x2*)o1 + lane;
#pragma unroll
    for (int j = 0; j < 4; ++j) { const f32x4 g = gr[64 * j]; u32x2 a; a.x = pk2(v[j].x * rs * g.x, v[j].y * rs * g.y); a.y = pk2(v[j].z * rs * g.z, v[j].w * rs * g.w); p0[64 * j] = a;
        u32x2 b; b.x = pk2(w[j].x * rt * g.x, w[j].y * rt * g.y); b.y = pk2(w[j].z * rt * g.z, w[j].w * rt * g.w); p1[64 * j] = b; }
}
__device__ __forceinline__ void p0_prologue(const KArgs& a, LAS unsigned char* lds, int G) {
    const int tid = threadIdx.x, lane = tid & 63, wave = tid >> 6;
    LAS float* scr = (LAS float*)(lds + wave * 16384);
    const int gw = blockIdx.x * 8 + wave, NGW = G * 8;
    bf16* H = (bf16*)(a.ws + WS_H); bf16* WinT = (bf16*)(a.ws + WS_WIN); bf16* WdT = (bf16*)(a.ws + WS_WD); bf16* Wo3 = (bf16*)(a.ws + WS_WO3);
    bf16* PwT = (bf16*)(a.ws + WS_PW); bf16* SW = (bf16*)(a.ws + WS_SW);
    constexpr int I_IN = 16 * (INC / 32), I_KV = 16 * (2048 / 32), I_D = 16 * 32, I_O = 16 * 32, I_P = 4 * 8;
    constexpr int NITEMS = I_IN + I_KV + 3 * I_D + I_O + 4 * I_P;
    for (int it = gw; it < NITEMS; it += NGW) {
        int r = it;
        if (r < I_IN) { p0_transpose_item(a.in[I_WIN], INC, WinT, 0, DM, 0, scr, r, lane); continue; } r -= I_IN;
        if (r < I_KV) { p0_transpose_item(a.in[I_WKV], 2048, WinT, INC, DM, 0, scr, r, lane); continue; } r -= I_KV;
        if (r < 3 * I_D) { const int b = r / I_D; p0_transpose_item(a.in[I_WDOWN] + (size_t)b * DM * DM, DM, WdT, b * DM, DM, 0, scr, r % I_D, lane); continue; } r -= 3 * I_D;
        if (r < I_O) { p0_transpose_item(a.in[I_WOUT], DM, Wo3, 0, DM, 0, scr, r, lane); continue; } r -= I_O;
        { const int g = r / I_P; p0_transpose_item(a.in[I_POOLW] + (size_t)g * 256 * 256, 256, PwT, g * 256, 256, 0, scr, r % I_P, lane); }
    }
    for (int m = gw; m + NGW < MPR; m += 2 * NGW)
        rms_row2_to_bf16(a.in[I_XP] + (size_t)m * DM, a.in[I_XP] + (size_t)(m + NGW) * DM, a.in[I_NORMG], H + (size_t)m * DM, H + (size_t)(m + NGW) * DM, lane);
    const int mdone = (MPR / (2 * NGW)) * (2 * NGW);
    for (int m = mdone + gw; m < MP + 2048; m += NGW) {
        bf16* orow = H + (size_t)m * DM;
        if (m < MPR) rms_row_to_bf16(a.in[I_XP] + (size_t)m * DM, a.in[I_NORMG], orow, lane);
        else if (m < MV) rms_row_to_bf16(a.in[I_XS] + (size_t)(m - MPR) * DM, a.in[I_NORMG], orow, lane);
        else if (m < MP) { u32x2* o8 = (u32x2*)orow + lane;
#pragma unroll
            for (int j = 0; j < 4; ++j) o8[64 * j] = (u32x2){0u, 0u}; }
        else rms_row_to_bf16(a.in[I_MEM] + (size_t)(m - MP) * DM, a.in[I_MEMNG], orow, lane);
    }
    const size_t gt = (size_t)blockIdx.x * 512 + tid, NGT = (size_t)G * 512;
    for (size_t i = gt; i < (size_t)4 * 128 * 128; i += NGT) { const int s = (int)(i & 127), t = (int)((i >> 7) & 127); SW[i] = (bf16)(s <= t ? f2bf(a.in[I_SGUW][i]) : 0u); }
    for (size_t i = gt; i < (size_t)NS * 256; i += NGT) { const size_t smp = i >> 8, c = (i & 255) * 4; const int w = 2 << (int)(c >> 8); f32x4 sm = (f32x4){0.f, 0.f, 0.f, 0.f};
#pragma unroll
        for (int j = 0; j < 15; ++j) if (j < w - 1) sm = sm + *(const f32x4*)(a.in[I_SPOOL] + (smp * 15 + 14 - j) * DM + c);
        *(f32x4*)((float*)(a.ws + WS_HS) + smp * DM + c) = sm; }
    for (size_t i = gt; i < (size_t)NS * 14 * 256; i += NGT) { const size_t smp = i / (14 * 256), rem = i % (14 * 256), r = rem / 256, c4 = rem % 256;
        __builtin_nontemporal_store(*(const f32x4*)(a.in[I_SPOOL] + (smp * 15 + r + 1) * DM + c4 * 4), (f32x4*)(a.out + O_POOLS + (smp * 15 + r) * DM + c4 * 4)); }
}

constexpr int RSV = 544;
constexpr int RS = 528;
__device__ __forceinline__ void pool_part(const KArgs& a, LAS unsigned char* lds, int rt, int g) {
    int tid_ = threadIdx.x; asm volatile("" : "+v"(tid_));
    const int tid = tid_, lane = tid & 63, wv = tid >> 6, fr = lane & 15, fq = lane >> 4;
    const int m0 = rt * 128, w = 2 << g;
    const bf16* PIN = (const bf16*)(a.ws + WS_PROJ); const bf16* PZ = PIN + (size_t)MP * DM;
    const bf16* PwT = (const bf16*)(a.ws + WS_PW); bf16* BR0 = (bf16*)(a.ws + WS_BR);
    LAS unsigned char* Pb = lds; LAS unsigned char* Db = lds + 75520;
    u32x4 zf[8]; f32x4 scv[2]; bf16x8 Bf[2][8];
    const bf16* pw = PwT + (size_t)(g * 256 + wv * 32 + 8 * (fr >> 2) + (fr & 3)) * 256 + fq * 8;
    if (rt < 128) {
        const int t0 = (rt & 15) * 128;
        u32x4 tv[9];
#pragma unroll
        for (int i = 0; i < 9; ++i) { const int idx = tid + i * 512, row = idx >> 5, ch = idx & 31; tv[i] = (u32x4){0u, 0u, 0u, 0u};
            if (idx < 143 * 32 && !(t0 == 0 && row < 15)) tv[i] = *(const u32x4*)(PIN + (size_t)(m0 - 15 + row) * DM + g * 256 + ch * 8); }
#pragma unroll
        for (int rb = 0; rb < 8; ++rb) zf[rb] = __builtin_nontemporal_load((const u32x4*)(PZ + (size_t)(m0 + rb * 16 + fr) * DM + g * 256 + wv * 32 + 8 * fq));
#pragma unroll
        for (int nn = 0; nn < 2; ++nn) { scv[nn] = *(const f32x4*)(a.in[I_POOLSC] + g * 256 + wv * 32 + 8 * fq + 4 * nn);
#pragma unroll
            for (int ks = 0; ks < 8; ++ks) Bf[nn][ks] = *(const bf16x8*)(pw + nn * 4 * 256 + ks * 32); }
#pragma unroll
        for (int i = 0; i < 9; ++i) { const int idx = tid + i * 512, row = idx >> 5, ch = idx & 31; if (idx < 143 * 32) *(LAS u32x4*)(Pb + row * RS + ch * 16) = tv[i]; }
        __syncthreads();
        {
            const int ch = tid & 31, r0 = (tid >> 5) * 8;
            float s0 = 0.f, s1 = 0.f, s2 = 0.f, s3 = 0.f, s4 = 0.f, s5 = 0.f, s6 = 0.f, s7 = 0.f;
            for (int j = 1; j < w; ++j) { const u32x4 v = *(const LAS u32x4*)(Pb + (r0 + 15 - j) * RS + ch * 16);
                s0 += bflo(v.x); s1 += bfhi(v.x); s2 += bflo(v.y); s3 += bfhi(v.y); s4 += bflo(v.z); s5 += bfhi(v.z); s6 += bflo(v.w); s7 += bfhi(v.w); }
#pragma unroll
            for (int i = 0; i < 8; ++i) { const int r = r0 + i;
                const u32x4 own = *(const LAS u32x4*)(Pb + (r + 15) * RS + ch * 16); const u32x4 old = *(const LAS u32x4*)(Pb + (r + 16 - w) * RS + ch * 16);
                s0 += bflo(own.x); s1 += bfhi(own.x); s2 += bflo(own.y); s3 += bfhi(own.y); s4 += bflo(own.z); s5 += bfhi(own.z); s6 += bflo(own.w); s7 += bfhi(own.w);
                const int cnt = min(w, t0 + r + 1); const float inv = 1.f / (float)cnt;
                u32x4 d; d.x = pk2(s0 * inv - bflo(own.x), s1 * inv - bfhi(own.x)); d.y = pk2(s2 * inv - bflo(own.y), s3 * inv - bfhi(own.y));
                d.z = pk2(s4 * inv - bflo(own.z), s5 * inv - bfhi(own.z)); d.w = pk2(s6 * inv - bflo(own.w), s7 * inv - bfhi(own.w));
                *(LAS u32x4*)(Db + r * RS + ch * 16) = d;
                s0 -= bflo(old.x); s1 -= bfhi(old.x); s2 -= bflo(old.y); s3 -= bfhi(old.y); s4 -= bflo(old.z); s5 -= bfhi(old.z); s6 -= bflo(old.w); s7 -= bfhi(old.w); }
        }
    } else {
#pragma unroll
        for (int rb = 0; rb < 8; ++rb) zf[rb] = __builtin_nontemporal_load((const u32x4*)(PZ + (size_t)(m0 + rb * 16 + fr) * DM + g * 256 + wv * 32 + 8 * fq));
#pragma unroll
        for (int nn = 0; nn < 2; ++nn) { scv[nn] = *(const f32x4*)(a.in[I_POOLSC] + g * 256 + wv * 32 + 8 * fq + 4 * nn);
#pragma unroll
            for (int ks = 0; ks < 8; ++ks) Bf[nn][ks] = *(const bf16x8*)(pw + nn * 4 * 256 + ks * 32); }
        const bf16* DS = (const bf16*)(a.ws + WS_DS);
        u32x4 td[8];
#pragma unroll
        for (int i = 0; i < 8; ++i) { const int idx = tid + i * 512, r = idx >> 5, ch = idx & 31; td[i] = *(const u32x4*)(DS + (size_t)r * DM + g * 256 + ch * 8); }
#pragma unroll
        for (int i = 0; i < 8; ++i) { const int idx = tid + i * 512, r = idx >> 5, ch = idx & 31; *(LAS u32x4*)(Db + r * RS + ch * 16) = td[i]; }
    }
    __syncthreads();
#pragma unroll
    for (int rb = 0; rb < 8; ++rb) {
        f32x4 acc0 = (f32x4){0.f, 0.f, 0.f, 0.f}, acc1 = acc0;
#pragma unroll
        for (int ks = 0; ks < 8; ++ks) { const bf16x8 A = *(const LAS bf16x8*)(Db + (rb * 16 + fr) * RS + (ks * 32 + fq * 8) * 2);
            acc0 = __builtin_amdgcn_mfma_f32_16x16x32_bf16(Bf[0][ks], A, acc0, 0, 0, 0); acc1 = __builtin_amdgcn_mfma_f32_16x16x32_bf16(Bf[1][ks], A, acc1, 0, 0, 0); }
        const size_t m = (size_t)(m0 + rb * 16 + fr); const int c = g * 256 + wv * 32 + 8 * fq; const u32x4 z = zf[rb];
        u32x4 o; o.x = pk2(acc0[0] * scv[0].x * bflo(z.x), acc0[1] * scv[0].y * bfhi(z.x)); o.y = pk2(acc0[2] * scv[0].z * bflo(z.y), acc0[3] * scv[0].w * bfhi(z.y));
        o.z = pk2(acc1[0] * scv[1].x * bflo(z.z), acc1[1] * scv[1].y * bfhi(z.z)); o.w = pk2(acc1[2] * scv[1].z * bflo(z.w), acc1[3] * scv[1].w * bfhi(z.w));
        *(u32x4*)(BR0 + m * DM + c) = o;
    }
    __syncthreads();
}
__device__ __forceinline__ void sgu_part(const KArgs& a, LAS unsigned char* lds, int rt, int g) {
    int tid_ = threadIdx.x; asm volatile("" : "+v"(tid_));
    const int tid = tid_, lane = tid & 63, wv = tid >> 6, fr = lane & 15, fq = lane >> 4;
    const int m0 = rt * 128;
    const bf16* U = (const bf16*)(a.ws + WS_PROJ) + (size_t)2 * MP * DM; const bf16* V = U + (size_t)MP * DM;
    const bf16* SW = (const bf16*)(a.ws + WS_SW); const float* VSS = (const float*)(a.ws + WS_VSS); bf16* BR1 = (bf16*)(a.ws + WS_BR) + (size_t)MP * DM;
    LAS unsigned char* Vb = lds; LAS unsigned char* UZb = lds + 128 * RS; LAS float* rbuf = (LAS float*)(lds + 256 * RS);
    u32x4 tv[8], tu[8];
#pragma unroll
    for (int i = 0; i < 8; ++i) { const int idx = tid + i * 512, s = idx >> 5, ch = idx & 31; const size_t o = (size_t)(m0 + s) * DM + g * 256 + ch * 8;
        tv[i] = __builtin_nontemporal_load((const u32x4*)(V + o)); tu[i] = __builtin_nontemporal_load((const u32x4*)(U + o)); }
    if (tid < 128) { const f32x4* p = (const f32x4*)(VSS + (size_t)(m0 + tid) * 16); const f32x4 p0 = p[0], p1 = p[1], p2 = p[2], p3 = p[3];
        const float s = ((p0.x + p0.y) + (p0.z + p0.w)) + ((p1.x + p1.y) + (p1.z + p1.w)) + ((p2.x + p2.y) + (p2.z + p2.w)) + ((p3.x + p3.y) + (p3.z + p3.w));
        rbuf[tid] = rsqrtf(s * (1.f / DM) + EPS); }
    const f32x4 gv0 = *(const f32x4*)(a.in[I_SGUNG] + g * 256 + wv * 32 + 8 * fq), gv1 = *(const f32x4*)(a.in[I_SGUNG] + g * 256 + wv * 32 + 8 * fq + 4);
    float biasv[8];
#pragma unroll
    for (int tb = 0; tb < 8; ++tb) biasv[tb] = a.in[I_SGUB][g * 128 + tb * 16 + fr];
    __syncthreads();
#pragma unroll
    for (int i = 0; i < 8; ++i) { const int idx = tid + i * 512, s = idx >> 5, ch = idx & 31; const float r = rbuf[s];
        u32x4 v; v.x = pk2(bflo(tv[i].x) * r, bfhi(tv[i].x) * r); v.y = pk2(bflo(tv[i].y) * r, bfhi(tv[i].y) * r); v.z = pk2(bflo(tv[i].z) * r, bfhi(tv[i].z) * r); v.w = pk2(bflo(tv[i].w) * r, bfhi(tv[i].w) * r);
        *(LAS u32x4*)(Vb + s * RS + ch * 16) = v;
        const u32x4 q = tu[i];
        *(LAS u32x4*)(UZb + s * RS + ch * 16) = q; }
    __syncthreads();
    const int q = fr >> 2, p = fr & 3;
    bf16x8 Vf[4][2];
#pragma unroll
    for (int ks = 0; ks < 4; ++ks)
#pragma unroll
        for (int nn = 0; nn < 2; ++nn) { const LAS unsigned char* a0 = Vb + (32 * ks + 8 * fq + q) * RS + (wv * 32 + 8 * p + 4 * nn) * 2; Vf[ks][nn] = tr_read2(a0, a0 + 4 * RS); }
#pragma unroll
    for (int tb = 0; tb < 8; ++tb) {
        f32x4 acc0 = (f32x4){0.f, 0.f, 0.f, 0.f}, acc1 = acc0;
        const int t = tb * 16 + fr;
#pragma unroll
        for (int ks = 0; ks < 4; ++ks) if (ks <= (tb >> 1)) {
            const bf16x8 A = *(const bf16x8*)(SW + (size_t)(g * 128 + t) * 128 + ks * 32 + fq * 8);
            acc0 = __builtin_amdgcn_mfma_f32_16x16x32_bf16(Vf[ks][0], A, acc0, 0, 0, 0); acc1 = __builtin_amdgcn_mfma_f32_16x16x32_bf16(Vf[ks][1], A, acc1, 0, 0, 0);
        }
        const size_t m = (size_t)(m0 + t); const float bias = biasv[tb];
        { const int cl = wv * 32 + 8 * fq; const u32x4 uz = *(const LAS u32x4*)(UZb + t * RS + cl * 2);
          u32x4 o; o.x = pk2((acc0[0] * gv0.x + bias) * bflo(uz.x), (acc0[1] * gv0.y + bias) * bfhi(uz.x)); o.y = pk2((acc0[2] * gv0.z + bias) * bflo(uz.y), (acc0[3] * gv0.w + bias) * bfhi(uz.y));
          o.z = pk2((acc1[0] * gv1.x + bias) * bflo(uz.z), (acc1[1] * gv1.y + bias) * bfhi(uz.z)); o.w = pk2((acc1[2] * gv1.z + bias) * bflo(uz.w), (acc1[3] * gv1.w + bias) * bfhi(uz.w));
          *(u32x4*)(BR1 + m * DM + g * 256 + cl) = o; }
    }
    __syncthreads();
}
__device__ __forceinline__ void attn_part(const KArgs& a, LAS unsigned char* lds, int rt, int g) {
    int tid_ = threadIdx.x; asm volatile("" : "+v"(tid_));
    const int tid = tid_, lane = tid & 63, wv = tid >> 6, fr = lane & 15, fq = lane >> 4;
    const int m0 = rt * 128, b = rt >> 4;
    const bf16* Q = (const bf16*)(a.ws + WS_PROJ) + (size_t)5 * MP * DM; const bf16* AZ = Q + (size_t)MP * DM;
    const bf16* KB = (const bf16*)(a.ws + WS_KB); const bf16* VB = (const bf16*)(a.ws + WS_VB); bf16* BR2 = (bf16*)(a.ws + WS_BR) + (size_t)2 * MP * DM;
    LAS unsigned char* Kb = lds;
    const size_t m = (size_t)(m0 + wv * 16 + fr);
    bf16x8 Qf[8];
    {
        u32x4 tk[16];
#pragma unroll
        for (int i = 0; i < 16; ++i) { const int idx = tid + i * 512, key = idx >> 5, ch = idx & 31; tk[i] = *(const u32x4*)(KB + (size_t)(b * 256 + key) * DM + g * 256 + ch * 8); }
#pragma unroll
        for (int ks = 0; ks < 8; ++ks) Qf[ks] = __builtin_nontemporal_load((const bf16x8*)(Q + m * DM + g * 256 + ks * 32 + fq * 8));
#pragma unroll
        for (int i = 0; i < 16; ++i) { const int idx = tid + i * 512, key = idx >> 5, ch = idx & 31; *(LAS u32x4*)(Kb + key * RS + ch * 16) = tk[i]; }
    }
    __syncthreads();
    u32x4 tvv[16];
#pragma unroll
    for (int i = 0; i < 16; ++i) { const int idx = tid + i * 512, key = idx >> 5, ch = idx & 31; tvv[i] = *(const u32x4*)(VB + (size_t)(b * 256 + key) * DM + g * 256 + ch * 8); }
    f32x4 sacc[16];
#pragma unroll
    for (int kb = 0; kb < 16; ++kb) { sacc[kb] = (f32x4){0.f, 0.f, 0.f, 0.f};
#pragma unroll
        for (int ks = 0; ks < 8; ++ks) { const bf16x8 Kf = *(const LAS bf16x8*)(Kb + (kb * 16 + fr) * RS + (ks * 32 + fq * 8) * 2);
            sacc[kb] = __builtin_amdgcn_mfma_f32_16x16x32_bf16(Kf, Qf[ks], sacc[kb], 0, 0, 0); }
        if (kb & 1) __builtin_amdgcn_sched_barrier(0); }
    float mx = -3.0e38f;
#pragma unroll
    for (int kb = 0; kb < 16; ++kb) mx = fmaxf(mx, fmaxf(fmaxf(sacc[kb][0], sacc[kb][1]), fmaxf(sacc[kb][2], sacc[kb][3])));
    mx = fmaxf(mx, __shfl_xor(mx, 16)); mx = fmaxf(mx, __shfl_xor(mx, 32));
    float sum = 0.f;
#pragma unroll
    for (int kb = 0; kb < 16; ++kb)
#pragma unroll
        for (int j = 0; j < 4; ++j) { const float pj = __expf((sacc[kb][j] - mx) * 0.0625f); sacc[kb][j] = pj; sum += pj; }
    sum += __shfl_xor(sum, 16); sum += __shfl_xor(sum, 32);
    const float isum = 1.f / sum;
    bf16x8 Pf[8];
#pragma unroll
    for (int k2 = 0; k2 < 8; ++k2) { u32x4 w; w.x = pk2(sacc[2 * k2][0], sacc[2 * k2][1]); w.y = pk2(sacc[2 * k2][2], sacc[2 * k2][3]);
        w.z = pk2(sacc[2 * k2 + 1][0], sacc[2 * k2 + 1][1]); w.w = pk2(sacc[2 * k2 + 1][2], sacc[2 * k2 + 1][3]); Pf[k2] = __builtin_bit_cast(bf16x8, w); }
    __syncthreads();
#pragma unroll
    for (int i = 0; i < 16; ++i) { const int idx = tid + i * 512, key = idx >> 5, ch = idx & 31; *(LAS u32x4*)(Kb + key * RSV + ch * 16) = tvv[i]; }
    u32x4 zf[8];
#pragma unroll
    for (int d2 = 0; d2 < 8; ++d2) zf[d2] = __builtin_nontemporal_load((const u32x4*)(AZ + m * DM + g * 256 + d2 * 32 + 8 * fq));
    __syncthreads();
    const int q = fr >> 2, p = fr & 3;
#pragma unroll
    for (int d2 = 0; d2 < 8; ++d2) {
        f32x4 o0 = (f32x4){0.f, 0.f, 0.f, 0.f}, o1 = o0;
#pragma unroll
        for (int k2 = 0; k2 < 8; ++k2) { const LAS unsigned char* a0 = Kb + (32 * k2 + 4 * fq + q) * RSV + (d2 * 32 + 8 * p) * 2;
            const bf16x8 Vf0 = tr_read2(a0, a0 + 16 * RSV), Vf1 = tr_read2(a0 + 8, a0 + 8 + 16 * RSV);
            o0 = __builtin_amdgcn_mfma_f32_16x16x32_bf16(Vf0, Pf[k2], o0, 0, 0, 0); o1 = __builtin_amdgcn_mfma_f32_16x16x32_bf16(Vf1, Pf[k2], o1, 0, 0, 0); }
        const int c = g * 256 + d2 * 32 + 8 * fq; const u32x4 z = zf[d2];
        u32x4 w; w.x = pk2(o0[0] * isum * bflo(z.x), o0[1] * isum * bfhi(z.x)); w.y = pk2(o0[2] * isum * bflo(z.y), o0[3] * isum * bfhi(z.y));
        w.z = pk2(o1[0] * isum * bflo(z.z), o1[1] * isum * bfhi(z.z)); w.w = pk2(o1[2] * isum * bflo(z.w), o1[3] * isum * bfhi(z.w));
        *(u32x4*)(BR2 + m * DM + c) = w;
        __builtin_amdgcn_sched_barrier(0);
    }
    __syncthreads();
}
__device__ __forceinline__ void sgu_sample(const KArgs& a, int g, int rb) {
    int tid_ = threadIdx.x; asm volatile("" : "+v"(tid_));
    const int tid = tid_;
    const bf16* U = (const bf16*)(a.ws + WS_PROJ) + (size_t)2 * MP * DM; const bf16* V = U + (size_t)MP * DM;
    const float* VSS = (const float*)(a.ws + WS_VSS); bf16* BR1 = (bf16*)(a.ws + WS_BR) + (size_t)MP * DM;
    const float w00 = a.in[I_SGUW][(size_t)g * 128 * 128], b0 = a.in[I_SGUB][g * 128];
    for (int idx = tid; idx < 16 * 64; idx += 512) {
        const int i = rb * 16 + (idx >> 6), c = g * 256 + (idx & 63) * 4; const size_t m = (size_t)(MPR + i);
        const float s = wave_sum((idx & 63) < 16 ? VSS[m * 16 + (idx & 63)] : 0.f);
        const float rs = rsqrtf(s * (1.f / DM) + EPS);
        const f32x4 gv = *(const f32x4*)(a.in[I_SGUNG] + c);
        const u32x2 v4 = *(const u32x2*)(V + m * DM + c), u4 = *(const u32x2*)(U + m * DM + c);
        f32x4 vn; vn.x = bflo(v4.x) * rs * gv.x; vn.y = bfhi(v4.x) * rs * gv.y; vn.z = bflo(v4.y) * rs * gv.z; vn.w = bfhi(v4.y) * rs * gv.w;
        *(f32x4*)(a.out + O_SV + (size_t)i * DM + c) = vn;
        u32x2 o; o.x = pk2(bflo(u4.x) * (w00 * vn.x + b0), bfhi(u4.x) * (w00 * vn.y + b0));
        o.y = pk2(bflo(u4.y) * (w00 * vn.z + b0), bfhi(u4.y) * (w00 * vn.w + b0));
        *(u32x2*)(BR1 + m * DM + c) = o;
    }
}
__device__ __forceinline__ void attn_sample(const KArgs& a, LAS unsigned char* lds, int i, int h) {
    int tid_ = threadIdx.x; asm volatile("" : "+v"(tid_));
    const int tid = tid_, lane = tid & 63, wv = tid >> 6;
    const bf16* Q = (const bf16*)(a.ws + WS_PROJ) + (size_t)5 * MP * DM; const bf16* AZ = Q + (size_t)MP * DM; bf16* BR2 = (bf16*)(a.ws + WS_BR) + (size_t)2 * MP * DM;
    const size_t m = (size_t)(MPR + i);
    const float* Kc = a.in[I_CK] + ((size_t)i * NMEM * 4 + h) * 256 + lane * 4;
    const float* Vc = a.in[I_CV] + ((size_t)i * NMEM * 4 + h) * 256 + lane * 4;
    LAS float* sc = (LAS float*)lds; LAS float* part = (LAS float*)(lds + 1024);
    const u32x2 q2 = *(const u32x2*)(Q + m * DM + h * 256 + lane * 4);
    const f32x4 qv = (f32x4){bflo(q2.x), bfhi(q2.x), bflo(q2.y), bfhi(q2.y)};
    {
        f32x4 kv[32]; float pd[32];
#pragma unroll
        for (int j = 0; j < 32; ++j) kv[j] = __builtin_nontemporal_load((const f32x4*)(Kc + (size_t)(wv * 32 + j) * 1024));
#pragma unroll
        for (int j = 0; j < 32; ++j) pd[j] = (kv[j].x * qv.x + kv[j].y * qv.y) + (kv[j].z * qv.z + kv[j].w * qv.w);
#pragma unroll
        for (int j = 0; j < 32; ++j) { const float d = wave_sum(pd[j]); if (lane == 0) sc[wv * 32 + j] = d * 0.0625f; }
    }
    f32x4 vv[32];
#pragma unroll
    for (int j = 0; j < 32; ++j) vv[j] = __builtin_nontemporal_load((const f32x4*)(Vc + (size_t)(wv * 32 + j) * 1024));
    __syncthreads();
    const f32x4 s4 = *(const LAS f32x4*)(sc + lane * 4);
    const float mx = wave_max(fmaxf(fmaxf(s4.x, s4.y), fmaxf(s4.z, s4.w)));
    const float sum = wave_sum((__expf(s4.x - mx) + __expf(s4.y - mx)) + (__expf(s4.z - mx) + __expf(s4.w - mx)));
    f32x4 o = (f32x4){0.f, 0.f, 0.f, 0.f};
#pragma unroll
    for (int j = 0; j < 32; ++j) { const float pj = __expf(sc[wv * 32 + j] - mx); o += vv[j] * pj; }
    *(LAS f32x4*)(part + wv * 256 + lane * 4) = o;
    __syncthreads();
    if (tid < 256) { float t = 0.f;
#pragma unroll
        for (int w8 = 0; w8 < 8; ++w8) t += part[w8 * 256 + tid];
        const int c = h * 256 + tid; const unsigned short zb = AZ[m * DM + c]; const float z = __builtin_bit_cast(float, (unsigned)zb << 16);
        BR2[m * DM + c] = (bf16)f2bf(t / sum * z); }
    __syncthreads();
}
__device__ __forceinline__ void p2_mixers(const KArgs& a, LAS unsigned char* lds, int G) {
    constexpr int NU = 512 + 512 + 4 + 32;
    if (G == 256) {
        const int c = blockIdx.x;
        for (int k = 0; k < 4; ++k) { const int kk = (c & 1) ? (k ^ 2) : k;
            if (kk < 2) { const int u = c + kk * 256, rt = u >> 2, g = u & 3; pool_part(a, lds, rt, g); sgu_part(a, lds, rt, g); attn_part(a, lds, rt, g); }
            else { const int e = c + (kk - 2) * 256; attn_sample(a, lds, e >> 2, e & 3); } }
        if (c < 4) pool_part(a, lds, 128, c); else if (c >= 8 && c < 40) sgu_sample(a, (c - 8) >> 3, (c - 8) & 7);
        return;
    }
    for (int u = blockIdx.x; u < NU; u += G) {
        if (u < 512) { const int rt = u >> 2, g = u & 3; pool_part(a, lds, rt, g); sgu_part(a, lds, rt, g); attn_part(a, lds, rt, g); }
        else if (u < 1024) { const int e = u - 512; attn_sample(a, lds, e >> 2, e & 3); }
        else if (u < 1028) pool_part(a, lds, 128, u - 1024);
        else sgu_sample(a, (u - 1028) >> 3, (u - 1028) & 7);
    }
}
__device__ __forceinline__ void p5_norm(const KArgs& a, int G) {
    const int tid = threadIdx.x, lane = tid & 63, wave = tid >> 6;
    const int gw = blockIdx.x * 8 + wave, NGW = G * 8;
    const f32x4* gr = (const f32x4*)a.in[I_NORMF] + lane;
    for (int m = gw; m < MV; m += NGW) {
        f32x4* xr = (f32x4*)(a.out + (size_t)m * DM) + lane;
        f32x4 v[4]; float s = 0.f;
#pragma unroll
        for (int j = 0; j < 4; ++j) { v[j] = xr[64 * j]; s += (v[j].x * v[j].x + v[j].y * v[j].y) + (v[j].z * v[j].z + v[j].w * v[j].w); }
        const float rs = rsqrtf(wave_sum(s) * (1.f / DM) + EPS);
#pragma unroll
        for (int j = 0; j < 4; ++j) { const f32x4 g = gr[64 * j]; xr[64 * j] = (f32x4){v[j].x * rs * g.x, v[j].y * rs * g.y, v[j].z * rs * g.z, v[j].w * rs * g.w}; }
    }
}

__global__ void __launch_bounds__(512, 2) fwd_megakernel(KArgs a) {
    extern __shared__ __attribute__((aligned(16))) unsigned char lds_raw[];
    LAS unsigned char* lds = (LAS unsigned char*)lds_raw;
    cg::grid_group grid = cg::this_grid();
    const int G = gridDim.x;
    const int lo = a.ph_lo, hi = a.ph_hi;
    volatile LAS unsigned* bst = (volatile LAS unsigned*)(lds + LDS_BYTES - 64);
    if (threadIdx.x == 0) { bst[0] = 0u; bst[1] = 0u; }
    __syncthreads();
    const XcdBarrier bar = xcd_barrier_post((unsigned*)(a.ws + WS_CTL), bst);
#define IN(k) (lo <= (k) && (k) < hi)
#define SEAM(k) do { if (IN(k) && IN((k) + 1)) { if (a.cg_sync) grid.sync(); else xcd_barrier(bar); } } while (0)
    if (IN(0)) p0_prologue(a, lds, G);
    SEAM(0);
    if (IN(1)) {
        pg8::Gemm g{(const bf16*)(a.ws + WS_H), (const bf16*)(a.ws + WS_WIN), MP, INC, DM};
        P1Order S; S.init(G, (int)blockIdx.x);
        EpiProj E{(bf16*)(a.ws + WS_PROJ), (bf16*)(a.ws + WS_GATE), (float*)(a.ws + WS_VSS), (bf16*)(a.ws + WS_KB), (bf16*)(a.ws + WS_VB), a.out, (const float*)(a.ws + WS_HS), (bf16*)(a.ws + WS_DS)};
        pg8::gemm_phase<EpiProj, P1Order>(lds, g, S, E);
    }
    SEAM(1);
    if (IN(2)) p2_mixers(a, lds, G);
    SEAM(2);
    if (IN(3)) {
        pg8::Gemm g{(const bf16*)(a.ws + WS_BR), (const bf16*)(a.ws + WS_WD), MPR, 3 * DM, DM};
        P3Order S; S.init(G, (int)blockIdx.x);
        EpiGate E{(const bf16*)(a.ws + WS_GATE), (bf16*)(a.ws + WS_MG)};
        pg8::gemm_phase<EpiGate, P3Order>(lds, g, S, E);
        EpiS3 E3{(const bf16*)(a.ws + WS_GATE), (bf16*)(a.ws + WS_GYS)};
        skinny_gemm(lds, (const bf16*)(a.ws + WS_BR) + (size_t)MPR * DM, DM, (size_t)MP * DM, 64, 1, 0, (const bf16*)(a.ws + WS_WD), DM, DM, 192, (int)blockIdx.x, G, E3);
    }
    SEAM(3);
    if (IN(4)) {
        pg8::Gemm g{(const bf16*)(a.ws + WS_MG), (const bf16*)(a.ws + WS_WO3), MPR, DM, DM};
        pg8::StaticOrder S; S.init(MPR, DM, G, (int)blockIdx.x);
        unsigned* ctl = (unsigned*)(a.ws + WS_CTL);
        EpiOutNorm E{a.in[I_XP], a.in[I_NORMF], a.out, (float*)(a.ws + WS_VSS), ctl + CW_PANEL};
        pg8::gemm_phase<EpiOutNorm, pg8::StaticOrder>(lds, g, S, E);
        sample_out_split(a, lds, (int)blockIdx.x);
    }
#undef IN
#undef SEAM
}

extern "C" void kernel_launch(void* const* d_in, const int* in_sizes, int n_in, void* d_out, int out_size, void* d_ws, size_t ws_size, hipStream_t stream) {
    static int grid = 0;
    if (grid == 0) {
        if (n_in != 18 || (size_t)out_size != O_END || ws_size < WS_END) { fprintf(stderr, "kernel_launch: unexpected shapes (n_in %d out %d ws %zu, need %zu)\n", n_in, out_size, ws_size, (size_t)WS_END); grid = -1; return; }
        int dev = 0, cus = 0, per_cu = 0;
        hipGetDevice(&dev); hipDeviceGetAttribute(&cus, hipDeviceAttributeMultiprocessorCount, dev);
        if (hipFuncSetAttribute((const void*)fwd_megakernel, hipFuncAttributeMaxDynamicSharedMemorySize, LDS_BYTES) != hipSuccess) { fprintf(stderr, "kernel_launch: hipFuncSetAttribute failed\n"); grid = -1; return; }
        if (hipOccupancyMaxActiveBlocksPerMultiprocessor(&per_cu, (const void*)fwd_megakernel, 512, LDS_BYTES) != hipSuccess || per_cu < 1) { fprintf(stderr, "kernel_launch: occupancy query failed (%d)\n", per_cu); grid = -1; return; }
        if (cus != 256) { fprintf(stderr, "kernel_launch: built for a 256-CU device (one 256x256 tile per workgroup in the last two phases), got %d\n", cus); grid = -1; return; }
        grid = cus;
    }
    if (grid < 0) return;
    if (hipMemsetAsync((char*)d_ws + WS_CTL, 0, CTL_BYTES, stream) != hipSuccess) { fprintf(stderr, "kernel_launch: memset failed\n"); return; }
    KArgs a{};
    for (int i = 0; i < 18; ++i) a.in[i] = (const float*)d_in[i];
    a.out = (float*)d_out; a.ws = (unsigned char*)d_ws; a.ph_lo = 0; a.ph_hi = 5;
    void* args[] = {&a};
    hipError_t e = hipLaunchCooperativeKernel((const void*)fwd_megakernel, dim3(grid), dim3(512), args, LDS_BYTES, stream);
    if (e != hipSuccess) fprintf(stderr, "cooperative launch failed: %s (grid %d)\n", hipGetErrorString(e), grid);
}
```

```cpp
#include <hip/hip_runtime.h>
#include <hip/hip_cooperative_groups.h>
#include <cstdio>
#include <cstdint>
namespace cg = cooperative_groups;

#define LAS __attribute__((address_space(3)))
typedef unsigned short bf16;
typedef short bf16x8 __attribute__((ext_vector_type(8)));
typedef short s16x4 __attribute__((ext_vector_type(4)));
typedef float f32x4 __attribute__((ext_vector_type(4)));
typedef unsigned u32x4 __attribute__((ext_vector_type(4)));
typedef unsigned u32x2 __attribute__((ext_vector_type(2)));

constexpr int DM = 1024, NBATCH = 8, SEQ = 2048, NS = 128, NMEM = 256;
constexpr int MPR = NBATCH * SEQ;
constexpr int MV = MPR + NS;
constexpr int MP = MPR + 256;
constexpr int NPAN = MP / 256;
constexpr int INC = 10240;
constexpr float EPS = 1e-6f;
constexpr size_t O_YP = 0, O_YS = O_YP + (size_t)MPR * DM, O_POOLP = O_YS + (size_t)NS * DM, O_POOLS = O_POOLP + (size_t)NBATCH * 15 * DM,
                 O_MK = O_POOLS + (size_t)NS * 15 * DM, O_MV = O_MK + (size_t)NBATCH * NMEM * DM, O_SV = O_MV + (size_t)NBATCH * NMEM * DM, O_END = O_SV + (size_t)NS * DM;
constexpr size_t ROWB = (size_t)MP * DM * 2;
constexpr size_t WS_CTL = 0, CTL_BYTES = 40960;
constexpr size_t WS_VSS2 = CTL_BYTES;
constexpr size_t WS_DS = WS_VSS2 + 32768;
constexpr size_t WS_HS = WS_DS + 262144;
constexpr size_t WS_H = WS_HS + 524288;
constexpr size_t WS_WIN = WS_H + (size_t)(MP + 2048) * DM * 2;
constexpr size_t WS_WD = WS_WIN + (size_t)(INC + 2048) * DM * 2;
constexpr size_t WS_WO3 = WS_WD + (size_t)3 * DM * DM * 2;
constexpr size_t WS_PW = WS_WO3 + (size_t)3 * DM * DM * 2;
constexpr size_t WS_SW = WS_PW + (size_t)4 * 256 * 256 * 2;
constexpr size_t WS_VSS = WS_SW + (size_t)4 * 128 * 128 * 2;
constexpr size_t WS_KB = WS_VSS + (size_t)MP * 16 * 4;
constexpr size_t WS_VB = WS_KB + (size_t)2048 * DM * 2;
constexpr size_t WS_PROJ = WS_VB + (size_t)2048 * DM * 2;
constexpr size_t WS_GATE = WS_PROJ + 7 * ROWB;
constexpr size_t WS_BR = WS_GATE + 3 * ROWB;
constexpr size_t WS_MG = WS_PROJ;
constexpr size_t WS_GYS = WS_H;
constexpr size_t WS_END = WS_BR + 3 * ROWB;
constexpr int LDS_BYTES = 147456;
constexpr int CW_PANEL = 4096, CW_SAMPLE = 4096 + 64 * 64;

__device__ __forceinline__ unsigned f2bf(float f) { unsigned u = __builtin_bit_cast(unsigned, f); return (u + 0x7fffu + ((u >> 16) & 1u)) >> 16; }
__device__ __forceinline__ unsigned pk2(float lo, float hi) { unsigned r; asm volatile("v_cvt_pk_bf16_f32 %0, %1, %2" : "=v"(r) : "v"(lo), "v"(hi)); return r; }
__device__ __forceinline__ float bflo(unsigned w) { return __builtin_bit_cast(float, w << 16); }
__device__ __forceinline__ float bfhi(unsigned w) { return __builtin_bit_cast(float, w & 0xffff0000u); }
__device__ __forceinline__ float silu_f(float x) { return x * __builtin_amdgcn_rcpf(1.f + __expf(-x)); }
__device__ __forceinline__ float sigm_f(float x) { return __builtin_amdgcn_rcpf(1.f + __expf(-x)); }
__device__ __forceinline__ float wave_sum(float v) {
#pragma unroll
    for (int o = 1; o < 64; o <<= 1) v += __shfl_xor(v, o);
    return v;
}
__device__ __forceinline__ float wave_max(float v) {
#pragma unroll
    for (int o = 1; o < 64; o <<= 1) v = fmaxf(v, __shfl_xor(v, o));
    return v;
}
__device__ __forceinline__ bf16x8 tr_read2(const LAS unsigned char* a0, const LAS unsigned char* a1) {
    const s16x4 lo = __builtin_amdgcn_ds_read_tr16_b64_v4i16((LAS s16x4*)a0);
    const s16x4 hi = __builtin_amdgcn_ds_read_tr16_b64_v4i16((LAS s16x4*)a1);
    return (bf16x8){lo[0], lo[1], lo[2], lo[3], hi[0], hi[1], hi[2], hi[3]};
}

#define XB_TMO      128
#define XB_XCNT(j)  (256  + 64 * (j))
#define XB_XSUB(j)  (1280 + 64 * (j))
#define XB_XGEN(j)  (2304 + 64 * (j))
#define XB_TOP      3328
#define XB_TOPGEN   3392
#define XCD_BAR_WORDS 3456
#define XB_SPIN_CAP (1u << 18)

__device__ __forceinline__ unsigned xb_ld(unsigned* p)              { return __hip_atomic_load(p, __ATOMIC_RELAXED, __HIP_MEMORY_SCOPE_AGENT); }
__device__ __forceinline__ unsigned xb_add(unsigned* p, unsigned v) { return __hip_atomic_fetch_add(p, v, __ATOMIC_RELAXED, __HIP_MEMORY_SCOPE_AGENT); }
__device__ __forceinline__ unsigned xb_xcc_id() { return (unsigned)__builtin_amdgcn_s_getreg((3 << 11) | 20) & 0xFu; }
#define XB_SPIN(cond, bar) do { unsigned _sp = 0; while (cond) { __builtin_amdgcn_s_sleep(1); \
    if ((++_sp & 255u) == 0u) { if (xb_ld(&(bar)[XB_TMO])) break; if (_sp > XB_SPIN_CAP) { atomicAdd(&(bar)[XB_TMO], 1u); break; } } } } while (0)

struct XcdBarrier {
    unsigned* bar; unsigned x;
    volatile LAS unsigned* st;
};

__device__ __forceinline__ XcdBarrier xcd_barrier_post(unsigned* bar, volatile LAS unsigned* st) {
    XcdBarrier b; b.bar = bar; b.x = xb_xcc_id(); b.st = st;
    if (threadIdx.x == 0) (void)xb_add(&bar[XB_XCNT(b.x)], 1u);
    return b;
}
__device__ __forceinline__ void xcd_barrier_complete(unsigned* bar, unsigned x, unsigned& nloc, unsigned& nx) {
    const unsigned G = gridDim.x;
    unsigned sum, cnt, mine, sp = 0u;
    for (;;) {
        sum = 0u; cnt = 0u; mine = 0u;
#pragma unroll
        for (unsigned j = 0; j < 16; ++j) { const unsigned c = xb_ld(&bar[XB_XCNT(j)]); sum += c; cnt += (c > 0u) ? 1u : 0u; mine = (j == x) ? c : mine; }
        if (sum == G) break;
        __builtin_amdgcn_s_sleep(1);
        if ((++sp & 255u) == 0u) { if (xb_ld(&bar[XB_TMO])) break; if (sp > XB_SPIN_CAP) { atomicAdd(&bar[XB_TMO], 1u); break; } }
    }
    nloc = mine > 0u ? mine : 1u; nx = cnt > 0u ? cnt : 1u;
}

__device__ __forceinline__ void xcd_barrier(const XcdBarrier& b) {
    asm volatile("s_waitcnt vmcnt(0)" ::: "memory");
    __syncthreads();
    if (threadIdx.x == 0) {
        unsigned* bar = b.bar;
        __builtin_amdgcn_s_waitcnt(0);
        unsigned nloc = b.st[0], nx = b.st[1];
        if (nloc == 0u) { xcd_barrier_complete(bar, b.x, nloc, nx); b.st[0] = nloc; b.st[1] = nx; }
        const unsigned old = xb_add(&bar[XB_XSUB(b.x)], 1u);
        const unsigned gen = old / nloc;
        if (old + 1u == (gen + 1u) * nloc) {
            __builtin_amdgcn_fence(__ATOMIC_RELEASE, "agent");
            asm volatile("s_waitcnt vmcnt(0)" ::: "memory");
            const unsigned og = xb_add(&bar[XB_TOP], 1u);
            const unsigned tg = og / nx;
            if (og + 1u == (tg + 1u) * nx) xb_add(&bar[XB_TOPGEN], 1u);
            else XB_SPIN(xb_ld(&bar[XB_TOPGEN]) == tg, bar);
            __builtin_amdgcn_fence(__ATOMIC_ACQUIRE, "agent");
            xb_add(&bar[XB_XGEN(b.x)], 1u);
            asm volatile("s_waitcnt vmcnt(0)" ::: "memory");
        } else {
            XB_SPIN(xb_ld(&bar[XB_XGEN(b.x)]) == gen, bar);
            __builtin_amdgcn_fence(__ATOMIC_ACQUIRE, "agent");
            asm volatile("s_waitcnt vmcnt(0)" ::: "memory");
        }
    }
    __syncthreads();
}

namespace pg8 {
#define PG8_LAS __attribute__((address_space(3)))
typedef unsigned short bf16_t;
constexpr int BM = 256, BK = 64, HALF = 128, HTB = HALF * BK * 2, STAGE_BYTES = 8 * HTB, NXCD = 8, WGM = 8;
__host__ __device__ __forceinline__ int lds_byte(int r, int c) { const int st = (r >> 4) * 2 + (c >> 5), rr = r & 15, cc = c & 31, ob = rr * 64 + cc * 2; return st * 1024 + (ob ^ (((ob >> 9) & 1) << 5)); }
__host__ __device__ __forceinline__ void stage_rc(int b, int& R, int& C) { const int st = b / 1024, sb = b % 1024, swz = sb ^ (((sb >> 9) & 1) << 5); R = (st >> 1) * 16 + swz / 64; C = (st & 1) * 32 + (swz % 64) / 2; }
__host__ __device__ __forceinline__ int perm32(int rho) { const int n = rho >> 4, i = rho & 15; return 8 * (i >> 2) + 4 * n + (i & 3); }
struct Unit { int pm, pn; int brow, fz; };
struct Gemm { const bf16_t* A; const bf16_t* Bt; int M, N, K; };
struct StaticOrder {
    int nM, nN, nwg, G, c;
    __host__ __device__ void init(int M, int N, int G_, int c_) { nM = M / BM; nN = N / BM; nwg = nM * nN; G = G_; c = c_; }
    __host__ __device__ bool next(int i, Unit& u) const {
        const long L = (long)i * G + c; if (L >= nwg) return false;
        int wgid = (int)L; { const int q = nwg / NXCD, r = nwg % NXCD, xcd = wgid % NXCD, off = wgid / NXCD; wgid = (xcd < r ? xcd * (q + 1) : r * (q + 1) + (xcd - r) * q) + off; }
        const int nig = WGM * nN, gid = wgid / nig, fm = gid * WGM, gsz = (nM - fm) < WGM ? (nM - fm) : WGM;
        u.pm = fm + ((wgid % nig) % gsz); u.pn = (wgid % nig) / gsz; u.brow = u.pn * BM; u.fz = 0; return true;
    }
    __device__ __forceinline__ void a_ready(const Unit&) const {}
    __device__ __forceinline__ void done(const Unit&) const {}
};

template <class Epi, class Sched>
__device__ __forceinline__ void gemm_phase(PG8_LAS unsigned char* lds, const Gemm g, const Sched& S, const Epi& E) {
    const int tid = threadIdx.x, wid = __builtin_amdgcn_readfirstlane(tid >> 6), lane = tid & 63, wr = wid >> 2, wc = wid & 3, fr = lane & 15, fq = lane >> 4;
    const int K = g.K, nt = K / BK;
    unsigned voffA[2], voffB[2], voffBf[2];
#pragma unroll
    for (int i = 0; i < 2; ++i) { int R, C; stage_rc(tid * 16 + i * 8192, R, C); const int Rb = Epi::PERM ? ((R >> 5) * 64 + perm32(R & 31)) : R;
        voffA[i] = (unsigned)(R * K + C) * 2u; voffB[i] = (unsigned)(Rb * K + C) * 2u; voffBf[i] = (unsigned)((Rb - (R >> 5) * 32) * K + C) * 2u; }
    const size_t kstep = (size_t)(BK * 2);
    const size_t hstep = (size_t)HALF * K * 2;
    const size_t hstepB = Epi::PERM ? (size_t)32 * K * 2 : hstep;
    const size_t tstep = 2 * hstep;
    const unsigned ldsw = (unsigned)wid * 1024u;
    const int aoff = lds_byte(wr * 64 + fr, fq * 8), boff = lds_byte(wc * 32 + fr, fq * 8);
#define PG8_SA(b, h) (((b) * 2 + (h)) * HTB)
#define PG8_SB(b, h) ((4 + (b) * 2 + (h)) * HTB)
#define PG8_STAGE(bufoff, gbase, voff) do { _Pragma("unroll") for (int _i = 0; _i < 2; ++_i) \
        __builtin_amdgcn_global_load_lds((const unsigned*)((const char*)(gbase) + (voff)[_i]), (PG8_LAS unsigned*)(lds + (bufoff) + ldsw + _i * 8192), 16, 0, 0); } while (0)
#define PG8_LDA(dst, b, h) do { _Pragma("unroll") for (int m = 0; m < 4; ++m) _Pragma("unroll") for (int k = 0; k < 2; ++k) dst[m][k] = *(const PG8_LAS bf16x8*)(lds + PG8_SA(b, h) + aoff + m * 2048 + k * 1024); } while (0)
#define PG8_LDB(dst, b, h) do { _Pragma("unroll") for (int n = 0; n < 2; ++n) _Pragma("unroll") for (int k = 0; k < 2; ++k) dst[n][k] = *(const PG8_LAS bf16x8*)(lds + PG8_SB(b, h) + boff + n * 2048 + k * 1024); } while (0)
#define PG8_MMA(ai, bj, At, Bt) do { __builtin_amdgcn_s_setprio(1); _Pragma("unroll") for (int m = 0; m < 4; ++m) _Pragma("unroll") for (int n = 0; n < 2; ++n) _Pragma("unroll") for (int k = 0; k < 2; ++k) \
        acc[ai][bj][m][n] = __builtin_amdgcn_mfma_f32_16x16x32_bf16(Bt[n][k], At[m][k], acc[ai][bj][m][n], 0, 0, 0); __builtin_amdgcn_s_setprio(0); } while (0)
#define PG8_WAIT_V(n) asm volatile("s_waitcnt vmcnt(" #n ")" ::: "memory")
#define PG8_WAIT_L(n) asm volatile("s_waitcnt lgkmcnt(" #n ")" ::: "memory")
#define PG8_BAR __builtin_amdgcn_s_barrier()
#define PG8_SCHED __builtin_amdgcn_sched_barrier(0)
    Unit cur, nxt; int ui = 0;
    if (!S.next(0, cur)) return;
    f32x4 acc[2][2][4][2];
#pragma unroll
    for (int a = 0; a < 2; ++a)
#pragma unroll
        for (int b = 0; b < 2; ++b)
#pragma unroll
            for (int m = 0; m < 4; ++m)
#pragma unroll
                for (int n = 0; n < 2; ++n) acc[a][b][m][n] = (f32x4){0.f, 0.f, 0.f, 0.f};
    bf16x8 At[4][2], B0[2][2], B1[2][2];
    const size_t rowB = (size_t)K * 2, hstepBf = (size_t)2048 * K * 2;
    const char* cA = (const char*)g.A + (size_t)cur.pm * tstep; const char* cB = (const char*)g.Bt + (size_t)cur.brow * rowB;
    S.a_ready(cur);
    { unsigned vB[2] = {cur.fz ? voffBf[0] : voffB[0], cur.fz ? voffBf[1] : voffB[1]}; const size_t hB = cur.fz ? hstepBf : hstepB;
    PG8_STAGE(PG8_SB(0, 0), cB, vB); PG8_STAGE(PG8_SA(0, 0), cA, voffA); PG8_STAGE(PG8_SB(0, 1), cB + hB, vB); PG8_STAGE(PG8_SA(0, 1), cA + hstep, voffA);
    if (wr == 1) PG8_BAR;
    PG8_WAIT_V(4); PG8_BAR;
    PG8_STAGE(PG8_SB(1, 0), cB + kstep, vB); PG8_STAGE(PG8_SA(1, 0), cA + kstep, voffA); PG8_STAGE(PG8_SB(1, 1), cB + hB + kstep, vB);
    PG8_WAIT_V(6); PG8_BAR; }
    for (;;) {
        const bool has_next = S.next(ui + 1, nxt);
        const char* nA = has_next ? (const char*)g.A + (size_t)nxt.pm * tstep : cA; const char* nB = has_next ? (const char*)g.Bt + (size_t)nxt.brow * rowB : cB;
        const int nfz = has_next ? nxt.fz : cur.fz;
        E.prefetch(cur, wid, lane, lds + STAGE_BYTES + wid * 1024);
        for (int t = 0; t < nt; t += 2) {
            const bool last = (t == nt - 2);
            const char* a1 = cA + (size_t)(t + 1) * kstep;
            const char* a2 = last ? nA : cA + (size_t)(t + 2) * kstep; const char* b2 = last ? nB : cB + (size_t)(t + 2) * kstep;
            const char* a3 = a2 + kstep; const char* b3 = b2 + kstep;
            const int fzt = last ? nfz : cur.fz; unsigned vB[2] = {fzt ? voffBf[0] : voffB[0], fzt ? voffBf[1] : voffB[1]}; const size_t hB = fzt ? hstepBf : hstepB;
            if (last && has_next) S.a_ready(nxt);
            PG8_LDB(B0, 0, 0); PG8_SCHED; PG8_LDA(At, 0, 0); PG8_STAGE(PG8_SA(1, 1), a1 + hstep, voffA);
            PG8_WAIT_L(8); PG8_BAR; PG8_WAIT_L(0); PG8_MMA(0, 0, At, B0); PG8_BAR; PG8_SCHED;
            PG8_LDB(B1, 0, 1); PG8_STAGE(PG8_SB(0, 0), b2, vB);
            PG8_BAR; PG8_WAIT_L(0); PG8_MMA(0, 1, At, B1); PG8_BAR;
            PG8_LDA(At, 0, 1); PG8_STAGE(PG8_SA(0, 0), a2, voffA);
            PG8_BAR; PG8_WAIT_L(0); PG8_MMA(1, 0, At, B0); PG8_BAR; PG8_SCHED;
            PG8_STAGE(PG8_SB(0, 1), b2 + hB, vB);
            PG8_WAIT_V(6); PG8_BAR; PG8_MMA(1, 1, At, B1); PG8_BAR;
            PG8_LDB(B0, 1, 0); PG8_SCHED; PG8_LDA(At, 1, 0); PG8_STAGE(PG8_SA(0, 1), a2 + hstep, voffA);
            PG8_WAIT_L(8); PG8_BAR; PG8_WAIT_L(0); PG8_MMA(0, 0, At, B0); PG8_BAR; PG8_SCHED;
            PG8_LDB(B1, 1, 1); PG8_STAGE(PG8_SB(1, 0), b3, vB);
            PG8_BAR; PG8_WAIT_L(0); PG8_MMA(0, 1, At, B1); PG8_BAR;
            PG8_LDA(At, 1, 1); PG8_STAGE(PG8_SA(1, 0), a3, voffA);
            PG8_BAR; PG8_WAIT_L(0); PG8_MMA(1, 0, At, B0); PG8_BAR; PG8_SCHED;
            PG8_STAGE(PG8_SB(1, 1), b3 + hB, vB);
            PG8_WAIT_V(6); PG8_BAR; PG8_MMA(1, 1, At, B1); PG8_BAR;
        }
        if constexpr (!Epi::AFTER_DRAIN) { E(acc, cur, wr, wc, fr, fq); S.done(cur); }
        if (!has_next) break;
#pragma unroll
        for (int a = 0; a < 2; ++a)
#pragma unroll
            for (int b = 0; b < 2; ++b)
#pragma unroll
                for (int m = 0; m < 4; ++m)
#pragma unroll
                    for (int n = 0; n < 2; ++n) acc[a][b][m][n] = (f32x4){0.f, 0.f, 0.f, 0.f};
        cur = nxt; cA = nA; cB = nB; ++ui;
    }
    PG8_WAIT_V(0);
    if (wr == 0) PG8_BAR;
    PG8_BAR;
    if constexpr (Epi::AFTER_DRAIN) { E.fused(acc, cur, wr, wc, fr, fq); S.done(cur); }
#undef PG8_SA
#undef PG8_SB
#undef PG8_STAGE
#undef PG8_LDA
#undef PG8_LDB
#undef PG8_MMA
#undef PG8_WAIT_V
#undef PG8_WAIT_L
#undef PG8_BAR
#undef PG8_SCHED
}
}

struct KArgs {
    const float* in[18];
    float* out;
    unsigned char* ws;
    int ph_lo, ph_hi;
    int cg_sync, pad;
};
enum { I_XP = 0, I_XS, I_SPOOL, I_CK, I_CV, I_MEM, I_NORMG, I_WIN, I_POOLW, I_POOLSC, I_SGUNG, I_SGUW, I_SGUB, I_MEMNG, I_WKV, I_WDOWN, I_WOUT, I_NORMF };

struct P1Order {
    pg8::StaticOrder so; int G, c;
    __device__ void init(int G_, int c_) { so.init(MPR, INC, G_, c_); G = G_; c = c_; }
    __device__ bool next(int i, pg8::Unit& u) const {
        const long L = (long)i * G + c;
        if (L < so.nwg) so.next(i, u);
        else { const int e = (int)(L - so.nwg); if (e >= 104) return false;
            if (e < 64) { u.pm = NPAN + (e >> 3); u.pn = 40 + (e & 7); } else { u.pm = 64; u.pn = e - 64; } }
        u.brow = u.pn * 256; u.fz = 0;
        if (u.pn >= 8 && u.pn < 12) { u.brow = 2 * DM + 128 * (u.pn - 8); u.fz = 1; } else if (u.pn >= 16 && u.pn < 20) { u.brow = 2 * DM + 128 * (4 + u.pn - 16); u.fz = 1; }
        return true;
    }
    __device__ __forceinline__ void a_ready(const pg8::Unit&) const {}
    __device__ __forceinline__ void done(const pg8::Unit&) const {}
};
struct EpiProj {
    static constexpr bool PERM = true, AFTER_DRAIN = false;
    bf16* proj; bf16* gate; float* vss; bf16* kb; bf16* vb; float* out; const float* hs; bf16* dsr;
    __device__ __forceinline__ void prefetch(const pg8::Unit&, int, int, LAS unsigned char*) const {}
    __device__ __forceinline__ void operator()(const f32x4 (&acc)[2][2][4][2], const pg8::Unit& u, int wr, int wc, int fr, int fq) const {
        if (u.fz) {
            const int j = (u.pn < 12) ? u.pn - 8 : 4 + u.pn - 16; bf16* uz = proj + (size_t)2 * MP * DM;
            const int row0 = u.pm * 256 + wr * 64 + fr, c = 128 * j + wc * 32 + 8 * fq;
#pragma unroll
            for (int ai = 0; ai < 2; ++ai)
#pragma unroll
                for (int m = 0; m < 4; ++m) { const size_t r = (size_t)(row0 + ai * 128 + m * 16);
                    const f32x4 u0 = acc[ai][0][m][0], u1 = acc[ai][0][m][1], z0 = acc[ai][1][m][0], z1 = acc[ai][1][m][1];
                    u32x4 w; w.x = pk2(u0[0] * silu_f(z0[0]), u0[1] * silu_f(z0[1])); w.y = pk2(u0[2] * silu_f(z0[2]), u0[3] * silu_f(z0[3]));
                    w.z = pk2(u1[0] * silu_f(z1[0]), u1[1] * silu_f(z1[1])); w.w = pk2(u1[2] * silu_f(z1[2]), u1[3] * silu_f(z1[3]));
                    __builtin_nontemporal_store(w, (u32x4*)(uz + r * DM + c)); }
        } else if (u.pn < 40) {
            const int sec = u.pn >> 2;
            const int act = (sec == 1 || sec == 4 || sec == 6) ? 1 : (sec >= 7 ? 2 : 0);
            const int row0 = u.pm * 256 + wr * 64 + fr, cs0 = (u.pn & 3) * 256 + wc * 64 + 8 * fq;
            bf16* base; int ld;
            if (sec < 7) { base = proj + (size_t)sec * MP * DM; ld = DM; } else { base = gate + (sec - 7) * DM; ld = 3 * DM; }
            const bool poolrows = (sec == 0) && (((u.pm & 7) == 7) || u.pm == 64);
#pragma unroll
            for (int ai = 0; ai < 2; ++ai)
#pragma unroll
                for (int m = 0; m < 4; ++m) {
                    const int r = row0 + ai * 128 + m * 16; float ss = 0.f;
#pragma unroll
                    for (int bj = 0; bj < 2; ++bj) {
                        f32x4 v0 = acc[ai][bj][m][0], v1 = acc[ai][bj][m][1]; const int cs = cs0 + bj * 32;
                        if (sec == 3) ss += (v0[0] * v0[0] + v0[1] * v0[1]) + (v0[2] * v0[2] + v0[3] * v0[3]) + (v1[0] * v1[0] + v1[1] * v1[1]) + (v1[2] * v1[2] + v1[3] * v1[3]);
                        if (poolrows) {
                            float* dst = nullptr;
                            if (r < MPR) { const int t = r & (SEQ - 1); if (t >= SEQ - 15) dst = out + O_POOLP + ((size_t)(r >> 11) * 15 + (t - (SEQ - 15))) * DM + cs; }
                            else if (r < MV) { dst = out + O_POOLS + ((size_t)(r - MPR) * 15 + 14) * DM + cs;
                                const float* hp = hs + (size_t)(r - MPR) * DM + cs; const f32x4 h0 = *(const f32x4*)hp, h1 = *(const f32x4*)(hp + 4); const float inv = 1.f / (float)(2 << (cs >> 8));
                                u32x4 d; d.x = pk2((h0.x + v0[0]) * inv - v0[0], (h0.y + v0[1]) * inv - v0[1]); d.y = pk2((h0.z + v0[2]) * inv - v0[2], (h0.w + v0[3]) * inv - v0[3]);
                                d.z = pk2((h1.x + v1[0]) * inv - v1[0], (h1.y + v1[1]) * inv - v1[1]); d.w = pk2((h1.z + v1[2]) * inv - v1[2], (h1.w + v1[3]) * inv - v1[3]);
                                *(u32x4*)(dsr + (size_t)(r - MPR) * DM + cs) = d; }
                            if (dst) { *(f32x4*)dst = v0; *(f32x4*)(dst + 4) = v1; }
                        }
                        if (act == 1) {
#pragma unroll
                            for (int j = 0; j < 4; ++j) { v0[j] = silu_f(v0[j]); v1[j] = silu_f(v1[j]); } }
                        if (act == 2) {
#pragma unroll
                            for (int j = 0; j < 4; ++j) { v0[j] = sigm_f(v0[j]); v1[j] = sigm_f(v1[j]); } }
                        u32x4 w; w.x = pk2(v0[0], v0[1]); w.y = pk2(v0[2], v0[3]); w.z = pk2(v1[0], v1[1]); w.w = pk2(v1[2], v1[3]);
                        __builtin_nontemporal_store(w, (u32x4*)(base + (size_t)r * ld + cs));
                    }
                    if (sec == 3) { ss += __shfl_xor(ss, 16); ss += __shfl_xor(ss, 32); if (fq == 0) vss[(size_t)r * 16 + (u.pn & 3) * 4 + wc] = ss; }
                }
        } else {
            const int b = u.pm - NPAN, ct = (u.pn - 40) * 256;
            const bool isv = ct >= DM; const int cb = (isv ? ct - DM : ct) + wc * 64 + 8 * fq;
            float* of = out + (isv ? O_MV : O_MK); bf16* ob = isv ? vb : kb;
#pragma unroll
            for (int ai = 0; ai < 2; ++ai)
#pragma unroll
                for (int m = 0; m < 4; ++m) {
                    const size_t j = (size_t)b * 256 + ai * 128 + wr * 64 + m * 16 + fr;
#pragma unroll
                    for (int bj = 0; bj < 2; ++bj) {
                        const f32x4 v0 = acc[ai][bj][m][0], v1 = acc[ai][bj][m][1]; const int cs = cb + bj * 32;
                        __builtin_nontemporal_store(v0, (f32x4*)(of + j * DM + cs)); __builtin_nontemporal_store(v1, (f32x4*)(of + j * DM + cs + 4));
                        u32x4 w; w.x = pk2(v0[0], v0[1]); w.y = pk2(v0[2], v0[3]); w.z = pk2(v1[0], v1[1]); w.w = pk2(v1[2], v1[3]);
                        *(u32x4*)(ob + j * DM + cs) = w;
                    }
                }
        }
    }
};
struct P3Order {
    pg8::StaticOrder so;
    __device__ void init(int G_, int c_) { so.init(MPR, DM, G_, c_); }
    __device__ bool next(int i, pg8::Unit& u) const { const int rnd = i / 3, b = i - 3 * rnd; pg8::Unit t; if (!so.next(rnd, t)) return false; u.pm = b * NPAN + t.pm; u.pn = b * 4 + t.pn; u.brow = u.pn * 256; u.fz = 0; return true; }
    __device__ __forceinline__ void a_ready(const pg8::Unit&) const {}
    __device__ __forceinline__ void done(const pg8::Unit&) const {}
};
struct EpiGate {
    static constexpr bool PERM = true, AFTER_DRAIN = false;
    const bf16* gate; bf16* mg;
    __device__ __forceinline__ void prefetch(const pg8::Unit& u, int wid, int lane, LAS unsigned char* scr) const {
        const int b = u.pn >> 2, pm = u.pm - b * NPAN, t = wid * 64 + lane;
#pragma unroll
        for (int j = 0; j < 2; ++j) { const int li = t + 512 * j, row = li >> 2, seg = li & 3; const size_t r = (size_t)(pm * 256 + row);
            __builtin_amdgcn_global_load_lds((const unsigned*)(gate + r * (3 * DM) + b * DM + (u.pn & 3) * 256 + seg * 64), (LAS unsigned*)(scr + j * 256), 4, 0, 0); }
    }
    __device__ __forceinline__ void operator()(const f32x4 (&acc)[2][2][4][2], const pg8::Unit& u, int wr, int wc, int fr, int fq) const {
        const int b = u.pn >> 2, pm = u.pm - b * NPAN;
        const int row0 = pm * 256 + wr * 64 + fr, c0 = (u.pn & 3) * 256 + wc * 64 + 8 * fq;
#pragma unroll
        for (int ai = 0; ai < 2; ++ai) {
            u32x4 g8[4][2], p8[4][2];
#pragma unroll
            for (int m = 0; m < 4; ++m)
#pragma unroll
                for (int bj = 0; bj < 2; ++bj) { const size_t r = (size_t)(row0 + ai * 128 + m * 16); const int c = c0 + bj * 32;
                    g8[m][bj] = *(const u32x4*)(gate + r * (3 * DM) + b * DM + c);
                    p8[m][bj] = (u32x4){0u, 0u, 0u, 0u}; if (b > 0) p8[m][bj] = *(const u32x4*)(mg + r * DM + c); }
            asm volatile("" ::: "memory");
#pragma unroll
            for (int m = 0; m < 4; ++m)
#pragma unroll
                for (int bj = 0; bj < 2; ++bj) { const size_t r = (size_t)(row0 + ai * 128 + m * 16); const int c = c0 + bj * 32;
                    const f32x4 v0 = acc[ai][bj][m][0], v1 = acc[ai][bj][m][1]; const u32x4 gq = g8[m][bj], p = p8[m][bj];
                    const float o0 = v0[0] * bflo(gq.x) + bflo(p.x), o1 = v0[1] * bfhi(gq.x) + bfhi(p.x), o2 = v0[2] * bflo(gq.y) + bflo(p.y), o3 = v0[3] * bfhi(gq.y) + bfhi(p.y);
                    const float o4 = v1[0] * bflo(gq.z) + bflo(p.z), o5 = v1[1] * bfhi(gq.z) + bfhi(p.z), o6 = v1[2] * bflo(gq.w) + bflo(p.w), o7 = v1[3] * bfhi(gq.w) + bfhi(p.w);
                    u32x4 w; w.x = pk2(o0, o1); w.y = pk2(o2, o3); w.z = pk2(o4, o5); w.w = pk2(o6, o7);
                    if (b == 2) __builtin_nontemporal_store(w, (u32x4*)(mg + r * DM + c)); else *(u32x4*)(mg + r * DM + c) = w; }
        }
    }
};
__device__ __forceinline__ void st_agent(float* p, float v) { __hip_atomic_store((unsigned*)p, __builtin_bit_cast(unsigned, v), __ATOMIC_RELAXED, __HIP_MEMORY_SCOPE_AGENT); }
__device__ __forceinline__ float ld_agent(const float* p) { return __builtin_bit_cast(float, __hip_atomic_load((unsigned*)p, __ATOMIC_RELAXED, __HIP_MEMORY_SCOPE_AGENT)); }
__device__ __forceinline__ void wait_count(unsigned* w, unsigned want) {
    unsigned sp = 0;
    while ((unsigned)__builtin_amdgcn_readfirstlane(__hip_atomic_load(w, __ATOMIC_RELAXED, __HIP_MEMORY_SCOPE_AGENT)) < want) { __builtin_amdgcn_s_sleep(2); if (++sp > (1u << 22)) break; }
    __builtin_amdgcn_fence(__ATOMIC_ACQUIRE, "agent");
    asm volatile("s_waitcnt vmcnt(0)" ::: "memory");
}
struct EpiOutNorm {
    static constexpr bool PERM = false, AFTER_DRAIN = true;
    const float* xp; const float* gf; float* out; float* slots; unsigned* cnt;
    __device__ __forceinline__ void prefetch(const pg8::Unit& u, int wid, int lane, LAS unsigned char* scr) const {
        const int t = wid * 64 + lane;
#pragma unroll
        for (int j = 0; j < 4; ++j) { const int li = t + 512 * j, row = li >> 3, seg = li & 7;
            __builtin_amdgcn_global_load_lds((const unsigned*)(xp + (size_t)(u.pm * 256 + row) * DM + u.pn * 256 + seg * 32), (LAS unsigned*)(scr + j * 256), 4, 0, 0); }
    }
    __device__ __forceinline__ void operator()(const f32x4 (&)[2][2][4][2], const pg8::Unit&, int, int, int, int) const {}
    __device__ __forceinline__ void fused(f32x4 (&acc)[2][2][4][2], const pg8::Unit& u, int wr, int wc, int fr, int fq) const {
        const int row0 = u.pm * 256 + wr * 64 + fr, col0 = u.pn * 256 + wc * 32 + 4 * fq;
#pragma unroll
        for (int ai = 0; ai < 2; ++ai)
#pragma unroll
            for (int m = 0; m < 4; ++m) { const size_t r = (size_t)(row0 + ai * 128 + m * 16); float ss = 0.f;
#pragma unroll
                for (int bj = 0; bj < 2; ++bj)
#pragma unroll
                    for (int n = 0; n < 2; ++n) { const int c = col0 + bj * 128 + n * 16; const f32x4 v = acc[ai][bj][m][n] + __builtin_nontemporal_load((const f32x4*)(xp + r * DM + c)); acc[ai][bj][m][n] = v;
                        ss += (v.x * v.x + v.y * v.y) + (v.z * v.z + v.w * v.w); }
                ss += __shfl_xor(ss, 16); ss += __shfl_xor(ss, 32);
                if (fq == 0) st_agent(slots + r * 16 + u.pn * 4 + wc, ss); }
        asm volatile("s_waitcnt vmcnt(0)" ::: "memory");
        if (fr == 0 && fq == 0) __hip_atomic_fetch_add(cnt + 64 * u.pm, 1u, __ATOMIC_RELAXED, __HIP_MEMORY_SCOPE_AGENT);
        if (threadIdx.x < 64) wait_count(cnt + 64 * u.pm, 32u);
        __syncthreads();
#pragma unroll
        for (int ai = 0; ai < 2; ++ai)
#pragma unroll
            for (int m = 0; m < 4; ++m) { const size_t r = (size_t)(row0 + ai * 128 + m * 16); float tot = 0.f;
                { const f32x4* sp = (const f32x4*)(slots + r * 16); const f32x4 p0 = sp[0], p1 = sp[1], p2 = sp[2], p3 = sp[3];
                  tot = (((p0.x + p0.y) + (p0.z + p0.w)) + ((p1.x + p1.y) + (p1.z + p1.w))) + (((p2.x + p2.y) + (p2.z + p2.w)) + ((p3.x + p3.y) + (p3.z + p3.w))); }
                const float rs = rsqrtf(tot * (1.f / DM) + EPS);
#pragma unroll
                for (int bj = 0; bj < 2; ++bj)
#pragma unroll
                    for (int n = 0; n < 2; ++n) { const int c = col0 + bj * 128 + n * 16; const f32x4 g = *(const f32x4*)(gf + c); const f32x4 v = acc[ai][bj][m][n];
                        __builtin_nontemporal_store((f32x4){v.x * rs * g.x, v.y * rs * g.y, v.z * rs * g.z, v.w * rs * g.w}, (f32x4*)(out + O_YP + r * DM + c)); } }
    }
};

template <class Epi>
__device__ __forceinline__ void skinny_gemm(LAS unsigned char* lds, const bf16* A0, int lda, size_t a_grp_stride, int strips_per_grp, int nseg, int aseg,
                                            const bf16* Bt, int ldb, int K, int nstrips, int first, int step, const Epi& E) {
    int tid_ = threadIdx.x; asm volatile("" : "+v"(tid_));
    const int tid = tid_, lane = tid & 63, wv = tid >> 6, fr = lane & 15, fq = lane >> 4, rh = wv & 1, kq = wv >> 1;
    LAS float* part = (LAS float*)lds;
    const int nks = K / 128;
    for (int s = first; s < nstrips; s += step) {
        const bf16* A = A0 + (size_t)(s / strips_per_grp) * a_grp_stride + (size_t)(rh * 64 + fr) * lda + fq * 8;
        const bf16* B = Bt + (size_t)(16 * s + fr) * ldb + fq * 8;
        f32x4 acc[4];
#pragma unroll
        for (int rb = 0; rb < 4; ++rb) acc[rb] = (f32x4){0.f, 0.f, 0.f, 0.f};
        for (int seg = 0; seg < nseg; ++seg) {
#pragma unroll 4
            for (int k = 0; k < nks; ++k) {
                const int ko = (kq * nks + k) * 32;
                const bf16x8 bfr = *(const bf16x8*)(B + ko);
#pragma unroll
                for (int rb = 0; rb < 4; ++rb) { const bf16x8 afr = *(const bf16x8*)(A + (size_t)rb * 16 * lda + seg * aseg + ko);
                    acc[rb] = __builtin_amdgcn_mfma_f32_16x16x32_bf16(bfr, afr, acc[rb], 0, 0, 0); }
            }
        }
#pragma unroll
        for (int rb = 0; rb < 4; ++rb) *(LAS f32x4*)(part + ((kq * 128 + rh * 64 + rb * 16 + fr) * 16 + fq * 4)) = acc[rb];
        __syncthreads();
        { const int row = tid >> 2, cq = tid & 3; const LAS float* p = part + row * 16 + cq * 4;
          const f32x4 v = (*(const LAS f32x4*)p + *(const LAS f32x4*)(p + 2048)) + (*(const LAS f32x4*)(p + 4096) + *(const LAS f32x4*)(p + 6144));
          E(s, row, 16 * s + cq * 4, v, cq); }
        __syncthreads();
    }
}
struct EpiS1 {
    bf16* proj; bf16* gate; float* vss2; float* out; const float* hist; bf16* ds;
    __device__ __forceinline__ void operator()(int s, int row, int c, f32x4 v, int cq) const {
        const int sec = c >> 10, cs = c & 1023; const size_t m = (size_t)(MPR + row);
        if (sec == 0) { *(f32x4*)(out + O_POOLS + ((size_t)row * 15 + 14) * DM + cs) = v;
            const int w = 2 << (cs >> 8); f32x4 sm = v;
#pragma unroll
            for (int j = 0; j < 15; ++j) if (j < w - 1) sm = sm + *(const f32x4*)(hist + ((size_t)row * 15 + 14 - j) * DM + cs);
            const float inv = 1.f / (float)w;
            u32x2 d; d.x = pk2(sm.x * inv - v.x, sm.y * inv - v.y); d.y = pk2(sm.z * inv - v.z, sm.w * inv - v.w);
            *(u32x2*)(ds + (size_t)row * DM + cs) = d; }
        if (sec == 3) { float ss = (v.x * v.x + v.y * v.y) + (v.z * v.z + v.w * v.w); ss += __shfl_xor(ss, 1); ss += __shfl_xor(ss, 2); if (cq == 0) vss2[row * 64 + (s - 192)] = ss; }
        if (sec == 1 || sec == 4 || sec == 6) { v.x = silu_f(v.x); v.y = silu_f(v.y); v.z = silu_f(v.z); v.w = silu_f(v.w); }
        if (sec >= 7) { v.x = sigm_f(v.x); v.y = sigm_f(v.y); v.z = sigm_f(v.z); v.w = sigm_f(v.w); }
        u32x2 w; w.x = pk2(v.x, v.y); w.y = pk2(v.z, v.w);
        if (sec < 7) *(u32x2*)(proj + (size_t)sec * MP * DM + m * DM + cs) = w; else *(u32x2*)(gate + m * (3 * DM) + (sec - 7) * DM + cs) = w;
    }
};
struct EpiS3 {
    const bf16* gate; bf16* gys;
    __device__ __forceinline__ void operator()(int s, int row, int c, f32x4 v, int cq) const {
        const u32x2 g = *(const u32x2*)(gate + (size_t)(MPR + row) * (3 * DM) + c);
        u32x2 w; w.x = pk2(v.x * bflo(g.x), v.y * bfhi(g.x)); w.y = pk2(v.z * bflo(g.y), v.w * bfhi(g.y));
        *(u32x2*)(gys + (size_t)row * (3 * DM) + c) = w;
    }
};
struct EpiS4 {
    const float* xs; const float* gf; float* out; float* slots2; unsigned* cnt2;
    __device__ __forceinline__ void operator()(int s, int row, int c, f32x4 v, int cq) const {
        v = v + *(const f32x4*)(xs + (size_t)row * DM + c);
        float ss = (v.x * v.x + v.y * v.y) + (v.z * v.z + v.w * v.w); ss += __shfl_xor(ss, 1); ss += __shfl_xor(ss, 2);
        if (cq == 0) st_agent(slots2 + row * 64 + s, ss);
        asm volatile("s_waitcnt vmcnt(0)" ::: "memory");
        __syncthreads();
        if (threadIdx.x == 0) __hip_atomic_fetch_add(cnt2, 1u, __ATOMIC_RELAXED, __HIP_MEMORY_SCOPE_AGENT);
        if (threadIdx.x < 64) wait_count(cnt2, 64u);
        __syncthreads();
        float tot = 0.f;
        { const f32x4* sp = (const f32x4*)(slots2 + row * 64 + cq * 16); const f32x4 p0 = sp[0], p1 = sp[1], p2 = sp[2], p3 = sp[3];
          tot = (((p0.x + p0.y) + (p0.z + p0.w)) + ((p1.x + p1.y) + (p1.z + p1.w))) + (((p2.x + p2.y) + (p2.z + p2.w)) + ((p3.x + p3.y) + (p3.z + p3.w))); }
        tot += __shfl_xor(tot, 1); tot += __shfl_xor(tot, 2);
        const float rs = rsqrtf(tot * (1.f / DM) + EPS); const f32x4 g = *(const f32x4*)(gf + c);
        *(f32x4*)(out + O_YS + (size_t)row * DM + c) = (f32x4){v.x * rs * g.x, v.y * rs * g.y, v.z * rs * g.z, v.w * rs * g.w};
    }
};


__device__ __forceinline__ void sample_out_split(const KArgs& a, LAS unsigned char* lds, int item) {
    int tid_ = threadIdx.x; asm volatile("" : "+v"(tid_));
    const int tid = tid_, lane = tid & 63, wv = tid >> 6, fr = lane & 15, fq = lane >> 4, s = item >> 2, rq = item & 3;
    const bf16* A = (const bf16*)(a.ws + WS_GYS) + (size_t)(rq * 32 + fr) * (3 * DM) + fq * 8;
    const bf16* B = (const bf16*)(a.ws + WS_WO3) + (size_t)(16 * s + fr) * DM + fq * 8;
    f32x4 acc0 = (f32x4){0.f, 0.f, 0.f, 0.f}, acc1 = acc0;
#pragma unroll
    for (int kk = 0; kk < 12; ++kk) { const int k = 384 * wv + 32 * kk;
        const bf16x8 bfr = *(const bf16x8*)(B + (k & 1023)); const bf16x8 a0 = *(const bf16x8*)(A + k), a1 = *(const bf16x8*)(A + (size_t)16 * (3 * DM) + k);
        acc0 = __builtin_amdgcn_mfma_f32_16x16x32_bf16(bfr, a0, acc0, 0, 0, 0); acc1 = __builtin_amdgcn_mfma_f32_16x16x32_bf16(bfr, a1, acc1, 0, 0, 0); }
    LAS float* part = (LAS float*)lds;
    *(LAS f32x4*)(part + (wv * 32 + fr) * 16 + fq * 4) = acc0; *(LAS f32x4*)(part + (wv * 32 + 16 + fr) * 16 + fq * 4) = acc1;
    __syncthreads();
    const int row = tid >> 4, col = tid & 15, grow = rq * 32 + row, c = 16 * s + col;
    float v = 0.f;
#pragma unroll
    for (int w8 = 0; w8 < 8; ++w8) v += part[(w8 * 32 + row) * 16 + col];
    v += a.in[I_XS][(size_t)grow * DM + c];
    float ss = v * v; ss += __shfl_xor(ss, 1); ss += __shfl_xor(ss, 2); ss += __shfl_xor(ss, 4); ss += __shfl_xor(ss, 8);
    float* slots2 = (float*)(a.ws + WS_VSS2); unsigned* cnt = (unsigned*)(a.ws + WS_CTL) + CW_SAMPLE + 64 * rq;
    if (col == 0) st_agent(slots2 + grow * 64 + s, ss);
    asm volatile("s_waitcnt vmcnt(0)" ::: "memory");
    __syncthreads();
    if (tid == 0) __hip_atomic_fetch_add(cnt, 1u, __ATOMIC_RELAXED, __HIP_MEMORY_SCOPE_AGENT);
    if (tid < 64) wait_count(cnt, 64u);
    __syncthreads();
    const f32x4 p4 = *(const f32x4*)(slots2 + grow * 64 + col * 4);
    float tot = (p4.x + p4.y) + (p4.z + p4.w); tot += __shfl_xor(tot, 1); tot += __shfl_xor(tot, 2); tot += __shfl_xor(tot, 4); tot += __shfl_xor(tot, 8);
    a.out[O_YS + (size_t)grow * DM + c] = v * rsqrtf(tot * (1.f / DM) + EPS) * a.in[I_NORMF][c];
    __syncthreads();
}

__device__ __forceinline__ void p0_transpose_item(const float* W, int N, bf16* WT, int row_off, int ldo, int koff, LAS float* scr, int item, int lane) {
    const int nblk = N / 32, kb = item / nblk, nb = item % nblk, k0 = 64 * kb, n0 = 32 * nb;
    float wv_[32];
#pragma unroll
    for (int i = 0; i < 32; ++i) { const int kk = 2 * i + (lane >> 5); wv_[i] = __builtin_nontemporal_load(W + (size_t)(k0 + kk) * N + n0 + (lane & 31)); }
#pragma unroll
    for (int i = 0; i < 32; ++i) { const int kk = 2 * i + (lane >> 5); scr[kk * 33 + (lane & 31)] = wv_[i]; }
    asm volatile("s_waitcnt lgkmcnt(0)" ::: "memory");
    const int c = lane & 7;
#pragma unroll
    for (int j = 0; j < 4; ++j) { const int n = (lane >> 3) + 8 * j; const LAS float* s = scr + (8 * c) * 33 + n;
        u32x4 o; o.x = pk2(s[0 * 33], s[1 * 33]); o.y = pk2(s[2 * 33], s[3 * 33]); o.z = pk2(s[4 * 33], s[5 * 33]); o.w = pk2(s[6 * 33], s[7 * 33]);
        *(u32x4*)(WT + (size_t)(row_off + n0 + n) * ldo + koff + k0 + 8 * c) = o; }
    asm volatile("s_waitcnt lgkmcnt(0)" ::: "memory");
}
__device__ __forceinline__ void rms_row_to_bf16(const float* xrow, const float* gain, bf16* orow, int lane) {
    const f32x4* xr = (const f32x4*)xrow + lane; const f32x4* gr = (const f32x4*)gain + lane;
    f32x4 v[4]; float s = 0.f;
#pragma unroll
    for (int j = 0; j < 4; ++j) { v[j] = xr[64 * j]; s += (v[j].x * v[j].x + v[j].y * v[j].y) + (v[j].z * v[j].z + v[j].w * v[j].w); }
    const float rs = rsqrtf(wave_sum(s) * (1.f / DM) + EPS);
    u32x2* o8 = (u32x2*)orow + lane;
#pragma unroll
    for (int j = 0; j < 4; ++j) { const f32x4 g = gr[64 * j]; u32x2 w; w.x = pk2(v[j].x * rs * g.x, v[j].y * rs * g.y); w.y = pk2(v[j].z * rs * g.z, v[j].w * rs * g.w); o8[64 * j] = w; }
}
__device__ __forceinline__ void rms_row2_to_bf16(const float* x0, const float* x1, const float* gain, bf16* o0, bf16* o1, int lane) {
    const f32x4* xr0 = (const f32x4*)x0 + lane; const f32x4* xr1 = (const f32x4*)x1 + lane; const f32x4* gr = (const f32x4*)gain + lane;
    f32x4 v[4], w[4]; float s = 0.f, t = 0.f;
#pragma unroll
    for (int j = 0; j < 4; ++j) { v[j] = __builtin_nontemporal_load(xr0 + 64 * j); w[j] = __builtin_nontemporal_load(xr1 + 64 * j); }
#pragma unroll
    for (int j = 0; j < 4; ++j) { s += (v[j].x * v[j].x + v[j].y * v[j].y) + (v[j].z * v[j].z + v[j].w * v[j].w); t += (w[j].x * w[j].x + w[j].y * w[j].y) + (w[j].z * w[j].z + w[j].w * w[j].w); }
#pragma unroll
    for (int o = 1; o < 64; o <<= 1) { s += __shfl_xor(s, o); t += __shfl_xor(t, o); }
    const float rs = rsqrtf(s * (1.f / DM) + EPS), rt = rsqrtf(t * (1.f / DM) + EPS);
    u32x2* p0 = (u32x2*)o0 + lane; u32x2* p1 = (u32x2*)o1 + lane;
#pragma unroll
    for (int j = 0; j < 4; ++j) { const f32x4 g = gr[64 * j]; u32x2 a; a.x = pk2(v[j].x * rs * g.x, v[j].y * rs * g.y); a.y = pk2(v[j].z * rs * g.z, v[j].w * rs * g.w); p0[64 * j] = a;
        u32x2 b; b.x = pk2(w[j].x * rt * g.x, w[j].y * rt * g.y); b.y = pk2(w[j].z * rt * g.z, w[j].w * rt * g.w); p1[64 * j] = b; }
}
__device__ __forceinline__ void p0_prologue(const KArgs& a, LAS unsigned char* lds, int G) {
    const int tid = threadIdx.x, lane = tid & 63, wave = tid >> 6;
    LAS float* scr = (LAS float*)(lds + wave * 16384);
    const int gw = blockIdx.x * 8 + wave, NGW = G * 8;
    bf16* H = (bf16*)(a.ws + WS_H); bf16* WinT = (bf16*)(a.ws + WS_WIN); bf16* WdT = (bf16*)(a.ws + WS_WD); bf16* Wo3 = (bf16*)(a.ws + WS_WO3);
    bf16* PwT = (bf16*)(a.ws + WS_PW); bf16* SW = (bf16*)(a.ws + WS_SW);
    constexpr int I_IN = 16 * (INC / 32), I_KV = 16 * (2048 / 32), I_D = 16 * 32, I_O = 16 * 32, I_P = 4 * 8;
    constexpr int NITEMS = I_IN + I_KV + 3 * I_D + I_O + 4 * I_P;
    for (int it = gw; it < NITEMS; it += NGW) {
        int r = it;
        if (r < I_IN) { p0_transpose_item(a.in[I_WIN], INC, WinT, 0, DM, 0, scr, r, lane); continue; } r -= I_IN;
        if (r < I_KV) { p0_transpose_item(a.in[I_WKV], 2048, WinT, INC, DM, 0, scr, r, lane); continue; } r -= I_KV;
        if (r < 3 * I_D) { const int b = r / I_D; p0_transpose_item(a.in[I_WDOWN] + (size_t)b * DM * DM, DM, WdT, b * DM, DM, 0, scr, r % I_D, lane); continue; } r -= 3 * I_D;
        if (r < I_O) { p0_transpose_item(a.in[I_WOUT], DM, Wo3, 0, DM, 0, scr, r, lane); continue; } r -= I_O;
        { const int g = r / I_P; p0_transpose_item(a.in[I_POOLW] + (size_t)g * 256 * 256, 256, PwT, g * 256, 256, 0, scr, r % I_P, lane); }
    }
    for (int m = gw; m + NGW < MPR; m += 2 * NGW)
        rms_row2_to_bf16(a.in[I_XP] + (size_t)m * DM, a.in[I_XP] + (size_t)(m + NGW) * DM, a.in[I_NORMG], H + (size_t)m * DM, H + (size_t)(m + NGW) * DM, lane);
    const int mdone = (MPR / (2 * NGW)) * (2 * NGW);
    for (int m = mdone + gw; m < MP + 2048; m += NGW) {
        bf16* orow = H + (size_t)m * DM;
        if (m < MPR) rms_row_to_bf16(a.in[I_XP] + (size_t)m * DM, a.in[I_NORMG], orow, lane);
        else if (m < MV) rms_row_to_bf16(a.in[I_XS] + (size_t)(m - MPR) * DM, a.in[I_NORMG], orow, lane);
        else if (m < MP) { u32x2* o8 = (u32x2*)orow + lane;
#pragma unroll
            for (int j = 0; j < 4; ++j) o8[64 * j] = (u32x2){0u, 0u}; }
        else rms_row_to_bf16(a.in[I_MEM] + (size_t)(m - MP) * DM, a.in[I_MEMNG], orow, lane);
    }
    const size_t gt = (size_t)blockIdx.x * 512 + tid, NGT = (size_t)G * 512;
    for (size_t i = gt; i < (size_t)4 * 128 * 128; i += NGT) { const int s = (int)(i & 127), t = (int)((i >> 7) & 127); SW[i] = (bf16)(s <= t ? f2bf(a.in[I_SGUW][i]) : 0u); }
    for (size_t i = gt; i < (size_t)NS * 256; i += NGT) { const size_t smp = i >> 8, c = (i & 255) * 4; const int w = 2 << (int)(c >> 8); f32x4 sm = (f32x4){0.f, 0.f, 0.f, 0.f};
#pragma unroll
        for (int j = 0; j < 15; ++j) if (j < w - 1) sm = sm + *(const f32x4*)(a.in[I_SPOOL] + (smp * 15 + 14 - j) * DM + c);
        *(f32x4*)((float*)(a.ws + WS_HS) + smp * DM + c) = sm; }
    for (size_t i = gt; i < (size_t)NS * 14 * 256; i += NGT) { const size_t smp = i / (14 * 256), rem = i % (14 * 256), r = rem / 256, c4 = rem % 256;
        __builtin_nontemporal_store(*(const f32x4*)(a.in[I_SPOOL] + (smp * 15 + r + 1) * DM + c4 * 4), (f32x4*)(a.out + O_POOLS + (smp * 15 + r) * DM + c4 * 4)); }
}

constexpr int RSV = 544;
constexpr int RS = 528;
__device__ __forceinline__ void pool_part(const KArgs& a, LAS unsigned char* lds, int rt, int g) {
    int tid_ = threadIdx.x; asm volatile("" : "+v"(tid_));
    const int tid = tid_, lane = tid & 63, wv = tid >> 6, fr = lane & 15, fq = lane >> 4;
    const int m0 = rt * 128, w = 2 << g;
    const bf16* PIN = (const bf16*)(a.ws + WS_PROJ); const bf16* PZ = PIN + (size_t)MP * DM;
    const bf16* PwT = (const bf16*)(a.ws + WS_PW); bf16* BR0 = (bf16*)(a.ws + WS_BR);
    LAS unsigned char* Pb = lds; LAS unsigned char* Db = lds + 75520;
    u32x4 zf[8]; f32x4 scv[2]; bf16x8 Bf[2][8];
    const bf16* pw = PwT + (size_t)(g * 256 + wv * 32 + 8 * (fr >> 2) + (fr & 3)) * 256 + fq * 8;
    if (rt < 128) {
        const int t0 = (rt & 15) * 128;
        u32x4 tv[9];
#pragma unroll
        for (int i = 0; i < 9; ++i) { const int idx = tid + i * 512, row = idx >> 5, ch = idx & 31; tv[i] = (u32x4){0u, 0u, 0u, 0u};
            if (idx < 143 * 32 && !(t0 == 0 && row < 15)) tv[i] = *(const u32x4*)(PIN + (size_t)(m0 - 15 + row) * DM + g * 256 + ch * 8); }
#pragma unroll
        for (int rb = 0; rb < 8; ++rb) zf[rb] = __builtin_nontemporal_load((const u32x4*)(PZ + (size_t)(m0 + rb * 16 + fr) * DM + g * 256 + wv * 32 + 8 * fq));
#pragma unroll
        for (int nn = 0; nn < 2; ++nn) { scv[nn] = *(const f32x4*)(a.in[I_POOLSC] + g * 256 + wv * 32 + 8 * fq + 4 * nn);
#pragma unroll
            for (int ks = 0; ks < 8; ++ks) Bf[nn][ks] = *(const bf16x8*)(pw + nn * 4 * 256 + ks * 32); }
#pragma unroll
        for (int i = 0; i < 9; ++i) { const int idx = tid + i * 512, row = idx >> 5, ch = idx & 31; if (idx < 143 * 32) *(LAS u32x4*)(Pb + row * RS + ch * 16) = tv[i]; }
        __syncthreads();
        {
            const int ch = tid & 31, r0 = (tid >> 5) * 8;
            float s0 = 0.f, s1 = 0.f, s2 = 0.f, s3 = 0.f, s4 = 0.f, s5 = 0.f, s6 = 0.f, s7 = 0.f;
            for (int j = 1; j < w; ++j) { const u32x4 v = *(const LAS u32x4*)(Pb + (r0 + 15 - j) * RS + ch * 16);
                s0 += bflo(v.x); s1 += bfhi(v.x); s2 += bflo(v.y); s3 += bfhi(v.y); s4 += bflo(v.z); s5 += bfhi(v.z); s6 += bflo(v.w); s7 += bfhi(v.w); }
#pragma unroll
            for (int i = 0; i < 8; ++i) { const int r = r0 + i;
                const u32x4 own = *(const LAS u32x4*)(Pb + (r + 15) * RS + ch * 16); const u32x4 old = *(const LAS u32x4*)(Pb + (r + 16 - w) * RS + ch * 16);
                s0 += bflo(own.x); s1 += bfhi(own.x); s2 += bflo(own.y); s3 += bfhi(own.y); s4 += bflo(own.z); s5 += bfhi(own.z); s6 += bflo(own.w); s7 += bfhi(own.w);
                const int cnt = min(w, t0 + r + 1); const float inv = 1.f / (float)cnt;
                u32x4 d; d.x = pk2(s0 * inv - bflo(own.x), s1 * inv - bfhi(own.x)); d.y = pk2(s2 * inv - bflo(own.y), s3 * inv - bfhi(own.y));
                d.z = pk2(s4 * inv - bflo(own.z), s5 * inv - bfhi(own.z)); d.w = pk2(s6 * inv - bflo(own.w), s7 * inv - bfhi(own.w));
                *(LAS u32x4*)(Db + r * RS + ch * 16) = d;
                s0 -= bflo(old.x); s1 -= bfhi(old.x); s2 -= bflo(old.y); s3 -= bfhi(old.y); s4 -= bflo(old.z); s5 -= bfhi(old.z); s6 -= bflo(old.w); s7 -= bfhi(old.w); }
        }
    } else {
#pragma unroll
        for (int rb = 0; rb < 8; ++rb) zf[rb] = __builtin_nontemporal_load((const u32x4*)(PZ + (size_t)(m0 + rb * 16 + fr) * DM + g * 256 + wv * 32 + 8 * fq));
#pragma unroll
        for (int nn = 0; nn < 2; ++nn) { scv[nn] = *(const f32x4*)(a.in[I_POOLSC] + g * 256 + wv * 32 + 8 * fq + 4 * nn);
#pragma unroll
            for (int ks = 0; ks < 8; ++ks) Bf[nn][ks] = *(const bf16x8*)(pw + nn * 4 * 256 + ks * 32); }
        const bf16* DS = (const bf16*)(a.ws + WS_DS);
        u32x4 td[8];
#pragma unroll
        for (int i = 0; i < 8; ++i) { const int idx = tid + i * 512, r = idx >> 5, ch = idx & 31; td[i] = *(const u32x4*)(DS + (size_t)r * DM + g * 256 + ch * 8); }
#pragma unroll
        for (int i = 0; i < 8; ++i) { const int idx = tid + i * 512, r = idx >> 5, ch = idx & 31; *(LAS u32x4*)(Db + r * RS + ch * 16) = td[i]; }
    }
    __syncthreads();
#pragma unroll
    for (int rb = 0; rb < 8; ++rb) {
        f32x4 acc0 = (f32x4){0.f, 0.f, 0.f, 0.f}, acc1 = acc0;
#pragma unroll
        for (int ks = 0; ks < 8; ++ks) { const bf16x8 A = *(const LAS bf16x8*)(Db + (rb * 16 + fr) * RS + (ks * 32 + fq * 8) * 2);
            acc0 = __builtin_amdgcn_mfma_f32_16x16x32_bf16(Bf[0][ks], A, acc0, 0, 0, 0); acc1 = __builtin_amdgcn_mfma_f32_16x16x32_bf16(Bf[1][ks], A, acc1, 0, 0, 0); }
        const size_t m = (size_t)(m0 + rb * 16 + fr); const int c = g * 256 + wv * 32 + 8 * fq; const u32x4 z = zf[rb];
        u32x4 o; o.x = pk2(acc0[0] * scv[0].x * bflo(z.x), acc0[1] * scv[0].y * bfhi(z.x)); o.y = pk2(acc0[2] * scv[0].z * bflo(z.y), acc0[3] * scv[0].w * bfhi(z.y));
        o.z = pk2(acc1[0] * scv[1].x * bflo(z.z), acc1[1] * scv[1].y * bfhi(z.z)); o.w = pk2(acc1[2] * scv[1].z * bflo(z.w), acc1[3] * scv[1].w * bfhi(z.w));
        __builtin_nontemporal_store(o, (u32x4*)(BR0 + m * DM + c));
    }
    __syncthreads();
}
__device__ __forceinline__ void sgu_part(const KArgs& a, LAS unsigned char* lds, int rt, int g) {
    int tid_ = threadIdx.x; asm volatile("" : "+v"(tid_));
    const int tid = tid_, lane = tid & 63, wv = tid >> 6, fr = lane & 15, fq = lane >> 4;
    const int m0 = rt * 128;
    const bf16* U = (const bf16*)(a.ws + WS_PROJ) + (size_t)2 * MP * DM; const bf16* V = U + (size_t)MP * DM;
    const bf16* SW = (const bf16*)(a.ws + WS_SW); const float* VSS = (const float*)(a.ws + WS_VSS); bf16* BR1 = (bf16*)(a.ws + WS_BR) + (size_t)MP * DM;
    LAS unsigned char* Vb = lds; LAS unsigned char* UZb = lds + 128 * RS; LAS float* rbuf = (LAS float*)(lds + 256 * RS);
    u32x4 tv[8], tu[8];
#pragma unroll
    for (int i = 0; i < 8; ++i) { const int idx = tid + i * 512, s = idx >> 5, ch = idx & 31; const size_t o = (size_t)(m0 + s) * DM + g * 256 + ch * 8;
        tv[i] = __builtin_nontemporal_load((const u32x4*)(V + o)); tu[i] = __builtin_nontemporal_load((const u32x4*)(U + o)); }
    if (tid < 128) { const f32x4* p = (const f32x4*)(VSS + (size_t)(m0 + tid) * 16); const f32x4 p0 = p[0], p1 = p[1], p2 = p[2], p3 = p[3];
        const float s = ((p0.x + p0.y) + (p0.z + p0.w)) + ((p1.x + p1.y) + (p1.z + p1.w)) + ((p2.x + p2.y) + (p2.z + p2.w)) + ((p3.x + p3.y) + (p3.z + p3.w));
        rbuf[tid] = rsqrtf(s * (1.f / DM) + EPS); }
    const f32x4 gv0 = *(const f32x4*)(a.in[I_SGUNG] + g * 256 + wv * 32 + 8 * fq), gv1 = *(const f32x4*)(a.in[I_SGUNG] + g * 256 + wv * 32 + 8 * fq + 4);
    float biasv[8];
#pragma unroll
    for (int tb = 0; tb < 8; ++tb) biasv[tb] = a.in[I_SGUB][g * 128 + tb * 16 + fr];
    __syncthreads();
#pragma unroll
    for (int i = 0; i < 8; ++i) { const int idx = tid + i * 512, s = idx >> 5, ch = idx & 31; const float r = rbuf[s];
        u32x4 v; v.x = pk2(bflo(tv[i].x) * r, bfhi(tv[i].x) * r); v.y = pk2(bflo(tv[i].y) * r, bfhi(tv[i].y) * r); v.z = pk2(bflo(tv[i].z) * r, bfhi(tv[i].z) * r); v.w = pk2(bflo(tv[i].w) * r, bfhi(tv[i].w) * r);
        *(LAS u32x4*)(Vb + s * RS + ch * 16) = v;
        const u32x4 q = tu[i];
        *(LAS u32x4*)(UZb + s * RS + ch * 16) = q; }
    __syncthreads();
    const int q = fr >> 2, p = fr & 3;
    bf16x8 Vf[4][2];
#pragma unroll
    for (int ks = 0; ks < 4; ++ks)
#pragma unroll
        for (int nn = 0; nn < 2; ++nn) { const LAS unsigned char* a0 = Vb + (32 * ks + 8 * fq + q) * RS + (wv * 32 + 8 * p + 4 * nn) * 2; Vf[ks][nn] = tr_read2(a0, a0 + 4 * RS); }
#pragma unroll
    for (int tb = 0; tb < 8; ++tb) {
        f32x4 acc0 = (f32x4){0.f, 0.f, 0.f, 0.f}, acc1 = acc0;
        const int t = tb * 16 + fr;
#pragma unroll
        for (int ks = 0; ks < 4; ++ks) if (ks <= (tb >> 1)) {
            const bf16x8 A = *(const bf16x8*)(SW + (size_t)(g * 128 + t) * 128 + ks * 32 + fq * 8);
            acc0 = __builtin_amdgcn_mfma_f32_16x16x32_bf16(Vf[ks][0], A, acc0, 0, 0, 0); acc1 = __builtin_amdgcn_mfma_f32_16x16x32_bf16(Vf[ks][1], A, acc1, 0, 0, 0);
        }
        const size_t m = (size_t)(m0 + t); const float bias = biasv[tb];
        { const int cl = wv * 32 + 8 * fq; const u32x4 uz = *(const LAS u32x4*)(UZb + t * RS + cl * 2);
          u32x4 o; o.x = pk2((acc0[0] * gv0.x + bias) * bflo(uz.x), (acc0[1] * gv0.y + bias) * bfhi(uz.x)); o.y = pk2((acc0[2] * gv0.z + bias) * bflo(uz.y), (acc0[3] * gv0.w + bias) * bfhi(uz.y));
          o.z = pk2((acc1[0] * gv1.x + bias) * bflo(uz.z), (acc1[1] * gv1.y + bias) * bfhi(uz.z)); o.w = pk2((acc1[2] * gv1.z + bias) * bflo(uz.w), (acc1[3] * gv1.w + bias) * bfhi(uz.w));
          __builtin_nontemporal_store(o, (u32x4*)(BR1 + m * DM + g * 256 + cl)); }
    }
    __syncthreads();
}
__device__ __forceinline__ void attn_part(const KArgs& a, LAS unsigned char* lds, int rt, int g) {
    int tid_ = threadIdx.x; asm volatile("" : "+v"(tid_));
    const int tid = tid_, lane = tid & 63, wv = tid >> 6, fr = lane & 15, fq = lane >> 4;
    const int m0 = rt * 128, b = rt >> 4;
    const bf16* Q = (const bf16*)(a.ws + WS_PROJ) + (size_t)5 * MP * DM; const bf16* AZ = Q + (size_t)MP * DM;
    const bf16* KB = (const bf16*)(a.ws + WS_KB); const bf16* VB = (const bf16*)(a.ws + WS_VB); bf16* BR2 = (bf16*)(a.ws + WS_BR) + (size_t)2 * MP * DM;
    LAS unsigned char* Kb = lds;
    const size_t m = (size_t)(m0 + wv * 16 + fr);
    bf16x8 Qf[8];
    {
        u32x4 tk[16];
#pragma unroll
        for (int i = 0; i < 16; ++i) { const int idx = tid + i * 512, key = idx >> 5, ch = idx & 31; tk[i] = *(const u32x4*)(KB + (size_t)(b * 256 + key) * DM + g * 256 + ch * 8); }
#pragma unroll
        for (int ks = 0; ks < 8; ++ks) Qf[ks] = __builtin_nontemporal_load((const bf16x8*)(Q + m * DM + g * 256 + ks * 32 + fq * 8));
#pragma unroll
        for (int i = 0; i < 16; ++i) { const int idx = tid + i * 512, key = idx >> 5, ch = idx & 31; *(LAS u32x4*)(Kb + key * RS + ch * 16) = tk[i]; }
    }
    __syncthreads();
    u32x4 tvv[16];
#pragma unroll
    for (int i = 0; i < 16; ++i) { const int idx = tid + i * 512, key = idx >> 5, ch = idx & 31; tvv[i] = *(const u32x4*)(VB + (size_t)(b * 256 + key) * DM + g * 256 + ch * 8); }
    f32x4 sacc[16];
#pragma unroll
    for (int kb = 0; kb < 16; ++kb) { sacc[kb] = (f32x4){0.f, 0.f, 0.f, 0.f};
#pragma unroll
        for (int ks = 0; ks < 8; ++ks) { const bf16x8 Kf = *(const LAS bf16x8*)(Kb + (kb * 16 + fr) * RS + (ks * 32 + fq * 8) * 2);
            sacc[kb] = __builtin_amdgcn_mfma_f32_16x16x32_bf16(Kf, Qf[ks], sacc[kb], 0, 0, 0); }
        if (kb & 1) __builtin_amdgcn_sched_barrier(0); }
    float mx = -3.0e38f;
#pragma unroll
    for (int kb = 0; kb < 16; ++kb) mx = fmaxf(mx, fmaxf(fmaxf(sacc[kb][0], sacc[kb][1]), fmaxf(sacc[kb][2], sacc[kb][3])));
    mx = fmaxf(mx, __shfl_xor(mx, 16)); mx = fmaxf(mx, __shfl_xor(mx, 32));
    float sum = 0.f;
#pragma unroll
    for (int kb = 0; kb < 16; ++kb)
#pragma unroll
        for (int j = 0; j < 4; ++j) { const float pj = __expf((sacc[kb][j] - mx) * 0.0625f); sacc[kb][j] = pj; sum += pj; }
    sum += __shfl_xor(sum, 16); sum += __shfl_xor(sum, 32);
    const float isum = 1.f / sum;
    bf16x8 Pf[8];
#pragma unroll
    for (int k2 = 0; k2 < 8; ++k2) { u32x4 w; w.x = pk2(sacc[2 * k2][0], sacc[2 * k2][1]); w.y = pk2(sacc[2 * k2][2], sacc[2 * k2][3]);
        w.z = pk2(sacc[2 * k2 + 1][0], sacc[2 * k2 + 1][1]); w.w = pk2(sacc[2 * k2 + 1][2], sacc[2 * k2 + 1][3]); Pf[k2] = __builtin_bit_cast(bf16x8, w); }
    __syncthreads();
#pragma unroll
    for (int i = 0; i < 16; ++i) { const int idx = tid + i * 512, key = idx >> 5, ch = idx & 31; *(LAS u32x4*)(Kb + key * RSV + ch * 16) = tvv[i]; }
    u32x4 zf[8];
#pragma unroll
    for (int d2 = 0; d2 < 8; ++d2) zf[d2] = __builtin_nontemporal_load((const u32x4*)(AZ + m * DM + g * 256 + d2 * 32 + 8 * fq));
    __syncthreads();
    const int q = fr >> 2, p = fr & 3;
#pragma unroll
    for (int d2 = 0; d2 < 8; ++d2) {
        f32x4 o0 = (f32x4){0.f, 0.f, 0.f, 0.f}, o1 = o0;
#pragma unroll
        for (int k2 = 0; k2 < 8; ++k2) { const LAS unsigned char* a0 = Kb + (32 * k2 + 4 * fq + q) * RSV + (d2 * 32 + 8 * p) * 2;
            const bf16x8 Vf0 = tr_read2(a0, a0 + 16 * RSV), Vf1 = tr_read2(a0 + 8, a0 + 8 + 16 * RSV);
            o0 = __builtin_amdgcn_mfma_f32_16x16x32_bf16(Vf0, Pf[k2], o0, 0, 0, 0); o1 = __builtin_amdgcn_mfma_f32_16x16x32_bf16(Vf1, Pf[k2], o1, 0, 0, 0); }
        const int c = g * 256 + d2 * 32 + 8 * fq; const u32x4 z = zf[d2];
        u32x4 w; w.x = pk2(o0[0] * isum * bflo(z.x), o0[1] * isum * bfhi(z.x)); w.y = pk2(o0[2] * isum * bflo(z.y), o0[3] * isum * bfhi(z.y));
        w.z = pk2(o1[0] * isum * bflo(z.z), o1[1] * isum * bfhi(z.z)); w.w = pk2(o1[2] * isum * bflo(z.w), o1[3] * isum * bfhi(z.w));
        __builtin_nontemporal_store(w, (u32x4*)(BR2 + m * DM + c));
        __builtin_amdgcn_sched_barrier(0);
    }
    __syncthreads();
}
__device__ __forceinline__ void sgu_sample(const KArgs& a, int g, int rb) {
    int tid_ = threadIdx.x; asm volatile("" : "+v"(tid_));
    const int tid = tid_;
    const bf16* U = (const bf16*)(a.ws + WS_PROJ) + (size_t)2 * MP * DM; const bf16* V = U + (size_t)MP * DM;
    const float* VSS = (const float*)(a.ws + WS_VSS); bf16* BR1 = (bf16*)(a.ws + WS_BR) + (size_t)MP * DM;
    const float w00 = a.in[I_SGUW][(size_t)g * 128 * 128], b0 = a.in[I_SGUB][g * 128];
    for (int idx = tid; idx < 16 * 64; idx += 512) {
        const int i = rb * 16 + (idx >> 6), c = g * 256 + (idx & 63) * 4; const size_t m = (size_t)(MPR + i);
        const float s = wave_sum((idx & 63) < 16 ? VSS[m * 16 + (idx & 63)] : 0.f);
        const float rs = rsqrtf(s * (1.f / DM) + EPS);
        const f32x4 gv = *(const f32x4*)(a.in[I_SGUNG] + c);
        const u32x2 v4 = *(const u32x2*)(V + m * DM + c), u4 = *(const u32x2*)(U + m * DM + c);
        f32x4 vn; vn.x = bflo(v4.x) * rs * gv.x; vn.y = bfhi(v4.x) * rs * gv.y; vn.z = bflo(v4.y) * rs * gv.z; vn.w = bfhi(v4.y) * rs * gv.w;
        *(f32x4*)(a.out + O_SV + (size_t)i * DM + c) = vn;
        u32x2 o; o.x = pk2(bflo(u4.x) * (w00 * vn.x + b0), bfhi(u4.x) * (w00 * vn.y + b0));
        o.y = pk2(bflo(u4.y) * (w00 * vn.z + b0), bfhi(u4.y) * (w00 * vn.w + b0));
        *(u32x2*)(BR1 + m * DM + c) = o;
    }
}
__device__ __forceinline__ void attn_sample(const KArgs& a, LAS unsigned char* lds, int i, int h) {
    int tid_ = threadIdx.x; asm volatile("" : "+v"(tid_));
    const int tid = tid_, lane = tid & 63, wv = tid >> 6;
    const bf16* Q = (const bf16*)(a.ws + WS_PROJ) + (size_t)5 * MP * DM; const bf16* AZ = Q + (size_t)MP * DM; bf16* BR2 = (bf16*)(a.ws + WS_BR) + (size_t)2 * MP * DM;
    const size_t m = (size_t)(MPR + i);
    const float* Kc = a.in[I_CK] + ((size_t)i * NMEM * 4 + h) * 256 + lane * 4;
    const float* Vc = a.in[I_CV] + ((size_t)i * NMEM * 4 + h) * 256 + lane * 4;
    LAS float* sc = (LAS float*)lds; LAS float* part = (LAS float*)(lds + 1024);
    const u32x2 q2 = *(const u32x2*)(Q + m * DM + h * 256 + lane * 4);
    const f32x4 qv = (f32x4){bflo(q2.x), bfhi(q2.x), bflo(q2.y), bfhi(q2.y)};
    {
        f32x4 kv[32]; float pd[32];
#pragma unroll
        for (int j = 0; j < 32; ++j) kv[j] = __builtin_nontemporal_load((const f32x4*)(Kc + (size_t)(wv * 32 + j) * 1024));
#pragma unroll
        for (int j = 0; j < 32; ++j) pd[j] = (kv[j].x * qv.x + kv[j].y * qv.y) + (kv[j].z * qv.z + kv[j].w * qv.w);
#pragma unroll
        for (int j = 0; j < 32; ++j) { const float d = wave_sum(pd[j]); if (lane == 0) sc[wv * 32 + j] = d * 0.0625f; }
    }
    f32x4 vv[32];
#pragma unroll
    for (int j = 0; j < 32; ++j) vv[j] = __builtin_nontemporal_load((const f32x4*)(Vc + (size_t)(wv * 32 + j) * 1024));
    __syncthreads();
    const f32x4 s4 = *(const LAS f32x4*)(sc + lane * 4);
    const float mx = wave_max(fmaxf(fmaxf(s4.x, s4.y), fmaxf(s4.z, s4.w)));
    const float sum = wave_sum((__expf(s4.x - mx) + __expf(s4.y - mx)) + (__expf(s4.z - mx) + __expf(s4.w - mx)));
    f32x4 o = (f32x4){0.f, 0.f, 0.f, 0.f};
#pragma unroll
    for (int j = 0; j < 32; ++j) { const float pj = __expf(sc[wv * 32 + j] - mx); o += vv[j] * pj; }
    *(LAS f32x4*)(part + wv * 256 + lane * 4) = o;
    __syncthreads();
    if (tid < 256) { float t = 0.f;
#pragma unroll
        for (int w8 = 0; w8 < 8; ++w8) t += part[w8 * 256 + tid];
        const int c = h * 256 + tid; const unsigned short zb = AZ[m * DM + c]; const float z = __builtin_bit_cast(float, (unsigned)zb << 16);
        BR2[m * DM + c] = (bf16)f2bf(t / sum * z); }
    __syncthreads();
}
__device__ __forceinline__ void p2_mixers(const KArgs& a, LAS unsigned char* lds, int G) {
    constexpr int NU = 512 + 512 + 4 + 32;
    if (G == 256) {
        const int c = blockIdx.x;
        for (int k = 0; k < 4; ++k) { const int kk = (c & 1) ? (k ^ 2) : k;
            if (kk < 2) { const int u = c + kk * 256, rt = u >> 2, g = u & 3; pool_part(a, lds, rt, g); sgu_part(a, lds, rt, g); attn_part(a, lds, rt, g); }
            else { const int e = c + (kk - 2) * 256; attn_sample(a, lds, e >> 2, e & 3); } }
        if (c < 4) pool_part(a, lds, 128, c); else if (c >= 8 && c < 40) sgu_sample(a, (c - 8) >> 3, (c - 8) & 7);
        return;
    }
    for (int u = blockIdx.x; u < NU; u += G) {
        if (u < 512) { const int rt = u >> 2, g = u & 3; pool_part(a, lds, rt, g); sgu_part(a, lds, rt, g); attn_part(a, lds, rt, g); }
        else if (u < 1024) { const int e = u - 512; attn_sample(a, lds, e >> 2, e & 3); }
        else if (u < 1028) pool_part(a, lds, 128, u - 1024);
        else sgu_sample(a, (u - 1028) >> 3, (u - 1028) & 7);
    }
}
__device__ __forceinline__ void p5_norm(const KArgs& a, int G) {
    const int tid = threadIdx.x, lane = tid & 63, wave = tid >> 6;
    const int gw = blockIdx.x * 8 + wave, NGW = G * 8;
    const f32x4* gr = (const f32x4*)a.in[I_NORMF] + lane;
    for (int m = gw; m < MV; m += NGW) {
        f32x4* xr = (f32x4*)(a.out + (size_t)m * DM) + lane;
        f32x4 v[4]; float s = 0.f;
#pragma unroll
        for (int j = 0; j < 4; ++j) { v[j] = xr[64 * j]; s += (v[j].x * v[j].x + v[j].y * v[j].y) + (v[j].z * v[j].z + v[j].w * v[j].w); }
        const float rs = rsqrtf(wave_sum(s) * (1.f / DM) + EPS);
#pragma unroll
        for (int j = 0; j < 4; ++j) { const f32x4 g = gr[64 * j]; xr[64 * j] = (f32x4){v[j].x * rs * g.x, v[j].y * rs * g.y, v[j].z * rs * g.z, v[j].w * rs * g.w}; }
    }
}

__global__ void __launch_bounds__(512, 2) fwd_megakernel(KArgs a) {
    extern __shared__ __attribute__((aligned(16))) unsigned char lds_raw[];
    LAS unsigned char* lds = (LAS unsigned char*)lds_raw;
    cg::grid_group grid = cg::this_grid();
    const int G = gridDim.x;
    const int lo = a.ph_lo, hi = a.ph_hi;
    volatile LAS unsigned* bst = (volatile LAS unsigned*)(lds + LDS_BYTES - 64);
    if (threadIdx.x == 0) { bst[0] = 0u; bst[1] = 0u; }
    __syncthreads();
    const XcdBarrier bar = xcd_barrier_post((unsigned*)(a.ws + WS_CTL), bst);
#define IN(k) (lo <= (k) && (k) < hi)
#define SEAM(k) do { if (IN(k) && IN((k) + 1)) { if (a.cg_sync) grid.sync(); else xcd_barrier(bar); } } while (0)
    if (IN(0)) p0_prologue(a, lds, G);
    SEAM(0);
    if (IN(1)) {
        pg8::Gemm g{(const bf16*)(a.ws + WS_H), (const bf16*)(a.ws + WS_WIN), MP, INC, DM};
        P1Order S; S.init(G, (int)blockIdx.x);
        EpiProj E{(bf16*)(a.ws + WS_PROJ), (bf16*)(a.ws + WS_GATE), (float*)(a.ws + WS_VSS), (bf16*)(a.ws + WS_KB), (bf16*)(a.ws + WS_VB), a.out, (const float*)(a.ws + WS_HS), (bf16*)(a.ws + WS_DS)};
        pg8::gemm_phase<EpiProj, P1Order>(lds, g, S, E);
    }
    SEAM(1);
    if (IN(2)) p2_mixers(a, lds, G);
    SEAM(2);
    if (IN(3)) {
        pg8::Gemm g{(const bf16*)(a.ws + WS_BR), (const bf16*)(a.ws + WS_WD), MPR, 3 * DM, DM};
        P3Order S; S.init(G, (int)blockIdx.x);
        EpiGate E{(const bf16*)(a.ws + WS_GATE), (bf16*)(a.ws + WS_MG)};
        pg8::gemm_phase<EpiGate, P3Order>(lds, g, S, E);
        EpiS3 E3{(const bf16*)(a.ws + WS_GATE), (bf16*)(a.ws + WS_GYS)};
        skinny_gemm(lds, (const bf16*)(a.ws + WS_BR) + (size_t)MPR * DM, DM, (size_t)MP * DM, 64, 1, 0, (const bf16*)(a.ws + WS_WD), DM, DM, 192, (int)blockIdx.x, G, E3);
    }
    SEAM(3);
    if (IN(4)) {
        pg8::Gemm g{(const bf16*)(a.ws + WS_MG), (const bf16*)(a.ws + WS_WO3), MPR, DM, DM};
        pg8::StaticOrder S; S.init(MPR, DM, G, (int)blockIdx.x);
        unsigned* ctl = (unsigned*)(a.ws + WS_CTL);
        EpiOutNorm E{a.in[I_XP], a.in[I_NORMF], a.out, (float*)(a.ws + WS_VSS), ctl + CW_PANEL};
        pg8::gemm_phase<EpiOutNorm, pg8::StaticOrder>(lds, g, S, E);
        sample_out_split(a, lds, (int)blockIdx.x);
    }
#undef IN
#undef SEAM
}

extern "C" void kernel_launch(void* const* d_in, const int* in_sizes, int n_in, void* d_out, int out_size, void* d_ws, size_t ws_size, hipStream_t stream) {
    static int grid = 0;
    if (grid == 0) {
        if (n_in != 18 || (size_t)out_size != O_END || ws_size < WS_END) { fprintf(stderr, "kernel_launch: unexpected shapes (n_in %d out %d ws %zu, need %zu)\n", n_in, out_size, ws_size, (size_t)WS_END); grid = -1; return; }
        int dev = 0, cus = 0, per_cu = 0;
        hipGetDevice(&dev); hipDeviceGetAttribute(&cus, hipDeviceAttributeMultiprocessorCount, dev);
        if (hipFuncSetAttribute((const void*)fwd_megakernel, hipFuncAttributeMaxDynamicSharedMemorySize, LDS_BYTES) != hipSuccess) { fprintf(stderr, "kernel_launch: hipFuncSetAttribute failed\n"); grid = -1; return; }
        if (hipOccupancyMaxActiveBlocksPerMultiprocessor(&per_cu, (const void*)fwd_megakernel, 512, LDS_BYTES) != hipSuccess || per_cu < 1) { fprintf(stderr, "kernel_launch: occupancy query failed (%d)\n", per_cu); grid = -1; return; }
        if (cus != 256) { fprintf(stderr, "kernel_launch: built for a 256-CU device (one 256x256 tile per workgroup in the last two phases), got %d\n", cus); grid = -1; return; }
        grid = cus;
    }
    if (grid < 0) return;
    if (hipMemsetAsync((char*)d_ws + WS_CTL, 0, CTL_BYTES, stream) != hipSuccess) { fprintf(stderr, "kernel_launch: memset failed\n"); return; }
    KArgs a{};
    for (int i = 0; i < 18; ++i) a.in[i] = (const float*)d_in[i];
    a.out = (float*)d_out; a.ws = (unsigned char*)d_ws; a.ph_lo = 0; a.ph_hi = 5;
    void* args[] = {&a};
    hipError_t e = hipLaunchCooperativeKernel((const void*)fwd_megakernel, dim3(grid), dim3(512), args, LDS_BYTES, stream);
    if (e != hipSuccess) fprintf(stderr, "cooperative launch failed: %s (grid %d)\n", hipGetErrorString(e), grid);
}
```

```cpp
#include <hip/hip_runtime.h>
#include <hip/hip_cooperative_groups.h>
#include <cstdio>
#include <cstdint>
namespace cg = cooperative_groups;

#define LAS __attribute__((address_space(3)))
typedef unsigned short bf16;
typedef short bf16x8 __attribute__((ext_vector_type(8)));
typedef short s16x4 __attribute__((ext_vector_type(4)));
typedef float f32x4 __attribute__((ext_vector_type(4)));
typedef unsigned u32x4 __attribute__((ext_vector_type(4)));
typedef unsigned u32x2 __attribute__((ext_vector_type(2)));

constexpr int DM = 1024, NBATCH = 8, SEQ = 2048, NS = 128, NMEM = 256;
constexpr int MPR = NBATCH * SEQ;
constexpr int MV = MPR + NS;
constexpr int MP = MPR + 256;
constexpr int NPAN = MP / 256;
constexpr int INC = 10240;
constexpr float EPS = 1e-6f;
constexpr size_t O_YP = 0, O_YS = O_YP + (size_t)MPR * DM, O_POOLP = O_YS + (size_t)NS * DM, O_POOLS = O_POOLP + (size_t)NBATCH * 15 * DM,
                 O_MK = O_POOLS + (size_t)NS * 15 * DM, O_MV = O_MK + (size_t)NBATCH * NMEM * DM, O_SV = O_MV + (size_t)NBATCH * NMEM * DM, O_END = O_SV + (size_t)NS * DM;
constexpr size_t ROWB = (size_t)MP * DM * 2;
constexpr size_t WS_CTL = 0, CTL_BYTES = 40960;
constexpr size_t WS_VSS2 = CTL_BYTES;
constexpr size_t WS_DS = WS_VSS2 + 32768;
constexpr size_t WS_HS = WS_DS + 262144;
constexpr size_t WS_H = WS_HS + 524288;
constexpr size_t WS_WIN = WS_H + (size_t)(MP + 2048) * DM * 2;
constexpr size_t WS_WD = WS_WIN + (size_t)(INC + 2048) * DM * 2;
constexpr size_t WS_WO3 = WS_WD + (size_t)3 * DM * DM * 2;
constexpr size_t WS_PW = WS_WO3 + (size_t)3 * DM * DM * 2;
constexpr size_t WS_SW = WS_PW + (size_t)4 * 256 * 256 * 2;
constexpr size_t WS_VSS = WS_SW + (size_t)4 * 128 * 128 * 2;
constexpr size_t WS_KB = WS_VSS + (size_t)MP * 16 * 4;
constexpr size_t WS_VB = WS_KB + (size_t)2048 * DM * 2;
constexpr size_t WS_PROJ = WS_VB + (size_t)2048 * DM * 2;
constexpr size_t WS_GATE = WS_PROJ + 7 * ROWB;
constexpr size_t WS_BR = WS_GATE + 3 * ROWB;
constexpr size_t WS_MG = WS_PROJ;
constexpr size_t WS_GYS = WS_H;
constexpr size_t WS_END = WS_BR + 3 * ROWB;
constexpr int LDS_BYTES = 147456;
constexpr int CW_PANEL = 4096, CW_SAMPLE = 4096 + 64 * 64;

__device__ __forceinline__ unsigned f2bf(float f) { unsigned u = __builtin_bit_cast(unsigned, f); return (u + 0x7fffu + ((u >> 16) & 1u)) >> 16; }
__device__ __forceinline__ unsigned pk2(float lo, float hi) { unsigned r; asm volatile("v_cvt_pk_bf16_f32 %0, %1, %2" : "=v"(r) : "v"(lo), "v"(hi)); return r; }
__device__ __forceinline__ float bflo(unsigned w) { return __builtin_bit_cast(float, w << 16); }
__device__ __forceinline__ float bfhi(unsigned w) { return __builtin_bit_cast(float, w & 0xffff0000u); }
__device__ __forceinline__ float silu_f(float x) { return x * __builtin_amdgcn_rcpf(1.f + __expf(-x)); }
__device__ __forceinline__ float sigm_f(float x) { return __builtin_amdgcn_rcpf(1.f + __expf(-x)); }
__device__ __forceinline__ float wave_sum(float v) {
#pragma unroll
    for (int o = 1; o < 64; o <<= 1) v += __shfl_xor(v, o);
    return v;
}
__device__ __forceinline__ float wave_max(float v) {
#pragma unroll
    for (int o = 1; o < 64; o <<= 1) v = fmaxf(v, __shfl_xor(v, o));
    return v;
}
__device__ __forceinline__ bf16x8 tr_read2(const LAS unsigned char* a0, const LAS unsigned char* a1) {
    const s16x4 lo = __builtin_amdgcn_ds_read_tr16_b64_v4i16((LAS s16x4*)a0);
    const s16x4 hi = __builtin_amdgcn_ds_read_tr16_b64_v4i16((LAS s16x4*)a1);
    return (bf16x8){lo[0], lo[1], lo[2], lo[3], hi[0], hi[1], hi[2], hi[3]};
}

#define XB_TMO      128
#define XB_XCNT(j)  (256  + 64 * (j))
#define XB_XSUB(j)  (1280 + 64 * (j))
#define XB_XGEN(j)  (2304 + 64 * (j))
#define XB_TOP      3328
#define XB_TOPGEN   3392
#define XCD_BAR_WORDS 3456
#define XB_SPIN_CAP (1u << 18)

__device__ __forceinline__ unsigned xb_ld(unsigned* p)              { return __hip_atomic_load(p, __ATOMIC_RELAXED, __HIP_MEMORY_SCOPE_AGENT); }
__device__ __forceinline__ unsigned xb_add(unsigned* p, unsigned v) { return __hip_atomic_fetch_add(p, v, __ATOMIC_RELAXED, __HIP_MEMORY_SCOPE_AGENT); }
__device__ __forceinline__ unsigned xb_xcc_id() { return (unsigned)__builtin_amdgcn_s_getreg((3 << 11) | 20) & 0xFu; }
#define XB_SPIN(cond, bar) do { unsigned _sp = 0; while (cond) { __builtin_amdgcn_s_sleep(1); \
    if ((++_sp & 255u) == 0u) { if (xb_ld(&(bar)[XB_TMO])) break; if (_sp > XB_SPIN_CAP) { atomicAdd(&(bar)[XB_TMO], 1u); break; } } } } while (0)

struct XcdBarrier {
    unsigned* bar; unsigned x;
    volatile LAS unsigned* st;
};

__device__ __forceinline__ XcdBarrier xcd_barrier_post(unsigned* bar, volatile LAS unsigned* st) {
    XcdBarrier b; b.bar = bar; b.x = xb_xcc_id(); b.st = st;
    if (threadIdx.x == 0) (void)xb_add(&bar[XB_XCNT(b.x)], 1u);
    return b;
}
__device__ __forceinline__ void xcd_barrier_complete(unsigned* bar, unsigned x, unsigned& nloc, unsigned& nx) {
    const unsigned G = gridDim.x;
    unsigned sum, cnt, mine, sp = 0u;
    for (;;) {
        sum = 0u; cnt = 0u; mine = 0u;
#pragma unroll
        for (unsigned j = 0; j < 16; ++j) { const unsigned c = xb_ld(&bar[XB_XCNT(j)]); sum += c; cnt += (c > 0u) ? 1u : 0u; mine = (j == x) ? c : mine; }
        if (sum == G) break;
        __builtin_amdgcn_s_sleep(1);
        if ((++sp & 255u) == 0u) { if (xb_ld(&bar[XB_TMO])) break; if (sp > XB_SPIN_CAP) { atomicAdd(&bar[XB_TMO], 1u); break; } }
    }
    nloc = mine > 0u ? mine : 1u; nx = cnt > 0u ? cnt : 1u;
}

__device__ __forceinline__ void xcd_barrier(const XcdBarrier& b) {
    asm volatile("s_waitcnt vmcnt(0)" ::: "memory");
    __syncthreads();
    if (threadIdx.x == 0) {
        unsigned* bar = b.bar;
        __builtin_amdgcn_s_waitcnt(0);
        unsigned nloc = b.st[0], nx = b.st[1];
        if (nloc == 0u) { xcd_barrier_complete(bar, b.x, nloc, nx); b.st[0] = nloc; b.st[1] = nx; }
        const unsigned old = xb_add(&bar[XB_XSUB(b.x)], 1u);
        const unsigned gen = old / nloc;
        if (old + 1u == (gen + 1u) * nloc) {
            __builtin_amdgcn_fence(__ATOMIC_RELEASE, "agent");
            asm volatile("s_waitcnt vmcnt(0)" ::: "memory");
            const unsigned og = xb_add(&bar[XB_TOP], 1u);
            const unsigned tg = og / nx;
            if (og + 1u == (tg + 1u) * nx) xb_add(&bar[XB_TOPGEN], 1u);
            else XB_SPIN(xb_ld(&bar[XB_TOPGEN]) == tg, bar);
            __builtin_amdgcn_fence(__ATOMIC_ACQUIRE, "agent");
            xb_add(&bar[XB_XGEN(b.x)], 1u);
            asm volatile("s_waitcnt vmcnt(0)" ::: "memory");
        } else {
            XB_SPIN(xb_ld(&bar[XB_XGEN(b.x)]) == gen, bar);
            __builtin_amdgcn_fence(__ATOMIC_ACQUIRE, "agent");
            asm volatile("s_waitcnt vmcnt(0)" ::: "memory");
        }
    }
    __syncthreads();
}

namespace pg8 {
#define PG8_LAS __attribute__((address_space(3)))
typedef unsigned short bf16_t;
constexpr int BM = 256, BK = 64, HALF = 128, HTB = HALF * BK * 2, STAGE_BYTES = 8 * HTB, NXCD = 8, WGM = 8;
__host__ __device__ __forceinline__ int lds_byte(int r, int c) { const int st = (r >> 4) * 2 + (c >> 5), rr = r & 15, cc = c & 31, ob = rr * 64 + cc * 2; return st * 1024 + (ob ^ (((ob >> 9) & 1) << 5)); }
__host__ __device__ __forceinline__ void stage_rc(int b, int& R, int& C) { const int st = b / 1024, sb = b % 1024, swz = sb ^ (((sb >> 9) & 1) << 5); R = (st >> 1) * 16 + swz / 64; C = (st & 1) * 32 + (swz % 64) / 2; }
__host__ __device__ __forceinline__ int perm32(int rho) { const int n = rho >> 4, i = rho & 15; return 8 * (i >> 2) + 4 * n + (i & 3); }
struct Unit { int pm, pn; int brow, fz; };
struct Gemm { const bf16_t* A; const bf16_t* Bt; int M, N, K; };
struct StaticOrder {
    int nM, nN, nwg, G, c;
    __host__ __device__ void init(int M, int N, int G_, int c_) { nM = M / BM; nN = N / BM; nwg = nM * nN; G = G_; c = c_; }
    __host__ __device__ bool next(int i, Unit& u) const {
        const long L = (long)i * G + c; if (L >= nwg) return false;
        int wgid = (int)L; { const int q = nwg / NXCD, r = nwg % NXCD, xcd = wgid % NXCD, off = wgid / NXCD; wgid = (xcd < r ? xcd * (q + 1) : r * (q + 1) + (xcd - r) * q) + off; }
        const int nig = WGM * nN, gid = wgid / nig, fm = gid * WGM, gsz = (nM - fm) < WGM ? (nM - fm) : WGM;
        u.pm = fm + ((wgid % nig) % gsz); u.pn = (wgid % nig) / gsz; u.brow = u.pn * BM; u.fz = 0; return true;
    }
    __device__ __forceinline__ void a_ready(const Unit&) const {}
    __device__ __forceinline__ void done(const Unit&) const {}
};

template <class Epi, class Sched>
__device__ __forceinline__ void gemm_phase(PG8_LAS unsigned char* lds, const Gemm g, const Sched& S, const Epi& E) {
    const int tid = threadIdx.x, wid = __builtin_amdgcn_readfirstlane(tid >> 6), lane = tid & 63, wr = wid >> 2, wc = wid & 3, fr = lane & 15, fq = lane >> 4;
    const int K = g.K, nt = K / BK;
    unsigned voffA[2], voffB[2], voffBf[2];
#pragma unroll
    for (int i = 0; i < 2; ++i) { int R, C; stage_rc(tid * 16 + i * 8192, R, C); const int Rb = Epi::PERM ? ((R >> 5) * 64 + perm32(R & 31)) : R;
        voffA[i] = (unsigned)(R * K + C) * 2u; voffB[i] = (unsigned)(Rb * K + C) * 2u; voffBf[i] = (unsigned)((Rb - (R >> 5) * 32) * K + C) * 2u; }
    const size_t kstep = (size_t)(BK * 2);
    const size_t hstep = (size_t)HALF * K * 2;
    const size_t hstepB = Epi::PERM ? (size_t)32 * K * 2 : hstep;
    const size_t tstep = 2 * hstep;
    const unsigned ldsw = (unsigned)wid * 1024u;
    const int aoff = lds_byte(wr * 64 + fr, fq * 8), boff = lds_byte(wc * 32 + fr, fq * 8);
#define PG8_SA(b, h) (((b) * 2 + (h)) * HTB)
#define PG8_SB(b, h) ((4 + (b) * 2 + (h)) * HTB)
#define PG8_STAGE(bufoff, gbase, voff) do { _Pragma("unroll") for (int _i = 0; _i < 2; ++_i) \
        __builtin_amdgcn_global_load_lds((const unsigned*)((const char*)(gbase) + (voff)[_i]), (PG8_LAS unsigned*)(lds + (bufoff) + ldsw + _i * 8192), 16, 0, 0); } while (0)
#define PG8_LDA(dst, b, h) do { _Pragma("unroll") for (int m = 0; m < 4; ++m) _Pragma("unroll") for (int k = 0; k < 2; ++k) dst[m][k] = *(const PG8_LAS bf16x8*)(lds + PG8_SA(b, h) + aoff + m * 2048 + k * 1024); } while (0)
#define PG8_LDB(dst, b, h) do { _Pragma("unroll") for (int n = 0; n < 2; ++n) _Pragma("unroll") for (int k = 0; k < 2; ++k) dst[n][k] = *(const PG8_LAS bf16x8*)(lds + PG8_SB(b, h) + boff + n * 2048 + k * 1024); } while (0)
#define PG8_MMA(ai, bj, At, Bt) do { __builtin_amdgcn_s_setprio(1); _Pragma("unroll") for (int m = 0; m < 4; ++m) _Pragma("unroll") for (int n = 0; n < 2; ++n) _Pragma("unroll") for (int k = 0; k < 2; ++k) \
        acc[ai][bj][m][n] = __builtin_amdgcn_mfma_f32_16x16x32_bf16(Bt[n][k], At[m][k], acc[ai][bj][m][n], 0, 0, 0); __builtin_amdgcn_s_setprio(0); } while (0)
#define PG8_WAIT_V(n) asm volatile("s_waitcnt vmcnt(" #n ")" ::: "memory")
#define PG8_WAIT_L(n) asm volatile("s_waitcnt lgkmcnt(" #n ")" ::: "memory")
#define PG8_BAR __builtin_amdgcn_s_barrier()
#define PG8_SCHED __builtin_amdgcn_sched_barrier(0)
    Unit cur, nxt; int ui = 0;
    if (!S.next(0, cur)) return;
    f32x4 acc[2][2][4][2];
#pragma unroll
    for (int a = 0; a < 2; ++a)
#pragma unroll
        for (int b = 0; b < 2; ++b)
#pragma unroll
            for (int m = 0; m < 4; ++m)
#pragma unroll
                for (int n = 0; n < 2; ++n) acc[a][b][m][n] = (f32x4){0.f, 0.f, 0.f, 0.f};
    bf16x8 At[4][2], B0[2][2], B1[2][2];
    const size_t rowB = (size_t)K * 2, hstepBf = (size_t)2048 * K * 2;
    const char* cA = (const char*)g.A + (size_t)cur.pm * tstep; const char* cB = (const char*)g.Bt + (size_t)cur.brow * rowB;
    S.a_ready(cur);
    { unsigned vB[2] = {cur.fz ? voffBf[0] : voffB[0], cur.fz ? voffBf[1] : voffB[1]}; const size_t hB = cur.fz ? hstepBf : hstepB;
    PG8_STAGE(PG8_SB(0, 0), cB, vB); PG8_STAGE(PG8_SB(0, 1), cB + hB, vB); PG8_STAGE(PG8_SA(0, 0), cA, voffA); PG8_STAGE(PG8_SA(0, 1), cA + hstep, voffA);
    if (wr == 1) PG8_BAR;
    PG8_WAIT_V(2); PG8_BAR;
    PG8_STAGE(PG8_SB(1, 0), cB + kstep, vB); PG8_STAGE(PG8_SA(1, 0), cA + kstep, voffA); PG8_STAGE(PG8_SB(1, 1), cB + hB + kstep, vB);
    PG8_WAIT_V(6); PG8_BAR; }
    for (;;) {
        const bool has_next = S.next(ui + 1, nxt);
        const char* nA = has_next ? (const char*)g.A + (size_t)nxt.pm * tstep : cA; const char* nB = has_next ? (const char*)g.Bt + (size_t)nxt.brow * rowB : cB;
        const int nfz = has_next ? nxt.fz : cur.fz;
        E.prefetch(cur, wid, lane, lds + STAGE_BYTES + wid * 1024);
        for (int t = 0; t < nt; t += 2) {
            const bool last = (t == nt - 2);
            const char* a1 = cA + (size_t)(t + 1) * kstep;
            const char* a2 = last ? nA : cA + (size_t)(t + 2) * kstep; const char* b2 = last ? nB : cB + (size_t)(t + 2) * kstep;
            const char* a3 = a2 + kstep; const char* b3 = b2 + kstep;
            const int fzt = last ? nfz : cur.fz; unsigned vB[2] = {fzt ? voffBf[0] : voffB[0], fzt ? voffBf[1] : voffB[1]}; const size_t hB = fzt ? hstepBf : hstepB;
            if (last && has_next) S.a_ready(nxt);
            PG8_LDB(B0, 0, 0); PG8_LDB(B1, 0, 1); PG8_SCHED; PG8_LDA(At, 0, 0); PG8_STAGE(PG8_SA(1, 1), a1 + hstep, voffA);
            PG8_WAIT_V(8); PG8_WAIT_L(0); PG8_BAR; PG8_MMA(0, 0, At, B0); PG8_MMA(0, 1, At, B1); PG8_BAR; PG8_SCHED;
            PG8_LDA(At, 0, 1); PG8_STAGE(PG8_SB(0, 0), b2, vB); PG8_STAGE(PG8_SB(0, 1), b2 + hB, vB); PG8_STAGE(PG8_SA(0, 0), a2, voffA);
            PG8_WAIT_V(8); PG8_WAIT_L(0); PG8_BAR; PG8_MMA(1, 0, At, B0); PG8_MMA(1, 1, At, B1); PG8_BAR; PG8_SCHED;
            PG8_LDB(B0, 1, 0); PG8_LDB(B1, 1, 1); PG8_SCHED; PG8_LDA(At, 1, 0); PG8_STAGE(PG8_SA(0, 1), a2 + hstep, voffA);
            PG8_WAIT_V(8); PG8_WAIT_L(0); PG8_BAR; PG8_MMA(0, 0, At, B0); PG8_MMA(0, 1, At, B1); PG8_BAR; PG8_SCHED;
            PG8_LDA(At, 1, 1); PG8_STAGE(PG8_SB(1, 0), b3, vB); PG8_STAGE(PG8_SB(1, 1), b3 + hB, vB); PG8_STAGE(PG8_SA(1, 0), a3, voffA);
            PG8_WAIT_V(8); PG8_WAIT_L(0); PG8_BAR; PG8_MMA(1, 0, At, B0); PG8_MMA(1, 1, At, B1); PG8_BAR; PG8_SCHED;
        }
        if constexpr (!Epi::AFTER_DRAIN) { E(acc, cur, wr, wc, fr, fq); S.done(cur); }
        if (!has_next) break;
#pragma unroll
        for (int a = 0; a < 2; ++a)
#pragma unroll
            for (int b = 0; b < 2; ++b)
#pragma unroll
                for (int m = 0; m < 4; ++m)
#pragma unroll
                    for (int n = 0; n < 2; ++n) acc[a][b][m][n] = (f32x4){0.f, 0.f, 0.f, 0.f};
        cur = nxt; cA = nA; cB = nB; ++ui;
    }
    PG8_WAIT_V(0);
    if (wr == 0) PG8_BAR;
    PG8_BAR;
    if constexpr (Epi::AFTER_DRAIN) { E.fused(acc, cur, wr, wc, fr, fq); S.done(cur); }
#undef PG8_SA
#undef PG8_SB
#undef PG8_STAGE
#undef PG8_LDA
#undef PG8_LDB
#undef PG8_MMA
#undef PG8_WAIT_V
#undef PG8_WAIT_L
#undef PG8_BAR
#undef PG8_SCHED
}
}

struct KArgs {
    const float* in[18];
    float* out;
    unsigned char* ws;
    int ph_lo, ph_hi;
    int cg_sync, pad;
};
enum { I_XP = 0, I_XS, I_SPOOL, I_CK, I_CV, I_MEM, I_NORMG, I_WIN, I_POOLW, I_POOLSC, I_SGUNG, I_SGUW, I_SGUB, I_MEMNG, I_WKV, I_WDOWN, I_WOUT, I_NORMF };

struct P1Order {
    pg8::StaticOrder so; int G, c;
    __device__ void init(int G_, int c_) { so.init(MPR, INC, G_, c_); G = G_; c = c_; }
    __device__ bool next(int i, pg8::Unit& u) const {
        const long L = (long)i * G + c;
        if (L < so.nwg) so.next(i, u);
        else { const int e = (int)(L - so.nwg); if (e >= 104) return false;
            if (e < 64) { u.pm = NPAN + (e >> 3); u.pn = 40 + (e & 7); } else { u.pm = 64; u.pn = e - 64; } }
        u.brow = u.pn * 256; u.fz = 0;
        if (u.pn >= 8 && u.pn < 12) { u.brow = 2 * DM + 128 * (u.pn - 8); u.fz = 1; } else if (u.pn >= 16 && u.pn < 20) { u.brow = 2 * DM + 128 * (4 + u.pn - 16); u.fz = 1; }
        return true;
    }
    __device__ __forceinline__ void a_ready(const pg8::Unit&) const {}
    __device__ __forceinline__ void done(const pg8::Unit&) const {}
};
struct EpiProj {
    static constexpr bool PERM = true, AFTER_DRAIN = false;
    bf16* proj; bf16* gate; float* vss; bf16* kb; bf16* vb; float* out; const float* hs; bf16* dsr;
    __device__ __forceinline__ void prefetch(const pg8::Unit&, int, int, LAS unsigned char*) const {}
    __device__ __forceinline__ void operator()(const f32x4 (&acc)[2][2][4][2], const pg8::Unit& u, int wr, int wc, int fr, int fq) const {
        if (u.fz) {
            const int j = (u.pn < 12) ? u.pn - 8 : 4 + u.pn - 16; bf16* uz = proj + (size_t)2 * MP * DM;
            const int row0 = u.pm * 256 + wr * 64 + fr, c = 128 * j + wc * 32 + 8 * fq;
#pragma unroll
            for (int ai = 0; ai < 2; ++ai)
#pragma unroll
                for (int m = 0; m < 4; ++m) { const size_t r = (size_t)(row0 + ai * 128 + m * 16);
                    const f32x4 u0 = acc[ai][0][m][0], u1 = acc[ai][0][m][1], z0 = acc[ai][1][m][0], z1 = acc[ai][1][m][1];
                    u32x4 w; w.x = pk2(u0[0] * silu_f(z0[0]), u0[1] * silu_f(z0[1])); w.y = pk2(u0[2] * silu_f(z0[2]), u0[3] * silu_f(z0[3]));
                    w.z = pk2(u1[0] * silu_f(z1[0]), u1[1] * silu_f(z1[1])); w.w = pk2(u1[2] * silu_f(z1[2]), u1[3] * silu_f(z1[3]));
                    __builtin_nontemporal_store(w, (u32x4*)(uz + r * DM + c)); }
        } else if (u.pn < 40) {
            const int sec = u.pn >> 2;
            const int act = (sec == 1 || sec == 4 || sec == 6) ? 1 : (sec >= 7 ? 2 : 0);
            const int row0 = u.pm * 256 + wr * 64 + fr, cs0 = (u.pn & 3) * 256 + wc * 64 + 8 * fq;
            bf16* base; int ld;
            if (sec < 7) { base = proj + (size_t)sec * MP * DM; ld = DM; } else { base = gate + (sec - 7) * DM; ld = 3 * DM; }
            const bool poolrows = (sec == 0) && (((u.pm & 7) == 7) || u.pm == 64);
#pragma unroll
            for (int ai = 0; ai < 2; ++ai)
#pragma unroll
                for (int m = 0; m < 4; ++m) {
                    const int r = row0 + ai * 128 + m * 16; float ss = 0.f;
#pragma unroll
                    for (int bj = 0; bj < 2; ++bj) {
                        f32x4 v0 = acc[ai][bj][m][0], v1 = acc[ai][bj][m][1]; const int cs = cs0 + bj * 32;
                        if (sec == 3) ss += (v0[0] * v0[0] + v0[1] * v0[1]) + (v0[2] * v0[2] + v0[3] * v0[3]) + (v1[0] * v1[0] + v1[1] * v1[1]) + (v1[2] * v1[2] + v1[3] * v1[3]);
                        if (poolrows) {
                            float* dst = nullptr;
                            if (r < MPR) { const int t = r & (SEQ - 1); if (t >= SEQ - 15) dst = out + O_POOLP + ((size_t)(r >> 11) * 15 + (t - (SEQ - 15))) * DM + cs; }
                            else if (r < MV) { dst = out + O_POOLS + ((size_t)(r - MPR) * 15 + 14) * DM + cs;
                                const float* hp = hs + (size_t)(r - MPR) * DM + cs; const f32x4 h0 = *(const f32x4*)hp, h1 = *(const f32x4*)(hp + 4); const float inv = 1.f / (float)(2 << (cs >> 8));
                                u32x4 d; d.x = pk2((h0.x + v0[0]) * inv - v0[0], (h0.y + v0[1]) * inv - v0[1]); d.y = pk2((h0.z + v0[2]) * inv - v0[2], (h0.w + v0[3]) * inv - v0[3]);
                                d.z = pk2((h1.x + v1[0]) * inv - v1[0], (h1.y + v1[1]) * inv - v1[1]); d.w = pk2((h1.z + v1[2]) * inv - v1[2], (h1.w + v1[3]) * inv - v1[3]);
                                *(u32x4*)(dsr + (size_t)(r - MPR) * DM + cs) = d; }
                            if (dst) { *(f32x4*)dst = v0; *(f32x4*)(dst + 4) = v1; }
                        }
                        if (act == 1) {
#pragma unroll
                            for (int j = 0; j < 4; ++j) { v0[j] = silu_f(v0[j]); v1[j] = silu_f(v1[j]); } }
                        if (act == 2) {
#pragma unroll
                            for (int j = 0; j < 4; ++j) { v0[j] = sigm_f(v0[j]); v1[j] = sigm_f(v1[j]); } }
                        u32x4 w; w.x = pk2(v0[0], v0[1]); w.y = pk2(v0[2], v0[3]); w.z = pk2(v1[0], v1[1]); w.w = pk2(v1[2], v1[3]);
                        __builtin_nontemporal_store(w, (u32x4*)(base + (size_t)r * ld + cs));
                    }
                    if (sec == 3) { ss += __shfl_xor(ss, 16); ss += __shfl_xor(ss, 32); if (fq == 0) vss[(size_t)r * 16 + (u.pn & 3) * 4 + wc] = ss; }
                }
        } else {
            const int b = u.pm - NPAN, ct = (u.pn - 40) * 256;
            const bool isv = ct >= DM; const int cb = (isv ? ct - DM : ct) + wc * 64 + 8 * fq;
            float* of = out + (isv ? O_MV : O_MK); bf16* ob = isv ? vb : kb;
#pragma unroll
            for (int ai = 0; ai < 2; ++ai)
#pragma unroll
                for (int m = 0; m < 4; ++m) {
                    const size_t j = (size_t)b * 256 + ai * 128 + wr * 64 + m * 16 + fr;
#pragma unroll
                    for (int bj = 0; bj < 2; ++bj) {
                        const f32x4 v0 = acc[ai][bj][m][0], v1 = acc[ai][bj][m][1]; const int cs = cb + bj * 32;
                        __builtin_nontemporal_store(v0, (f32x4*)(of + j * DM + cs)); __builtin_nontemporal_store(v1, (f32x4*)(of + j * DM + cs + 4));
                        u32x4 w; w.x = pk2(v0[0], v0[1]); w.y = pk2(v0[2], v0[3]); w.z = pk2(v1[0], v1[1]); w.w = pk2(v1[2], v1[3]);
                        *(u32x4*)(ob + j * DM + cs) = w;
                    }
                }
        }
    }
};
struct P3Order {
    pg8::StaticOrder so;
    __device__ void init(int G_, int c_) { so.init(MPR, DM, G_, c_); }
    __device__ bool next(int i, pg8::Unit& u) const { const int rnd = i / 3, b = i - 3 * rnd; pg8::Unit t; if (!so.next(rnd, t)) return false; u.pm = b * NPAN + t.pm; u.pn = b * 4 + t.pn; u.brow = u.pn * 256; u.fz = 0; return true; }
    __device__ __forceinline__ void a_ready(const pg8::Unit&) const {}
    __device__ __forceinline__ void done(const pg8::Unit&) const {}
};
struct EpiGate {
    static constexpr bool PERM = true, AFTER_DRAIN = false;
    const bf16* gate; bf16* mg;
    __device__ __forceinline__ void prefetch(const pg8::Unit& u, int wid, int lane, LAS unsigned char* scr) const {
        const int b = u.pn >> 2, pm = u.pm - b * NPAN, t = wid * 64 + lane;
#pragma unroll
        for (int j = 0; j < 2; ++j) { const int li = t + 512 * j, row = li >> 2, seg = li & 3; const size_t r = (size_t)(pm * 256 + row);
            __builtin_amdgcn_global_load_lds((const unsigned*)(gate + r * (3 * DM) + b * DM + (u.pn & 3) * 256 + seg * 64), (LAS unsigned*)(scr + j * 256), 4, 0, 0); }
    }
    __device__ __forceinline__ void operator()(const f32x4 (&acc)[2][2][4][2], const pg8::Unit& u, int wr, int wc, int fr, int fq) const {
        const int b = u.pn >> 2, pm = u.pm - b * NPAN;
        const int row0 = pm * 256 + wr * 64 + fr, c0 = (u.pn & 3) * 256 + wc * 64 + 8 * fq;
#pragma unroll
        for (int ai = 0; ai < 2; ++ai) {
            u32x4 g8[4][2], p8[4][2];
#pragma unroll
            for (int m = 0; m < 4; ++m)
#pragma unroll
                for (int bj = 0; bj < 2; ++bj) { const size_t r = (size_t)(row0 + ai * 128 + m * 16); const int c = c0 + bj * 32;
                    g8[m][bj] = *(const u32x4*)(gate + r * (3 * DM) + b * DM + c);
                    p8[m][bj] = (u32x4){0u, 0u, 0u, 0u}; if (b > 0) p8[m][bj] = *(const u32x4*)(mg + r * DM + c); }
            asm volatile("" ::: "memory");
#pragma unroll
            for (int m = 0; m < 4; ++m)
#pragma unroll
                for (int bj = 0; bj < 2; ++bj) { const size_t r = (size_t)(row0 + ai * 128 + m * 16); const int c = c0 + bj * 32;
                    const f32x4 v0 = acc[ai][bj][m][0], v1 = acc[ai][bj][m][1]; const u32x4 gq = g8[m][bj], p = p8[m][bj];
                    const float o0 = v0[0] * bflo(gq.x) + bflo(p.x), o1 = v0[1] * bfhi(gq.x) + bfhi(p.x), o2 = v0[2] * bflo(gq.y) + bflo(p.y), o3 = v0[3] * bfhi(gq.y) + bfhi(p.y);
                    const float o4 = v1[0] * bflo(gq.z) + bflo(p.z), o5 = v1[1] * bfhi(gq.z) + bfhi(p.z), o6 = v1[2] * bflo(gq.w) + bflo(p.w), o7 = v1[3] * bfhi(gq.w) + bfhi(p.w);
                    u32x4 w; w.x = pk2(o0, o1); w.y = pk2(o2, o3); w.z = pk2(o4, o5); w.w = pk2(o6, o7);
                    if (b == 2) __builtin_nontemporal_store(w, (u32x4*)(mg + r * DM + c)); else *(u32x4*)(mg + r * DM + c) = w; }
        }
    }
};
__device__ __forceinline__ void st_agent(float* p, float v) { __hip_atomic_store((unsigned*)p, __builtin_bit_cast(unsigned, v), __ATOMIC_RELAXED, __HIP_MEMORY_SCOPE_AGENT); }
__device__ __forceinline__ float ld_agent(const float* p) { return __builtin_bit_cast(float, __hip_atomic_load((unsigned*)p, __ATOMIC_RELAXED, __HIP_MEMORY_SCOPE_AGENT)); }
__device__ __forceinline__ void wait_count(unsigned* w, unsigned want) {
    unsigned sp = 0;
    while ((unsigned)__builtin_amdgcn_readfirstlane(__hip_atomic_load(w, __ATOMIC_RELAXED, __HIP_MEMORY_SCOPE_AGENT)) < want) { __builtin_amdgcn_s_sleep(2); if (++sp > (1u << 22)) break; }
    __builtin_amdgcn_fence(__ATOMIC_ACQUIRE, "agent");
    asm volatile("s_waitcnt vmcnt(0)" ::: "memory");
}
struct EpiOutNorm {
    static constexpr bool PERM = false, AFTER_DRAIN = true;
    const float* xp; const float* gf; float* out; float* slots; unsigned* cnt;
    __device__ __forceinline__ void prefetch(const pg8::Unit& u, int wid, int lane, LAS unsigned char* scr) const {
        const int t = wid * 64 + lane;
#pragma unroll
        for (int j = 0; j < 4; ++j) { const int li = t + 512 * j, row = li >> 3, seg = li & 7;
            __builtin_amdgcn_global_load_lds((const unsigned*)(xp + (size_t)(u.pm * 256 + row) * DM + u.pn * 256 + seg * 32), (LAS unsigned*)(scr + j * 256), 4, 0, 0); }
    }
    __device__ __forceinline__ void operator()(const f32x4 (&)[2][2][4][2], const pg8::Unit&, int, int, int, int) const {}
    __device__ __forceinline__ void fused(f32x4 (&acc)[2][2][4][2], const pg8::Unit& u, int wr, int wc, int fr, int fq) const {
        const int row0 = u.pm * 256 + wr * 64 + fr, col0 = u.pn * 256 + wc * 32 + 4 * fq;
#pragma unroll
        for (int ai = 0; ai < 2; ++ai)
#pragma unroll
            for (int m = 0; m < 4; ++m) { const size_t r = (size_t)(row0 + ai * 128 + m * 16); float ss = 0.f;
#pragma unroll
                for (int bj = 0; bj < 2; ++bj)
#pragma unroll
                    for (int n = 0; n < 2; ++n) { const int c = col0 + bj * 128 + n * 16; const f32x4 v = acc[ai][bj][m][n] + __builtin_nontemporal_load((const f32x4*)(xp + r * DM + c)); acc[ai][bj][m][n] = v;
                        ss += (v.x * v.x + v.y * v.y) + (v.z * v.z + v.w * v.w); }
                ss += __shfl_xor(ss, 16); ss += __shfl_xor(ss, 32);
                if (fq == 0) st_agent(slots + r * 16 + u.pn * 4 + wc, ss); }
        asm volatile("s_waitcnt vmcnt(0)" ::: "memory");
        if (fr == 0 && fq == 0) __hip_atomic_fetch_add(cnt + 64 * u.pm, 1u, __ATOMIC_RELAXED, __HIP_MEMORY_SCOPE_AGENT);
        if (threadIdx.x < 64) wait_count(cnt + 64 * u.pm, 32u);
        __syncthreads();
#pragma unroll
        for (int ai = 0; ai < 2; ++ai)
#pragma unroll
            for (int m = 0; m < 4; ++m) { const size_t r = (size_t)(row0 + ai * 128 + m * 16); float tot = 0.f;
                { const f32x4* sp = (const f32x4*)(slots + r * 16); const f32x4 p0 = sp[0], p1 = sp[1], p2 = sp[2], p3 = sp[3];
                  tot = (((p0.x + p0.y) + (p0.z + p0.w)) + ((p1.x + p1.y) + (p1.z + p1.w))) + (((p2.x + p2.y) + (p2.z + p2.w)) + ((p3.x + p3.y) + (p3.z + p3.w))); }
                const float rs = rsqrtf(tot * (1.f / DM) + EPS);
#pragma unroll
                for (int bj = 0; bj < 2; ++bj)
#pragma unroll
                    for (int n = 0; n < 2; ++n) { const int c = col0 + bj * 128 + n * 16; const f32x4 g = *(const f32x4*)(gf + c); const f32x4 v = acc[ai][bj][m][n];
                        __builtin_nontemporal_store((f32x4){v.x * rs * g.x, v.y * rs * g.y, v.z * rs * g.z, v.w * rs * g.w}, (f32x4*)(out + O_YP + r * DM + c)); } }
    }
};

template <class Epi>
__device__ __forceinline__ void skinny_gemm(LAS unsigned char* lds, const bf16* A0, int lda, size_t a_grp_stride, int strips_per_grp, int nseg, int aseg,
                                            const bf16* Bt, int ldb, int K, int nstrips, int first, int step, const Epi& E) {
    int tid_ = threadIdx.x; asm volatile("" : "+v"(tid_));
    const int tid = tid_, lane = tid & 63, wv = tid >> 6, fr = lane & 15, fq = lane >> 4, rh = wv & 1, kq = wv >> 1;
    LAS float* part = (LAS float*)lds;
    const int nks = K / 128;
    for (int s = first; s < nstrips; s += step) {
        const bf16* A = A0 + (size_t)(s / strips_per_grp) * a_grp_stride + (size_t)(rh * 64 + fr) * lda + fq * 8;
        const bf16* B = Bt + (size_t)(16 * s + fr) * ldb + fq * 8;
        f32x4 acc[4];
#pragma unroll
        for (int rb = 0; rb < 4; ++rb) acc[rb] = (f32x4){0.f, 0.f, 0.f, 0.f};
        for (int seg = 0; seg < nseg; ++seg) {
#pragma unroll 4
            for (int k = 0; k < nks; ++k) {
                const int ko = (kq * nks + k) * 32;
                const bf16x8 bfr = *(const bf16x8*)(B + ko);
#pragma unroll
                for (int rb = 0; rb < 4; ++rb) { const bf16x8 afr = *(const bf16x8*)(A + (size_t)rb * 16 * lda + seg * aseg + ko);
                    acc[rb] = __builtin_amdgcn_mfma_f32_16x16x32_bf16(bfr, afr, acc[rb], 0, 0, 0); }
            }
        }
#pragma unroll
        for (int rb = 0; rb < 4; ++rb) *(LAS f32x4*)(part + ((kq * 128 + rh * 64 + rb * 16 + fr) * 16 + fq * 4)) = acc[rb];
        __syncthreads();
        { const int row = tid >> 2, cq = tid & 3; const LAS float* p = part + row * 16 + cq * 4;
          const f32x4 v = (*(const LAS f32x4*)p + *(const LAS f32x4*)(p + 2048)) + (*(const LAS f32x4*)(p + 4096) + *(const LAS f32x4*)(p + 6144));
          E(s, row, 16 * s + cq * 4, v, cq); }
        __syncthreads();
    }
}
struct EpiS1 {
    bf16* proj; bf16* gate; float* vss2; float* out; const float* hist; bf16* ds;
    __device__ __forceinline__ void operator()(int s, int row, int c, f32x4 v, int cq) const {
        const int sec = c >> 10, cs = c & 1023; const size_t m = (size_t)(MPR + row);
        if (sec == 0) { *(f32x4*)(out + O_POOLS + ((size_t)row * 15 + 14) * DM + cs) = v;
            const int w = 2 << (cs >> 8); f32x4 sm = v;
#pragma unroll
            for (int j = 0; j < 15; ++j) if (j < w - 1) sm = sm + *(const f32x4*)(hist + ((size_t)row * 15 + 14 - j) * DM + cs);
            const float inv = 1.f / (float)w;
            u32x2 d; d.x = pk2(sm.x * inv - v.x, sm.y * inv - v.y); d.y = pk2(sm.z * inv - v.z, sm.w * inv - v.w);
            *(u32x2*)(ds + (size_t)row * DM + cs) = d; }
        if (sec == 3) { float ss = (v.x * v.x + v.y * v.y) + (v.z * v.z + v.w * v.w); ss += __shfl_xor(ss, 1); ss += __shfl_xor(ss, 2); if (cq == 0) vss2[row * 64 + (s - 192)] = ss; }
        if (sec == 1 || sec == 4 || sec == 6) { v.x = silu_f(v.x); v.y = silu_f(v.y); v.z = silu_f(v.z); v.w = silu_f(v.w); }
        if (sec >= 7) { v.x = sigm_f(v.x); v.y = sigm_f(v.y); v.z = sigm_f(v.z); v.w = sigm_f(v.w); }
        u32x2 w; w.x = pk2(v.x, v.y); w.y = pk2(v.z, v.w);
        if (sec < 7) *(u32x2*)(proj + (size_t)sec * MP * DM + m * DM + cs) = w; else *(u32x2*)(gate + m * (3 * DM) + (sec - 7) * DM + cs) = w;
    }
};
struct EpiS3 {
    const bf16* gate; bf16* gys;
    __device__ __forceinline__ void operator()(int s, int row, int c, f32x4 v, int cq) const {
        const u32x2 g = *(const u32x2*)(gate + (size_t)(MPR + row) * (3 * DM) + c);
        u32x2 w; w.x = pk2(v.x * bflo(g.x), v.y * bfhi(g.x)); w.y = pk2(v.z * bflo(g.y), v.w * bfhi(g.y));
        *(u32x2*)(gys + (size_t)row * (3 * DM) + c) = w;
    }
};
struct EpiS4 {
    const float* xs; const float* gf; float* out; float* slots2; unsigned* cnt2;
    __device__ __forceinline__ void operator()(int s, int row, int c, f32x4 v, int cq) const {
        v = v + *(const f32x4*)(xs + (size_t)row * DM + c);
        float ss = (v.x * v.x + v.y * v.y) + (v.z * v.z + v.w * v.w); ss += __shfl_xor(ss, 1); ss += __shfl_xor(ss, 2);
        if (cq == 0) st_agent(slots2 + row * 64 + s, ss);
        asm volatile("s_waitcnt vmcnt(0)" ::: "memory");
        __syncthreads();
        if (threadIdx.x == 0) __hip_atomic_fetch_add(cnt2, 1u, __ATOMIC_RELAXED, __HIP_MEMORY_SCOPE_AGENT);
        if (threadIdx.x < 64) wait_count(cnt2, 64u);
        __syncthreads();
        float tot = 0.f;
        { const f32x4* sp = (const f32x4*)(slots2 + row * 64 + cq * 16); const f32x4 p0 = sp[0], p1 = sp[1], p2 = sp[2], p3 = sp[3];
          tot = (((p0.x + p0.y) + (p0.z + p0.w)) + ((p1.x + p1.y) + (p1.z + p1.w))) + (((p2.x + p2.y) + (p2.z + p2.w)) + ((p3.x + p3.y) + (p3.z + p3.w))); }
        tot += __shfl_xor(tot, 1); tot += __shfl_xor(tot, 2);
        const float rs = rsqrtf(tot * (1.f / DM) + EPS); const f32x4 g = *(const f32x4*)(gf + c);
        *(f32x4*)(out + O_YS + (size_t)row * DM + c) = (f32x4){v.x * rs * g.x, v.y * rs * g.y, v.z * rs * g.z, v.w * rs * g.w};
    }
};


__device__ __forceinline__ void sample_out_split(const KArgs& a, LAS unsigned char* lds, int item) {
    int tid_ = threadIdx.x; asm volatile("" : "+v"(tid_));
    const int tid = tid_, lane = tid & 63, wv = tid >> 6, fr = lane & 15, fq = lane >> 4, s = item >> 2, rq = item & 3;
    const bf16* A = (const bf16*)(a.ws + WS_GYS) + (size_t)(rq * 32 + fr) * (3 * DM) + fq * 8;
    const bf16* B = (const bf16*)(a.ws + WS_WO3) + (size_t)(16 * s + fr) * DM + fq * 8;
    f32x4 acc0 = (f32x4){0.f, 0.f, 0.f, 0.f}, acc1 = acc0;
#pragma unroll
    for (int kk = 0; kk < 12; ++kk) { const int k = 384 * wv + 32 * kk;
        const bf16x8 bfr = *(const bf16x8*)(B + (k & 1023)); const bf16x8 a0 = *(const bf16x8*)(A + k), a1 = *(const bf16x8*)(A + (size_t)16 * (3 * DM) + k);
        acc0 = __builtin_amdgcn_mfma_f32_16x16x32_bf16(bfr, a0, acc0, 0, 0, 0); acc1 = __builtin_amdgcn_mfma_f32_16x16x32_bf16(bfr, a1, acc1, 0, 0, 0); }
    LAS float* part = (LAS float*)lds;
    *(LAS f32x4*)(part + (wv * 32 + fr) * 16 + fq * 4) = acc0; *(LAS f32x4*)(part + (wv * 32 + 16 + fr) * 16 + fq * 4) = acc1;
    __syncthreads();
    const int row = tid >> 4, col = tid & 15, grow = rq * 32 + row, c = 16 * s + col;
    float v = 0.f;
#pragma unroll
    for (int w8 = 0; w8 < 8; ++w8) v += part[(w8 * 32 + row) * 16 + col];
    v += a.in[I_XS][(size_t)grow * DM + c];
    float ss = v * v; ss += __shfl_xor(ss, 1); ss += __shfl_xor(ss, 2); ss += __shfl_xor(ss, 4); ss += __shfl_xor(ss, 8);
    float* slots2 = (float*)(a.ws + WS_VSS2); unsigned* cnt = (unsigned*)(a.ws + WS_CTL) + CW_SAMPLE + 64 * rq;
    if (col == 0) st_agent(slots2 + grow * 64 + s, ss);
    asm volatile("s_waitcnt vmcnt(0)" ::: "memory");
    __syncthreads();
    if (tid == 0) __hip_atomic_fetch_add(cnt, 1u, __ATOMIC_RELAXED, __HIP_MEMORY_SCOPE_AGENT);
    if (tid < 64) wait_count(cnt, 64u);
    __syncthreads();
    const f32x4 p4 = *(const f32x4*)(slots2 + grow * 64 + col * 4);
    float tot = (p4.x + p4.y) + (p4.z + p4.w); tot += __shfl_xor(tot, 1); tot += __shfl_xor(tot, 2); tot += __shfl_xor(tot, 4); tot += __shfl_xor(tot, 8);
    a.out[O_YS + (size_t)grow * DM + c] = v * rsqrtf(tot * (1.f / DM) + EPS) * a.in[I_NORMF][c];
    __syncthreads();
}

__device__ __forceinline__ void p0_transpose_item(const float* W, int N, bf16* WT, int row_off, int ldo, int koff, LAS float* scr, int item, int lane) {
    const int nblk = N / 32, kb = item / nblk, nb = item % nblk, k0 = 64 * kb, n0 = 32 * nb;
    float wv_[32];
#pragma unroll
    for (int i = 0; i < 32; ++i) { const int kk = 2 * i + (lane >> 5); wv_[i] = __builtin_nontemporal_load(W + (size_t)(k0 + kk) * N + n0 + (lane & 31)); }
#pragma unroll
    for (int i = 0; i < 32; ++i) { const int kk = 2 * i + (lane >> 5); scr[kk * 33 + (lane & 31)] = wv_[i]; }
    asm volatile("s_waitcnt lgkmcnt(0)" ::: "memory");
    const int c = lane & 7;
#pragma unroll
    for (int j = 0; j < 4; ++j) { const int n = (lane >> 3) + 8 * j; const LAS float* s = scr + (8 * c) * 33 + n;
        u32x4 o; o.x = pk2(s[0 * 33], s[1 * 33]); o.y = pk2(s[2 * 33], s[3 * 33]); o.z = pk2(s[4 * 33], s[5 * 33]); o.w = pk2(s[6 * 33], s[7 * 33]);
        *(u32x4*)(WT + (size_t)(row_off + n0 + n) * ldo + koff + k0 + 8 * c) = o; }
    asm volatile("s_waitcnt lgkmcnt(0)" ::: "memory");
}
__device__ __forceinline__ void rms_row_to_bf16(const float* xrow, const float* gain, bf16* orow, int lane) {
    const f32x4* xr = (const f32x4*)xrow + lane; const f32x4* gr = (const f32x4*)gain + lane;
    f32x4 v[4]; float s = 0.f;
#pragma unroll
    for (int j = 0; j < 4; ++j) { v[j] = xr[64 * j]; s += (v[j].x * v[j].x + v[j].y * v[j].y) + (v[j].z * v[j].z + v[j].w * v[j].w); }
    const float rs = rsqrtf(wave_sum(s) * (1.f / DM) + EPS);
    u32x2* o8 = (u32x2*)orow + lane;
#pragma unroll
    for (int j = 0; j < 4; ++j) { const f32x4 g = gr[64 * j]; u32x2 w; w.x = pk2(v[j].x * rs * g.x, v[j].y * rs * g.y); w.y = pk2(v[j].z * rs * g.z, v[j].w * rs * g.w); o8[64 * j] = w; }
}
__device__ __forceinline__ void rms_row2_to_bf16(const float* x0, const float* x1, const float* gain, bf16* o0, bf16* o1, int lane) {
    const f32x4* xr0 = (const f32x4*)x0 + lane; const f32x4* xr1 = (const f32x4*)x1 + lane; const f32x4* gr = (const f32x4*)gain + lane;
    f32x4 v[4], w[4]; float s = 0.f, t = 0.f;
#pragma unroll
    for (int j = 0; j < 4; ++j) { v[j] = __builtin_nontemporal_load(xr0 + 64 * j); w[j] = __builtin_nontemporal_load(xr1 + 64 * j); }
#pragma unroll
    for (int j = 0; j < 4; ++j) { s += (v[j].x * v[j].x + v[j].y * v[j].y) + (v[j].z * v[j].z + v[j].w * v[j].w); t += (w[j].x * w[j].x + w[j].y * w[j].y) + (w[j].z * w[j].z + w[j].w * w[j].w); }
#pragma unroll
    for (int o = 1; o < 64; o <<= 1) { s += __shfl_xor(s, o); t += __shfl_xor(t, o); }
    const float rs = rsqrtf(s * (1.f / DM) + EPS), rt = rsqrtf(t * (1.f / DM) + EPS);
    u32x2* p0 = (u32x2*)o0 + lane; u32x2* p1 = (u32x2*)o1 + lane;
#pragma unroll
    for (int j = 0; j < 4; ++j) { const f32x4 g = gr[64 * j]; u32x2 a; a.x = pk2(v[j].x * rs * g.x, v[j].y * rs * g.y); a.y = pk2(v[j].z * rs * g.z, v[j].w * rs * g.w); p0[64 * j] = a;
        u32x2 b; b.x = pk2(w[j].x * rt * g.x, w[j].y * rt * g.y); b.y = pk2(w[j].z * rt * g.z, w[j].w * rt * g.w); p1[64 * j] = b; }
}
__device__ __forceinline__ void p0_prologue(const KArgs& a, LAS unsigned char* lds, int G) {
    const int tid = threadIdx.x, lane = tid & 63, wave = tid >> 6;
    LAS float* scr = (LAS float*)(lds + wave * 16384);
    const int gw = blockIdx.x * 8 + wave, NGW = G * 8;
    bf16* H = (bf16*)(a.ws + WS_H); bf16* WinT = (bf16*)(a.ws + WS_WIN); bf16* WdT = (bf16*)(a.ws + WS_WD); bf16* Wo3 = (bf16*)(a.ws + WS_WO3);
    bf16* PwT = (bf16*)(a.ws + WS_PW); bf16* SW = (bf16*)(a.ws + WS_SW);
    constexpr int I_IN = 16 * (INC / 32), I_KV = 16 * (2048 / 32), I_D = 16 * 32, I_O = 16 * 32, I_P = 4 * 8;
    constexpr int NITEMS = I_IN + I_KV + 3 * I_D + I_O + 4 * I_P;
    for (int it = gw; it < NITEMS; it += NGW) {
        int r = it;
        if (r < I_IN) { p0_transpose_item(a.in[I_WIN], INC, WinT, 0, DM, 0, scr, r, lane); continue; } r -= I_IN;
        if (r < I_KV) { p0_transpose_item(a.in[I_WKV], 2048, WinT, INC, DM, 0, scr, r, lane); continue; } r -= I_KV;
        if (r < 3 * I_D) { const int b = r / I_D; p0_transpose_item(a.in[I_WDOWN] + (size_t)b * DM * DM, DM, WdT, b * DM, DM, 0, scr, r % I_D, lane); continue; } r -= 3 * I_D;
        if (r < I_O) { p0_transpose_item(a.in[I_WOUT], DM, Wo3, 0, DM, 0, scr, r, lane); continue; } r -= I_O;
        { const int g = r / I_P; p0_transpose_item(a.in[I_POOLW] + (size_t)g * 256 * 256, 256, PwT, g * 256, 256, 0, scr, r % I_P, lane); }
    }
    for (int m = gw; m + NGW < MPR; m += 2 * NGW)
        rms_row2_to_bf16(a.in[I_XP] + (size_t)m * DM, a.in[I_XP] + (size_t)(m + NGW) * DM, a.in[I_NORMG], H + (size_t)m * DM, H + (size_t)(m + NGW) * DM, lane);
    const int mdone = (MPR / (2 * NGW)) * (2 * NGW);
    for (int m = mdone + gw; m < MP + 2048; m += NGW) {
        bf16* orow = H + (size_t)m * DM;
        if (m < MPR) rms_row_to_bf16(a.in[I_XP] + (size_t)m * DM, a.in[I_NORMG], orow, lane);
        else if (m < MV) rms_row_to_bf16(a.in[I_XS] + (size_t)(m - MPR) * DM, a.in[I_NORMG], orow, lane);
        else if (m < MP) { u32x2* o8 = (u32x2*)orow + lane;
#pragma unroll
            for (int j = 0; j < 4; ++j) o8[64 * j] = (u32x2){0u, 0u}; }
        else rms_row_to_bf16(a.in[I_MEM] + (size_t)(m - MP) * DM, a.in[I_MEMNG], orow, lane);
    }
    const size_t gt = (size_t)blockIdx.x * 512 + tid, NGT = (size_t)G * 512;
    for (size_t i = gt; i < (size_t)4 * 128 * 128; i += NGT) { const int s = (int)(i & 127), t = (int)((i >> 7) & 127); SW[i] = (bf16)(s <= t ? f2bf(a.in[I_SGUW][i]) : 0u); }
    for (size_t i = gt; i < (size_t)NS * 256; i += NGT) { const size_t smp = i >> 8, c = (i & 255) * 4; const int w = 2 << (int)(c >> 8); f32x4 sm = (f32x4){0.f, 0.f, 0.f, 0.f};
#pragma unroll
        for (int j = 0; j < 15; ++j) if (j < w - 1) sm = sm + *(const f32x4*)(a.in[I_SPOOL] + (smp * 15 + 14 - j) * DM + c);
        *(f32x4*)((float*)(a.ws + WS_HS) + smp * DM + c) = sm; }
    for (size_t i = gt; i < (size_t)NS * 14 * 256; i += NGT) { const size_t smp = i / (14 * 256), rem = i % (14 * 256), r = rem / 256, c4 = rem % 256;
        __builtin_nontemporal_store(*(const f32x4*)(a.in[I_SPOOL] + (smp * 15 + r + 1) * DM + c4 * 4), (f32x4*)(a.out + O_POOLS + (smp * 15 + r) * DM + c4 * 4)); }
}

constexpr int RSV = 544;
constexpr int RS = 528;
__device__ __forceinline__ void pool_part(const KArgs& a, LAS unsigned char* lds, int rt, int g) {
    int tid_ = threadIdx.x; asm volatile("" : "+v"(tid_));
    const int tid = tid_, lane = tid & 63, wv = tid >> 6, fr = lane & 15, fq = lane >> 4;
    const int m0 = rt * 128, w = 2 << g;
    const bf16* PIN = (const bf16*)(a.ws + WS_PROJ); const bf16* PZ = PIN + (size_t)MP * DM;
    const bf16* PwT = (const bf16*)(a.ws + WS_PW); bf16* BR0 = (bf16*)(a.ws + WS_BR);
    LAS unsigned char* Pb = lds; LAS unsigned char* Db = lds + 75520;
    u32x4 zf[8]; f32x4 scv[2]; bf16x8 Bf[2][8];
    const bf16* pw = PwT + (size_t)(g * 256 + wv * 32 + 8 * (fr >> 2) + (fr & 3)) * 256 + fq * 8;
    if (rt < 128) {
        const int t0 = (rt & 15) * 128;
        u32x4 tv[9];
#pragma unroll
        for (int i = 0; i < 9; ++i) { const int idx = tid + i * 512, row = idx >> 5, ch = idx & 31; tv[i] = (u32x4){0u, 0u, 0u, 0u};
            if (idx < 143 * 32 && !(t0 == 0 && row < 15)) tv[i] = *(const u32x4*)(PIN + (size_t)(m0 - 15 + row) * DM + g * 256 + ch * 8); }
#pragma unroll
        for (int rb = 0; rb < 8; ++rb) zf[rb] = __builtin_nontemporal_load((const u32x4*)(PZ + (size_t)(m0 + rb * 16 + fr) * DM + g * 256 + wv * 32 + 8 * fq));
#pragma unroll
        for (int nn = 0; nn < 2; ++nn) { scv[nn] = *(const f32x4*)(a.in[I_POOLSC] + g * 256 + wv * 32 + 8 * fq + 4 * nn);
#pragma unroll
            for (int ks = 0; ks < 8; ++ks) Bf[nn][ks] = *(const bf16x8*)(pw + nn * 4 * 256 + ks * 32); }
#pragma unroll
        for (int i = 0; i < 9; ++i) { const int idx = tid + i * 512, row = idx >> 5, ch = idx & 31; if (idx < 143 * 32) *(LAS u32x4*)(Pb + row * RS + ch * 16) = tv[i]; }
        __syncthreads();
        {
            const int ch = tid & 31, r0 = (tid >> 5) * 8;
            float s0 = 0.f, s1 = 0.f, s2 = 0.f, s3 = 0.f, s4 = 0.f, s5 = 0.f, s6 = 0.f, s7 = 0.f;
            for (int j = 1; j < w; ++j) { const u32x4 v = *(const LAS u32x4*)(Pb + (r0 + 15 - j) * RS + ch * 16);
                s0 += bflo(v.x); s1 += bfhi(v.x); s2 += bflo(v.y); s3 += bfhi(v.y); s4 += bflo(v.z); s5 += bfhi(v.z); s6 += bflo(v.w); s7 += bfhi(v.w); }
#pragma unroll
            for (int i = 0; i < 8; ++i) { const int r = r0 + i;
                const u32x4 own = *(const LAS u32x4*)(Pb + (r + 15) * RS + ch * 16); const u32x4 old = *(const LAS u32x4*)(Pb + (r + 16 - w) * RS + ch * 16);
                s0 += bflo(own.x); s1 += bfhi(own.x); s2 += bflo(own.y); s3 += bfhi(own.y); s4 += bflo(own.z); s5 += bfhi(own.z); s6 += bflo(own.w); s7 += bfhi(own.w);
                const int cnt = min(w, t0 + r + 1); const float inv = 1.f / (float)cnt;
                u32x4 d; d.x = pk2(s0 * inv - bflo(own.x), s1 * inv - bfhi(own.x)); d.y = pk2(s2 * inv - bflo(own.y), s3 * inv - bfhi(own.y));
                d.z = pk2(s4 * inv - bflo(own.z), s5 * inv - bfhi(own.z)); d.w = pk2(s6 * inv - bflo(own.w), s7 * inv - bfhi(own.w));
                *(LAS u32x4*)(Db + r * RS + ch * 16) = d;
                s0 -= bflo(old.x); s1 -= bfhi(old.x); s2 -= bflo(old.y); s3 -= bfhi(old.y); s4 -= bflo(old.z); s5 -= bfhi(old.z); s6 -= bflo(old.w); s7 -= bfhi(old.w); }
        }
    } else {
#pragma unroll
        for (int rb = 0; rb < 8; ++rb) zf[rb] = __builtin_nontemporal_load((const u32x4*)(PZ + (size_t)(m0 + rb * 16 + fr) * DM + g * 256 + wv * 32 + 8 * fq));
#pragma unroll
        for (int nn = 0; nn < 2; ++nn) { scv[nn] = *(const f32x4*)(a.in[I_POOLSC] + g * 256 + wv * 32 + 8 * fq + 4 * nn);
#pragma unroll
            for (int ks = 0; ks < 8; ++ks) Bf[nn][ks] = *(const bf16x8*)(pw + nn * 4 * 256 + ks * 32); }
        const bf16* DS = (const bf16*)(a.ws + WS_DS);
        u32x4 td[8];
#pragma unroll
        for (int i = 0; i < 8; ++i) { const int idx = tid + i * 512, r = idx >> 5, ch = idx & 31; td[i] = *(const u32x4*)(DS + (size_t)r * DM + g * 256 + ch * 8); }
#pragma unroll
        for (int i = 0; i < 8; ++i) { const int idx = tid + i * 512, r = idx >> 5, ch = idx & 31; *(LAS u32x4*)(Db + r * RS + ch * 16) = td[i]; }
    }
    __syncthreads();
#pragma unroll
    for (int rb = 0; rb < 8; ++rb) {
        f32x4 acc0 = (f32x4){0.f, 0.f, 0.f, 0.f}, acc1 = acc0;
#pragma unroll
        for (int ks = 0; ks < 8; ++ks) { const bf16x8 A = *(const LAS bf16x8*)(Db + (rb * 16 + fr) * RS + (ks * 32 + fq * 8) * 2);
            acc0 = __builtin_amdgcn_mfma_f32_16x16x32_bf16(Bf[0][ks], A, acc0, 0, 0, 0); acc1 = __builtin_amdgcn_mfma_f32_16x16x32_bf16(Bf[1][ks], A, acc1, 0, 0, 0); }
        const size_t m = (size_t)(m0 + rb * 16 + fr); const int c = g * 256 + wv * 32 + 8 * fq; const u32x4 z = zf[rb];
        u32x4 o; o.x = pk2(acc0[0] * scv[0].x * bflo(z.x), acc0[1] * scv[0].y * bfhi(z.x)); o.y = pk2(acc0[2] * scv[0].z * bflo(z.y), acc0[3] * scv[0].w * bfhi(z.y));
        o.z = pk2(acc1[0] * scv[1].x * bflo(z.z), acc1[1] * scv[1].y * bfhi(z.z)); o.w = pk2(acc1[2] * scv[1].z * bflo(z.w), acc1[3] * scv[1].w * bfhi(z.w));
        __builtin_nontemporal_store(o, (u32x4*)(BR0 + m * DM + c));
    }
    __syncthreads();
}
__device__ __forceinline__ void sgu_part(const KArgs& a, LAS unsigned char* lds, int rt, int g) {
    int tid_ = threadIdx.x; asm volatile("" : "+v"(tid_));
    const int tid = tid_, lane = tid & 63, wv = tid >> 6, fr = lane & 15, fq = lane >> 4;
    const int m0 = rt * 128;
    const bf16* U = (const bf16*)(a.ws + WS_PROJ) + (size_t)2 * MP * DM; const bf16* V = U + (size_t)MP * DM;
    const bf16* SW = (const bf16*)(a.ws + WS_SW); const float* VSS = (const float*)(a.ws + WS_VSS); bf16* BR1 = (bf16*)(a.ws + WS_BR) + (size_t)MP * DM;
    LAS unsigned char* Vb = lds; LAS unsigned char* UZb = lds + 128 * RS; LAS float* rbuf = (LAS float*)(lds + 256 * RS);
    u32x4 tv[8], tu[8];
#pragma unroll
    for (int i = 0; i < 8; ++i) { const int idx = tid + i * 512, s = idx >> 5, ch = idx & 31; const size_t o = (size_t)(m0 + s) * DM + g * 256 + ch * 8;
        tv[i] = __builtin_nontemporal_load((const u32x4*)(V + o)); tu[i] = __builtin_nontemporal_load((const u32x4*)(U + o)); }
    if (tid < 128) { const f32x4* p = (const f32x4*)(VSS + (size_t)(m0 + tid) * 16); const f32x4 p0 = p[0], p1 = p[1], p2 = p[2], p3 = p[3];
        const float s = ((p0.x + p0.y) + (p0.z + p0.w)) + ((p1.x + p1.y) + (p1.z + p1.w)) + ((p2.x + p2.y) + (p2.z + p2.w)) + ((p3.x + p3.y) + (p3.z + p3.w));
        rbuf[tid] = rsqrtf(s * (1.f / DM) + EPS); }
    const f32x4 gv0 = *(const f32x4*)(a.in[I_SGUNG] + g * 256 + wv * 32 + 8 * fq), gv1 = *(const f32x4*)(a.in[I_SGUNG] + g * 256 + wv * 32 + 8 * fq + 4);
    float biasv[8];
#pragma unroll
    for (int tb = 0; tb < 8; ++tb) biasv[tb] = a.in[I_SGUB][g * 128 + tb * 16 + fr];
    __syncthreads();
#pragma unroll
    for (int i = 0; i < 8; ++i) { const int idx = tid + i * 512, s = idx >> 5, ch = idx & 31; const float r = rbuf[s];
        u32x4 v; v.x = pk2(bflo(tv[i].x) * r, bfhi(tv[i].x) * r); v.y = pk2(bflo(tv[i].y) * r, bfhi(tv[i].y) * r); v.z = pk2(bflo(tv[i].z) * r, bfhi(tv[i].z) * r); v.w = pk2(bflo(tv[i].w) * r, bfhi(tv[i].w) * r);
        *(LAS u32x4*)(Vb + s * RS + ch * 16) = v;
        const u32x4 q = tu[i];
        *(LAS u32x4*)(UZb + s * RS + ch * 16) = q; }
    __syncthreads();
    const int q = fr >> 2, p = fr & 3;
    bf16x8 Vf[4][2];
#pragma unroll
    for (int ks = 0; ks < 4; ++ks)
#pragma unroll
        for (int nn = 0; nn < 2; ++nn) { const LAS unsigned char* a0 = Vb + (32 * ks + 8 * fq + q) * RS + (wv * 32 + 8 * p + 4 * nn) * 2; Vf[ks][nn] = tr_read2(a0, a0 + 4 * RS); }
#pragma unroll
    for (int tb = 0; tb < 8; ++tb) {
        f32x4 acc0 = (f32x4){0.f, 0.f, 0.f, 0.f}, acc1 = acc0;
        const int t = tb * 16 + fr;
#pragma unroll
        for (int ks = 0; ks < 4; ++ks) if (ks <= (tb >> 1)) {
            const bf16x8 A = *(const bf16x8*)(SW + (size_t)(g * 128 + t) * 128 + ks * 32 + fq * 8);
            acc0 = __builtin_amdgcn_mfma_f32_16x16x32_bf16(Vf[ks][0], A, acc0, 0, 0, 0); acc1 = __builtin_amdgcn_mfma_f32_16x16x32_bf16(Vf[ks][1], A, acc1, 0, 0, 0);
        }
        const size_t m = (size_t)(m0 + t); const float bias = biasv[tb];
        { const int cl = wv * 32 + 8 * fq; const u32x4 uz = *(const LAS u32x4*)(UZb + t * RS + cl * 2);
          u32x4 o; o.x = pk2((acc0[0] * gv0.x + bias) * bflo(uz.x), (acc0[1] * gv0.y + bias) * bfhi(uz.x)); o.y = pk2((acc0[2] * gv0.z + bias) * bflo(uz.y), (acc0[3] * gv0.w + bias) * bfhi(uz.y));
          o.z = pk2((acc1[0] * gv1.x + bias) * bflo(uz.z), (acc1[1] * gv1.y + bias) * bfhi(uz.z)); o.w = pk2((acc1[2] * gv1.z + bias) * bflo(uz.w), (acc1[3] * gv1.w + bias) * bfhi(uz.w));
          __builtin_nontemporal_store(o, (u32x4*)(BR1 + m * DM + g * 256 + cl)); }
    }
    __syncthreads();
}
__device__ __forceinline__ void attn_part(const KArgs& a, LAS unsigned char* lds, int rt, int g) {
    int tid_ = threadIdx.x; asm volatile("" : "+v"(tid_));
    const int tid = tid_, lane = tid & 63, wv = tid >> 6, fr = lane & 15, fq = lane >> 4;
    const int m0 = rt * 128, b = rt >> 4;
    const bf16* Q = (const bf16*)(a.ws + WS_PROJ) + (size_t)5 * MP * DM; const bf16* AZ = Q + (size_t)MP * DM;
    const bf16* KB = (const bf16*)(a.ws + WS_KB); const bf16* VB = (const bf16*)(a.ws + WS_VB); bf16* BR2 = (bf16*)(a.ws + WS_BR) + (size_t)2 * MP * DM;
    LAS unsigned char* Kb = lds;
    const size_t m = (size_t)(m0 + wv * 16 + fr);
    bf16x8 Qf[8];
    {
        u32x4 tk[16];
#pragma unroll
        for (int i = 0; i < 16; ++i) { const int idx = tid + i * 512, key = idx >> 5, ch = idx & 31; tk[i] = *(const u32x4*)(KB + (size_t)(b * 256 + key) * DM + g * 256 + ch * 8); }
#pragma unroll
        for (int ks = 0; ks < 8; ++ks) Qf[ks] = __builtin_nontemporal_load((const bf16x8*)(Q + m * DM + g * 256 + ks * 32 + fq * 8));
#pragma unroll
        for (int i = 0; i < 16; ++i) { const int idx = tid + i * 512, key = idx >> 5, ch = idx & 31; *(LAS u32x4*)(Kb + key * RS + ch * 16) = tk[i]; }
    }
    __syncthreads();
    u32x4 tvv[16];
#pragma unroll
    for (int i = 0; i < 16; ++i) { const int idx = tid + i * 512, key = idx >> 5, ch = idx & 31; tvv[i] = *(const u32x4*)(VB + (size_t)(b * 256 + key) * DM + g * 256 + ch * 8); }
    f32x4 sacc[16];
#pragma unroll
    for (int kb = 0; kb < 16; ++kb) { sacc[kb] = (f32x4){0.f, 0.f, 0.f, 0.f};
#pragma unroll
        for (int ks = 0; ks < 8; ++ks) { const bf16x8 Kf = *(const LAS bf16x8*)(Kb + (kb * 16 + fr) * RS + (ks * 32 + fq * 8) * 2);
            sacc[kb] = __builtin_amdgcn_mfma_f32_16x16x32_bf16(Kf, Qf[ks], sacc[kb], 0, 0, 0); }
        if (kb & 1) __builtin_amdgcn_sched_barrier(0); }
    float mx = -3.0e38f;
#pragma unroll
    for (int kb = 0; kb < 16; ++kb) mx = fmaxf(mx, fmaxf(fmaxf(sacc[kb][0], sacc[kb][1]), fmaxf(sacc[kb][2], sacc[kb][3])));
    mx = fmaxf(mx, __shfl_xor(mx, 16)); mx = fmaxf(mx, __shfl_xor(mx, 32));
    float sum = 0.f;
#pragma unroll
    for (int kb = 0; kb < 16; ++kb)
#pragma unroll
        for (int j = 0; j < 4; ++j) { const float pj = __expf((sacc[kb][j] - mx) * 0.0625f); sacc[kb][j] = pj; sum += pj; }
    sum += __shfl_xor(sum, 16); sum += __shfl_xor(sum, 32);
    const float isum = 1.f / sum;
    bf16x8 Pf[8];
#pragma unroll
    for (int k2 = 0; k2 < 8; ++k2) { u32x4 w; w.x = pk2(sacc[2 * k2][0], sacc[2 * k2][1]); w.y = pk2(sacc[2 * k2][2], sacc[2 * k2][3]);
        w.z = pk2(sacc[2 * k2 + 1][0], sacc[2 * k2 + 1][1]); w.w = pk2(sacc[2 * k2 + 1][2], sacc[2 * k2 + 1][3]); Pf[k2] = __builtin_bit_cast(bf16x8, w); }
    __syncthreads();
#pragma unroll
    for (int i = 0; i < 16; ++i) { const int idx = tid + i * 512, key = idx >> 5, ch = idx & 31; *(LAS u32x4*)(Kb + key * RSV + ch * 16) = tvv[i]; }
    u32x4 zf[8];
#pragma unroll
    for (int d2 = 0; d2 < 8; ++d2) zf[d2] = __builtin_nontemporal_load((const u32x4*)(AZ + m * DM + g * 256 + d2 * 32 + 8 * fq));
    __syncthreads();
    const int q = fr >> 2, p = fr & 3;
#pragma unroll
    for (int d2 = 0; d2 < 8; ++d2) {
        f32x4 o0 = (f32x4){0.f, 0.f, 0.f, 0.f}, o1 = o0;
#pragma unroll
        for (int k2 = 0; k2 < 8; ++k2) { const LAS unsigned char* a0 = Kb + (32 * k2 + 4 * fq + q) * RSV + (d2 * 32 + 8 * p) * 2;
            const bf16x8 Vf0 = tr_read2(a0, a0 + 16 * RSV), Vf1 = tr_read2(a0 + 8, a0 + 8 + 16 * RSV);
            o0 = __builtin_amdgcn_mfma_f32_16x16x32_bf16(Vf0, Pf[k2], o0, 0, 0, 0); o1 = __builtin_amdgcn_mfma_f32_16x16x32_bf16(Vf1, Pf[k2], o1, 0, 0, 0); }
        const int c = g * 256 + d2 * 32 + 8 * fq; const u32x4 z = zf[d2];
        u32x4 w; w.x = pk2(o0[0] * isum * bflo(z.x), o0[1] * isum * bfhi(z.x)); w.y = pk2(o0[2] * isum * bflo(z.y), o0[3] * isum * bfhi(z.y));
        w.z = pk2(o1[0] * isum * bflo(z.z), o1[1] * isum * bfhi(z.z)); w.w = pk2(o1[2] * isum * bflo(z.w), o1[3] * isum * bfhi(z.w));
        __builtin_nontemporal_store(w, (u32x4*)(BR2 + m * DM + c));
        __builtin_amdgcn_sched_barrier(0);
    }
    __syncthreads();
}
__device__ __forceinline__ void sgu_sample(const KArgs& a, int g, int rb) {
    int tid_ = threadIdx.x; asm volatile("" : "+v"(tid_));
    const int tid = tid_;
    const bf16* U = (const bf16*)(a.ws + WS_PROJ) + (size_t)2 * MP * DM; const bf16* V = U + (size_t)MP * DM;
    const float* VSS = (const float*)(a.ws + WS_VSS); bf16* BR1 = (bf16*)(a.ws + WS_BR) + (size_t)MP * DM;
    const float w00 = a.in[I_SGUW][(size_t)g * 128 * 128], b0 = a.in[I_SGUB][g * 128];
    for (int idx = tid; idx < 16 * 64; idx += 512) {
        const int i = rb * 16 + (idx >> 6), c = g * 256 + (idx & 63) * 4; const size_t m = (size_t)(MPR + i);
        const float s = wave_sum((idx & 63) < 16 ? VSS[m * 16 + (idx & 63)] : 0.f);
        const float rs = rsqrtf(s * (1.f / DM) + EPS);
        const f32x4 gv = *(const f32x4*)(a.in[I_SGUNG] + c);
        const u32x2 v4 = *(const u32x2*)(V + m * DM + c), u4 = *(const u32x2*)(U + m * DM + c);
        f32x4 vn; vn.x = bflo(v4.x) * rs * gv.x; vn.y = bfhi(v4.x) * rs * gv.y; vn.z = bflo(v4.y) * rs * gv.z; vn.w = bfhi(v4.y) * rs * gv.w;
        *(f32x4*)(a.out + O_SV + (size_t)i * DM + c) = vn;
        u32x2 o; o.x = pk2(bflo(u4.x) * (w00 * vn.x + b0), bfhi(u4.x) * (w00 * vn.y + b0));
        o.y = pk2(bflo(u4.y) * (w00 * vn.z + b0), bfhi(u4.y) * (w00 * vn.w + b0));
        *(u32x2*)(BR1 + m * DM + c) = o;
    }
}
__device__ __forceinline__ void attn_sample(const KArgs& a, LAS unsigned char* lds, int i, int h) {
    int tid_ = threadIdx.x; asm volatile("" : "+v"(tid_));
    const int tid = tid_, lane = tid & 63, wv = tid >> 6;
    const bf16* Q = (const bf16*)(a.ws + WS_PROJ) + (size_t)5 * MP * DM; const bf16* AZ = Q + (size_t)MP * DM; bf16* BR2 = (bf16*)(a.ws + WS_BR) + (size_t)2 * MP * DM;
    const size_t m = (size_t)(MPR + i);
    const float* Kc = a.in[I_CK] + ((size_t)i * NMEM * 4 + h) * 256 + lane * 4;
    const float* Vc = a.in[I_CV] + ((size_t)i * NMEM * 4 + h) * 256 + lane * 4;
    LAS float* sc = (LAS float*)lds; LAS float* part = (LAS float*)(lds + 1024);
    const u32x2 q2 = *(const u32x2*)(Q + m * DM + h * 256 + lane * 4);
    const f32x4 qv = (f32x4){bflo(q2.x), bfhi(q2.x), bflo(q2.y), bfhi(q2.y)};
    {
        f32x4 kv[32]; float pd[32];
#pragma unroll
        for (int j = 0; j < 32; ++j) kv[j] = __builtin_nontemporal_load((const f32x4*)(Kc + (size_t)(wv * 32 + j) * 1024));
#pragma unroll
        for (int j = 0; j < 32; ++j) pd[j] = (kv[j].x * qv.x + kv[j].y * qv.y) + (kv[j].z * qv.z + kv[j].w * qv.w);
#pragma unroll
        for (int j = 0; j < 32; ++j) { const float d = wave_sum(pd[j]); if (lane == 0) sc[wv * 32 + j] = d * 0.0625f; }
    }
    f32x4 vv[32];
#pragma unroll
    for (int j = 0; j < 32; ++j) vv[j] = __builtin_nontemporal_load((const f32x4*)(Vc + (size_t)(wv * 32 + j) * 1024));
    __syncthreads();
    const f32x4 s4 = *(const LAS f32x4*)(sc + lane * 4);
    const float mx = wave_max(fmaxf(fmaxf(s4.x, s4.y), fmaxf(s4.z, s4.w)));
    const float sum = wave_sum((__expf(s4.x - mx) + __expf(s4.y - mx)) + (__expf(s4.z - mx) + __expf(s4.w - mx)));
    f32x4 o = (f32x4){0.f, 0.f, 0.f, 0.f};
#pragma unroll
    for (int j = 0; j < 32; ++j) { const float pj = __expf(sc[wv * 32 + j] - mx); o += vv[j] * pj; }
    *(LAS f32x4*)(part + wv * 256 + lane * 4) = o;
    __syncthreads();
    if (tid < 256) { float t = 0.f;
#pragma unroll
        for (int w8 = 0; w8 < 8; ++w8) t += part[w8 * 256 + tid];
        const int c = h * 256 + tid; const unsigned short zb = AZ[m * DM + c]; const float z = __builtin_bit_cast(float, (unsigned)zb << 16);
        BR2[m * DM + c] = (bf16)f2bf(t / sum * z); }
    __syncthreads();
}
__device__ __forceinline__ void p2_mixers(const KArgs& a, LAS unsigned char* lds, int G) {
    constexpr int NU = 512 + 512 + 4 + 32;
    if (G == 256) {
        const int c = blockIdx.x;
        for (int k = 0; k < 4; ++k) { const int kk = (c & 1) ? (k ^ 2) : k;
            if (kk < 2) { const int u = c + kk * 256, rt = u >> 2, g = u & 3; pool_part(a, lds, rt, g); sgu_part(a, lds, rt, g); attn_part(a, lds, rt, g); }
            else { const int e = c + (kk - 2) * 256; attn_sample(a, lds, e >> 2, e & 3); } }
        if (c < 4) pool_part(a, lds, 128, c); else if (c >= 8 && c < 40) sgu_sample(a, (c - 8) >> 3, (c - 8) & 7);
        return;
    }
    for (int u = blockIdx.x; u < NU; u += G) {
        if (u < 512) { const int rt = u >> 2, g = u & 3; pool_part(a, lds, rt, g); sgu_part(a, lds, rt, g); attn_part(a, lds, rt, g); }
        else if (u < 1024) { const int e = u - 512; attn_sample(a, lds, e >> 2, e & 3); }
        else if (u < 1028) pool_part(a, lds, 128, u - 1024);
        else sgu_sample(a, (u - 1028) >> 3, (u - 1028) & 7);
    }
}
__device__ __forceinline__ void p5_norm(const KArgs& a, int G) {
    const int tid = threadIdx.x, lane = tid & 63, wave = tid >> 6;
    const int gw = blockIdx.x * 8 + wave, NGW = G * 8;
    const f32x4* gr = (const f32x4*)a.in[I_NORMF] + lane;
    for (int m = gw; m < MV; m += NGW) {
        f32x4* xr = (f32x4*)(a.out + (size_t)m * DM) + lane;
        f32x4 v[4]; float s = 0.f;
#pragma unroll
        for (int j = 0; j < 4; ++j) { v[j] = xr[64 * j]; s += (v[j].x * v[j].x + v[j].y * v[j].y) + (v[j].z * v[j].z + v[j].w * v[j].w); }
        const float rs = rsqrtf(wave_sum(s) * (1.f / DM) + EPS);
#pragma unroll
        for (int j = 0; j < 4; ++j) { const f32x4 g = gr[64 * j]; xr[64 * j] = (f32x4){v[j].x * rs * g.x, v[j].y * rs * g.y, v[j].z * rs * g.z, v[j].w * rs * g.w}; }
    }
}

__global__ void __launch_bounds__(512, 2) fwd_megakernel(KArgs a) {
    extern __shared__ __attribute__((aligned(16))) unsigned char lds_raw[];
    LAS unsigned char* lds = (LAS unsigned char*)lds_raw;
    cg::grid_group grid = cg::this_grid();
    const int G = gridDim.x;
    const int lo = a.ph_lo, hi = a.ph_hi;
    volatile LAS unsigned* bst = (volatile LAS unsigned*)(lds + LDS_BYTES - 64);
    if (threadIdx.x == 0) { bst[0] = 0u; bst[1] = 0u; }
    __syncthreads();
    const XcdBarrier bar = xcd_barrier_post((unsigned*)(a.ws + WS_CTL), bst);
#define IN(k) (lo <= (k) && (k) < hi)
#define SEAM(k) do { if (IN(k) && IN((k) + 1)) { if (a.cg_sync) grid.sync(); else xcd_barrier(bar); } } while (0)
    if (IN(0)) p0_prologue(a, lds, G);
    SEAM(0);
    if (IN(1)) {
        pg8::Gemm g{(const bf16*)(a.ws + WS_H), (const bf16*)(a.ws + WS_WIN), MP, INC, DM};
        P1Order S; S.init(G, (int)blockIdx.x);
        EpiProj E{(bf16*)(a.ws + WS_PROJ), (bf16*)(a.ws + WS_GATE), (float*)(a.ws + WS_VSS), (bf16*)(a.ws + WS_KB), (bf16*)(a.ws + WS_VB), a.out, (const float*)(a.ws + WS_HS), (bf16*)(a.ws + WS_DS)};
        pg8::gemm_phase<EpiProj, P1Order>(lds, g, S, E);
    }
    SEAM(1);
    if (IN(2)) p2_mixers(a, lds, G);
    SEAM(2);
    if (IN(3)) {
        pg8::Gemm g{(const bf16*)(a.ws + WS_BR), (const bf16*)(a.ws + WS_WD), MPR, 3 * DM, DM};
        P3Order S; S.init(G, (int)blockIdx.x);
        EpiGate E{(const bf16*)(a.ws + WS_GATE), (bf16*)(a.ws + WS_MG)};
        pg8::gemm_phase<EpiGate, P3Order>(lds, g, S, E);
        EpiS3 E3{(const bf16*)(a.ws + WS_GATE), (bf16*)(a.ws + WS_GYS)};
        skinny_gemm(lds, (const bf16*)(a.ws + WS_BR) + (size_t)MPR * DM, DM, (size_t)MP * DM, 64, 1, 0, (const bf16*)(a.ws + WS_WD), DM, DM, 192, (int)blockIdx.x, G, E3);
    }
    SEAM(3);
    if (IN(4)) {
        pg8::Gemm g{(const bf16*)(a.ws + WS_MG), (const bf16*)(a.ws + WS_WO3), MPR, DM, DM};
        pg8::StaticOrder S; S.init(MPR, DM, G, (int)blockIdx.x);
        unsigned* ctl = (unsigned*)(a.ws + WS_CTL);
        EpiOutNorm E{a.in[I_XP], a.in[I_NORMF], a.out, (float*)(a.ws + WS_VSS), ctl + CW_PANEL};
        pg8::gemm_phase<EpiOutNorm, pg8::StaticOrder>(lds, g, S, E);
        sample_out_split(a, lds, (int)blockIdx.x);
    }
#undef IN
#undef SEAM
}

extern "C" void kernel_launch(void* const* d_in, const int* in_sizes, int n_in, void* d_out, int out_size, void* d_ws, size_t ws_size, hipStream_t stream) {
    static int grid = 0;
    if (grid == 0) {
        if (n_in != 18 || (size_t)out_size != O_END || ws_size < WS_END) { fprintf(stderr, "kernel_launch: unexpected shapes (n_in %d out %d ws %zu, need %zu)\n", n_in, out_size, ws_size, (size_t)WS_END); grid = -1; return; }
        int dev = 0, cus = 0, per_cu = 0;
        hipGetDevice(&dev); hipDeviceGetAttribute(&cus, hipDeviceAttributeMultiprocessorCount, dev);
        if (hipFuncSetAttribute((const void*)fwd_megakernel, hipFuncAttributeMaxDynamicSharedMemorySize, LDS_BYTES) != hipSuccess) { fprintf(stderr, "kernel_launch: hipFuncSetAttribute failed\n"); grid = -1; return; }
        if (hipOccupancyMaxActiveBlocksPerMultiprocessor(&per_cu, (const void*)fwd_megakernel, 512, LDS_BYTES) != hipSuccess || per_cu < 1) { fprintf(stderr, "kernel_launch: occupancy query failed (%d)\n", per_cu); grid = -1; return; }
        if (cus != 256) { fprintf(stderr, "kernel_launch: built for a 256-CU device (one 256x256 tile per workgroup in the last two phases), got %d\n", cus); grid = -1; return; }
        grid = cus;
    }
    if (grid < 0) return;
    if (hipMemsetAsync((char*)d_ws + WS_CTL, 0, CTL_BYTES, stream) != hipSuccess) { fprintf(stderr, "kernel_launch: memset failed\n"); return; }
    KArgs a{};
    for (int i = 0; i < 18; ++i) a.in[i] = (const float*)d_in[i];
    a.out = (float*)d_out; a.ws = (unsigned char*)d_ws; a.ph_lo = 0; a.ph_hi = 5;
    void* args[] = {&a};
    hipError_t e = hipLaunchCooperativeKernel((const void*)fwd_megakernel, dim3(grid), dim3(512), args, LDS_BYTES, stream);
    if (e != hipSuccess) fprintf(stderr, "cooperative launch failed: %s (grid %d)\n", hipGetErrorString(e), grid);
}
```

```cpp
#include <hip/hip_runtime.h>
#include <hip/hip_cooperative_groups.h>
#include <cstdio>
#include <cstdint>
namespace cg = cooperative_groups;

#define LAS __attribute__((address_space(3)))
typedef unsigned short bf16;
typedef short bf16x8 __attribute__((ext_vector_type(8)));
typedef short s16x4 __attribute__((ext_vector_type(4)));
typedef float f32x4 __attribute__((ext_vector_type(4)));
typedef unsigned u32x4 __attribute__((ext_vector_type(4)));
typedef unsigned u32x2 __attribute__((ext_vector_type(2)));

constexpr int DM = 1024, NBATCH = 8, SEQ = 2048, NS = 128, NMEM = 256;
constexpr int MPR = NBATCH * SEQ;
constexpr int MV = MPR + NS;
constexpr int MP = MPR + 256;
constexpr int NPAN = MP / 256;
constexpr int INC = 10240;
constexpr float EPS = 1e-6f;
constexpr size_t O_YP = 0, O_YS = O_YP + (size_t)MPR * DM, O_POOLP = O_YS + (size_t)NS * DM, O_POOLS = O_POOLP + (size_t)NBATCH * 15 * DM,
                 O_MK = O_POOLS + (size_t)NS * 15 * DM, O_MV = O_MK + (size_t)NBATCH * NMEM * DM, O_SV = O_MV + (size_t)NBATCH * NMEM * DM, O_END = O_SV + (size_t)NS * DM;
constexpr size_t ROWB = (size_t)MP * DM * 2;
constexpr size_t WS_CTL = 0, CTL_BYTES = 40960;
constexpr size_t WS_VSS2 = CTL_BYTES;
constexpr size_t WS_DS = WS_VSS2 + 32768;
constexpr size_t WS_HS = WS_DS + 262144;
constexpr size_t WS_H = WS_HS + 524288;
constexpr size_t WS_WIN = WS_H + (size_t)(MP + 2048) * DM * 2;
constexpr size_t WS_WD = WS_WIN + (size_t)(INC + 2048) * DM * 2;
constexpr size_t WS_WO3 = WS_WD + (size_t)3 * DM * DM * 2;
constexpr size_t WS_PW = WS_WO3 + (size_t)3 * DM * DM * 2;
constexpr size_t WS_SW = WS_PW + (size_t)4 * 256 * 256 * 2;
constexpr size_t WS_VSS = WS_SW + (size_t)4 * 128 * 128 * 2;
constexpr size_t WS_KB = WS_VSS + (size_t)MP * 16 * 4;
constexpr size_t WS_VB = WS_KB + (size_t)2048 * DM * 2;
constexpr size_t WS_PROJ = WS_VB + (size_t)2048 * DM * 2;
constexpr size_t WS_GATE = WS_PROJ + 7 * ROWB;
constexpr size_t WS_BR = WS_GATE + 3 * ROWB;
constexpr size_t WS_MG = WS_PROJ;
constexpr size_t WS_GYS = WS_H;
constexpr size_t WS_END = WS_BR + 3 * ROWB;
constexpr int LDS_BYTES = 147456;
constexpr int CW_PANEL = 4096, CW_SAMPLE = 4096 + 64 * 64;

__device__ __forceinline__ unsigned f2bf(float f) { unsigned u = __builtin_bit_cast(unsigned, f); return (u + 0x7fffu + ((u >> 16) & 1u)) >> 16; }
__device__ __forceinline__ unsigned pk2(float lo, float hi) { unsigned r; asm volatile("v_cvt_pk_bf16_f32 %0, %1, %2" : "=v"(r) : "v"(lo), "v"(hi)); return r; }
__device__ __forceinline__ float bflo(unsigned w) { return __builtin_bit_cast(float, w << 16); }
__device__ __forceinline__ float bfhi(unsigned w) { return __builtin_bit_cast(float, w & 0xffff0000u); }
__device__ __forceinline__ float silu_f(float x) { return x * __builtin_amdgcn_rcpf(1.f + __expf(-x)); }
__device__ __forceinline__ float sigm_f(float x) { return __builtin_amdgcn_rcpf(1.f + __expf(-x)); }
__device__ __forceinline__ float wave_sum(float v) {
#pragma unroll
    for (int o = 1; o < 64; o <<= 1) v += __shfl_xor(v, o);
    return v;
}
__device__ __forceinline__ float wave_max(float v) {
#pragma unroll
    for (int o = 1; o < 64; o <<= 1) v = fmaxf(v, __shfl_xor(v, o));
    return v;
}
__device__ __forceinline__ bf16x8 tr_read2(const LAS unsigned char* a0, const LAS unsigned char* a1) {
    const s16x4 lo = __builtin_amdgcn_ds_read_tr16_b64_v4i16((LAS s16x4*)a0);
    const s16x4 hi = __builtin_amdgcn_ds_read_tr16_b64_v4i16((LAS s16x4*)a1);
    return (bf16x8){lo[0], lo[1], lo[2], lo[3], hi[0], hi[1], hi[2], hi[3]};
}

#define XB_TMO      128
#define XB_XCNT(j)  (256  + 64 * (j))
#define XB_XSUB(j)  (1280 + 64 * (j))
#define XB_XGEN(j)  (2304 + 64 * (j))
#define XB_TOP      3328
#define XB_TOPGEN   3392
#define XCD_BAR_WORDS 3456
#define XB_SPIN_CAP (1u << 18)

__device__ __forceinline__ unsigned xb_ld(unsigned* p)              { return __hip_atomic_load(p, __ATOMIC_RELAXED, __HIP_MEMORY_SCOPE_AGENT); }
__device__ __forceinline__ unsigned xb_add(unsigned* p, unsigned v) { return __hip_atomic_fetch_add(p, v, __ATOMIC_RELAXED, __HIP_MEMORY_SCOPE_AGENT); }
__device__ __forceinline__ unsigned xb_xcc_id() { return (unsigned)__builtin_amdgcn_s_getreg((3 << 11) | 20) & 0xFu; }
#define XB_SPIN(cond, bar) do { unsigned _sp = 0; while (cond) { __builtin_amdgcn_s_sleep(1); \
    if ((++_sp & 255u) == 0u) { if (xb_ld(&(bar)[XB_TMO])) break; if (_sp > XB_SPIN_CAP) { atomicAdd(&(bar)[XB_TMO], 1u); break; } } } } while (0)

struct XcdBarrier {
    unsigned* bar; unsigned x;
    volatile LAS unsigned* st;
};

__device__ __forceinline__ XcdBarrier xcd_barrier_post(unsigned* bar, volatile LAS unsigned* st) {
    XcdBarrier b; b.bar = bar; b.x = xb_xcc_id(); b.st = st;
    if (threadIdx.x == 0) (void)xb_add(&bar[XB_XCNT(b.x)], 1u);
    return b;
}
__device__ __forceinline__ void xcd_barrier_complete(unsigned* bar, unsigned x, unsigned& nloc, unsigned& nx) {
    const unsigned G = gridDim.x;
    unsigned sum, cnt, mine, sp = 0u;
    for (;;) {
        sum = 0u; cnt = 0u; mine = 0u;
#pragma unroll
        for (unsigned j = 0; j < 16; ++j) { const unsigned c = xb_ld(&bar[XB_XCNT(j)]); sum += c; cnt += (c > 0u) ? 1u : 0u; mine = (j == x) ? c : mine; }
        if (sum == G) break;
        __builtin_amdgcn_s_sleep(1);
        if ((++sp & 255u) == 0u) { if (xb_ld(&bar[XB_TMO])) break; if (sp > XB_SPIN_CAP) { atomicAdd(&bar[XB_TMO], 1u); break; } }
    }
    nloc = mine > 0u ? mine : 1u; nx = cnt > 0u ? cnt : 1u;
}

__device__ __forceinline__ void xcd_barrier(const XcdBarrier& b) {
    asm volatile("s_waitcnt vmcnt(0)" ::: "memory");
    __syncthreads();
    if (threadIdx.x == 0) {
        unsigned* bar = b.bar;
        __builtin_amdgcn_s_waitcnt(0);
        unsigned nloc = b.st[0], nx = b.st[1];
        if (nloc == 0u) { xcd_barrier_complete(bar, b.x, nloc, nx); b.st[0] = nloc; b.st[1] = nx; }
        const unsigned old = xb_add(&bar[XB_XSUB(b.x)], 1u);
        const unsigned gen = old / nloc;
        if (old + 1u == (gen + 1u) * nloc) {
            __builtin_amdgcn_fence(__ATOMIC_RELEASE, "agent");
            asm volatile("s_waitcnt vmcnt(0)" ::: "memory");
            const unsigned og = xb_add(&bar[XB_TOP], 1u);
            const unsigned tg = og / nx;
            if (og + 1u == (tg + 1u) * nx) xb_add(&bar[XB_TOPGEN], 1u);
            else XB_SPIN(xb_ld(&bar[XB_TOPGEN]) == tg, bar);
            __builtin_amdgcn_fence(__ATOMIC_ACQUIRE, "agent");
            xb_add(&bar[XB_XGEN(b.x)], 1u);
            asm volatile("s_waitcnt vmcnt(0)" ::: "memory");
        } else {
            XB_SPIN(xb_ld(&bar[XB_XGEN(b.x)]) == gen, bar);
            __builtin_amdgcn_fence(__ATOMIC_ACQUIRE, "agent");
            asm volatile("s_waitcnt vmcnt(0)" ::: "memory");
        }
    }
    __syncthreads();
}

namespace pg8 {
#define PG8_LAS __attribute__((address_space(3)))
typedef unsigned short bf16_t;
constexpr int BM = 256, BK = 64, HALF = 128, HTB = HALF * BK * 2, STAGE_BYTES = 8 * HTB, NXCD = 8, WGM = 8;
__host__ __device__ __forceinline__ int lds_byte(int r, int c) { const int st = (r >> 4) * 2 + (c >> 5), rr = r & 15, cc = c & 31, ob = rr * 64 + cc * 2; return st * 1024 + (ob ^ (((ob >> 9) & 1) << 5)); }
__host__ __device__ __forceinline__ void stage_rc(int b, int& R, int& C) { const int st = b / 1024, sb = b % 1024, swz = sb ^ (((sb >> 9) & 1) << 5); R = (st >> 1) * 16 + swz / 64; C = (st & 1) * 32 + (swz % 64) / 2; }
__host__ __device__ __forceinline__ int perm32(int rho) { const int n = rho >> 4, i = rho & 15; return 8 * (i >> 2) + 4 * n + (i & 3); }
struct Unit { int pm, pn; int brow, fz; };
struct Gemm { const bf16_t* A; const bf16_t* Bt; int M, N, K; };
struct StaticOrder {
    int nM, nN, nwg, G, c;
    __host__ __device__ void init(int M, int N, int G_, int c_) { nM = M / BM; nN = N / BM; nwg = nM * nN; G = G_; c = c_; }
    __host__ __device__ bool next(int i, Unit& u) const {
        const long L = (long)i * G + c; if (L >= nwg) return false;
        int wgid = (int)L; { const int q = nwg / NXCD, r = nwg % NXCD, xcd = wgid % NXCD, off = wgid / NXCD; wgid = (xcd < r ? xcd * (q + 1) : r * (q + 1) + (xcd - r) * q) + off; }
        const int nig = WGM * nN, gid = wgid / nig, fm = gid * WGM, gsz = (nM - fm) < WGM ? (nM - fm) : WGM;
        u.pm = fm + ((wgid % nig) % gsz); u.pn = (wgid % nig) / gsz; u.brow = u.pn * BM; u.fz = 0; return true;
    }
    __device__ __forceinline__ void a_ready(const Unit&) const {}
    __device__ __forceinline__ void done(const Unit&) const {}
};

template <class Epi, class Sched>
__device__ __forceinline__ void gemm_phase(PG8_LAS unsigned char* lds, const Gemm g, const Sched& S, const Epi& E) {
    constexpr bool ALIGN_EPI = !Epi::AFTER_DRAIN;
    const int tid = threadIdx.x, wid = __builtin_amdgcn_readfirstlane(tid >> 6), lane = tid & 63, wr = wid >> 2, wc = wid & 3, fr = lane & 15, fq = lane >> 4;
    const int K = g.K, nt = K / BK;
    unsigned voffA[2], voffB[2], voffBf[2];
#pragma unroll
    for (int i = 0; i < 2; ++i) { int R, C; stage_rc(tid * 16 + i * 8192, R, C); const int Rb = Epi::PERM ? ((R >> 5) * 64 + perm32(R & 31)) : R;
        voffA[i] = (unsigned)(R * K + C) * 2u; voffB[i] = (unsigned)(Rb * K + C) * 2u; voffBf[i] = (unsigned)((Rb - (R >> 5) * 32) * K + C) * 2u; }
    const size_t kstep = (size_t)(BK * 2);
    const size_t hstep = (size_t)HALF * K * 2;
    const size_t hstepB = Epi::PERM ? (size_t)32 * K * 2 : hstep;
    const size_t tstep = 2 * hstep;
    const unsigned ldsw = (unsigned)wid * 1024u;
    const int aoff = lds_byte(wr * 64 + fr, fq * 8), boff = lds_byte(wc * 32 + fr, fq * 8);
#define PG8_SA(b, h) (((b) * 2 + (h)) * HTB)
#define PG8_SB(b, h) ((4 + (b) * 2 + (h)) * HTB)
#define PG8_STAGE(bufoff, gbase, voff) do { _Pragma("unroll") for (int _i = 0; _i < 2; ++_i) \
        __builtin_amdgcn_global_load_lds((const unsigned*)((const char*)(gbase) + (voff)[_i]), (PG8_LAS unsigned*)(lds + (bufoff) + ldsw + _i * 8192), 16, 0, 0); } while (0)
#define PG8_LDA(dst, b, h) do { _Pragma("unroll") for (int m = 0; m < 4; ++m) _Pragma("unroll") for (int k = 0; k < 2; ++k) dst[m][k] = *(const PG8_LAS bf16x8*)(lds + PG8_SA(b, h) + aoff + m * 2048 + k * 1024); } while (0)
#define PG8_LDB(dst, b, h) do { _Pragma("unroll") for (int n = 0; n < 2; ++n) _Pragma("unroll") for (int k = 0; k < 2; ++k) dst[n][k] = *(const PG8_LAS bf16x8*)(lds + PG8_SB(b, h) + boff + n * 2048 + k * 1024); } while (0)
#define PG8_MMA(ai, bj, At, Bt) do { __builtin_amdgcn_s_setprio(1); _Pragma("unroll") for (int m = 0; m < 4; ++m) _Pragma("unroll") for (int n = 0; n < 2; ++n) _Pragma("unroll") for (int k = 0; k < 2; ++k) \
        acc[ai][bj][m][n] = __builtin_amdgcn_mfma_f32_16x16x32_bf16(Bt[n][k], At[m][k], acc[ai][bj][m][n], 0, 0, 0); __builtin_amdgcn_s_setprio(0); } while (0)
#define PG8_WAIT_V(n) asm volatile("s_waitcnt vmcnt(" #n ")" ::: "memory")
#define PG8_WAIT_L(n) asm volatile("s_waitcnt lgkmcnt(" #n ")" ::: "memory")
#define PG8_BAR __builtin_amdgcn_s_barrier()
#define PG8_SCHED __builtin_amdgcn_sched_barrier(0)
    Unit cur, nxt; int ui = 0;
    if (!S.next(0, cur)) return;
    f32x4 acc[2][2][4][2];
#pragma unroll
    for (int a = 0; a < 2; ++a)
#pragma unroll
        for (int b = 0; b < 2; ++b)
#pragma unroll
            for (int m = 0; m < 4; ++m)
#pragma unroll
                for (int n = 0; n < 2; ++n) acc[a][b][m][n] = (f32x4){0.f, 0.f, 0.f, 0.f};
    bf16x8 At[4][2], B0[2][2], B1[2][2];
    const size_t rowB = (size_t)K * 2, hstepBf = (size_t)2048 * K * 2;
    const char* cA = (const char*)g.A + (size_t)cur.pm * tstep; const char* cB = (const char*)g.Bt + (size_t)cur.brow * rowB;
    S.a_ready(cur);
    { unsigned vB[2] = {cur.fz ? voffBf[0] : voffB[0], cur.fz ? voffBf[1] : voffB[1]}; const size_t hB = cur.fz ? hstepBf : hstepB;
    PG8_STAGE(PG8_SB(0, 0), cB, vB); PG8_STAGE(PG8_SB(0, 1), cB + hB, vB); PG8_STAGE(PG8_SA(0, 0), cA, voffA); PG8_STAGE(PG8_SA(0, 1), cA + hstep, voffA);
    if (wr == 1) PG8_BAR;
    PG8_WAIT_V(2); PG8_BAR;
    PG8_STAGE(PG8_SB(1, 0), cB + kstep, vB); PG8_STAGE(PG8_SA(1, 0), cA + kstep, voffA); PG8_STAGE(PG8_SB(1, 1), cB + hB + kstep, vB);
    PG8_WAIT_V(6); PG8_BAR; }
    for (;;) {
        const bool has_next = S.next(ui + 1, nxt);
        const char* nA = has_next ? (const char*)g.A + (size_t)nxt.pm * tstep : cA; const char* nB = has_next ? (const char*)g.Bt + (size_t)nxt.brow * rowB : cB;
        const int nfz = has_next ? nxt.fz : cur.fz;
        E.prefetch(cur, wid, lane, lds + STAGE_BYTES + wid * 1024);
        for (int t = 0; t < nt; t += 2) {
            const bool last = (t == nt - 2);
            const char* a1 = cA + (size_t)(t + 1) * kstep;
            const char* a2 = last ? nA : cA + (size_t)(t + 2) * kstep; const char* b2 = last ? nB : cB + (size_t)(t + 2) * kstep;
            const char* a3 = a2 + kstep; const char* b3 = b2 + kstep;
            const int fzt = last ? nfz : cur.fz; unsigned vB[2] = {fzt ? voffBf[0] : voffB[0], fzt ? voffBf[1] : voffB[1]}; const size_t hB = fzt ? hstepBf : hstepB;
            if (last && has_next) S.a_ready(nxt);
            PG8_LDB(B0, 0, 0); PG8_LDB(B1, 0, 1); PG8_SCHED; PG8_LDA(At, 0, 0); PG8_STAGE(PG8_SA(1, 1), a1 + hstep, voffA);
            PG8_WAIT_V(8); PG8_WAIT_L(0); PG8_BAR; PG8_MMA(0, 0, At, B0); PG8_MMA(0, 1, At, B1); PG8_BAR; PG8_SCHED;
            PG8_LDA(At, 0, 1); PG8_STAGE(PG8_SB(0, 0), b2, vB); PG8_STAGE(PG8_SB(0, 1), b2 + hB, vB); PG8_STAGE(PG8_SA(0, 0), a2, voffA);
            PG8_WAIT_V(8); PG8_WAIT_L(0); PG8_BAR; PG8_MMA(1, 0, At, B0); PG8_MMA(1, 1, At, B1); PG8_BAR; PG8_SCHED;
            PG8_LDB(B0, 1, 0); PG8_LDB(B1, 1, 1); PG8_SCHED; PG8_LDA(At, 1, 0); PG8_STAGE(PG8_SA(0, 1), a2 + hstep, voffA);
            PG8_WAIT_V(8); PG8_WAIT_L(0); PG8_BAR; PG8_MMA(0, 0, At, B0); PG8_MMA(0, 1, At, B1); PG8_BAR; PG8_SCHED;
            PG8_LDA(At, 1, 1); PG8_STAGE(PG8_SB(1, 0), b3, vB); PG8_STAGE(PG8_SB(1, 1), b3 + hB, vB); PG8_STAGE(PG8_SA(1, 0), a3, voffA);
            PG8_WAIT_V(8); PG8_WAIT_L(0); PG8_BAR; PG8_MMA(1, 0, At, B0); PG8_MMA(1, 1, At, B1); PG8_BAR; PG8_SCHED;
        }
        if constexpr (ALIGN_EPI) { if (wr == 0) PG8_BAR; }
        if constexpr (!Epi::AFTER_DRAIN) { E(acc, cur, wr, wc, fr, fq); S.done(cur); }
        if (!has_next) break;
#pragma unroll
        for (int a = 0; a < 2; ++a)
#pragma unroll
            for (int b = 0; b < 2; ++b)
#pragma unroll
                for (int m = 0; m < 4; ++m)
#pragma unroll
                    for (int n = 0; n < 2; ++n) acc[a][b][m][n] = (f32x4){0.f, 0.f, 0.f, 0.f};
        cur = nxt; cA = nA; cB = nB; ++ui;
        if constexpr (ALIGN_EPI) { if (wr == 1) PG8_BAR; }
    }
    PG8_WAIT_V(0);
    if constexpr (!ALIGN_EPI) { if (wr == 0) PG8_BAR; }
    PG8_BAR;
    if constexpr (Epi::AFTER_DRAIN) { E.fused(acc, cur, wr, wc, fr, fq); S.done(cur); }
#undef PG8_SA
#undef PG8_SB
#undef PG8_STAGE
#undef PG8_LDA
#undef PG8_LDB
#undef PG8_MMA
#undef PG8_WAIT_V
#undef PG8_WAIT_L
#undef PG8_BAR
#undef PG8_SCHED
}
}

struct KArgs {
    const float* in[18];
    float* out;
    unsigned char* ws;
    int ph_lo, ph_hi;
    int cg_sync, pad;
};
enum { I_XP = 0, I_XS, I_SPOOL, I_CK, I_CV, I_MEM, I_NORMG, I_WIN, I_POOLW, I_POOLSC, I_SGUNG, I_SGUW, I_SGUB, I_MEMNG, I_WKV, I_WDOWN, I_WOUT, I_NORMF };

struct P1Order {
    pg8::StaticOrder so; int G, c;
    __device__ void init(int G_, int c_) { so.init(MPR, INC, G_, c_); G = G_; c = c_; }
    __device__ bool next(int i, pg8::Unit& u) const {
        const long L = (long)i * G + c;
        if (L < so.nwg) so.next(i, u);
        else { const int e = (int)(L - so.nwg); if (e >= 104) return false;
            if (e < 64) { u.pm = NPAN + (e >> 3); u.pn = 40 + (e & 7); } else { u.pm = 64; u.pn = e - 64; } }
        u.brow = u.pn * 256; u.fz = 0;
        if (u.pn >= 8 && u.pn < 12) { u.brow = 2 * DM + 128 * (u.pn - 8); u.fz = 1; } else if (u.pn >= 16 && u.pn < 20) { u.brow = 2 * DM + 128 * (4 + u.pn - 16); u.fz = 1; }
        return true;
    }
    __device__ __forceinline__ void a_ready(const pg8::Unit&) const {}
    __device__ __forceinline__ void done(const pg8::Unit&) const {}
};
struct EpiProj {
    static constexpr bool PERM = true, AFTER_DRAIN = false;
    bf16* proj; bf16* gate; float* vss; bf16* kb; bf16* vb; float* out; const float* hs; bf16* dsr;
    __device__ __forceinline__ void prefetch(const pg8::Unit&, int, int, LAS unsigned char*) const {}
    __device__ __forceinline__ void operator()(const f32x4 (&acc)[2][2][4][2], const pg8::Unit& u, int wr, int wc, int fr, int fq) const {
        if (u.fz) {
            const int j = (u.pn < 12) ? u.pn - 8 : 4 + u.pn - 16; bf16* uz = proj + (size_t)2 * MP * DM;
            const int row0 = u.pm * 256 + wr * 64 + fr, c = 128 * j + wc * 32 + 8 * fq;
#pragma unroll
            for (int ai = 0; ai < 2; ++ai)
#pragma unroll
                for (int m = 0; m < 4; ++m) { const size_t r = (size_t)(row0 + ai * 128 + m * 16);
                    const f32x4 u0 = acc[ai][0][m][0], u1 = acc[ai][0][m][1], z0 = acc[ai][1][m][0], z1 = acc[ai][1][m][1];
                    u32x4 w; w.x = pk2(u0[0] * silu_f(z0[0]), u0[1] * silu_f(z0[1])); w.y = pk2(u0[2] * silu_f(z0[2]), u0[3] * silu_f(z0[3]));
                    w.z = pk2(u1[0] * silu_f(z1[0]), u1[1] * silu_f(z1[1])); w.w = pk2(u1[2] * silu_f(z1[2]), u1[3] * silu_f(z1[3]));
                    __builtin_nontemporal_store(w, (u32x4*)(uz + r * DM + c)); }
        } else if (u.pn < 40) {
            const int sec = u.pn >> 2;
            const int act = (sec == 1 || sec == 4 || sec == 6) ? 1 : (sec >= 7 ? 2 : 0);
            const int row0 = u.pm * 256 + wr * 64 + fr, cs0 = (u.pn & 3) * 256 + wc * 64 + 8 * fq;
            bf16* base; int ld;
            if (sec < 7) { base = proj + (size_t)sec * MP * DM; ld = DM; } else { base = gate + (sec - 7) * DM; ld = 3 * DM; }
            const bool poolrows = (sec == 0) && (((u.pm & 7) == 7) || u.pm == 64);
#pragma unroll
            for (int ai = 0; ai < 2; ++ai)
#pragma unroll
                for (int m = 0; m < 4; ++m) {
                    const int r = row0 + ai * 128 + m * 16; float ss = 0.f;
#pragma unroll
                    for (int bj = 0; bj < 2; ++bj) {
                        f32x4 v0 = acc[ai][bj][m][0], v1 = acc[ai][bj][m][1]; const int cs = cs0 + bj * 32;
                        if (sec == 3) ss += (v0[0] * v0[0] + v0[1] * v0[1]) + (v0[2] * v0[2] + v0[3] * v0[3]) + (v1[0] * v1[0] + v1[1] * v1[1]) + (v1[2] * v1[2] + v1[3] * v1[3]);
                        if (poolrows) {
                            float* dst = nullptr;
                            if (r < MPR) { const int t = r & (SEQ - 1); if (t >= SEQ - 15) dst = out + O_POOLP + ((size_t)(r >> 11) * 15 + (t - (SEQ - 15))) * DM + cs; }
                            else if (r < MV) { dst = out + O_POOLS + ((size_t)(r - MPR) * 15 + 14) * DM + cs;
                                const float* hp = hs + (size_t)(r - MPR) * DM + cs; const f32x4 h0 = *(const f32x4*)hp, h1 = *(const f32x4*)(hp + 4); const float inv = 1.f / (float)(2 << (cs >> 8));
                                u32x4 d; d.x = pk2((h0.x + v0[0]) * inv - v0[0], (h0.y + v0[1]) * inv - v0[1]); d.y = pk2((h0.z + v0[2]) * inv - v0[2], (h0.w + v0[3]) * inv - v0[3]);
                                d.z = pk2((h1.x + v1[0]) * inv - v1[0], (h1.y + v1[1]) * inv - v1[1]); d.w = pk2((h1.z + v1[2]) * inv - v1[2], (h1.w + v1[3]) * inv - v1[3]);
                                *(u32x4*)(dsr + (size_t)(r - MPR) * DM + cs) = d; }
                            if (dst) { *(f32x4*)dst = v0; *(f32x4*)(dst + 4) = v1; }
                        }
                        if (act == 1) {
#pragma unroll
                            for (int j = 0; j < 4; ++j) { v0[j] = silu_f(v0[j]); v1[j] = silu_f(v1[j]); } }
                        if (act == 2) {
#pragma unroll
                            for (int j = 0; j < 4; ++j) { v0[j] = sigm_f(v0[j]); v1[j] = sigm_f(v1[j]); } }
                        u32x4 w; w.x = pk2(v0[0], v0[1]); w.y = pk2(v0[2], v0[3]); w.z = pk2(v1[0], v1[1]); w.w = pk2(v1[2], v1[3]);
                        __builtin_nontemporal_store(w, (u32x4*)(base + (size_t)r * ld + cs));
                    }
                    if (sec == 3) { ss += __shfl_xor(ss, 16); ss += __shfl_xor(ss, 32); if (fq == 0) vss[(size_t)r * 16 + (u.pn & 3) * 4 + wc] = ss; }
                }
        } else {
            const int b = u.pm - NPAN, ct = (u.pn - 40) * 256;
            const bool isv = ct >= DM; const int cb = (isv ? ct - DM : ct) + wc * 64 + 8 * fq;
            float* of = out + (isv ? O_MV : O_MK); bf16* ob = isv ? vb : kb;
#pragma unroll
            for (int ai = 0; ai < 2; ++ai)
#pragma unroll
                for (int m = 0; m < 4; ++m) {
                    const size_t j = (size_t)b * 256 + ai * 128 + wr * 64 + m * 16 + fr;
#pragma unroll
                    for (int bj = 0; bj < 2; ++bj) {
                        const f32x4 v0 = acc[ai][bj][m][0], v1 = acc[ai][bj][m][1]; const int cs = cb + bj * 32;
                        __builtin_nontemporal_store(v0, (f32x4*)(of + j * DM + cs)); __builtin_nontemporal_store(v1, (f32x4*)(of + j * DM + cs + 4));
                        u32x4 w; w.x = pk2(v0[0], v0[1]); w.y = pk2(v0[2], v0[3]); w.z = pk2(v1[0], v1[1]); w.w = pk2(v1[2], v1[3]);
                        *(u32x4*)(ob + j * DM + cs) = w;
                    }
                }
        }
    }
};
struct P3Order {
    pg8::StaticOrder so;
    __device__ void init(int G_, int c_) { so.init(MPR, DM, G_, c_); }
    __device__ bool next(int i, pg8::Unit& u) const { const int rnd = i / 3, b = i - 3 * rnd; pg8::Unit t; if (!so.next(rnd, t)) return false; u.pm = b * NPAN + t.pm; u.pn = b * 4 + t.pn; u.brow = u.pn * 256; u.fz = 0; return true; }
    __device__ __forceinline__ void a_ready(const pg8::Unit&) const {}
    __device__ __forceinline__ void done(const pg8::Unit&) const {}
};
struct EpiGate {
    static constexpr bool PERM = true, AFTER_DRAIN = false;
    const bf16* gate; bf16* mg;
    __device__ __forceinline__ void prefetch(const pg8::Unit& u, int wid, int lane, LAS unsigned char* scr) const {
        const int b = u.pn >> 2, pm = u.pm - b * NPAN, t = wid * 64 + lane;
#pragma unroll
        for (int j = 0; j < 2; ++j) { const int li = t + 512 * j, row = li >> 2, seg = li & 3; const size_t r = (size_t)(pm * 256 + row);
            __builtin_amdgcn_global_load_lds((const unsigned*)(gate + r * (3 * DM) + b * DM + (u.pn & 3) * 256 + seg * 64), (LAS unsigned*)(scr + j * 256), 4, 0, 0); }
    }
    __device__ __forceinline__ void operator()(const f32x4 (&acc)[2][2][4][2], const pg8::Unit& u, int wr, int wc, int fr, int fq) const {
        const int b = u.pn >> 2, pm = u.pm - b * NPAN;
        const int row0 = pm * 256 + wr * 64 + fr, c0 = (u.pn & 3) * 256 + wc * 64 + 8 * fq;
#pragma unroll
        for (int ai = 0; ai < 2; ++ai) {
            u32x4 g8[4][2], p8[4][2];
#pragma unroll
            for (int m = 0; m < 4; ++m)
#pragma unroll
                for (int bj = 0; bj < 2; ++bj) { const size_t r = (size_t)(row0 + ai * 128 + m * 16); const int c = c0 + bj * 32;
                    g8[m][bj] = *(const u32x4*)(gate + r * (3 * DM) + b * DM + c);
                    p8[m][bj] = (u32x4){0u, 0u, 0u, 0u}; if (b > 0) p8[m][bj] = *(const u32x4*)(mg + r * DM + c); }
            asm volatile("" ::: "memory");
#pragma unroll
            for (int m = 0; m < 4; ++m)
#pragma unroll
                for (int bj = 0; bj < 2; ++bj) { const size_t r = (size_t)(row0 + ai * 128 + m * 16); const int c = c0 + bj * 32;
                    const f32x4 v0 = acc[ai][bj][m][0], v1 = acc[ai][bj][m][1]; const u32x4 gq = g8[m][bj], p = p8[m][bj];
                    const float o0 = v0[0] * bflo(gq.x) + bflo(p.x), o1 = v0[1] * bfhi(gq.x) + bfhi(p.x), o2 = v0[2] * bflo(gq.y) + bflo(p.y), o3 = v0[3] * bfhi(gq.y) + bfhi(p.y);
                    const float o4 = v1[0] * bflo(gq.z) + bflo(p.z), o5 = v1[1] * bfhi(gq.z) + bfhi(p.z), o6 = v1[2] * bflo(gq.w) + bflo(p.w), o7 = v1[3] * bfhi(gq.w) + bfhi(p.w);
                    u32x4 w; w.x = pk2(o0, o1); w.y = pk2(o2, o3); w.z = pk2(o4, o5); w.w = pk2(o6, o7);
                    if (b == 2) __builtin_nontemporal_store(w, (u32x4*)(mg + r * DM + c)); else *(u32x4*)(mg + r * DM + c) = w; }
        }
    }
};
__device__ __forceinline__ void st_agent(float* p, float v) { __hip_atomic_store((unsigned*)p, __builtin_bit_cast(unsigned, v), __ATOMIC_RELAXED, __HIP_MEMORY_SCOPE_AGENT); }
__device__ __forceinline__ float ld_agent(const float* p) { return __builtin_bit_cast(float, __hip_atomic_load((unsigned*)p, __ATOMIC_RELAXED, __HIP_MEMORY_SCOPE_AGENT)); }
__device__ __forceinline__ void wait_count(unsigned* w, unsigned want) {
    unsigned sp = 0;
    while ((unsigned)__builtin_amdgcn_readfirstlane(__hip_atomic_load(w, __ATOMIC_RELAXED, __HIP_MEMORY_SCOPE_AGENT)) < want) { __builtin_amdgcn_s_sleep(2); if (++sp > (1u << 22)) break; }
    __builtin_amdgcn_fence(__ATOMIC_ACQUIRE, "agent");
    asm volatile("s_waitcnt vmcnt(0)" ::: "memory");
}
struct EpiOutNorm {
    static constexpr bool PERM = false, AFTER_DRAIN = true;
    const float* xp; const float* gf; float* out; float* slots; unsigned* cnt;
    __device__ __forceinline__ void prefetch(const pg8::Unit& u, int wid, int lane, LAS unsigned char* scr) const {
        const int t = wid * 64 + lane;
#pragma unroll
        for (int j = 0; j < 4; ++j) { const int li = t + 512 * j, row = li >> 3, seg = li & 7;
            __builtin_amdgcn_global_load_lds((const unsigned*)(xp + (size_t)(u.pm * 256 + row) * DM + u.pn * 256 + seg * 32), (LAS unsigned*)(scr + j * 256), 4, 0, 0); }
    }
    __device__ __forceinline__ void operator()(const f32x4 (&)[2][2][4][2], const pg8::Unit&, int, int, int, int) const {}
    __device__ __forceinline__ void fused(f32x4 (&acc)[2][2][4][2], const pg8::Unit& u, int wr, int wc, int fr, int fq) const {
        const int row0 = u.pm * 256 + wr * 64 + fr, col0 = u.pn * 256 + wc * 32 + 4 * fq;
#pragma unroll
        for (int ai = 0; ai < 2; ++ai)
#pragma unroll
            for (int m = 0; m < 4; ++m) { const size_t r = (size_t)(row0 + ai * 128 + m * 16); float ss = 0.f;
#pragma unroll
                for (int bj = 0; bj < 2; ++bj)
#pragma unroll
                    for (int n = 0; n < 2; ++n) { const int c = col0 + bj * 128 + n * 16; const f32x4 v = acc[ai][bj][m][n] + __builtin_nontemporal_load((const f32x4*)(xp + r * DM + c)); acc[ai][bj][m][n] = v;
                        ss += (v.x * v.x + v.y * v.y) + (v.z * v.z + v.w * v.w); }
                ss += __shfl_xor(ss, 16); ss += __shfl_xor(ss, 32);
                if (fq == 0) st_agent(slots + r * 16 + u.pn * 4 + wc, ss); }
        asm volatile("s_waitcnt vmcnt(0)" ::: "memory");
        if (fr == 0 && fq == 0) __hip_atomic_fetch_add(cnt + 64 * u.pm, 1u, __ATOMIC_RELAXED, __HIP_MEMORY_SCOPE_AGENT);
        if (threadIdx.x < 64) wait_count(cnt + 64 * u.pm, 32u);
        __syncthreads();
#pragma unroll
        for (int ai = 0; ai < 2; ++ai)
#pragma unroll
            for (int m = 0; m < 4; ++m) { const size_t r = (size_t)(row0 + ai * 128 + m * 16); float tot = 0.f;
                { const f32x4* sp = (const f32x4*)(slots + r * 16); const f32x4 p0 = sp[0], p1 = sp[1], p2 = sp[2], p3 = sp[3];
                  tot = (((p0.x + p0.y) + (p0.z + p0.w)) + ((p1.x + p1.y) + (p1.z + p1.w))) + (((p2.x + p2.y) + (p2.z + p2.w)) + ((p3.x + p3.y) + (p3.z + p3.w))); }
                const float rs = rsqrtf(tot * (1.f / DM) + EPS);
#pragma unroll
                for (int bj = 0; bj < 2; ++bj)
#pragma unroll
                    for (int n = 0; n < 2; ++n) { const int c = col0 + bj * 128 + n * 16; const f32x4 g = *(const f32x4*)(gf + c); const f32x4 v = acc[ai][bj][m][n];
                        __builtin_nontemporal_store((f32x4){v.x * rs * g.x, v.y * rs * g.y, v.z * rs * g.z, v.w * rs * g.w}, (f32x4*)(out + O_YP + r * DM + c)); } }
    }
};

template <class Epi>
__device__ __forceinline__ void skinny_gemm(LAS unsigned char* lds, const bf16* A0, int lda, size_t a_grp_stride, int strips_per_grp, int nseg, int aseg,
                                            const bf16* Bt, int ldb, int K, int nstrips, int first, int step, const Epi& E) {
    int tid_ = threadIdx.x; asm volatile("" : "+v"(tid_));
    const int tid = tid_, lane = tid & 63, wv = tid >> 6, fr = lane & 15, fq = lane >> 4, rh = wv & 1, kq = wv >> 1;
    LAS float* part = (LAS float*)lds;
    const int nks = K / 128;
    for (int s = first; s < nstrips; s += step) {
        const bf16* A = A0 + (size_t)(s / strips_per_grp) * a_grp_stride + (size_t)(rh * 64 + fr) * lda + fq * 8;
        const bf16* B = Bt + (size_t)(16 * s + fr) * ldb + fq * 8;
        f32x4 acc[4];
#pragma unroll
        for (int rb = 0; rb < 4; ++rb) acc[rb] = (f32x4){0.f, 0.f, 0.f, 0.f};
        for (int seg = 0; seg < nseg; ++seg) {
#pragma unroll 4
            for (int k = 0; k < nks; ++k) {
                const int ko = (kq * nks + k) * 32;
                const bf16x8 bfr = *(const bf16x8*)(B + ko);
#pragma unroll
                for (int rb = 0; rb < 4; ++rb) { const bf16x8 afr = *(const bf16x8*)(A + (size_t)rb * 16 * lda + seg * aseg + ko);
                    acc[rb] = __builtin_amdgcn_mfma_f32_16x16x32_bf16(bfr, afr, acc[rb], 0, 0, 0); }
            }
        }
#pragma unroll
        for (int rb = 0; rb < 4; ++rb) *(LAS f32x4*)(part + ((kq * 128 + rh * 64 + rb * 16 + fr) * 16 + fq * 4)) = acc[rb];
        __syncthreads();
        { const int row = tid >> 2, cq = tid & 3; const LAS float* p = part + row * 16 + cq * 4;
          const f32x4 v = (*(const LAS f32x4*)p + *(const LAS f32x4*)(p + 2048)) + (*(const LAS f32x4*)(p + 4096) + *(const LAS f32x4*)(p + 6144));
          E(s, row, 16 * s + cq * 4, v, cq); }
        __syncthreads();
    }
}
struct EpiS1 {
    bf16* proj; bf16* gate; float* vss2; float* out; const float* hist; bf16* ds;
    __device__ __forceinline__ void operator()(int s, int row, int c, f32x4 v, int cq) const {
        const int sec = c >> 10, cs = c & 1023; const size_t m = (size_t)(MPR + row);
        if (sec == 0) { *(f32x4*)(out + O_POOLS + ((size_t)row * 15 + 14) * DM + cs) = v;
            const int w = 2 << (cs >> 8); f32x4 sm = v;
#pragma unroll
            for (int j = 0; j < 15; ++j) if (j < w - 1) sm = sm + *(const f32x4*)(hist + ((size_t)row * 15 + 14 - j) * DM + cs);
            const float inv = 1.f / (float)w;
            u32x2 d; d.x = pk2(sm.x * inv - v.x, sm.y * inv - v.y); d.y = pk2(sm.z * inv - v.z, sm.w * inv - v.w);
            *(u32x2*)(ds + (size_t)row * DM + cs) = d; }
        if (sec == 3) { float ss = (v.x * v.x + v.y * v.y) + (v.z * v.z + v.w * v.w); ss += __shfl_xor(ss, 1); ss += __shfl_xor(ss, 2); if (cq == 0) vss2[row * 64 + (s - 192)] = ss; }
        if (sec == 1 || sec == 4 || sec == 6) { v.x = silu_f(v.x); v.y = silu_f(v.y); v.z = silu_f(v.z); v.w = silu_f(v.w); }
        if (sec >= 7) { v.x = sigm_f(v.x); v.y = sigm_f(v.y); v.z = sigm_f(v.z); v.w = sigm_f(v.w); }
        u32x2 w; w.x = pk2(v.x, v.y); w.y = pk2(v.z, v.w);
        if (sec < 7) *(u32x2*)(proj + (size_t)sec * MP * DM + m * DM + cs) = w; else *(u32x2*)(gate + m * (3 * DM) + (sec - 7) * DM + cs) = w;
    }
};
struct EpiS3 {
    const bf16* gate; bf16* gys;
    __device__ __forceinline__ void operator()(int s, int row, int c, f32x4 v, int cq) const {
        const u32x2 g = *(const u32x2*)(gate + (size_t)(MPR + row) * (3 * DM) + c);
        u32x2 w; w.x = pk2(v.x * bflo(g.x), v.y * bfhi(g.x)); w.y = pk2(v.z * bflo(g.y), v.w * bfhi(g.y));
        *(u32x2*)(gys + (size_t)row * (3 * DM) + c) = w;
    }
};
struct EpiS4 {
    const float* xs; const float* gf; float* out; float* slots2; unsigned* cnt2;
    __device__ __forceinline__ void operator()(int s, int row, int c, f32x4 v, int cq) const {
        v = v + *(const f32x4*)(xs + (size_t)row * DM + c);
        float ss = (v.x * v.x + v.y * v.y) + (v.z * v.z + v.w * v.w); ss += __shfl_xor(ss, 1); ss += __shfl_xor(ss, 2);
        if (cq == 0) st_agent(slots2 + row * 64 + s, ss);
        asm volatile("s_waitcnt vmcnt(0)" ::: "memory");
        __syncthreads();
        if (threadIdx.x == 0) __hip_atomic_fetch_add(cnt2, 1u, __ATOMIC_RELAXED, __HIP_MEMORY_SCOPE_AGENT);
        if (threadIdx.x < 64) wait_count(cnt2, 64u);
        __syncthreads();
        float tot = 0.f;
        { const f32x4* sp = (const f32x4*)(slots2 + row * 64 + cq * 16); const f32x4 p0 = sp[0], p1 = sp[1], p2 = sp[2], p3 = sp[3];
          tot = (((p0.x + p0.y) + (p0.z + p0.w)) + ((p1.x + p1.y) + (p1.z + p1.w))) + (((p2.x + p2.y) + (p2.z + p2.w)) + ((p3.x + p3.y) + (p3.z + p3.w))); }
        tot += __shfl_xor(tot, 1); tot += __shfl_xor(tot, 2);
        const float rs = rsqrtf(tot * (1.f / DM) + EPS); const f32x4 g = *(const f32x4*)(gf + c);
        *(f32x4*)(out + O_YS + (size_t)row * DM + c) = (f32x4){v.x * rs * g.x, v.y * rs * g.y, v.z * rs * g.z, v.w * rs * g.w};
    }
};


__device__ __forceinline__ void sample_out_split(const KArgs& a, LAS unsigned char* lds, int item) {
    int tid_ = threadIdx.x; asm volatile("" : "+v"(tid_));
    const int tid = tid_, lane = tid & 63, wv = tid >> 6, fr = lane & 15, fq = lane >> 4, s = item >> 2, rq = item & 3;
    const bf16* A = (const bf16*)(a.ws + WS_GYS) + (size_t)(rq * 32 + fr) * (3 * DM) + fq * 8;
    const bf16* B = (const bf16*)(a.ws + WS_WO3) + (size_t)(16 * s + fr) * DM + fq * 8;
    f32x4 acc0 = (f32x4){0.f, 0.f, 0.f, 0.f}, acc1 = acc0;
#pragma unroll
    for (int kk = 0; kk < 12; ++kk) { const int k = 384 * wv + 32 * kk;
        const bf16x8 bfr = *(const bf16x8*)(B + (k & 1023)); const bf16x8 a0 = *(const bf16x8*)(A + k), a1 = *(const bf16x8*)(A + (size_t)16 * (3 * DM) + k);
        acc0 = __builtin_amdgcn_mfma_f32_16x16x32_bf16(bfr, a0, acc0, 0, 0, 0); acc1 = __builtin_amdgcn_mfma_f32_16x16x32_bf16(bfr, a1, acc1, 0, 0, 0); }
    LAS float* part = (LAS float*)lds;
    *(LAS f32x4*)(part + (wv * 32 + fr) * 16 + fq * 4) = acc0; *(LAS f32x4*)(part + (wv * 32 + 16 + fr) * 16 + fq * 4) = acc1;
    __syncthreads();
    const int row = tid >> 4, col = tid & 15, grow = rq * 32 + row, c = 16 * s + col;
    float v = 0.f;
#pragma unroll
    for (int w8 = 0; w8 < 8; ++w8) v += part[(w8 * 32 + row) * 16 + col];
    v += a.in[I_XS][(size_t)grow * DM + c];
    float ss = v * v; ss += __shfl_xor(ss, 1); ss += __shfl_xor(ss, 2); ss += __shfl_xor(ss, 4); ss += __shfl_xor(ss, 8);
    float* slots2 = (float*)(a.ws + WS_VSS2); unsigned* cnt = (unsigned*)(a.ws + WS_CTL) + CW_SAMPLE + 64 * rq;
    if (col == 0) st_agent(slots2 + grow * 64 + s, ss);
    asm volatile("s_waitcnt vmcnt(0)" ::: "memory");
    __syncthreads();
    if (tid == 0) __hip_atomic_fetch_add(cnt, 1u, __ATOMIC_RELAXED, __HIP_MEMORY_SCOPE_AGENT);
    if (tid < 64) wait_count(cnt, 64u);
    __syncthreads();
    const f32x4 p4 = *(const f32x4*)(slots2 + grow * 64 + col * 4);
    float tot = (p4.x + p4.y) + (p4.z + p4.w); tot += __shfl_xor(tot, 1); tot += __shfl_xor(tot, 2); tot += __shfl_xor(tot, 4); tot += __shfl_xor(tot, 8);
    a.out[O_YS + (size_t)grow * DM + c] = v * rsqrtf(tot * (1.f / DM) + EPS) * a.in[I_NORMF][c];
    __syncthreads();
}

__device__ __forceinline__ void p0_transpose_item(const float* W, int N, bf16* WT, int row_off, int ldo, int koff, LAS float* scr, int item, int lane) {
    const int nblk = N / 32, kb = item / nblk, nb = item % nblk, k0 = 64 * kb, n0 = 32 * nb;
    float wv_[32];
#pragma unroll
    for (int i = 0; i < 32; ++i) { const int kk = 2 * i + (lane >> 5); wv_[i] = __builtin_nontemporal_load(W + (size_t)(k0 + kk) * N + n0 + (lane & 31)); }
#pragma unroll
    for (int i = 0; i < 32; ++i) { const int kk = 2 * i + (lane >> 5); scr[kk * 33 + (lane & 31)] = wv_[i]; }
    asm volatile("s_waitcnt lgkmcnt(0)" ::: "memory");
    const int c = lane & 7;
#pragma unroll
    for (int j = 0; j < 4; ++j) { const int n = (lane >> 3) + 8 * j; const LAS float* s = scr + (8 * c) * 33 + n;
        u32x4 o; o.x = pk2(s[0 * 33], s[1 * 33]); o.y = pk2(s[2 * 33], s[3 * 33]); o.z = pk2(s[4 * 33], s[5 * 33]); o.w = pk2(s[6 * 33], s[7 * 33]);
        *(u32x4*)(WT + (size_t)(row_off + n0 + n) * ldo + koff + k0 + 8 * c) = o; }
    asm volatile("s_waitcnt lgkmcnt(0)" ::: "memory");
}
__device__ __forceinline__ void rms_row_to_bf16(const float* xrow, const float* gain, bf16* orow, int lane) {
    const f32x4* xr = (const f32x4*)xrow + lane; const f32x4* gr = (const f32x4*)gain + lane;
    f32x4 v[4]; float s = 0.f;
#pragma unroll
    for (int j = 0; j < 4; ++j) { v[j] = xr[64 * j]; s += (v[j].x * v[j].x + v[j].y * v[j].y) + (v[j].z * v[j].z + v[j].w * v[j].w); }
    const float rs = rsqrtf(wave_sum(s) * (1.f / DM) + EPS);
    u32x2* o8 = (u32x2*)orow + lane;
#pragma unroll
    for (int j = 0; j < 4; ++j) { const f32x4 g = gr[64 * j]; u32x2 w; w.x = pk2(v[j].x * rs * g.x, v[j].y * rs * g.y); w.y = pk2(v[j].z * rs * g.z, v[j].w * rs * g.w); o8[64 * j] = w; }
}
__device__ __forceinline__ void rms_row2_to_bf16(const float* x0, const float* x1, const float* gain, bf16* o0, bf16* o1, int lane) {
    const f32x4* xr0 = (const f32x4*)x0 + lane; const f32x4* xr1 = (const f32x4*)x1 + lane; const f32x4* gr = (const f32x4*)gain + lane;
    f32x4 v[4], w[4]; float s = 0.f, t = 0.f;
#pragma unroll
    for (int j = 0; j < 4; ++j) { v[j] = __builtin_nontemporal_load(xr0 + 64 * j); w[j] = __builtin_nontemporal_load(xr1 + 64 * j); }
#pragma unroll
    for (int j = 0; j < 4; ++j) { s += (v[j].x * v[j].x + v[j].y * v[j].y) + (v[j].z * v[j].z + v[j].w * v[j].w); t += (w[j].x * w[j].x + w[j].y * w[j].y) + (w[j].z * w[j].z + w[j].w * w[j].w); }
#pragma unroll
    for (int o = 1; o < 64; o <<= 1) { s += __shfl_xor(s, o); t += __shfl_xor(t, o); }
    const float rs = rsqrtf(s * (1.f / DM) + EPS), rt = rsqrtf(t * (1.f / DM) + EPS);
    u32x2* p0 = (u32x2*)o0 + lane; u32x2* p1 = (u32x2*)o1 + lane;
#pragma unroll
    for (int j = 0; j < 4; ++j) { const f32x4 g = gr[64 * j]; u32x2 a; a.x = pk2(v[j].x * rs * g.x, v[j].y * rs * g.y); a.y = pk2(v[j].z * rs * g.z, v[j].w * rs * g.w); p0[64 * j] = a;
        u32x2 b; b.x = pk2(w[j].x * rt * g.x, w[j].y * rt * g.y); b.y = pk2(w[j].z * rt * g.z, w[j].w * rt * g.w); p1[64 * j] = b; }
}
__device__ __forceinline__ void p0_prologue(const KArgs& a, LAS unsigned char* lds, int G) {
    const int tid = threadIdx.x, lane = tid & 63, wave = tid >> 6;
    LAS float* scr = (LAS float*)(lds + wave * 16384);
    const int gw = blockIdx.x * 8 + wave, NGW = G * 8;
    bf16* H = (bf16*)(a.ws + WS_H); bf16* WinT = (bf16*)(a.ws + WS_WIN); bf16* WdT = (bf16*)(a.ws + WS_WD); bf16* Wo3 = (bf16*)(a.ws + WS_WO3);
    bf16* PwT = (bf16*)(a.ws + WS_PW); bf16* SW = (bf16*)(a.ws + WS_SW);
    constexpr int I_IN = 16 * (INC / 32), I_KV = 16 * (2048 / 32), I_D = 16 * 32, I_O = 16 * 32, I_P = 4 * 8;
    constexpr int NITEMS = I_IN + I_KV + 3 * I_D + I_O + 4 * I_P;
    for (int it = gw; it < NITEMS; it += NGW) {
        int r = it;
        if (r < I_IN) { p0_transpose_item(a.in[I_WIN], INC, WinT, 0, DM, 0, scr, r, lane); continue; } r -= I_IN;
        if (r < I_KV) { p0_transpose_item(a.in[I_WKV], 2048, WinT, INC, DM, 0, scr, r, lane); continue; } r -= I_KV;
        if (r < 3 * I_D) { const int b = r / I_D; p0_transpose_item(a.in[I_WDOWN] + (size_t)b * DM * DM, DM, WdT, b * DM, DM, 0, scr, r % I_D, lane); continue; } r -= 3 * I_D;
        if (r < I_O) { p0_transpose_item(a.in[I_WOUT], DM, Wo3, 0, DM, 0, scr, r, lane); continue; } r -= I_O;
        { const int g = r / I_P; p0_transpose_item(a.in[I_POOLW] + (size_t)g * 256 * 256, 256, PwT, g * 256, 256, 0, scr, r % I_P, lane); }
    }
    for (int m = gw; m + NGW < MPR; m += 2 * NGW)
        rms_row2_to_bf16(a.in[I_XP] + (size_t)m * DM, a.in[I_XP] + (size_t)(m + NGW) * DM, a.in[I_NORMG], H + (size_t)m * DM, H + (size_t)(m + NGW) * DM, lane);
    const int mdone = (MPR / (2 * NGW)) * (2 * NGW);
    for (int m = mdone + gw; m < MP + 2048; m += NGW) {
        bf16* orow = H + (size_t)m * DM;
        if (m < MPR) rms_row_to_bf16(a.in[I_XP] + (size_t)m * DM, a.in[I_NORMG], orow, lane);
        else if (m < MV) rms_row_to_bf16(a.in[I_XS] + (size_t)(m - MPR) * DM, a.in[I_NORMG], orow, lane);
        else if (m < MP) { u32x2* o8 = (u32x2*)orow + lane;
#pragma unroll
            for (int j = 0; j < 4; ++j) o8[64 * j] = (u32x2){0u, 0u}; }
        else rms_row_to_bf16(a.in[I_MEM] + (size_t)(m - MP) * DM, a.in[I_MEMNG], orow, lane);
    }
    const size_t gt = (size_t)blockIdx.x * 512 + tid, NGT = (size_t)G * 512;
    for (size_t i = gt; i < (size_t)4 * 128 * 128; i += NGT) { const int s = (int)(i & 127), t = (int)((i >> 7) & 127); SW[i] = (bf16)(s <= t ? f2bf(a.in[I_SGUW][i]) : 0u); }
    for (size_t i = gt; i < (size_t)NS * 256; i += NGT) { const size_t smp = i >> 8, c = (i & 255) * 4; const int w = 2 << (int)(c >> 8); f32x4 sm = (f32x4){0.f, 0.f, 0.f, 0.f};
#pragma unroll
        for (int j = 0; j < 15; ++j) if (j < w - 1) sm = sm + *(const f32x4*)(a.in[I_SPOOL] + (smp * 15 + 14 - j) * DM + c);
        *(f32x4*)((float*)(a.ws + WS_HS) + smp * DM + c) = sm; }
    for (size_t i = gt; i < (size_t)NS * 14 * 256; i += NGT) { const size_t smp = i / (14 * 256), rem = i % (14 * 256), r = rem / 256, c4 = rem % 256;
        __builtin_nontemporal_store(*(const f32x4*)(a.in[I_SPOOL] + (smp * 15 + r + 1) * DM + c4 * 4), (f32x4*)(a.out + O_POOLS + (smp * 15 + r) * DM + c4 * 4)); }
}

constexpr int RSV = 544;
constexpr int RS = 528;
__device__ __forceinline__ void pool_part(const KArgs& a, LAS unsigned char* lds, int rt, int g) {
    int tid_ = threadIdx.x; asm volatile("" : "+v"(tid_));
    const int tid = tid_, lane = tid & 63, wv = tid >> 6, fr = lane & 15, fq = lane >> 4;
    const int m0 = rt * 128, w = 2 << g;
    const bf16* PIN = (const bf16*)(a.ws + WS_PROJ); const bf16* PZ = PIN + (size_t)MP * DM;
    const bf16* PwT = (const bf16*)(a.ws + WS_PW); bf16* BR0 = (bf16*)(a.ws + WS_BR);
    LAS unsigned char* Pb = lds; LAS unsigned char* Db = lds + 75520;
    u32x4 zf[8]; f32x4 scv[2]; bf16x8 Bf[2][8];
    const bf16* pw = PwT + (size_t)(g * 256 + wv * 32 + 8 * (fr >> 2) + (fr & 3)) * 256 + fq * 8;
    if (rt < 128) {
        const int t0 = (rt & 15) * 128;
        u32x4 tv[9];
#pragma unroll
        for (int i = 0; i < 9; ++i) { const int idx = tid + i * 512, row = idx >> 5, ch = idx & 31; tv[i] = (u32x4){0u, 0u, 0u, 0u};
            if (idx < 143 * 32 && !(t0 == 0 && row < 15)) tv[i] = *(const u32x4*)(PIN + (size_t)(m0 - 15 + row) * DM + g * 256 + ch * 8); }
#pragma unroll
        for (int rb = 0; rb < 8; ++rb) zf[rb] = __builtin_nontemporal_load((const u32x4*)(PZ + (size_t)(m0 + rb * 16 + fr) * DM + g * 256 + wv * 32 + 8 * fq));
#pragma unroll
        for (int nn = 0; nn < 2; ++nn) { scv[nn] = *(const f32x4*)(a.in[I_POOLSC] + g * 256 + wv * 32 + 8 * fq + 4 * nn);
#pragma unroll
            for (int ks = 0; ks < 8; ++ks) Bf[nn][ks] = *(const bf16x8*)(pw + nn * 4 * 256 + ks * 32); }
#pragma unroll
        for (int i = 0; i < 9; ++i) { const int idx = tid + i * 512, row = idx >> 5, ch = idx & 31; if (idx < 143 * 32) *(LAS u32x4*)(Pb + row * RS + ch * 16) = tv[i]; }
        __syncthreads();
        {
            const int ch = tid & 31, r0 = (tid >> 5) * 8;
            float s0 = 0.f, s1 = 0.f, s2 = 0.f, s3 = 0.f, s4 = 0.f, s5 = 0.f, s6 = 0.f, s7 = 0.f;
            for (int j = 1; j < w; ++j) { const u32x4 v = *(const LAS u32x4*)(Pb + (r0 + 15 - j) * RS + ch * 16);
                s0 += bflo(v.x); s1 += bfhi(v.x); s2 += bflo(v.y); s3 += bfhi(v.y); s4 += bflo(v.z); s5 += bfhi(v.z); s6 += bflo(v.w); s7 += bfhi(v.w); }
#pragma unroll
            for (int i = 0; i < 8; ++i) { const int r = r0 + i;
                const u32x4 own = *(const LAS u32x4*)(Pb + (r + 15) * RS + ch * 16); const u32x4 old = *(const LAS u32x4*)(Pb + (r + 16 - w) * RS + ch * 16);
                s0 += bflo(own.x); s1 += bfhi(own.x); s2 += bflo(own.y); s3 += bfhi(own.y); s4 += bflo(own.z); s5 += bfhi(own.z); s6 += bflo(own.w); s7 += bfhi(own.w);
                const int cnt = min(w, t0 + r + 1); const float inv = 1.f / (float)cnt;
                u32x4 d; d.x = pk2(s0 * inv - bflo(own.x), s1 * inv - bfhi(own.x)); d.y = pk2(s2 * inv - bflo(own.y), s3 * inv - bfhi(own.y));
                d.z = pk2(s4 * inv - bflo(own.z), s5 * inv - bfhi(own.z)); d.w = pk2(s6 * inv - bflo(own.w), s7 * inv - bfhi(own.w));
                *(LAS u32x4*)(Db + r * RS + ch * 16) = d;
                s0 -= bflo(old.x); s1 -= bfhi(old.x); s2 -= bflo(old.y); s3 -= bfhi(old.y); s4 -= bflo(old.z); s5 -= bfhi(old.z); s6 -= bflo(old.w); s7 -= bfhi(old.w); }
        }
    } else {
#pragma unroll
        for (int rb = 0; rb < 8; ++rb) zf[rb] = __builtin_nontemporal_load((const u32x4*)(PZ + (size_t)(m0 + rb * 16 + fr) * DM + g * 256 + wv * 32 + 8 * fq));
#pragma unroll
        for (int nn = 0; nn < 2; ++nn) { scv[nn] = *(const f32x4*)(a.in[I_POOLSC] + g * 256 + wv * 32 + 8 * fq + 4 * nn);
#pragma unroll
            for (int ks = 0; ks < 8; ++ks) Bf[nn][ks] = *(const bf16x8*)(pw + nn * 4 * 256 + ks * 32); }
        const bf16* DS = (const bf16*)(a.ws + WS_DS);
        u32x4 td[8];
#pragma unroll
        for (int i = 0; i < 8; ++i) { const int idx = tid + i * 512, r = idx >> 5, ch = idx & 31; td[i] = *(const u32x4*)(DS + (size_t)r * DM + g * 256 + ch * 8); }
#pragma unroll
        for (int i = 0; i < 8; ++i) { const int idx = tid + i * 512, r = idx >> 5, ch = idx & 31; *(LAS u32x4*)(Db + r * RS + ch * 16) = td[i]; }
    }
    __syncthreads();
#pragma unroll
    for (int rb = 0; rb < 8; ++rb) {
        f32x4 acc0 = (f32x4){0.f, 0.f, 0.f, 0.f}, acc1 = acc0;
#pragma unroll
        for (int ks = 0; ks < 8; ++ks) { const bf16x8 A = *(const LAS bf16x8*)(Db + (rb * 16 + fr) * RS + (ks * 32 + fq * 8) * 2);
            acc0 = __builtin_amdgcn_mfma_f32_16x16x32_bf16(Bf[0][ks], A, acc0, 0, 0, 0); acc1 = __builtin_amdgcn_mfma_f32_16x16x32_bf16(Bf[1][ks], A, acc1, 0, 0, 0); }
        const size_t m = (size_t)(m0 + rb * 16 + fr); const int c = g * 256 + wv * 32 + 8 * fq; const u32x4 z = zf[rb];
        u32x4 o; o.x = pk2(acc0[0] * scv[0].x * bflo(z.x), acc0[1] * scv[0].y * bfhi(z.x)); o.y = pk2(acc0[2] * scv[0].z * bflo(z.y), acc0[3] * scv[0].w * bfhi(z.y));
        o.z = pk2(acc1[0] * scv[1].x * bflo(z.z), acc1[1] * scv[1].y * bfhi(z.z)); o.w = pk2(acc1[2] * scv[1].z * bflo(z.w), acc1[3] * scv[1].w * bfhi(z.w));
        __builtin_nontemporal_store(o, (u32x4*)(BR0 + m * DM + c));
    }
    __syncthreads();
}
__device__ __forceinline__ void sgu_part(const KArgs& a, LAS unsigned char* lds, int rt, int g) {
    int tid_ = threadIdx.x; asm volatile("" : "+v"(tid_));
    const int tid = tid_, lane = tid & 63, wv = tid >> 6, fr = lane & 15, fq = lane >> 4;
    const int m0 = rt * 128;
    const bf16* U = (const bf16*)(a.ws + WS_PROJ) + (size_t)2 * MP * DM; const bf16* V = U + (size_t)MP * DM;
    const bf16* SW = (const bf16*)(a.ws + WS_SW); const float* VSS = (const float*)(a.ws + WS_VSS); bf16* BR1 = (bf16*)(a.ws + WS_BR) + (size_t)MP * DM;
    LAS unsigned char* Vb = lds; LAS unsigned char* UZb = lds + 128 * RS; LAS float* rbuf = (LAS float*)(lds + 256 * RS);
    u32x4 tv[8], tu[8];
#pragma unroll
    for (int i = 0; i < 8; ++i) { const int idx = tid + i * 512, s = idx >> 5, ch = idx & 31; const size_t o = (size_t)(m0 + s) * DM + g * 256 + ch * 8;
        tv[i] = __builtin_nontemporal_load((const u32x4*)(V + o)); tu[i] = __builtin_nontemporal_load((const u32x4*)(U + o)); }
    if (tid < 128) { const f32x4* p = (const f32x4*)(VSS + (size_t)(m0 + tid) * 16); const f32x4 p0 = p[0], p1 = p[1], p2 = p[2], p3 = p[3];
        const float s = ((p0.x + p0.y) + (p0.z + p0.w)) + ((p1.x + p1.y) + (p1.z + p1.w)) + ((p2.x + p2.y) + (p2.z + p2.w)) + ((p3.x + p3.y) + (p3.z + p3.w));
        rbuf[tid] = rsqrtf(s * (1.f / DM) + EPS); }
    const f32x4 gv0 = *(const f32x4*)(a.in[I_SGUNG] + g * 256 + wv * 32 + 8 * fq), gv1 = *(const f32x4*)(a.in[I_SGUNG] + g * 256 + wv * 32 + 8 * fq + 4);
    float biasv[8];
#pragma unroll
    for (int tb = 0; tb < 8; ++tb) biasv[tb] = a.in[I_SGUB][g * 128 + tb * 16 + fr];
    __syncthreads();
#pragma unroll
    for (int i = 0; i < 8; ++i) { const int idx = tid + i * 512, s = idx >> 5, ch = idx & 31; const float r = rbuf[s];
        u32x4 v; v.x = pk2(bflo(tv[i].x) * r, bfhi(tv[i].x) * r); v.y = pk2(bflo(tv[i].y) * r, bfhi(tv[i].y) * r); v.z = pk2(bflo(tv[i].z) * r, bfhi(tv[i].z) * r); v.w = pk2(bflo(tv[i].w) * r, bfhi(tv[i].w) * r);
        *(LAS u32x4*)(Vb + s * RS + ch * 16) = v;
        const u32x4 q = tu[i];
        *(LAS u32x4*)(UZb + s * RS + ch * 16) = q; }
    __syncthreads();
    const int q = fr >> 2, p = fr & 3;
    bf16x8 Vf[4][2];
#pragma unroll
    for (int ks = 0; ks < 4; ++ks)
#pragma unroll
        for (int nn = 0; nn < 2; ++nn) { const LAS unsigned char* a0 = Vb + (32 * ks + 8 * fq + q) * RS + (wv * 32 + 8 * p + 4 * nn) * 2; Vf[ks][nn] = tr_read2(a0, a0 + 4 * RS); }
#pragma unroll
    for (int tb = 0; tb < 8; ++tb) {
        f32x4 acc0 = (f32x4){0.f, 0.f, 0.f, 0.f}, acc1 = acc0;
        const int t = tb * 16 + fr;
#pragma unroll
        for (int ks = 0; ks < 4; ++ks) if (ks <= (tb >> 1)) {
            const bf16x8 A = *(const bf16x8*)(SW + (size_t)(g * 128 + t) * 128 + ks * 32 + fq * 8);
            acc0 = __builtin_amdgcn_mfma_f32_16x16x32_bf16(Vf[ks][0], A, acc0, 0, 0, 0); acc1 = __builtin_amdgcn_mfma_f32_16x16x32_bf16(Vf[ks][1], A, acc1, 0, 0, 0);
        }
        const size_t m = (size_t)(m0 + t); const float bias = biasv[tb];
        { const int cl = wv * 32 + 8 * fq; const u32x4 uz = *(const LAS u32x4*)(UZb + t * RS + cl * 2);
          u32x4 o; o.x = pk2((acc0[0] * gv0.x + bias) * bflo(uz.x), (acc0[1] * gv0.y + bias) * bfhi(uz.x)); o.y = pk2((acc0[2] * gv0.z + bias) * bflo(uz.y), (acc0[3] * gv0.w + bias) * bfhi(uz.y));
          o.z = pk2((acc1[0] * gv1.x + bias) * bflo(uz.z), (acc1[1] * gv1.y + bias) * bfhi(uz.z)); o.w = pk2((acc1[2] * gv1.z + bias) * bflo(uz.w), (acc1[3] * gv1.w + bias) * bfhi(uz.w));
          __builtin_nontemporal_store(o, (u32x4*)(BR1 + m * DM + g * 256 + cl)); }
    }
    __syncthreads();
}
__device__ __forceinline__ void attn_part(const KArgs& a, LAS unsigned char* lds, int rt, int g) {
    int tid_ = threadIdx.x; asm volatile("" : "+v"(tid_));
    const int tid = tid_, lane = tid & 63, wv = tid >> 6, fr = lane & 15, fq = lane >> 4;
    const int m0 = rt * 128, b = rt >> 4;
    const bf16* Q = (const bf16*)(a.ws + WS_PROJ) + (size_t)5 * MP * DM; const bf16* AZ = Q + (size_t)MP * DM;
    const bf16* KB = (const bf16*)(a.ws + WS_KB); const bf16* VB = (const bf16*)(a.ws + WS_VB); bf16* BR2 = (bf16*)(a.ws + WS_BR) + (size_t)2 * MP * DM;
    LAS unsigned char* Kb = lds;
    const size_t m = (size_t)(m0 + wv * 16 + fr);
    bf16x8 Qf[8];
    {
        u32x4 tk[16];
#pragma unroll
        for (int i = 0; i < 16; ++i) { const int idx = tid + i * 512, key = idx >> 5, ch = idx & 31; tk[i] = *(const u32x4*)(KB + (size_t)(b * 256 + key) * DM + g * 256 + ch * 8); }
#pragma unroll
        for (int ks = 0; ks < 8; ++ks) Qf[ks] = __builtin_nontemporal_load((const bf16x8*)(Q + m * DM + g * 256 + ks * 32 + fq * 8));
#pragma unroll
        for (int i = 0; i < 16; ++i) { const int idx = tid + i * 512, key = idx >> 5, ch = idx & 31; *(LAS u32x4*)(Kb + key * RS + ch * 16) = tk[i]; }
    }
    __syncthreads();
    u32x4 tvv[16];
#pragma unroll
    for (int i = 0; i < 16; ++i) { const int idx = tid + i * 512, key = idx >> 5, ch = idx & 31; tvv[i] = *(const u32x4*)(VB + (size_t)(b * 256 + key) * DM + g * 256 + ch * 8); }
    f32x4 sacc[16];
#pragma unroll
    for (int kb = 0; kb < 16; ++kb) { sacc[kb] = (f32x4){0.f, 0.f, 0.f, 0.f};
#pragma unroll
        for (int ks = 0; ks < 8; ++ks) { const bf16x8 Kf = *(const LAS bf16x8*)(Kb + (kb * 16 + fr) * RS + (ks * 32 + fq * 8) * 2);
            sacc[kb] = __builtin_amdgcn_mfma_f32_16x16x32_bf16(Kf, Qf[ks], sacc[kb], 0, 0, 0); }
        if (kb & 1) __builtin_amdgcn_sched_barrier(0); }
    float mx = -3.0e38f;
#pragma unroll
    for (int kb = 0; kb < 16; ++kb) mx = fmaxf(mx, fmaxf(fmaxf(sacc[kb][0], sacc[kb][1]), fmaxf(sacc[kb][2], sacc[kb][3])));
    mx = fmaxf(mx, __shfl_xor(mx, 16)); mx = fmaxf(mx, __shfl_xor(mx, 32));
    float sum = 0.f;
#pragma unroll
    for (int kb = 0; kb < 16; ++kb)
#pragma unroll
        for (int j = 0; j < 4; ++j) { const float pj = __expf((sacc[kb][j] - mx) * 0.0625f); sacc[kb][j] = pj; sum += pj; }
    sum += __shfl_xor(sum, 16); sum += __shfl_xor(sum, 32);
    const float isum = 1.f / sum;
    bf16x8 Pf[8];
#pragma unroll
    for (int k2 = 0; k2 < 8; ++k2) { u32x4 w; w.x = pk2(sacc[2 * k2][0], sacc[2 * k2][1]); w.y = pk2(sacc[2 * k2][2], sacc[2 * k2][3]);
        w.z = pk2(sacc[2 * k2 + 1][0], sacc[2 * k2 + 1][1]); w.w = pk2(sacc[2 * k2 + 1][2], sacc[2 * k2 + 1][3]); Pf[k2] = __builtin_bit_cast(bf16x8, w); }
    __syncthreads();
#pragma unroll
    for (int i = 0; i < 16; ++i) { const int idx = tid + i * 512, key = idx >> 5, ch = idx & 31; *(LAS u32x4*)(Kb + key * RSV + ch * 16) = tvv[i]; }
    u32x4 zf[8];
#pragma unroll
    for (int d2 = 0; d2 < 8; ++d2) zf[d2] = __builtin_nontemporal_load((const u32x4*)(AZ + m * DM + g * 256 + d2 * 32 + 8 * fq));
    __syncthreads();
    const int q = fr >> 2, p = fr & 3;
#pragma unroll
    for (int d2 = 0; d2 < 8; ++d2) {
        f32x4 o0 = (f32x4){0.f, 0.f, 0.f, 0.f}, o1 = o0;
#pragma unroll
        for (int k2 = 0; k2 < 8; ++k2) { const LAS unsigned char* a0 = Kb + (32 * k2 + 4 * fq + q) * RSV + (d2 * 32 + 8 * p) * 2;
            const bf16x8 Vf0 = tr_read2(a0, a0 + 16 * RSV), Vf1 = tr_read2(a0 + 8, a0 + 8 + 16 * RSV);
            o0 = __builtin_amdgcn_mfma_f32_16x16x32_bf16(Vf0, Pf[k2], o0, 0, 0, 0); o1 = __builtin_amdgcn_mfma_f32_16x16x32_bf16(Vf1, Pf[k2], o1, 0, 0, 0); }
        const int c = g * 256 + d2 * 32 + 8 * fq; const u32x4 z = zf[d2];
        u32x4 w; w.x = pk2(o0[0] * isum * bflo(z.x), o0[1] * isum * bfhi(z.x)); w.y = pk2(o0[2] * isum * bflo(z.y), o0[3] * isum * bfhi(z.y));
        w.z = pk2(o1[0] * isum * bflo(z.z), o1[1] * isum * bfhi(z.z)); w.w = pk2(o1[2] * isum * bflo(z.w), o1[3] * isum * bfhi(z.w));
        __builtin_nontemporal_store(w, (u32x4*)(BR2 + m * DM + c));
        __builtin_amdgcn_sched_barrier(0);
    }
    __syncthreads();
}
__device__ __forceinline__ void sgu_sample(const KArgs& a, int g, int rb) {
    int tid_ = threadIdx.x; asm volatile("" : "+v"(tid_));
    const int tid = tid_;
    const bf16* U = (const bf16*)(a.ws + WS_PROJ) + (size_t)2 * MP * DM; const bf16* V = U + (size_t)MP * DM;
    const float* VSS = (const float*)(a.ws + WS_VSS); bf16* BR1 = (bf16*)(a.ws + WS_BR) + (size_t)MP * DM;
    const float w00 = a.in[I_SGUW][(size_t)g * 128 * 128], b0 = a.in[I_SGUB][g * 128];
    for (int idx = tid; idx < 16 * 64; idx += 512) {
        const int i = rb * 16 + (idx >> 6), c = g * 256 + (idx & 63) * 4; const size_t m = (size_t)(MPR + i);
        const float s = wave_sum((idx & 63) < 16 ? VSS[m * 16 + (idx & 63)] : 0.f);
        const float rs = rsqrtf(s * (1.f / DM) + EPS);
        const f32x4 gv = *(const f32x4*)(a.in[I_SGUNG] + c);
        const u32x2 v4 = *(const u32x2*)(V + m * DM + c), u4 = *(const u32x2*)(U + m * DM + c);
        f32x4 vn; vn.x = bflo(v4.x) * rs * gv.x; vn.y = bfhi(v4.x) * rs * gv.y; vn.z = bflo(v4.y) * rs * gv.z; vn.w = bfhi(v4.y) * rs * gv.w;
        *(f32x4*)(a.out + O_SV + (size_t)i * DM + c) = vn;
        u32x2 o; o.x = pk2(bflo(u4.x) * (w00 * vn.x + b0), bfhi(u4.x) * (w00 * vn.y + b0));
        o.y = pk2(bflo(u4.y) * (w00 * vn.z + b0), bfhi(u4.y) * (w00 * vn.w + b0));
        *(u32x2*)(BR1 + m * DM + c) = o;
    }
}
__device__ __forceinline__ void attn_sample(const KArgs& a, LAS unsigned char* lds, int i, int h) {
    int tid_ = threadIdx.x; asm volatile("" : "+v"(tid_));
    const int tid = tid_, lane = tid & 63, wv = tid >> 6;
    const bf16* Q = (const bf16*)(a.ws + WS_PROJ) + (size_t)5 * MP * DM; const bf16* AZ = Q + (size_t)MP * DM; bf16* BR2 = (bf16*)(a.ws + WS_BR) + (size_t)2 * MP * DM;
    const size_t m = (size_t)(MPR + i);
    const float* Kc = a.in[I_CK] + ((size_t)i * NMEM * 4 + h) * 256 + lane * 4;
    const float* Vc = a.in[I_CV] + ((size_t)i * NMEM * 4 + h) * 256 + lane * 4;
    LAS float* sc = (LAS float*)lds; LAS float* part = (LAS float*)(lds + 1024);
    const u32x2 q2 = *(const u32x2*)(Q + m * DM + h * 256 + lane * 4);
    const f32x4 qv = (f32x4){bflo(q2.x), bfhi(q2.x), bflo(q2.y), bfhi(q2.y)};
    {
        f32x4 kv[32]; float pd[32];
#pragma unroll
        for (int j = 0; j < 32; ++j) kv[j] = __builtin_nontemporal_load((const f32x4*)(Kc + (size_t)(wv * 32 + j) * 1024));
#pragma unroll
        for (int j = 0; j < 32; ++j) pd[j] = (kv[j].x * qv.x + kv[j].y * qv.y) + (kv[j].z * qv.z + kv[j].w * qv.w);
#pragma unroll
        for (int j = 0; j < 32; ++j) { const float d = wave_sum(pd[j]); if (lane == 0) sc[wv * 32 + j] = d * 0.0625f; }
    }
    f32x4 vv[32];
#pragma unroll
    for (int j = 0; j < 32; ++j) vv[j] = __builtin_nontemporal_load((const f32x4*)(Vc + (size_t)(wv * 32 + j) * 1024));
    __syncthreads();
    const f32x4 s4 = *(const LAS f32x4*)(sc + lane * 4);
    const float mx = wave_max(fmaxf(fmaxf(s4.x, s4.y), fmaxf(s4.z, s4.w)));
    const float sum = wave_sum((__expf(s4.x - mx) + __expf(s4.y - mx)) + (__expf(s4.z - mx) + __expf(s4.w - mx)));
    f32x4 o = (f32x4){0.f, 0.f, 0.f, 0.f};
#pragma unroll
    for (int j = 0; j < 32; ++j) { const float pj = __expf(sc[wv * 32 + j] - mx); o += vv[j] * pj; }
    *(LAS f32x4*)(part + wv * 256 + lane * 4) = o;
    __syncthreads();
    if (tid < 256) { float t = 0.f;
#pragma unroll
        for (int w8 = 0; w8 < 8; ++w8) t += part[w8 * 256 + tid];
        const int c = h * 256 + tid; const unsigned short zb = AZ[m * DM + c]; const float z = __builtin_bit_cast(float, (unsigned)zb << 16);
        BR2[m * DM + c] = (bf16)f2bf(t / sum * z); }
    __syncthreads();
}
__device__ __forceinline__ void p2_mixers(const KArgs& a, LAS unsigned char* lds, int G) {
    constexpr int NU = 512 + 512 + 4 + 32;
    if (G == 256) {
        const int c = blockIdx.x;
        for (int k = 0; k < 4; ++k) { const int kk = (c & 1) ? (k ^ 2) : k;
            if (kk < 2) { const int u = c + kk * 256, rt = u >> 2, g = u & 3; pool_part(a, lds, rt, g); sgu_part(a, lds, rt, g); attn_part(a, lds, rt, g); }
            else { const int e = c + (kk - 2) * 256; attn_sample(a, lds, e >> 2, e & 3); } }
        if (c < 4) pool_part(a, lds, 128, c); else if (c >= 8 && c < 40) sgu_sample(a, (c - 8) >> 3, (c - 8) & 7);
        return;
    }
    for (int u = blockIdx.x; u < NU; u += G) {
        if (u < 512) { const int rt = u >> 2, g = u & 3; pool_part(a, lds, rt, g); sgu_part(a, lds, rt, g); attn_part(a, lds, rt, g); }
        else if (u < 1024) { const int e = u - 512; attn_sample(a, lds, e >> 2, e & 3); }
        else if (u < 1028) pool_part(a, lds, 128, u - 1024);
        else sgu_sample(a, (u - 1028) >> 3, (u - 1028) & 7);
    }
}
__device__ __forceinline__ void p5_norm(const KArgs& a, int G) {
    const int tid = threadIdx.x, lane = tid & 63, wave = tid >> 6;
    const int gw = blockIdx.x * 8 + wave, NGW = G * 8;
    const f32x4* gr = (const f32x4*)a.in[I_NORMF] + lane;
    for (int m = gw; m < MV; m += NGW) {
        f32x4* xr = (f32x4*)(a.out + (size_t)m * DM) + lane;
        f32x4 v[4]; float s = 0.f;
#pragma unroll
        for (int j = 0; j < 4; ++j) { v[j] = xr[64 * j]; s += (v[j].x * v[j].x + v[j].y * v[j].y) + (v[j].z * v[j].z + v[j].w * v[j].w); }
        const float rs = rsqrtf(wave_sum(s) * (1.f / DM) + EPS);
#pragma unroll
        for (int j = 0; j < 4; ++j) { const f32x4 g = gr[64 * j]; xr[64 * j] = (f32x4){v[j].x * rs * g.x, v[j].y * rs * g.y, v[j].z * rs * g.z, v[j].w * rs * g.w}; }
    }
}

__global__ void __launch_bounds__(512, 2) fwd_megakernel(KArgs a) {
    extern __shared__ __attribute__((aligned(16))) unsigned char lds_raw[];
    LAS unsigned char* lds = (LAS unsigned char*)lds_raw;
    cg::grid_group grid = cg::this_grid();
    const int G = gridDim.x;
    const int lo = a.ph_lo, hi = a.ph_hi;
    volatile LAS unsigned* bst = (volatile LAS unsigned*)(lds + LDS_BYTES - 64);
    if (threadIdx.x == 0) { bst[0] = 0u; bst[1] = 0u; }
    __syncthreads();
    const XcdBarrier bar = xcd_barrier_post((unsigned*)(a.ws + WS_CTL), bst);
#define IN(k) (lo <= (k) && (k) < hi)
#define SEAM(k) do { if (IN(k) && IN((k) + 1)) { if (a.cg_sync) grid.sync(); else xcd_barrier(bar); } } while (0)
    if (IN(0)) p0_prologue(a, lds, G);
    SEAM(0);
    if (IN(1)) {
        pg8::Gemm g{(const bf16*)(a.ws + WS_H), (const bf16*)(a.ws + WS_WIN), MP, INC, DM};
        P1Order S; S.init(G, (int)blockIdx.x);
        EpiProj E{(bf16*)(a.ws + WS_PROJ), (bf16*)(a.ws + WS_GATE), (float*)(a.ws + WS_VSS), (bf16*)(a.ws + WS_KB), (bf16*)(a.ws + WS_VB), a.out, (const float*)(a.ws + WS_HS), (bf16*)(a.ws + WS_DS)};
        pg8::gemm_phase<EpiProj, P1Order>(lds, g, S, E);
    }
    SEAM(1);
    if (IN(2)) p2_mixers(a, lds, G);
    SEAM(2);
    if (IN(3)) {
        pg8::Gemm g{(const bf16*)(a.ws + WS_BR), (const bf16*)(a.ws + WS_WD), MPR, 3 * DM, DM};
        P3Order S; S.init(G, (int)blockIdx.x);
        EpiGate E{(const bf16*)(a.ws + WS_GATE), (bf16*)(a.ws + WS_MG)};
        pg8::gemm_phase<EpiGate, P3Order>(lds, g, S, E);
        EpiS3 E3{(const bf16*)(a.ws + WS_GATE), (bf16*)(a.ws + WS_GYS)};
        skinny_gemm(lds, (const bf16*)(a.ws + WS_BR) + (size_t)MPR * DM, DM, (size_t)MP * DM, 64, 1, 0, (const bf16*)(a.ws + WS_WD), DM, DM, 192, (int)blockIdx.x, G, E3);
    }
    SEAM(3);
    if (IN(4)) {
        pg8::Gemm g{(const bf16*)(a.ws + WS_MG), (const bf16*)(a.ws + WS_WO3), MPR, DM, DM};
        pg8::StaticOrder S; S.init(MPR, DM, G, (int)blockIdx.x);
        unsigned* ctl = (unsigned*)(a.ws + WS_CTL);
        EpiOutNorm E{a.in[I_XP], a.in[I_NORMF], a.out, (float*)(a.ws + WS_VSS), ctl + CW_PANEL};
        pg8::gemm_phase<EpiOutNorm, pg8::StaticOrder>(lds, g, S, E);
        sample_out_split(a, lds, (int)blockIdx.x);
    }
#undef IN
#undef SEAM
}

extern "C" void kernel_launch(void* const* d_in, const int* in_sizes, int n_in, void* d_out, int out_size, void* d_ws, size_t ws_size, hipStream_t stream) {
    static int grid = 0;
    if (grid == 0) {
        if (n_in != 18 || (size_t)out_size != O_END || ws_size < WS_END) { fprintf(stderr, "kernel_launch: unexpected shapes (n_in %d out %d ws %zu, need %zu)\n", n_in, out_size, ws_size, (size_t)WS_END); grid = -1; return; }
        int dev = 0, cus = 0, per_cu = 0;
        hipGetDevice(&dev); hipDeviceGetAttribute(&cus, hipDeviceAttributeMultiprocessorCount, dev);
        if (hipFuncSetAttribute((const void*)fwd_megakernel, hipFuncAttributeMaxDynamicSharedMemorySize, LDS_BYTES) != hipSuccess) { fprintf(stderr, "kernel_launch: hipFuncSetAttribute failed\n"); grid = -1; return; }
        if (hipOccupancyMaxActiveBlocksPerMultiprocessor(&per_cu, (const void*)fwd_megakernel, 512, LDS_BYTES) != hipSuccess || per_cu < 1) { fprintf(stderr, "kernel_launch: occupancy query failed (%d)\n", per_cu); grid = -1; return; }
        if (cus != 256) { fprintf(stderr, "kernel_launch: built for a 256-CU device (one 256x256 tile per workgroup in the last two phases), got %d\n", cus); grid = -1; return; }
        grid = cus;
    }
    if (grid < 0) return;
    if (hipMemsetAsync((char*)d_ws + WS_CTL, 0, CTL_BYTES, stream) != hipSuccess) { fprintf(stderr, "kernel_launch: memset failed\n"); return; }
    KArgs a{};
    for (int i = 0; i < 18; ++i) a.in[i] = (const float*)d_in[i];
    a.out = (float*)d_out; a.ws = (unsigned char*)d_ws; a.ph_lo = 0; a.ph_hi = 5;
    void* args[] = {&a};
    hipError_t e = hipLaunchCooperativeKernel((const void*)fwd_megakernel, dim3(grid), dim3(512), args, LDS_BYTES, stream);
    if (e != hipSuccess) fprintf(stderr, "cooperative launch failed: %s (grid %d)\n", hipGetErrorString(e), grid);
}
```

```cpp
#include <hip/hip_runtime.h>
#include <hip/hip_cooperative_groups.h>
#include <cstdio>
#include <cstdint>
namespace cg = cooperative_groups;

#define LAS __attribute__((address_space(3)))
typedef unsigned short bf16;
typedef short bf16x8 __attribute__((ext_vector_type(8)));
typedef short s16x4 __attribute__((ext_vector_type(4)));
typedef float f32x4 __attribute__((ext_vector_type(4)));
typedef unsigned u32x4 __attribute__((ext_vector_type(4)));
typedef unsigned u32x2 __attribute__((ext_vector_type(2)));

constexpr int DM = 1024, NBATCH = 8, SEQ = 2048, NS = 128, NMEM = 256;
constexpr int MPR = NBATCH * SEQ;
constexpr int MV = MPR + NS;
constexpr int MP = MPR + 256;
constexpr int NPAN = MP / 256;
constexpr int INC = 10240;
constexpr float EPS = 1e-6f;
constexpr size_t O_YP = 0, O_YS = O_YP + (size_t)MPR * DM, O_POOLP = O_YS + (size_t)NS * DM, O_POOLS = O_POOLP + (size_t)NBATCH * 15 * DM,
                 O_MK = O_POOLS + (size_t)NS * 15 * DM, O_MV = O_MK + (size_t)NBATCH * NMEM * DM, O_SV = O_MV + (size_t)NBATCH * NMEM * DM, O_END = O_SV + (size_t)NS * DM;
constexpr size_t ROWB = (size_t)MP * DM * 2;
constexpr size_t WS_CTL = 0, CTL_BYTES = 40960;
constexpr size_t WS_VSS2 = CTL_BYTES;
constexpr size_t WS_DS = WS_VSS2 + 32768;
constexpr size_t WS_HS = WS_DS + 262144;
constexpr size_t WS_H = WS_HS + 524288;
constexpr size_t WS_WIN = WS_H + (size_t)(MP + 2048) * DM * 2;
constexpr size_t WS_WD = WS_WIN + (size_t)(INC + 2048) * DM * 2;
constexpr size_t WS_WO3 = WS_WD + (size_t)3 * DM * DM * 2;
constexpr size_t WS_PW = WS_WO3 + (size_t)3 * DM * DM * 2;
constexpr size_t WS_SW = WS_PW + (size_t)4 * 256 * 256 * 2;
constexpr size_t WS_VSS = WS_SW + (size_t)4 * 128 * 128 * 2;
constexpr size_t WS_KB = WS_VSS + (size_t)MP * 16 * 4;
constexpr size_t WS_VB = WS_KB + (size_t)2048 * DM * 2;
constexpr size_t WS_PROJ = WS_VB + (size_t)2048 * DM * 2;
constexpr size_t WS_GATE = WS_PROJ + 7 * ROWB;
constexpr size_t WS_BR = WS_GATE + 3 * ROWB;
constexpr size_t WS_MG = WS_PROJ;
constexpr size_t WS_GYS = WS_H;
constexpr size_t WS_END = WS_BR + 3 * ROWB;
constexpr int LDS_BYTES = 147456;
constexpr int CW_PANEL = 4096, CW_SAMPLE = 4096 + 64 * 64;

__device__ __forceinline__ unsigned f2bf(float f) { unsigned u = __builtin_bit_cast(unsigned, f); return (u + 0x7fffu + ((u >> 16) & 1u)) >> 16; }
__device__ __forceinline__ unsigned pk2(float lo, float hi) { unsigned r; asm volatile("v_cvt_pk_bf16_f32 %0, %1, %2" : "=v"(r) : "v"(lo), "v"(hi)); return r; }
__device__ __forceinline__ float bflo(unsigned w) { return __builtin_bit_cast(float, w << 16); }
__device__ __forceinline__ float bfhi(unsigned w) { return __builtin_bit_cast(float, w & 0xffff0000u); }
__device__ __forceinline__ float silu_f(float x) { return x * __builtin_amdgcn_rcpf(1.f + __expf(-x)); }
__device__ __forceinline__ float sigm_f(float x) { return __builtin_amdgcn_rcpf(1.f + __expf(-x)); }
__device__ __forceinline__ float wave_sum(float v) {
#pragma unroll
    for (int o = 1; o < 64; o <<= 1) v += __shfl_xor(v, o);
    return v;
}
__device__ __forceinline__ float wave_max(float v) {
#pragma unroll
    for (int o = 1; o < 64; o <<= 1) v = fmaxf(v, __shfl_xor(v, o));
    return v;
}
__device__ __forceinline__ bf16x8 tr_read2(const LAS unsigned char* a0, const LAS unsigned char* a1) {
    const s16x4 lo = __builtin_amdgcn_ds_read_tr16_b64_v4i16((LAS s16x4*)a0);
    const s16x4 hi = __builtin_amdgcn_ds_read_tr16_b64_v4i16((LAS s16x4*)a1);
    return (bf16x8){lo[0], lo[1], lo[2], lo[3], hi[0], hi[1], hi[2], hi[3]};
}

#define XB_TMO      128
#define XB_XCNT(j)  (256  + 64 * (j))
#define XB_XSUB(j)  (1280 + 64 * (j))
#define XB_XGEN(j)  (2304 + 64 * (j))
#define XB_TOP      3328
#define XB_TOPGEN   3392
#define XCD_BAR_WORDS 3456
#define XB_SPIN_CAP (1u << 18)

__device__ __forceinline__ unsigned xb_ld(unsigned* p)              { return __hip_atomic_load(p, __ATOMIC_RELAXED, __HIP_MEMORY_SCOPE_AGENT); }
__device__ __forceinline__ unsigned xb_add(unsigned* p, unsigned v) { return __hip_atomic_fetch_add(p, v, __ATOMIC_RELAXED, __HIP_MEMORY_SCOPE_AGENT); }
__device__ __forceinline__ unsigned xb_xcc_id() { return (unsigned)__builtin_amdgcn_s_getreg((3 << 11) | 20) & 0xFu; }
#define XB_SPIN(cond, bar) do { unsigned _sp = 0; while (cond) { __builtin_amdgcn_s_sleep(1); \
    if ((++_sp & 255u) == 0u) { if (xb_ld(&(bar)[XB_TMO])) break; if (_sp > XB_SPIN_CAP) { atomicAdd(&(bar)[XB_TMO], 1u); break; } } } } while (0)

struct XcdBarrier {
    unsigned* bar; unsigned x;
    volatile LAS unsigned* st;
};

__device__ __forceinline__ XcdBarrier xcd_barrier_post(unsigned* bar, volatile LAS unsigned* st) {
    XcdBarrier b; b.bar = bar; b.x = xb_xcc_id(); b.st = st;
    if (threadIdx.x == 0) (void)xb_add(&bar[XB_XCNT(b.x)], 1u);
    return b;
}
__device__ __forceinline__ void xcd_barrier_complete(unsigned* bar, unsigned x, unsigned& nloc, unsigned& nx) {
    const unsigned G = gridDim.x;
    unsigned sum, cnt, mine, sp = 0u;
    for (;;) {
        sum = 0u; cnt = 0u; mine = 0u;
#pragma unroll
        for (unsigned j = 0; j < 16; ++j) { const unsigned c = xb_ld(&bar[XB_XCNT(j)]); sum += c; cnt += (c > 0u) ? 1u : 0u; mine = (j == x) ? c : mine; }
        if (sum == G) break;
        __builtin_amdgcn_s_sleep(1);
        if ((++sp & 255u) == 0u) { if (xb_ld(&bar[XB_TMO])) break; if (sp > XB_SPIN_CAP) { atomicAdd(&bar[XB_TMO], 1u); break; } }
    }
    nloc = mine > 0u ? mine : 1u; nx = cnt > 0u ? cnt : 1u;
}

__device__ __forceinline__ void xcd_barrier(const XcdBarrier& b) {
    asm volatile("s_waitcnt vmcnt(0)" ::: "memory");
    __syncthreads();
    if (threadIdx.x == 0) {
        unsigned* bar = b.bar;
        __builtin_amdgcn_s_waitcnt(0);
        unsigned nloc = b.st[0], nx = b.st[1];
        if (nloc == 0u) { xcd_barrier_complete(bar, b.x, nloc, nx); b.st[0] = nloc; b.st[1] = nx; }
        const unsigned old = xb_add(&bar[XB_XSUB(b.x)], 1u);
        const unsigned gen = old / nloc;
        if (old + 1u == (gen + 1u) * nloc) {
            __builtin_amdgcn_fence(__ATOMIC_RELEASE, "agent");
            asm volatile("s_waitcnt vmcnt(0)" ::: "memory");
            const unsigned og = xb_add(&bar[XB_TOP], 1u);
            const unsigned tg = og / nx;
            if (og + 1u == (tg + 1u) * nx) xb_add(&bar[XB_TOPGEN], 1u);
            else XB_SPIN(xb_ld(&bar[XB_TOPGEN]) == tg, bar);
            __builtin_amdgcn_fence(__ATOMIC_ACQUIRE, "agent");
            xb_add(&bar[XB_XGEN(b.x)], 1u);
            asm volatile("s_waitcnt vmcnt(0)" ::: "memory");
        } else {
            XB_SPIN(xb_ld(&bar[XB_XGEN(b.x)]) == gen, bar);
            __builtin_amdgcn_fence(__ATOMIC_ACQUIRE, "agent");
            asm volatile("s_waitcnt vmcnt(0)" ::: "memory");
        }
    }
    __syncthreads();
}

namespace pg8 {
#define PG8_LAS __attribute__((address_space(3)))
typedef unsigned short bf16_t;
constexpr int BM = 256, BK = 64, HALF = 128, HTB = HALF * BK * 2, STAGE_BYTES = 8 * HTB, NXCD = 8, WGM = 8;
__host__ __device__ __forceinline__ int lds_byte(int r, int c) { const int st = (r >> 4) * 2 + (c >> 5), rr = r & 15, cc = c & 31, ob = rr * 64 + cc * 2; return st * 1024 + (ob ^ (((ob >> 9) & 1) << 5)); }
__host__ __device__ __forceinline__ void stage_rc(int b, int& R, int& C) { const int st = b / 1024, sb = b % 1024, swz = sb ^ (((sb >> 9) & 1) << 5); R = (st >> 1) * 16 + swz / 64; C = (st & 1) * 32 + (swz % 64) / 2; }
__host__ __device__ __forceinline__ int perm32(int rho) { const int n = rho >> 4, i = rho & 15; return 8 * (i >> 2) + 4 * n + (i & 3); }
struct Unit { int pm, pn; int brow, fz; };
struct Gemm { const bf16_t* A; const bf16_t* Bt; int M, N, K; };
struct StaticOrder {
    int nM, nN, nwg, G, c;
    __host__ __device__ void init(int M, int N, int G_, int c_) { nM = M / BM; nN = N / BM; nwg = nM * nN; G = G_; c = c_; }
    __host__ __device__ bool next(int i, Unit& u) const {
        const long L = (long)i * G + c; if (L >= nwg) return false;
        int wgid = (int)L; { const int q = nwg / NXCD, r = nwg % NXCD, xcd = wgid % NXCD, off = wgid / NXCD; wgid = (xcd < r ? xcd * (q + 1) : r * (q + 1) + (xcd - r) * q) + off; }
        const int nig = WGM * nN, gid = wgid / nig, fm = gid * WGM, gsz = (nM - fm) < WGM ? (nM - fm) : WGM;
        u.pm = fm + ((wgid % nig) % gsz); u.pn = (wgid % nig) / gsz; u.brow = u.pn * BM; u.fz = 0; return true;
    }
    __device__ __forceinline__ void a_ready(const Unit&) const {}
    __device__ __forceinline__ void done(const Unit&) const {}
};

template <class Epi, class Sched>
__device__ __forceinline__ void gemm_phase(PG8_LAS unsigned char* lds, const Gemm g, const Sched& S, const Epi& E) {
    constexpr bool ALIGN_EPI = !Epi::AFTER_DRAIN;
    const int tid = threadIdx.x, wid = __builtin_amdgcn_readfirstlane(tid >> 6), lane = tid & 63, wr = wid >> 2, wc = wid & 3, fr = lane & 15, fq = lane >> 4;
    const int K = g.K, nt = K / BK;
    unsigned voffA[2], voffB[2], voffBf[2];
#pragma unroll
    for (int i = 0; i < 2; ++i) { int R, C; stage_rc(tid * 16 + i * 8192, R, C); const int Rb = Epi::PERM ? ((R >> 5) * 64 + perm32(R & 31)) : R;
        voffA[i] = (unsigned)(R * K + C) * 2u; voffB[i] = (unsigned)(Rb * K + C) * 2u; voffBf[i] = (unsigned)((Rb - (R >> 5) * 32) * K + C) * 2u; }
    const size_t kstep = (size_t)(BK * 2);
    const size_t hstep = (size_t)HALF * K * 2;
    const size_t hstepB = Epi::PERM ? (size_t)32 * K * 2 : hstep;
    const size_t tstep = 2 * hstep;
    const unsigned ldsw = (unsigned)wid * 1024u;
    const int aoff = lds_byte(wr * 64 + fr, fq * 8), boff = lds_byte(wc * 32 + fr, fq * 8);
#define PG8_SA(b, h) (((b) * 2 + (h)) * HTB)
#define PG8_SB(b, h) ((4 + (b) * 2 + (h)) * HTB)
#define PG8_STAGE(bufoff, gbase, voff) do { _Pragma("unroll") for (int _i = 0; _i < 2; ++_i) \
        __builtin_amdgcn_global_load_lds((const unsigned*)((const char*)(gbase) + (voff)[_i]), (PG8_LAS unsigned*)(lds + (bufoff) + ldsw + _i * 8192), 16, 0, 0); } while (0)
#define PG8_LDA(dst, b, h) do { _Pragma("unroll") for (int m = 0; m < 4; ++m) _Pragma("unroll") for (int k = 0; k < 2; ++k) dst[m][k] = *(const PG8_LAS bf16x8*)(lds + PG8_SA(b, h) + aoff + m * 2048 + k * 1024); } while (0)
#define PG8_LDB(dst, b, h) do { _Pragma("unroll") for (int n = 0; n < 2; ++n) _Pragma("unroll") for (int k = 0; k < 2; ++k) dst[n][k] = *(const PG8_LAS bf16x8*)(lds + PG8_SB(b, h) + boff + n * 2048 + k * 1024); } while (0)
#define PG8_MMA(ai, bj, At, Bt) do { __builtin_amdgcn_s_setprio(1); _Pragma("unroll") for (int m = 0; m < 4; ++m) _Pragma("unroll") for (int n = 0; n < 2; ++n) _Pragma("unroll") for (int k = 0; k < 2; ++k) \
        acc[ai][bj][m][n] = __builtin_amdgcn_mfma_f32_16x16x32_bf16(Bt[n][k], At[m][k], acc[ai][bj][m][n], 0, 0, 0); __builtin_amdgcn_s_setprio(0); } while (0)
#define PG8_WAIT_V(n) asm volatile("s_waitcnt vmcnt(" #n ")" ::: "memory")
#define PG8_WAIT_L(n) asm volatile("s_waitcnt lgkmcnt(" #n ")" ::: "memory")
#define PG8_BAR __builtin_amdgcn_s_barrier()
#define PG8_SCHED __builtin_amdgcn_sched_barrier(0)
    Unit cur, nxt; int ui = 0;
    if (!S.next(0, cur)) return;
    f32x4 acc[2][2][4][2];
#pragma unroll
    for (int a = 0; a < 2; ++a)
#pragma unroll
        for (int b = 0; b < 2; ++b)
#pragma unroll
            for (int m = 0; m < 4; ++m)
#pragma unroll
                for (int n = 0; n < 2; ++n) acc[a][b][m][n] = (f32x4){0.f, 0.f, 0.f, 0.f};
    bf16x8 At[4][2], B0[2][2], B1[2][2];
    const size_t rowB = (size_t)K * 2, hstepBf = (size_t)2048 * K * 2;
    const char* cA = (const char*)g.A + (size_t)cur.pm * tstep; const char* cB = (const char*)g.Bt + (size_t)cur.brow * rowB;
    S.a_ready(cur);
    { unsigned vB[2] = {cur.fz ? voffBf[0] : voffB[0], cur.fz ? voffBf[1] : voffB[1]}; const size_t hB = cur.fz ? hstepBf : hstepB;
    PG8_STAGE(PG8_SB(0, 0), cB, vB); PG8_STAGE(PG8_SB(0, 1), cB + hB, vB); PG8_STAGE(PG8_SA(0, 0), cA, voffA); PG8_STAGE(PG8_SA(0, 1), cA + hstep, voffA);
    if (wr == 1) PG8_BAR;
    PG8_WAIT_V(2); PG8_BAR;
    PG8_STAGE(PG8_SB(1, 0), cB + kstep, vB); PG8_STAGE(PG8_SA(1, 0), cA + kstep, voffA); PG8_STAGE(PG8_SB(1, 1), cB + hB + kstep, vB);
    PG8_WAIT_V(6); PG8_BAR; }
    for (;;) {
        const bool has_next = S.next(ui + 1, nxt);
        const char* nA = has_next ? (const char*)g.A + (size_t)nxt.pm * tstep : cA; const char* nB = has_next ? (const char*)g.Bt + (size_t)nxt.brow * rowB : cB;
        const int nfz = has_next ? nxt.fz : cur.fz;
        E.prefetch(cur, wid, lane, lds + STAGE_BYTES + wid * 1024);
        for (int t = 0; t < nt; t += 2) {
            const bool last = (t == nt - 2);
            const char* a1 = cA + (size_t)(t + 1) * kstep;
            const char* a2 = last ? nA : cA + (size_t)(t + 2) * kstep; const char* b2 = last ? nB : cB + (size_t)(t + 2) * kstep;
            const char* a3 = a2 + kstep; const char* b3 = b2 + kstep;
            const int fzt = last ? nfz : cur.fz; unsigned vB[2] = {fzt ? voffBf[0] : voffB[0], fzt ? voffBf[1] : voffB[1]}; const size_t hB = fzt ? hstepBf : hstepB;
            if (last && has_next) S.a_ready(nxt);
            PG8_LDB(B0, 0, 0); PG8_LDB(B1, 0, 1); PG8_SCHED; PG8_LDA(At, 0, 0); PG8_STAGE(PG8_SA(1, 1), a1 + hstep, voffA);
            PG8_WAIT_V(8); PG8_WAIT_L(0); PG8_BAR; PG8_MMA(0, 0, At, B0); PG8_MMA(0, 1, At, B1); PG8_BAR; PG8_SCHED;
            PG8_LDA(At, 0, 1); PG8_STAGE(PG8_SB(0, 0), b2, vB); PG8_STAGE(PG8_SB(0, 1), b2 + hB, vB); PG8_STAGE(PG8_SA(0, 0), a2, voffA);
            PG8_WAIT_V(8); PG8_WAIT_L(0); PG8_BAR; PG8_MMA(1, 0, At, B0); PG8_MMA(1, 1, At, B1); PG8_BAR; PG8_SCHED;
            PG8_LDB(B0, 1, 0); PG8_LDB(B1, 1, 1); PG8_SCHED; PG8_LDA(At, 1, 0); PG8_STAGE(PG8_SA(0, 1), a2 + hstep, voffA);
            PG8_WAIT_V(8); PG8_WAIT_L(0); PG8_BAR; PG8_MMA(0, 0, At, B0); PG8_MMA(0, 1, At, B1); PG8_BAR; PG8_SCHED;
            PG8_LDA(At, 1, 1); PG8_STAGE(PG8_SB(1, 0), b3, vB); PG8_STAGE(PG8_SB(1, 1), b3 + hB, vB); PG8_STAGE(PG8_SA(1, 0), a3, voffA);
            PG8_WAIT_V(8); PG8_WAIT_L(0); PG8_BAR; PG8_MMA(1, 0, At, B0); PG8_MMA(1, 1, At, B1); PG8_BAR; PG8_SCHED;
        }
        if constexpr (ALIGN_EPI) { if (wr == 0) PG8_BAR; }
        if constexpr (!Epi::AFTER_DRAIN) { E(acc, cur, wr, wc, fr, fq); S.done(cur); }
        if (!has_next) break;
#pragma unroll
        for (int a = 0; a < 2; ++a)
#pragma unroll
            for (int b = 0; b < 2; ++b)
#pragma unroll
                for (int m = 0; m < 4; ++m)
#pragma unroll
                    for (int n = 0; n < 2; ++n) acc[a][b][m][n] = (f32x4){0.f, 0.f, 0.f, 0.f};
        cur = nxt; cA = nA; cB = nB; ++ui;
        if constexpr (ALIGN_EPI) { if (wr == 1) PG8_BAR; }
    }
    PG8_WAIT_V(0);
    if constexpr (!ALIGN_EPI) { if (wr == 0) PG8_BAR; }
    PG8_BAR;
    if constexpr (Epi::AFTER_DRAIN) { E.fused(acc, cur, wr, wc, fr, fq); S.done(cur); }
#undef PG8_SA
#undef PG8_SB
#undef PG8_STAGE
#undef PG8_LDA
#undef PG8_LDB
#undef PG8_MMA
#undef PG8_WAIT_V
#undef PG8_WAIT_L
#undef PG8_BAR
#undef PG8_SCHED
}
}

struct KArgs {
    const float* in[18];
    float* out;
    unsigned char* ws;
    int ph_lo, ph_hi;
    int cg_sync, pad;
};
enum { I_XP = 0, I_XS, I_SPOOL, I_CK, I_CV, I_MEM, I_NORMG, I_WIN, I_POOLW, I_POOLSC, I_SGUNG, I_SGUW, I_SGUB, I_MEMNG, I_WKV, I_WDOWN, I_WOUT, I_NORMF };

struct P1Order {
    pg8::StaticOrder so; int G, c;
    __device__ void init(int G_, int c_) { so.init(MPR, INC, G_, c_); G = G_; c = c_; }
    __device__ bool next(int i, pg8::Unit& u) const {
        const long L = (long)i * G + c;
        if (L < so.nwg) so.next(i, u);
        else { const int e = (int)(L - so.nwg); if (e >= 104) return false;
            if (e < 64) { u.pm = NPAN + (e >> 3); u.pn = 40 + (e & 7); } else { u.pm = 64; u.pn = e - 64; } }
        u.brow = u.pn * 256; u.fz = 0;
        if (u.pn >= 8 && u.pn < 12) { u.brow = 2 * DM + 128 * (u.pn - 8); u.fz = 1; } else if (u.pn >= 16 && u.pn < 20) { u.brow = 2 * DM + 128 * (4 + u.pn - 16); u.fz = 1; }
        return true;
    }
    __device__ __forceinline__ void a_ready(const pg8::Unit&) const {}
    __device__ __forceinline__ void done(const pg8::Unit&) const {}
};
struct EpiProj {
    static constexpr bool PERM = true, AFTER_DRAIN = false;
    bf16* proj; bf16* gate; float* vss; bf16* kb; bf16* vb; float* out; const float* hs; bf16* dsr;
    __device__ __forceinline__ void prefetch(const pg8::Unit&, int, int, LAS unsigned char*) const {}
    __device__ __forceinline__ void operator()(const f32x4 (&acc)[2][2][4][2], const pg8::Unit& u, int wr, int wc, int fr, int fq) const {
        if (u.fz) {
            const int j = (u.pn < 12) ? u.pn - 8 : 4 + u.pn - 16; bf16* uz = proj + (size_t)2 * MP * DM;
            const int row0 = u.pm * 256 + wr * 64 + fr, c = 128 * j + wc * 32 + 8 * fq;
#pragma unroll
            for (int ai = 0; ai < 2; ++ai)
#pragma unroll
                for (int m = 0; m < 4; ++m) { const size_t r = (size_t)(row0 + ai * 128 + m * 16);
                    const f32x4 u0 = acc[ai][0][m][0], u1 = acc[ai][0][m][1], z0 = acc[ai][1][m][0], z1 = acc[ai][1][m][1];
                    u32x4 w; w.x = pk2(u0[0] * silu_f(z0[0]), u0[1] * silu_f(z0[1])); w.y = pk2(u0[2] * silu_f(z0[2]), u0[3] * silu_f(z0[3]));
                    w.z = pk2(u1[0] * silu_f(z1[0]), u1[1] * silu_f(z1[1])); w.w = pk2(u1[2] * silu_f(z1[2]), u1[3] * silu_f(z1[3]));
                    __builtin_nontemporal_store(w, (u32x4*)(uz + r * DM + c)); }
        } else if (u.pn < 40) {
            const int sec = u.pn >> 2;
            const int act = (sec == 1 || sec == 4 || sec == 6) ? 1 : (sec >= 7 ? 2 : 0);
            const int row0 = u.pm * 256 + wr * 64 + fr, cs0 = (u.pn & 3) * 256 + wc * 64 + 8 * fq;
            bf16* base; int ld;
            if (sec < 7) { base = proj + (size_t)sec * MP * DM; ld = DM; } else { base = gate + (sec - 7) * DM; ld = 3 * DM; }
            const bool poolrows = (sec == 0) && (((u.pm & 7) == 7) || u.pm == 64);
#pragma unroll
            for (int ai = 0; ai < 2; ++ai)
#pragma unroll
                for (int m = 0; m < 4; ++m) {
                    const int r = row0 + ai * 128 + m * 16; float ss = 0.f;
#pragma unroll
                    for (int bj = 0; bj < 2; ++bj) {
                        f32x4 v0 = acc[ai][bj][m][0], v1 = acc[ai][bj][m][1]; const int cs = cs0 + bj * 32;
                        if (sec == 3) ss += (v0[0] * v0[0] + v0[1] * v0[1]) + (v0[2] * v0[2] + v0[3] * v0[3]) + (v1[0] * v1[0] + v1[1] * v1[1]) + (v1[2] * v1[2] + v1[3] * v1[3]);
                        if (poolrows) {
                            float* dst = nullptr;
                            if (r < MPR) { const int t = r & (SEQ - 1); if (t >= SEQ - 15) dst = out + O_POOLP + ((size_t)(r >> 11) * 15 + (t - (SEQ - 15))) * DM + cs; }
                            else if (r < MV) { dst = out + O_POOLS + ((size_t)(r - MPR) * 15 + 14) * DM + cs;
                                const float* hp = hs + (size_t)(r - MPR) * DM + cs; const f32x4 h0 = *(const f32x4*)hp, h1 = *(const f32x4*)(hp + 4); const float inv = 1.f / (float)(2 << (cs >> 8));
                                u32x4 d; d.x = pk2((h0.x + v0[0]) * inv - v0[0], (h0.y + v0[1]) * inv - v0[1]); d.y = pk2((h0.z + v0[2]) * inv - v0[2], (h0.w + v0[3]) * inv - v0[3]);
                                d.z = pk2((h1.x + v1[0]) * inv - v1[0], (h1.y + v1[1]) * inv - v1[1]); d.w = pk2((h1.z + v1[2]) * inv - v1[2], (h1.w + v1[3]) * inv - v1[3]);
                                *(u32x4*)(dsr + (size_t)(r - MPR) * DM + cs) = d; }
                            if (dst) { *(f32x4*)dst = v0; *(f32x4*)(dst + 4) = v1; }
                        }
                        if (act == 1) {
#pragma unroll
                            for (int j = 0; j < 4; ++j) { v0[j] = silu_f(v0[j]); v1[j] = silu_f(v1[j]); } }
                        if (act == 2) {
#pragma unroll
                            for (int j = 0; j < 4; ++j) { v0[j] = sigm_f(v0[j]); v1[j] = sigm_f(v1[j]); } }
                        u32x4 w; w.x = pk2(v0[0], v0[1]); w.y = pk2(v0[2], v0[3]); w.z = pk2(v1[0], v1[1]); w.w = pk2(v1[2], v1[3]);
                        __builtin_nontemporal_store(w, (u32x4*)(base + (size_t)r * ld + cs));
                    }
                    if (sec == 3) { ss += __shfl_xor(ss, 16); ss += __shfl_xor(ss, 32); if (fq == 0) vss[(size_t)r * 16 + (u.pn & 3) * 4 + wc] = ss; }
                }
        } else {
            const int b = u.pm - NPAN, ct = (u.pn - 40) * 256;
            const bool isv = ct >= DM; const int cb = (isv ? ct - DM : ct) + wc * 64 + 8 * fq;
            float* of = out + (isv ? O_MV : O_MK); bf16* ob = isv ? vb : kb;
#pragma unroll
            for (int ai = 0; ai < 2; ++ai)
#pragma unroll
                for (int m = 0; m < 4; ++m) {
                    const size_t j = (size_t)b * 256 + ai * 128 + wr * 64 + m * 16 + fr;
#pragma unroll
                    for (int bj = 0; bj < 2; ++bj) {
                        const f32x4 v0 = acc[ai][bj][m][0], v1 = acc[ai][bj][m][1]; const int cs = cb + bj * 32;
                        __builtin_nontemporal_store(v0, (f32x4*)(of + j * DM + cs)); __builtin_nontemporal_store(v1, (f32x4*)(of + j * DM + cs + 4));
                        u32x4 w; w.x = pk2(v0[0], v0[1]); w.y = pk2(v0[2], v0[3]); w.z = pk2(v1[0], v1[1]); w.w = pk2(v1[2], v1[3]);
                        *(u32x4*)(ob + j * DM + cs) = w;
                    }
                }
        }
    }
};
struct P3Order {
    pg8::StaticOrder so;
    __device__ void init(int G_, int c_) { so.init(MPR, DM, G_, c_); }
    __device__ bool next(int i, pg8::Unit& u) const { const int rnd = i / 3, b = i - 3 * rnd; pg8::Unit t; if (!so.next(rnd, t)) return false; u.pm = b * NPAN + t.pm; u.pn = b * 4 + t.pn; u.brow = u.pn * 256; u.fz = 0; return true; }
    __device__ __forceinline__ void a_ready(const pg8::Unit&) const {}
    __device__ __forceinline__ void done(const pg8::Unit&) const {}
};
struct EpiGate {
    static constexpr bool PERM = true, AFTER_DRAIN = false;
    const bf16* gate; bf16* mg;
    __device__ __forceinline__ void prefetch(const pg8::Unit& u, int wid, int lane, LAS unsigned char* scr) const {
        const int b = u.pn >> 2, pm = u.pm - b * NPAN, t = wid * 64 + lane;
#pragma unroll
        for (int j = 0; j < 2; ++j) { const int li = t + 512 * j, row = li >> 2, seg = li & 3; const size_t r = (size_t)(pm * 256 + row);
            __builtin_amdgcn_global_load_lds((const unsigned*)(gate + r * (3 * DM) + b * DM + (u.pn & 3) * 256 + seg * 64), (LAS unsigned*)(scr + j * 256), 4, 0, 0); }
    }
    __device__ __forceinline__ void operator()(const f32x4 (&acc)[2][2][4][2], const pg8::Unit& u, int wr, int wc, int fr, int fq) const {
        const int b = u.pn >> 2, pm = u.pm - b * NPAN;
        const int row0 = pm * 256 + wr * 64 + fr, c0 = (u.pn & 3) * 256 + wc * 64 + 8 * fq;
#pragma unroll
        for (int ai = 0; ai < 2; ++ai) {
            u32x4 g8[4][2], p8[4][2];
#pragma unroll
            for (int m = 0; m < 4; ++m)
#pragma unroll
                for (int bj = 0; bj < 2; ++bj) { const size_t r = (size_t)(row0 + ai * 128 + m * 16); const int c = c0 + bj * 32;
                    g8[m][bj] = *(const u32x4*)(gate + r * (3 * DM) + b * DM + c);
                    p8[m][bj] = (u32x4){0u, 0u, 0u, 0u}; if (b > 0) p8[m][bj] = *(const u32x4*)(mg + r * DM + c); }
            asm volatile("" ::: "memory");
#pragma unroll
            for (int m = 0; m < 4; ++m)
#pragma unroll
                for (int bj = 0; bj < 2; ++bj) { const size_t r = (size_t)(row0 + ai * 128 + m * 16); const int c = c0 + bj * 32;
                    const f32x4 v0 = acc[ai][bj][m][0], v1 = acc[ai][bj][m][1]; const u32x4 gq = g8[m][bj], p = p8[m][bj];
                    const float o0 = v0[0] * bflo(gq.x) + bflo(p.x), o1 = v0[1] * bfhi(gq.x) + bfhi(p.x), o2 = v0[2] * bflo(gq.y) + bflo(p.y), o3 = v0[3] * bfhi(gq.y) + bfhi(p.y);
                    const float o4 = v1[0] * bflo(gq.z) + bflo(p.z), o5 = v1[1] * bfhi(gq.z) + bfhi(p.z), o6 = v1[2] * bflo(gq.w) + bflo(p.w), o7 = v1[3] * bfhi(gq.w) + bfhi(p.w);
                    u32x4 w; w.x = pk2(o0, o1); w.y = pk2(o2, o3); w.z = pk2(o4, o5); w.w = pk2(o6, o7);
                    if (b == 2) __builtin_nontemporal_store(w, (u32x4*)(mg + r * DM + c)); else *(u32x4*)(mg + r * DM + c) = w; }
        }
    }
};
__device__ __forceinline__ void st_agent(float* p, float v) { __hip_atomic_store((unsigned*)p, __builtin_bit_cast(unsigned, v), __ATOMIC_RELAXED, __HIP_MEMORY_SCOPE_AGENT); }
__device__ __forceinline__ float ld_agent(const float* p) { return __builtin_bit_cast(float, __hip_atomic_load((unsigned*)p, __ATOMIC_RELAXED, __HIP_MEMORY_SCOPE_AGENT)); }
__device__ __forceinline__ void wait_count(unsigned* w, unsigned want) {
    unsigned sp = 0;
    while ((unsigned)__builtin_amdgcn_readfirstlane(__hip_atomic_load(w, __ATOMIC_RELAXED, __HIP_MEMORY_SCOPE_AGENT)) < want) { __builtin_amdgcn_s_sleep(2); if (++sp > (1u << 22)) break; }
    __builtin_amdgcn_fence(__ATOMIC_ACQUIRE, "agent");
    asm volatile("s_waitcnt vmcnt(0)" ::: "memory");
}
struct EpiOutNorm {
    static constexpr bool PERM = false, AFTER_DRAIN = true;
    const float* xp; const float* gf; float* out; float* slots; unsigned* cnt;
    __device__ __forceinline__ void prefetch(const pg8::Unit& u, int wid, int lane, LAS unsigned char* scr) const {
        const int t = wid * 64 + lane;
#pragma unroll
        for (int j = 0; j < 4; ++j) { const int li = t + 512 * j, row = li >> 3, seg = li & 7;
            __builtin_amdgcn_global_load_lds((const unsigned*)(xp + (size_t)(u.pm * 256 + row) * DM + u.pn * 256 + seg * 32), (LAS unsigned*)(scr + j * 256), 4, 0, 0); }
    }
    __device__ __forceinline__ void operator()(const f32x4 (&)[2][2][4][2], const pg8::Unit&, int, int, int, int) const {}
    __device__ __forceinline__ void fused(f32x4 (&acc)[2][2][4][2], const pg8::Unit& u, int wr, int wc, int fr, int fq) const {
        const int row0 = u.pm * 256 + wr * 64 + fr, col0 = u.pn * 256 + wc * 32 + 4 * fq;
#pragma unroll
        for (int ai = 0; ai < 2; ++ai)
#pragma unroll
            for (int m = 0; m < 4; ++m) { const size_t r = (size_t)(row0 + ai * 128 + m * 16); float ss = 0.f;
#pragma unroll
                for (int bj = 0; bj < 2; ++bj)
#pragma unroll
                    for (int n = 0; n < 2; ++n) { const int c = col0 + bj * 128 + n * 16; const f32x4 v = acc[ai][bj][m][n] + __builtin_nontemporal_load((const f32x4*)(xp + r * DM + c)); acc[ai][bj][m][n] = v;
                        ss += (v.x * v.x + v.y * v.y) + (v.z * v.z + v.w * v.w); }
                ss += __shfl_xor(ss, 16); ss += __shfl_xor(ss, 32);
                if (fq == 0) st_agent(slots + r * 16 + u.pn * 4 + wc, ss); }
        asm volatile("s_waitcnt vmcnt(0)" ::: "memory");
        if (fr == 0 && fq == 0) __hip_atomic_fetch_add(cnt + 64 * u.pm, 1u, __ATOMIC_RELAXED, __HIP_MEMORY_SCOPE_AGENT);
        if (threadIdx.x < 64) wait_count(cnt + 64 * u.pm, 32u);
        __syncthreads();
#pragma unroll
        for (int ai = 0; ai < 2; ++ai)
#pragma unroll
            for (int m = 0; m < 4; ++m) { const size_t r = (size_t)(row0 + ai * 128 + m * 16); float tot = 0.f;
                { const f32x4* sp = (const f32x4*)(slots + r * 16); const f32x4 p0 = sp[0], p1 = sp[1], p2 = sp[2], p3 = sp[3];
                  tot = (((p0.x + p0.y) + (p0.z + p0.w)) + ((p1.x + p1.y) + (p1.z + p1.w))) + (((p2.x + p2.y) + (p2.z + p2.w)) + ((p3.x + p3.y) + (p3.z + p3.w))); }
                const float rs = rsqrtf(tot * (1.f / DM) + EPS);
#pragma unroll
                for (int bj = 0; bj < 2; ++bj)
#pragma unroll
                    for (int n = 0; n < 2; ++n) { const int c = col0 + bj * 128 + n * 16; const f32x4 g = *(const f32x4*)(gf + c); const f32x4 v = acc[ai][bj][m][n];
                        __builtin_nontemporal_store((f32x4){v.x * rs * g.x, v.y * rs * g.y, v.z * rs * g.z, v.w * rs * g.w}, (f32x4*)(out + O_YP + r * DM + c)); } }
    }
};

template <class Epi>
__device__ __forceinline__ void skinny_gemm(LAS unsigned char* lds, const bf16* A0, int lda, size_t a_grp_stride, int strips_per_grp, int nseg, int aseg,
                                            const bf16* Bt, int ldb, int K, int nstrips, int first, int step, const Epi& E) {
    int tid_ = threadIdx.x; asm volatile("" : "+v"(tid_));
    const int tid = tid_, lane = tid & 63, wv = tid >> 6, fr = lane & 15, fq = lane >> 4, rh = wv & 1, kq = wv >> 1;
    LAS float* part = (LAS float*)lds;
    const int nks = K / 128;
    for (int s = first; s < nstrips; s += step) {
        const bf16* A = A0 + (size_t)(s / strips_per_grp) * a_grp_stride + (size_t)(rh * 64 + fr) * lda + fq * 8;
        const bf16* B = Bt + (size_t)(16 * s + fr) * ldb + fq * 8;
        f32x4 acc[4];
#pragma unroll
        for (int rb = 0; rb < 4; ++rb) acc[rb] = (f32x4){0.f, 0.f, 0.f, 0.f};
        for (int seg = 0; seg < nseg; ++seg) {
#pragma unroll 4
            for (int k = 0; k < nks; ++k) {
                const int ko = (kq * nks + k) * 32;
                const bf16x8 bfr = *(const bf16x8*)(B + ko);
#pragma unroll
                for (int rb = 0; rb < 4; ++rb) { const bf16x8 afr = *(const bf16x8*)(A + (size_t)rb * 16 * lda + seg * aseg + ko);
                    acc[rb] = __builtin_amdgcn_mfma_f32_16x16x32_bf16(bfr, afr, acc[rb], 0, 0, 0); }
            }
        }
#pragma unroll
        for (int rb = 0; rb < 4; ++rb) *(LAS f32x4*)(part + ((kq * 128 + rh * 64 + rb * 16 + fr) * 16 + fq * 4)) = acc[rb];
        __syncthreads();
        { const int row = tid >> 2, cq = tid & 3; const LAS float* p = part + row * 16 + cq * 4;
          const f32x4 v = (*(const LAS f32x4*)p + *(const LAS f32x4*)(p + 2048)) + (*(const LAS f32x4*)(p + 4096) + *(const LAS f32x4*)(p + 6144));
          E(s, row, 16 * s + cq * 4, v, cq); }
        __syncthreads();
    }
}
struct EpiS1 {
    bf16* proj; bf16* gate; float* vss2; float* out; const float* hist; bf16* ds;
    __device__ __forceinline__ void operator()(int s, int row, int c, f32x4 v, int cq) const {
        const int sec = c >> 10, cs = c & 1023; const size_t m = (size_t)(MPR + row);
        if (sec == 0) { *(f32x4*)(out + O_POOLS + ((size_t)row * 15 + 14) * DM + cs) = v;
            const int w = 2 << (cs >> 8); f32x4 sm = v;
#pragma unroll
            for (int j = 0; j < 15; ++j) if (j < w - 1) sm = sm + *(const f32x4*)(hist + ((size_t)row * 15 + 14 - j) * DM + cs);
            const float inv = 1.f / (float)w;
            u32x2 d; d.x = pk2(sm.x * inv - v.x, sm.y * inv - v.y); d.y = pk2(sm.z * inv - v.z, sm.w * inv - v.w);
            *(u32x2*)(ds + (size_t)row * DM + cs) = d; }
        if (sec == 3) { float ss = (v.x * v.x + v.y * v.y) + (v.z * v.z + v.w * v.w); ss += __shfl_xor(ss, 1); ss += __shfl_xor(ss, 2); if (cq == 0) vss2[row * 64 + (s - 192)] = ss; }
        if (sec == 1 || sec == 4 || sec == 6) { v.x = silu_f(v.x); v.y = silu_f(v.y); v.z = silu_f(v.z); v.w = silu_f(v.w); }
        if (sec >= 7) { v.x = sigm_f(v.x); v.y = sigm_f(v.y); v.z = sigm_f(v.z); v.w = sigm_f(v.w); }
        u32x2 w; w.x = pk2(v.x, v.y); w.y = pk2(v.z, v.w);
        if (sec < 7) *(u32x2*)(proj + (size_t)sec * MP * DM + m * DM + cs) = w; else *(u32x2*)(gate + m * (3 * DM) + (sec - 7) * DM + cs) = w;
    }
};
struct EpiS3 {
    const bf16* gate; bf16* gys;
    __device__ __forceinline__ void operator()(int s, int row, int c, f32x4 v, int cq) const {
        const u32x2 g = *(const u32x2*)(gate + (size_t)(MPR + row) * (3 * DM) + c);
        u32x2 w; w.x = pk2(v.x * bflo(g.x), v.y * bfhi(g.x)); w.y = pk2(v.z * bflo(g.y), v.w * bfhi(g.y));
        *(u32x2*)(gys + (size_t)row * (3 * DM) + c) = w;
    }
};
struct EpiS4 {
    const float* xs; const float* gf; float* out; float* slots2; unsigned* cnt2;
    __device__ __forceinline__ void operator()(int s, int row, int c, f32x4 v, int cq) const {
        v = v + *(const f32x4*)(xs + (size_t)row * DM + c);
        float ss = (v.x * v.x + v.y * v.y) + (v.z * v.z + v.w * v.w); ss += __shfl_xor(ss, 1); ss += __shfl_xor(ss, 2);
        if (cq == 0) st_agent(slots2 + row * 64 + s, ss);
        asm volatile("s_waitcnt vmcnt(0)" ::: "memory");
        __syncthreads();
        if (threadIdx.x == 0) __hip_atomic_fetch_add(cnt2, 1u, __ATOMIC_RELAXED, __HIP_MEMORY_SCOPE_AGENT);
        if (threadIdx.x < 64) wait_count(cnt2, 64u);
        __syncthreads();
        float tot = 0.f;
        { const f32x4* sp = (const f32x4*)(slots2 + row * 64 + cq * 16); const f32x4 p0 = sp[0], p1 = sp[1], p2 = sp[2], p3 = sp[3];
          tot = (((p0.x + p0.y) + (p0.z + p0.w)) + ((p1.x + p1.y) + (p1.z + p1.w))) + (((p2.x + p2.y) + (p2.z + p2.w)) + ((p3.x + p3.y) + (p3.z + p3.w))); }
        tot += __shfl_xor(tot, 1); tot += __shfl_xor(tot, 2);
        const float rs = rsqrtf(tot * (1.f / DM) + EPS); const f32x4 g = *(const f32x4*)(gf + c);
        *(f32x4*)(out + O_YS + (size_t)row * DM + c) = (f32x4){v.x * rs * g.x, v.y * rs * g.y, v.z * rs * g.z, v.w * rs * g.w};
    }
};


__device__ __forceinline__ void sample_out_split(const KArgs& a, LAS unsigned char* lds, int item) {
    int tid_ = threadIdx.x; asm volatile("" : "+v"(tid_));
    const int tid = tid_, lane = tid & 63, wv = tid >> 6, fr = lane & 15, fq = lane >> 4, s = item >> 2, rq = item & 3;
    const bf16* A = (const bf16*)(a.ws + WS_GYS) + (size_t)(rq * 32 + fr) * (3 * DM) + fq * 8;
    const bf16* B = (const bf16*)(a.ws + WS_WO3) + (size_t)(16 * s + fr) * DM + fq * 8;
    f32x4 acc0 = (f32x4){0.f, 0.f, 0.f, 0.f}, acc1 = acc0;
#pragma unroll
    for (int kk = 0; kk < 12; ++kk) { const int k = 384 * wv + 32 * kk;
        const bf16x8 bfr = *(const bf16x8*)(B + (k & 1023)); const bf16x8 a0 = *(const bf16x8*)(A + k), a1 = *(const bf16x8*)(A + (size_t)16 * (3 * DM) + k);
        acc0 = __builtin_amdgcn_mfma_f32_16x16x32_bf16(bfr, a0, acc0, 0, 0, 0); acc1 = __builtin_amdgcn_mfma_f32_16x16x32_bf16(bfr, a1, acc1, 0, 0, 0); }
    LAS float* part = (LAS float*)lds;
    *(LAS f32x4*)(part + (wv * 32 + fr) * 16 + fq * 4) = acc0; *(LAS f32x4*)(part + (wv * 32 + 16 + fr) * 16 + fq * 4) = acc1;
    __syncthreads();
    const int row = tid >> 4, col = tid & 15, grow = rq * 32 + row, c = 16 * s + col;
    float v = 0.f;
#pragma unroll
    for (int w8 = 0; w8 < 8; ++w8) v += part[(w8 * 32 + row) * 16 + col];
    v += a.in[I_XS][(size_t)grow * DM + c];
    float ss = v * v; ss += __shfl_xor(ss, 1); ss += __shfl_xor(ss, 2); ss += __shfl_xor(ss, 4); ss += __shfl_xor(ss, 8);
    float* slots2 = (float*)(a.ws + WS_VSS2); unsigned* cnt = (unsigned*)(a.ws + WS_CTL) + CW_SAMPLE + 64 * rq;
    if (col == 0) st_agent(slots2 + grow * 64 + s, ss);
    asm volatile("s_waitcnt vmcnt(0)" ::: "memory");
    __syncthreads();
    if (tid == 0) __hip_atomic_fetch_add(cnt, 1u, __ATOMIC_RELAXED, __HIP_MEMORY_SCOPE_AGENT);
    if (tid < 64) wait_count(cnt, 64u);
    __syncthreads();
    const f32x4 p4 = *(const f32x4*)(slots2 + grow * 64 + col * 4);
    float tot = (p4.x + p4.y) + (p4.z + p4.w); tot += __shfl_xor(tot, 1); tot += __shfl_xor(tot, 2); tot += __shfl_xor(tot, 4); tot += __shfl_xor(tot, 8);
    a.out[O_YS + (size_t)grow * DM + c] = v * rsqrtf(tot * (1.f / DM) + EPS) * a.in[I_NORMF][c];
    __syncthreads();
}

__device__ __forceinline__ void p0_transpose_item(const float* W, int N, bf16* WT, int row_off, int ldo, int koff, LAS float* scr, int item, int lane) {
    const int nblk = N / 32, kb = item / nblk, nb = item % nblk, k0 = 64 * kb, n0 = 32 * nb;
    float wv_[32];
#pragma unroll
    for (int i = 0; i < 32; ++i) { const int kk = 2 * i + (lane >> 5); wv_[i] = __builtin_nontemporal_load(W + (size_t)(k0 + kk) * N + n0 + (lane & 31)); }
#pragma unroll
    for (int i = 0; i < 32; ++i) { const int kk = 2 * i + (lane >> 5); scr[kk * 33 + (lane & 31)] = wv_[i]; }
    asm volatile("s_waitcnt lgkmcnt(0)" ::: "memory");
    const int c = lane & 7;
#pragma unroll
    for (int j = 0; j < 4; ++j) { const int n = (lane >> 3) + 8 * j; const LAS float* s = scr + (8 * c) * 33 + n;
        u32x4 o; o.x = pk2(s[0 * 33], s[1 * 33]); o.y = pk2(s[2 * 33], s[3 * 33]); o.z = pk2(s[4 * 33], s[5 * 33]); o.w = pk2(s[6 * 33], s[7 * 33]);
        *(u32x4*)(WT + (size_t)(row_off + n0 + n) * ldo + koff + k0 + 8 * c) = o; }
    asm volatile("s_waitcnt lgkmcnt(0)" ::: "memory");
}
__device__ __forceinline__ void rms_row_to_bf16(const float* xrow, const float* gain, bf16* orow, int lane) {
    const f32x4* xr = (const f32x4*)xrow + lane; const f32x4* gr = (const f32x4*)gain + lane;
    f32x4 v[4]; float s = 0.f;
#pragma unroll
    for (int j = 0; j < 4; ++j) { v[j] = xr[64 * j]; s += (v[j].x * v[j].x + v[j].y * v[j].y) + (v[j].z * v[j].z + v[j].w * v[j].w); }
    const float rs = rsqrtf(wave_sum(s) * (1.f / DM) + EPS);
    u32x2* o8 = (u32x2*)orow + lane;
#pragma unroll
    for (int j = 0; j < 4; ++j) { const f32x4 g = gr[64 * j]; u32x2 w; w.x = pk2(v[j].x * rs * g.x, v[j].y * rs * g.y); w.y = pk2(v[j].z * rs * g.z, v[j].w * rs * g.w); o8[64 * j] = w; }
}
__device__ __forceinline__ void rms_row2_to_bf16(const float* x0, const float* x1, const float* gain, bf16* o0, bf16* o1, int lane) {
    const f32x4* xr0 = (const f32x4*)x0 + lane; const f32x4* xr1 = (const f32x4*)x1 + lane; const f32x4* gr = (const f32x4*)gain + lane;
    f32x4 v[4], w[4]; float s = 0.f, t = 0.f;
#pragma unroll
    for (int j = 0; j < 4; ++j) { v[j] = __builtin_nontemporal_load(xr0 + 64 * j); w[j] = __builtin_nontemporal_load(xr1 + 64 * j); }
#pragma unroll
    for (int j = 0; j < 4; ++j) { s += (v[j].x * v[j].x + v[j].y * v[j].y) + (v[j].z * v[j].z + v[j].w * v[j].w); t += (w[j].x * w[j].x + w[j].y * w[j].y) + (w[j].z * w[j].z + w[j].w * w[j].w); }
#pragma unroll
    for (int o = 1; o < 64; o <<= 1) { s += __shfl_xor(s, o); t += __shfl_xor(t, o); }
    const float rs = rsqrtf(s * (1.f / DM) + EPS), rt = rsqrtf(t * (1.f / DM) + EPS);
    u32x2* p0 = (u32x2*)o0 + lane; u32x2* p1 = (u32x2*)o1 + lane;
#pragma unroll
    for (int j = 0; j < 4; ++j) { const f32x4 g = gr[64 * j]; u32x2 a; a.x = pk2(v[j].x * rs * g.x, v[j].y * rs * g.y); a.y = pk2(v[j].z * rs * g.z, v[j].w * rs * g.w); p0[64 * j] = a;
        u32x2 b; b.x = pk2(w[j].x * rt * g.x, w[j].y * rt * g.y); b.y = pk2(w[j].z * rt * g.z, w[j].w * rt * g.w); p1[64 * j] = b; }
}
__device__ __forceinline__ void p0_prologue(const KArgs& a, LAS unsigned char* lds, int G) {
    const int tid = threadIdx.x, lane = tid & 63, wave = tid >> 6;
    LAS float* scr = (LAS float*)(lds + wave * 16384);
    const int gw = blockIdx.x * 8 + wave, NGW = G * 8;
    bf16* H = (bf16*)(a.ws + WS_H); bf16* WinT = (bf16*)(a.ws + WS_WIN); bf16* WdT = (bf16*)(a.ws + WS_WD); bf16* Wo3 = (bf16*)(a.ws + WS_WO3);
    bf16* PwT = (bf16*)(a.ws + WS_PW); bf16* SW = (bf16*)(a.ws + WS_SW);
    constexpr int I_IN = 16 * (INC / 32), I_KV = 16 * (2048 / 32), I_D = 16 * 32, I_O = 16 * 32, I_P = 4 * 8;
    constexpr int NITEMS = I_IN + I_KV + 3 * I_D + I_O + 4 * I_P;
    for (int it = gw; it < NITEMS; it += NGW) {
        int r = it;
        if (r < I_IN) { p0_transpose_item(a.in[I_WIN], INC, WinT, 0, DM, 0, scr, r, lane); continue; } r -= I_IN;
        if (r < I_KV) { p0_transpose_item(a.in[I_WKV], 2048, WinT, INC, DM, 0, scr, r, lane); continue; } r -= I_KV;
        if (r < 3 * I_D) { const int b = r / I_D; p0_transpose_item(a.in[I_WDOWN] + (size_t)b * DM * DM, DM, WdT, b * DM, DM, 0, scr, r % I_D, lane); continue; } r -= 3 * I_D;
        if (r < I_O) { p0_transpose_item(a.in[I_WOUT], DM, Wo3, 0, DM, 0, scr, r, lane); continue; } r -= I_O;
        { const int g = r / I_P; p0_transpose_item(a.in[I_POOLW] + (size_t)g * 256 * 256, 256, PwT, g * 256, 256, 0, scr, r % I_P, lane); }
    }
    for (int m = gw; m + NGW < MPR; m += 2 * NGW)
        rms_row2_to_bf16(a.in[I_XP] + (size_t)m * DM, a.in[I_XP] + (size_t)(m + NGW) * DM, a.in[I_NORMG], H + (size_t)m * DM, H + (size_t)(m + NGW) * DM, lane);
    const int mdone = (MPR / (2 * NGW)) * (2 * NGW);
    for (int m = mdone + gw; m < MP + 2048; m += NGW) {
        bf16* orow = H + (size_t)m * DM;
        if (m < MPR) rms_row_to_bf16(a.in[I_XP] + (size_t)m * DM, a.in[I_NORMG], orow, lane);
        else if (m < MV) rms_row_to_bf16(a.in[I_XS] + (size_t)(m - MPR) * DM, a.in[I_NORMG], orow, lane);
        else if (m < MP) { u32x2* o8 = (u32x2*)orow + lane;
#pragma unroll
            for (int j = 0; j < 4; ++j) o8[64 * j] = (u32x2){0u, 0u}; }
        else rms_row_to_bf16(a.in[I_MEM] + (size_t)(m - MP) * DM, a.in[I_MEMNG], orow, lane);
    }
    const size_t gt = (size_t)blockIdx.x * 512 + tid, NGT = (size_t)G * 512;
    for (size_t i = gt; i < (size_t)4 * 128 * 128; i += NGT) { const int s = (int)(i & 127), t = (int)((i >> 7) & 127); SW[i] = (bf16)(s <= t ? f2bf(a.in[I_SGUW][i]) : 0u); }
    for (size_t i = gt; i < (size_t)NS * 256; i += NGT) { const size_t smp = i >> 8, c = (i & 255) * 4; const int w = 2 << (int)(c >> 8); f32x4 sm = (f32x4){0.f, 0.f, 0.f, 0.f};
#pragma unroll
        for (int j = 0; j < 15; ++j) if (j < w - 1) sm = sm + *(const f32x4*)(a.in[I_SPOOL] + (smp * 15 + 14 - j) * DM + c);
        *(f32x4*)((float*)(a.ws + WS_HS) + smp * DM + c) = sm; }
    for (size_t i = gt; i < (size_t)NS * 14 * 256; i += NGT) { const size_t smp = i / (14 * 256), rem = i % (14 * 256), r = rem / 256, c4 = rem % 256;
        __builtin_nontemporal_store(*(const f32x4*)(a.in[I_SPOOL] + (smp * 15 + r + 1) * DM + c4 * 4), (f32x4*)(a.out + O_POOLS + (smp * 15 + r) * DM + c4 * 4)); }
}

constexpr int RSV = 544;
constexpr int RS = 528;
__device__ __forceinline__ void pool_part(const KArgs& a, LAS unsigned char* lds, int rt, int g) {
    int tid_ = threadIdx.x; asm volatile("" : "+v"(tid_));
    const int tid = tid_, lane = tid & 63, wv = tid >> 6, fr = lane & 15, fq = lane >> 4;
    const int m0 = rt * 128, w = 2 << g;
    const bf16* PIN = (const bf16*)(a.ws + WS_PROJ); const bf16* PZ = PIN + (size_t)MP * DM;
    const bf16* PwT = (const bf16*)(a.ws + WS_PW); bf16* BR0 = (bf16*)(a.ws + WS_BR);
    LAS unsigned char* Pb = lds; LAS unsigned char* Db = lds + 75520;
    u32x4 zf[8]; f32x4 scv[2]; bf16x8 Bf[2][8];
    const bf16* pw = PwT + (size_t)(g * 256 + wv * 32 + 8 * (fr >> 2) + (fr & 3)) * 256 + fq * 8;
    if (rt < 128) {
        const int t0 = (rt & 15) * 128;
        u32x4 tv[9];
#pragma unroll
        for (int i = 0; i < 9; ++i) { const int idx = tid + i * 512, row = idx >> 5, ch = idx & 31; tv[i] = (u32x4){0u, 0u, 0u, 0u};
            if (idx < 143 * 32 && !(t0 == 0 && row < 15)) tv[i] = *(const u32x4*)(PIN + (size_t)(m0 - 15 + row) * DM + g * 256 + ch * 8); }
#pragma unroll
        for (int rb = 0; rb < 8; ++rb) zf[rb] = __builtin_nontemporal_load((const u32x4*)(PZ + (size_t)(m0 + rb * 16 + fr) * DM + g * 256 + wv * 32 + 8 * fq));
#pragma unroll
        for (int nn = 0; nn < 2; ++nn) { scv[nn] = *(const f32x4*)(a.in[I_POOLSC] + g * 256 + wv * 32 + 8 * fq + 4 * nn);
#pragma unroll
            for (int ks = 0; ks < 8; ++ks) Bf[nn][ks] = *(const bf16x8*)(pw + nn * 4 * 256 + ks * 32); }
#pragma unroll
        for (int i = 0; i < 9; ++i) { const int idx = tid + i * 512, row = idx >> 5, ch = idx & 31; if (idx < 143 * 32) *(LAS u32x4*)(Pb + row * RS + ch * 16) = tv[i]; }
        __syncthreads();
        {
            const int ch = tid & 31, r0 = (tid >> 5) * 8;
            float s0 = 0.f, s1 = 0.f, s2 = 0.f, s3 = 0.f, s4 = 0.f, s5 = 0.f, s6 = 0.f, s7 = 0.f;
            for (int j = 1; j < w; ++j) { const u32x4 v = *(const LAS u32x4*)(Pb + (r0 + 15 - j) * RS + ch * 16);
                s0 += bflo(v.x); s1 += bfhi(v.x); s2 += bflo(v.y); s3 += bfhi(v.y); s4 += bflo(v.z); s5 += bfhi(v.z); s6 += bflo(v.w); s7 += bfhi(v.w); }
#pragma unroll
            for (int i = 0; i < 8; ++i) { const int r = r0 + i;
                const u32x4 own = *(const LAS u32x4*)(Pb + (r + 15) * RS + ch * 16); const u32x4 old = *(const LAS u32x4*)(Pb + (r + 16 - w) * RS + ch * 16);
                s0 += bflo(own.x); s1 += bfhi(own.x); s2 += bflo(own.y); s3 += bfhi(own.y); s4 += bflo(own.z); s5 += bfhi(own.z); s6 += bflo(own.w); s7 += bfhi(own.w);
                const int cnt = min(w, t0 + r + 1); const float inv = 1.f / (float)cnt;
                u32x4 d; d.x = pk2(s0 * inv - bflo(own.x), s1 * inv - bfhi(own.x)); d.y = pk2(s2 * inv - bflo(own.y), s3 * inv - bfhi(own.y));
                d.z = pk2(s4 * inv - bflo(own.z), s5 * inv - bfhi(own.z)); d.w = pk2(s6 * inv - bflo(own.w), s7 * inv - bfhi(own.w));
                *(LAS u32x4*)(Db + r * RS + ch * 16) = d;
                s0 -= bflo(old.x); s1 -= bfhi(old.x); s2 -= bflo(old.y); s3 -= bfhi(old.y); s4 -= bflo(old.z); s5 -= bfhi(old.z); s6 -= bflo(old.w); s7 -= bfhi(old.w); }
        }
    } else {
#pragma unroll
        for (int rb = 0; rb < 8; ++rb) zf[rb] = __builtin_nontemporal_load((const u32x4*)(PZ + (size_t)(m0 + rb * 16 + fr) * DM + g * 256 + wv * 32 + 8 * fq));
#pragma unroll
        for (int nn = 0; nn < 2; ++nn) { scv[nn] = *(const f32x4*)(a.in[I_POOLSC] + g * 256 + wv * 32 + 8 * fq + 4 * nn);
#pragma unroll
            for (int ks = 0; ks < 8; ++ks) Bf[nn][ks] = *(const bf16x8*)(pw + nn * 4 * 256 + ks * 32); }
        const bf16* DS = (const bf16*)(a.ws + WS_DS);
        u32x4 td[8];
#pragma unroll
        for (int i = 0; i < 8; ++i) { const int idx = tid + i * 512, r = idx >> 5, ch = idx & 31; td[i] = *(const u32x4*)(DS + (size_t)r * DM + g * 256 + ch * 8); }
#pragma unroll
        for (int i = 0; i < 8; ++i) { const int idx = tid + i * 512, r = idx >> 5, ch = idx & 31; *(LAS u32x4*)(Db + r * RS + ch * 16) = td[i]; }
    }
    __syncthreads();
#pragma unroll
    for (int rb = 0; rb < 8; ++rb) {
        f32x4 acc0 = (f32x4){0.f, 0.f, 0.f, 0.f}, acc1 = acc0;
#pragma unroll
        for (int ks = 0; ks < 8; ++ks) { const bf16x8 A = *(const LAS bf16x8*)(Db + (rb * 16 + fr) * RS + (ks * 32 + fq * 8) * 2);
            acc0 = __builtin_amdgcn_mfma_f32_16x16x32_bf16(Bf[0][ks], A, acc0, 0, 0, 0); acc1 = __builtin_amdgcn_mfma_f32_16x16x32_bf16(Bf[1][ks], A, acc1, 0, 0, 0); }
        const size_t m = (size_t)(m0 + rb * 16 + fr); const int c = g * 256 + wv * 32 + 8 * fq; const u32x4 z = zf[rb];
        u32x4 o; o.x = pk2(acc0[0] * scv[0].x * bflo(z.x), acc0[1] * scv[0].y * bfhi(z.x)); o.y = pk2(acc0[2] * scv[0].z * bflo(z.y), acc0[3] * scv[0].w * bfhi(z.y));
        o.z = pk2(acc1[0] * scv[1].x * bflo(z.z), acc1[1] * scv[1].y * bfhi(z.z)); o.w = pk2(acc1[2] * scv[1].z * bflo(z.w), acc1[3] * scv[1].w * bfhi(z.w));
        __builtin_nontemporal_store(o, (u32x4*)(BR0 + m * DM + c));
    }
    __syncthreads();
}
__device__ __forceinline__ void sgu_part(const KArgs& a, LAS unsigned char* lds, int rt, int g) {
    int tid_ = threadIdx.x; asm volatile("" : "+v"(tid_));
    const int tid = tid_, lane = tid & 63, wv = tid >> 6, fr = lane & 15, fq = lane >> 4;
    const int m0 = rt * 128;
    const bf16* U = (const bf16*)(a.ws + WS_PROJ) + (size_t)2 * MP * DM; const bf16* V = U + (size_t)MP * DM;
    const bf16* SW = (const bf16*)(a.ws + WS_SW); const float* VSS = (const float*)(a.ws + WS_VSS); bf16* BR1 = (bf16*)(a.ws + WS_BR) + (size_t)MP * DM;
    LAS unsigned char* Vb = lds; LAS unsigned char* UZb = lds + 128 * RS; LAS float* rbuf = (LAS float*)(lds + 256 * RS);
    u32x4 tv[8], tu[8];
#pragma unroll
    for (int i = 0; i < 8; ++i) { const int idx = tid + i * 512, s = idx >> 5, ch = idx & 31; const size_t o = (size_t)(m0 + s) * DM + g * 256 + ch * 8;
        tv[i] = __builtin_nontemporal_load((const u32x4*)(V + o)); tu[i] = __builtin_nontemporal_load((const u32x4*)(U + o)); }
    if (tid < 128) { const f32x4* p = (const f32x4*)(VSS + (size_t)(m0 + tid) * 16); const f32x4 p0 = p[0], p1 = p[1], p2 = p[2], p3 = p[3];
        const float s = ((p0.x + p0.y) + (p0.z + p0.w)) + ((p1.x + p1.y) + (p1.z + p1.w)) + ((p2.x + p2.y) + (p2.z + p2.w)) + ((p3.x + p3.y) + (p3.z + p3.w));
        rbuf[tid] = rsqrtf(s * (1.f / DM) + EPS); }
    const f32x4 gv0 = *(const f32x4*)(a.in[I_SGUNG] + g * 256 + wv * 32 + 8 * fq), gv1 = *(const f32x4*)(a.in[I_SGUNG] + g * 256 + wv * 32 + 8 * fq + 4);
    float biasv[8];
#pragma unroll
    for (int tb = 0; tb < 8; ++tb) biasv[tb] = a.in[I_SGUB][g * 128 + tb * 16 + fr];
    __syncthreads();
#pragma unroll
    for (int i = 0; i < 8; ++i) { const int idx = tid + i * 512, s = idx >> 5, ch = idx & 31; const float r = rbuf[s];
        u32x4 v; v.x = pk2(bflo(tv[i].x) * r, bfhi(tv[i].x) * r); v.y = pk2(bflo(tv[i].y) * r, bfhi(tv[i].y) * r); v.z = pk2(bflo(tv[i].z) * r, bfhi(tv[i].z) * r); v.w = pk2(bflo(tv[i].w) * r, bfhi(tv[i].w) * r);
        *(LAS u32x4*)(Vb + s * RS + ch * 16) = v;
        const u32x4 q = tu[i];
        *(LAS u32x4*)(UZb + s * RS + ch * 16) = q; }
    __syncthreads();
    const int q = fr >> 2, p = fr & 3;
    bf16x8 Vf[4][2];
#pragma unroll
    for (int ks = 0; ks < 4; ++ks)
#pragma unroll
        for (int nn = 0; nn < 2; ++nn) { const LAS unsigned char* a0 = Vb + (32 * ks + 8 * fq + q) * RS + (wv * 32 + 8 * p + 4 * nn) * 2; Vf[ks][nn] = tr_read2(a0, a0 + 4 * RS); }
#pragma unroll
    for (int tb = 0; tb < 8; ++tb) {
        f32x4 acc0 = (f32x4){0.f, 0.f, 0.f, 0.f}, acc1 = acc0;
        const int t = tb * 16 + fr;
#pragma unroll
        for (int ks = 0; ks < 4; ++ks) if (ks <= (tb >> 1)) {
            const bf16x8 A = *(const bf16x8*)(SW + (size_t)(g * 128 + t) * 128 + ks * 32 + fq * 8);
            acc0 = __builtin_amdgcn_mfma_f32_16x16x32_bf16(Vf[ks][0], A, acc0, 0, 0, 0); acc1 = __builtin_amdgcn_mfma_f32_16x16x32_bf16(Vf[ks][1], A, acc1, 0, 0, 0);
        }
        const size_t m = (size_t)(m0 + t); const float bias = biasv[tb];
        { const int cl = wv * 32 + 8 * fq; const u32x4 uz = *(const LAS u32x4*)(UZb + t * RS + cl * 2);
          u32x4 o; o.x = pk2((acc0[0] * gv0.x + bias) * bflo(uz.x), (acc0[1] * gv0.y + bias) * bfhi(uz.x)); o.y = pk2((acc0[2] * gv0.z + bias) * bflo(uz.y), (acc0[3] * gv0.w + bias) * bfhi(uz.y));
          o.z = pk2((acc1[0] * gv1.x + bias) * bflo(uz.z), (acc1[1] * gv1.y + bias) * bfhi(uz.z)); o.w = pk2((acc1[2] * gv1.z + bias) * bflo(uz.w), (acc1[3] * gv1.w + bias) * bfhi(uz.w));
          __builtin_nontemporal_store(o, (u32x4*)(BR1 + m * DM + g * 256 + cl)); }
    }
    __syncthreads();
}
__device__ __forceinline__ void attn_part(const KArgs& a, LAS unsigned char* lds, int rt, int g) {
    int tid_ = threadIdx.x; asm volatile("" : "+v"(tid_));
    const int tid = tid_, lane = tid & 63, wv = tid >> 6, fr = lane & 15, fq = lane >> 4;
    const int m0 = rt * 128, b = rt >> 4;
    const bf16* Q = (const bf16*)(a.ws + WS_PROJ) + (size_t)5 * MP * DM; const bf16* AZ = Q + (size_t)MP * DM;
    const bf16* KB = (const bf16*)(a.ws + WS_KB); const bf16* VB = (const bf16*)(a.ws + WS_VB); bf16* BR2 = (bf16*)(a.ws + WS_BR) + (size_t)2 * MP * DM;
    LAS unsigned char* Kb = lds;
    const size_t m = (size_t)(m0 + wv * 16 + fr);
    bf16x8 Qf[8];
    {
        u32x4 tk[16];
#pragma unroll
        for (int i = 0; i < 16; ++i) { const int idx = tid + i * 512, key = idx >> 5, ch = idx & 31; tk[i] = *(const u32x4*)(KB + (size_t)(b * 256 + key) * DM + g * 256 + ch * 8); }
#pragma unroll
        for (int ks = 0; ks < 8; ++ks) Qf[ks] = __builtin_nontemporal_load((const bf16x8*)(Q + m * DM + g * 256 + ks * 32 + fq * 8));
#pragma unroll
        for (int i = 0; i < 16; ++i) { const int idx = tid + i * 512, key = idx >> 5, ch = idx & 31; *(LAS u32x4*)(Kb + key * RS + ch * 16) = tk[i]; }
    }
    __syncthreads();
    u32x4 tvv[16];
#pragma unroll
    for (int i = 0; i < 16; ++i) { const int idx = tid + i * 512, key = idx >> 5, ch = idx & 31; tvv[i] = *(const u32x4*)(VB + (size_t)(b * 256 + key) * DM + g * 256 + ch * 8); }
    f32x4 sacc[16];
#pragma unroll
    for (int kb = 0; kb < 16; ++kb) { sacc[kb] = (f32x4){0.f, 0.f, 0.f, 0.f};
#pragma unroll
        for (int ks = 0; ks < 8; ++ks) { const bf16x8 Kf = *(const LAS bf16x8*)(Kb + (kb * 16 + fr) * RS + (ks * 32 + fq * 8) * 2);
            sacc[kb] = __builtin_amdgcn_mfma_f32_16x16x32_bf16(Kf, Qf[ks], sacc[kb], 0, 0, 0); }
        }
    float mx = -3.0e38f;
#pragma unroll
    for (int kb = 0; kb < 16; ++kb) mx = fmaxf(mx, fmaxf(fmaxf(sacc[kb][0], sacc[kb][1]), fmaxf(sacc[kb][2], sacc[kb][3])));
    mx = fmaxf(mx, __shfl_xor(mx, 16)); mx = fmaxf(mx, __shfl_xor(mx, 32));
    float sum = 0.f;
#pragma unroll
    for (int kb = 0; kb < 16; ++kb)
#pragma unroll
        for (int j = 0; j < 4; ++j) { const float pj = __expf((sacc[kb][j] - mx) * 0.0625f); sacc[kb][j] = pj; sum += pj; }
    sum += __shfl_xor(sum, 16); sum += __shfl_xor(sum, 32);
    const float isum = 1.f / sum;
    bf16x8 Pf[8];
#pragma unroll
    for (int k2 = 0; k2 < 8; ++k2) { u32x4 w; w.x = pk2(sacc[2 * k2][0], sacc[2 * k2][1]); w.y = pk2(sacc[2 * k2][2], sacc[2 * k2][3]);
        w.z = pk2(sacc[2 * k2 + 1][0], sacc[2 * k2 + 1][1]); w.w = pk2(sacc[2 * k2 + 1][2], sacc[2 * k2 + 1][3]); Pf[k2] = __builtin_bit_cast(bf16x8, w); }
    __syncthreads();
#pragma unroll
    for (int i = 0; i < 16; ++i) { const int idx = tid + i * 512, key = idx >> 5, ch = idx & 31; *(LAS u32x4*)(Kb + key * RSV + ch * 16) = tvv[i]; }
    u32x4 zf[8];
#pragma unroll
    for (int d2 = 0; d2 < 8; ++d2) zf[d2] = __builtin_nontemporal_load((const u32x4*)(AZ + m * DM + g * 256 + d2 * 32 + 8 * fq));
    __syncthreads();
    const int q = fr >> 2, p = fr & 3;
#pragma unroll
    for (int d2 = 0; d2 < 8; ++d2) {
        f32x4 o0 = (f32x4){0.f, 0.f, 0.f, 0.f}, o1 = o0;
#pragma unroll
        for (int k2 = 0; k2 < 8; ++k2) { const LAS unsigned char* a0 = Kb + (32 * k2 + 4 * fq + q) * RSV + (d2 * 32 + 8 * p) * 2;
            const bf16x8 Vf0 = tr_read2(a0, a0 + 16 * RSV), Vf1 = tr_read2(a0 + 8, a0 + 8 + 16 * RSV);
            o0 = __builtin_amdgcn_mfma_f32_16x16x32_bf16(Vf0, Pf[k2], o0, 0, 0, 0); o1 = __builtin_amdgcn_mfma_f32_16x16x32_bf16(Vf1, Pf[k2], o1, 0, 0, 0); }
        const int c = g * 256 + d2 * 32 + 8 * fq; const u32x4 z = zf[d2];
        u32x4 w; w.x = pk2(o0[0] * isum * bflo(z.x), o0[1] * isum * bfhi(z.x)); w.y = pk2(o0[2] * isum * bflo(z.y), o0[3] * isum * bfhi(z.y));
        w.z = pk2(o1[0] * isum * bflo(z.z), o1[1] * isum * bfhi(z.z)); w.w = pk2(o1[2] * isum * bflo(z.w), o1[3] * isum * bfhi(z.w));
        __builtin_nontemporal_store(w, (u32x4*)(BR2 + m * DM + c));
    }
    __syncthreads();
}
__device__ __forceinline__ void sgu_sample(const KArgs& a, int g, int rb) {
    int tid_ = threadIdx.x; asm volatile("" : "+v"(tid_));
    const int tid = tid_;
    const bf16* U = (const bf16*)(a.ws + WS_PROJ) + (size_t)2 * MP * DM; const bf16* V = U + (size_t)MP * DM;
    const float* VSS = (const float*)(a.ws + WS_VSS); bf16* BR1 = (bf16*)(a.ws + WS_BR) + (size_t)MP * DM;
    const float w00 = a.in[I_SGUW][(size_t)g * 128 * 128], b0 = a.in[I_SGUB][g * 128];
    for (int idx = tid; idx < 16 * 64; idx += 512) {
        const int i = rb * 16 + (idx >> 6), c = g * 256 + (idx & 63) * 4; const size_t m = (size_t)(MPR + i);
        const float s = wave_sum((idx & 63) < 16 ? VSS[m * 16 + (idx & 63)] : 0.f);
        const float rs = rsqrtf(s * (1.f / DM) + EPS);
        const f32x4 gv = *(const f32x4*)(a.in[I_SGUNG] + c);
        const u32x2 v4 = *(const u32x2*)(V + m * DM + c), u4 = *(const u32x2*)(U + m * DM + c);
        f32x4 vn; vn.x = bflo(v4.x) * rs * gv.x; vn.y = bfhi(v4.x) * rs * gv.y; vn.z = bflo(v4.y) * rs * gv.z; vn.w = bfhi(v4.y) * rs * gv.w;
        *(f32x4*)(a.out + O_SV + (size_t)i * DM + c) = vn;
        u32x2 o; o.x = pk2(bflo(u4.x) * (w00 * vn.x + b0), bfhi(u4.x) * (w00 * vn.y + b0));
        o.y = pk2(bflo(u4.y) * (w00 * vn.z + b0), bfhi(u4.y) * (w00 * vn.w + b0));
        *(u32x2*)(BR1 + m * DM + c) = o;
    }
}
__device__ __forceinline__ void attn_sample(const KArgs& a, LAS unsigned char* lds, int i, int h) {
    int tid_ = threadIdx.x; asm volatile("" : "+v"(tid_));
    const int tid = tid_, lane = tid & 63, wv = tid >> 6;
    const bf16* Q = (const bf16*)(a.ws + WS_PROJ) + (size_t)5 * MP * DM; const bf16* AZ = Q + (size_t)MP * DM; bf16* BR2 = (bf16*)(a.ws + WS_BR) + (size_t)2 * MP * DM;
    const size_t m = (size_t)(MPR + i);
    const float* Kc = a.in[I_CK] + ((size_t)i * NMEM * 4 + h) * 256 + lane * 4;
    const float* Vc = a.in[I_CV] + ((size_t)i * NMEM * 4 + h) * 256 + lane * 4;
    LAS float* sc = (LAS float*)lds; LAS float* part = (LAS float*)(lds + 1024);
    const u32x2 q2 = *(const u32x2*)(Q + m * DM + h * 256 + lane * 4);
    const f32x4 qv = (f32x4){bflo(q2.x), bfhi(q2.x), bflo(q2.y), bfhi(q2.y)};
    {
        f32x4 kv[32]; float pd[32];
#pragma unroll
        for (int j = 0; j < 32; ++j) kv[j] = __builtin_nontemporal_load((const f32x4*)(Kc + (size_t)(wv * 32 + j) * 1024));
#pragma unroll
        for (int j = 0; j < 32; ++j) pd[j] = (kv[j].x * qv.x + kv[j].y * qv.y) + (kv[j].z * qv.z + kv[j].w * qv.w);
#pragma unroll
        for (int j = 0; j < 32; ++j) { const float d = wave_sum(pd[j]); if (lane == 0) sc[wv * 32 + j] = d * 0.0625f; }
    }
    f32x4 vv[32];
#pragma unroll
    for (int j = 0; j < 32; ++j) vv[j] = __builtin_nontemporal_load((const f32x4*)(Vc + (size_t)(wv * 32 + j) * 1024));
    __syncthreads();
    const f32x4 s4 = *(const LAS f32x4*)(sc + lane * 4);
    const float mx = wave_max(fmaxf(fmaxf(s4.x, s4.y), fmaxf(s4.z, s4.w)));
    const float sum = wave_sum((__expf(s4.x - mx) + __expf(s4.y - mx)) + (__expf(s4.z - mx) + __expf(s4.w - mx)));
    f32x4 o = (f32x4){0.f, 0.f, 0.f, 0.f};
#pragma unroll
    for (int j = 0; j < 32; ++j) { const float pj = __expf(sc[wv * 32 + j] - mx); o += vv[j] * pj; }
    *(LAS f32x4*)(part + wv * 256 + lane * 4) = o;
    __syncthreads();
    if (tid < 256) { float t = 0.f;
#pragma unroll
        for (int w8 = 0; w8 < 8; ++w8) t += part[w8 * 256 + tid];
        const int c = h * 256 + tid; const unsigned short zb = AZ[m * DM + c]; const float z = __builtin_bit_cast(float, (unsigned)zb << 16);
        BR2[m * DM + c] = (bf16)f2bf(t / sum * z); }
    __syncthreads();
}
__device__ __forceinline__ void p2_mixers(const KArgs& a, LAS unsigned char* lds, int G) {
    constexpr int NU = 512 + 512 + 4 + 32;
    if (G == 256) {
        const int c = blockIdx.x;
        for (int k = 0; k < 4; ++k) { const int kk = (c & 1) ? (k ^ 2) : k;
            if (kk < 2) { const int u = c + kk * 256, rt = u >> 2, g = u & 3; pool_part(a, lds, rt, g); sgu_part(a, lds, rt, g); attn_part(a, lds, rt, g); }
            else { const int e = c + (kk - 2) * 256; attn_sample(a, lds, e >> 2, e & 3); } }
        if (c < 4) pool_part(a, lds, 128, c); else if (c >= 8 && c < 40) sgu_sample(a, (c - 8) >> 3, (c - 8) & 7);
        return;
    }
    for (int u = blockIdx.x; u < NU; u += G) {
        if (u < 512) { const int rt = u >> 2, g = u & 3; pool_part(a, lds, rt, g); sgu_part(a, lds, rt, g); attn_part(a, lds, rt, g); }
        else if (u < 1024) { const int e = u - 512; attn_sample(a, lds, e >> 2, e & 3); }
        else if (u < 1028) pool_part(a, lds, 128, u - 1024);
        else sgu_sample(a, (u - 1028) >> 3, (u - 1028) & 7);
    }
}
__device__ __forceinline__ void p5_norm(const KArgs& a, int G) {
    const int tid = threadIdx.x, lane = tid & 63, wave = tid >> 6;
    const int gw = blockIdx.x * 8 + wave, NGW = G * 8;
    const f32x4* gr = (const f32x4*)a.in[I_NORMF] + lane;
    for (int m = gw; m < MV; m += NGW) {
        f32x4* xr = (f32x4*)(a.out + (size_t)m * DM) + lane;
        f32x4 v[4]; float s = 0.f;
#pragma unroll
        for (int j = 0; j < 4; ++j) { v[j] = xr[64 * j]; s += (v[j].x * v[j].x + v[j].y * v[j].y) + (v[j].z * v[j].z + v[j].w * v[j].w); }
        const float rs = rsqrtf(wave_sum(s) * (1.f / DM) + EPS);
#pragma unroll
        for (int j = 0; j < 4; ++j) { const f32x4 g = gr[64 * j]; xr[64 * j] = (f32x4){v[j].x * rs * g.x, v[j].y * rs * g.y, v[j].z * rs * g.z, v[j].w * rs * g.w}; }
    }
}

__global__ void __launch_bounds__(512, 2) fwd_megakernel(KArgs a) {
    extern __shared__ __attribute__((aligned(16))) unsigned char lds_raw[];
    LAS unsigned char* lds = (LAS unsigned char*)lds_raw;
    cg::grid_group grid = cg::this_grid();
    const int G = gridDim.x;
    const int lo = a.ph_lo, hi = a.ph_hi;
    volatile LAS unsigned* bst = (volatile LAS unsigned*)(lds + LDS_BYTES - 64);
    if (threadIdx.x == 0) { bst[0] = 0u; bst[1] = 0u; }
    __syncthreads();
    const XcdBarrier bar = xcd_barrier_post((unsigned*)(a.ws + WS_CTL), bst);
#define IN(k) (lo <= (k) && (k) < hi)
#define SEAM(k) do { if (IN(k) && IN((k) + 1)) { if (a.cg_sync) grid.sync(); else xcd_barrier(bar); } } while (0)
    if (IN(0)) p0_prologue(a, lds, G);
    SEAM(0);
    if (IN(1)) {
        pg8::Gemm g{(const bf16*)(a.ws + WS_H), (const bf16*)(a.ws + WS_WIN), MP, INC, DM};
        P1Order S; S.init(G, (int)blockIdx.x);
        EpiProj E{(bf16*)(a.ws + WS_PROJ), (bf16*)(a.ws + WS_GATE), (float*)(a.ws + WS_VSS), (bf16*)(a.ws + WS_KB), (bf16*)(a.ws + WS_VB), a.out, (const float*)(a.ws + WS_HS), (bf16*)(a.ws + WS_DS)};
        pg8::gemm_phase<EpiProj, P1Order>(lds, g, S, E);
    }
    SEAM(1);
    if (IN(2)) p2_mixers(a, lds, G);
    SEAM(2);
    if (IN(3)) {
        pg8::Gemm g{(const bf16*)(a.ws + WS_BR), (const bf16*)(a.ws + WS_WD), MPR, 3 * DM, DM};
        P3Order S; S.init(G, (int)blockIdx.x);
        EpiGate E{(const bf16*)(a.ws + WS_GATE), (bf16*)(a.ws + WS_MG)};
        pg8::gemm_phase<EpiGate, P3Order>(lds, g, S, E);
        EpiS3 E3{(const bf16*)(a.ws + WS_GATE), (bf16*)(a.ws + WS_GYS)};
        skinny_gemm(lds, (const bf16*)(a.ws + WS_BR) + (size_t)MPR * DM, DM, (size_t)MP * DM, 64, 1, 0, (const bf16*)(a.ws + WS_WD), DM, DM, 192, (int)blockIdx.x, G, E3);
    }
    SEAM(3);
    if (IN(4)) {
        pg8::Gemm g{(const bf16*)(a.ws + WS_MG), (const bf16*)(a.ws + WS_WO3), MPR, DM, DM};
        pg8::StaticOrder S; S.init(MPR, DM, G, (int)blockIdx.x);
        unsigned* ctl = (unsigned*)(a.ws + WS_CTL);
        EpiOutNorm E{a.in[I_XP], a.in[I_NORMF], a.out, (float*)(a.ws + WS_VSS), ctl + CW_PANEL};
        pg8::gemm_phase<EpiOutNorm, pg8::StaticOrder>(lds, g, S, E);
        sample_out_split(a, lds, (int)blockIdx.x);
    }
#undef IN
#undef SEAM
}

extern "C" void kernel_launch(void* const* d_in, const int* in_sizes, int n_in, void* d_out, int out_size, void* d_ws, size_t ws_size, hipStream_t stream) {
    static int grid = 0;
    if (grid == 0) {
        if (n_in != 18 || (size_t)out_size != O_END || ws_size < WS_END) { fprintf(stderr, "kernel_launch: unexpected shapes (n_in %d out %d ws %zu, need %zu)\n", n_in, out_size, ws_size, (size_t)WS_END); grid = -1; return; }
        int dev = 0, cus = 0, per_cu = 0;
        hipGetDevice(&dev); hipDeviceGetAttribute(&cus, hipDeviceAttributeMultiprocessorCount, dev);
        if (hipFuncSetAttribute((const void*)fwd_megakernel, hipFuncAttributeMaxDynamicSharedMemorySize, LDS_BYTES) != hipSuccess) { fprintf(stderr, "kernel_launch: hipFuncSetAttribute failed\n"); grid = -1; return; }
        if (hipOccupancyMaxActiveBlocksPerMultiprocessor(&per_cu, (const void*)fwd_megakernel, 512, LDS_BYTES) != hipSuccess || per_cu < 1) { fprintf(stderr, "kernel_launch: occupancy query failed (%d)\n", per_cu); grid = -1; return; }
        if (cus != 256) { fprintf(stderr, "kernel_launch: built for a 256-CU device (one 256x256 tile per workgroup in the last two phases), got %d\n", cus); grid = -1; return; }
        grid = cus;
    }
    if (grid < 0) return;
    if (hipMemsetAsync((char*)d_ws + WS_CTL, 0, CTL_BYTES, stream) != hipSuccess) { fprintf(stderr, "kernel_launch: memset failed\n"); return; }
    KArgs a{};
    for (int i = 0; i < 18; ++i) a.in[i] = (const float*)d_in[i];
    a.out = (float*)d_out; a.ws = (unsigned char*)d_ws; a.ph_lo = 0; a.ph_hi = 5;
    void* args[] = {&a};
    hipError_t e = hipLaunchCooperativeKernel((const void*)fwd_megakernel, dim3(grid), dim3(512), args, LDS_BYTES, stream);
    if (e != hipSuccess) fprintf(stderr, "cooperative launch failed: %s (grid %d)\n", hipGetErrorString(e), grid);
}
```
